# Optimizing an MI355X kernel written in HIP

```python
import math
import jax
import jax.numpy as jnp
from jax import lax
import numpy as np

D_MODEL = 1024
BATCH = 2
SEQ = 8192
DEPTH = 1
DEC_BATCH = 32
DEC_SEQ = 1
PAST_LEN = 16384
PAGE_SIZE = 128

HEAD_DIM = 64
A_HEADS = 8
KV_HEADS = 2
GROUP = A_HEADS // KV_HEADS
CMP_STRIDE = 16
CMP_LEN = 2 * CMP_STRIDE
SEL_BLOCK = 64
N_SELECT = 16
WINDOW = 512
Q_BLOCK = 128
ATTN_SCALE = HEAD_DIM ** -0.5
B_HEADS = 8
B_DK = 128
B_DV = 64
HGRN_CHUNK = 32
D_FF = 4 * D_MODEL
DEEPNORM_ALPHA = (2.0 * DEPTH) ** 0.25
DEEPNORM_BETA = (8.0 * DEPTH) ** -0.25
LN_EPS = 1e-5
NEG = -1e30
FORCE = 1e6
Q_A = A_HEADS * HEAD_DIM
KV_A = 2 * KV_HEADS * HEAD_DIM
GATE_A = 3 * A_HEADS
Q_B = B_HEADS * B_DK
F_B = B_HEADS * B_DK
I_B = B_HEADS * B_DV
G_B = B_HEADS * B_DV
MERGE = 2 * D_MODEL
SPLITS = (Q_A, KV_A, KV_A, KV_A, GATE_A, Q_B, F_B, I_B, G_B, MERGE)
D_IN = Q_A + 3 * KV_A + GATE_A + Q_B + F_B + I_B + G_B + MERGE

kernel_name = 'nsa_hgrn2_deepnorm_hybrid_step'


def layer_norm(x, g, b):
    xf = x.astype(jnp.float32)
    mu = jnp.mean(xf, axis=-1, keepdims=True)
    var = jnp.mean(jnp.square(xf - mu), axis=-1, keepdims=True)
    y = (xf - mu) * lax.rsqrt(var + LN_EPS) * g.astype(jnp.float32) + b.astype(jnp.float32)
    return y.astype(x.dtype)


def alibi_slopes():
    h = jnp.arange(1, A_HEADS + 1, dtype=jnp.float32)
    return jnp.exp2(-8.0 * h / A_HEADS).reshape(KV_HEADS, GROUP)


def masked_softmax(s, mask):
    s = jnp.where(mask, s.astype(jnp.float32), NEG)
    m = jnp.max(s, axis=-1, keepdims=True)
    p = jnp.where(mask, jnp.exp(s - m), 0.0)
    return p / jnp.maximum(jnp.sum(p, axis=-1, keepdims=True), 1e-30)


def split_projection(x, w_in):
    b, t = x.shape[:2]
    h = jnp.einsum('bsd,de->bse', x, w_in)
    parts = []
    off = 0
    for n in SPLITS:
        parts.append(h[..., off:off + n])
        off += n
    qa, kvc, kvs, kvw, gla, qb, fb, ib, gb, mg = parts
    kv = lambda a: a.reshape(b, t, 2, KV_HEADS, HEAD_DIM)
    return (qa.reshape(b, t, KV_HEADS, GROUP, HEAD_DIM), kv(kvc), kv(kvs), kv(kvw),
            gla.reshape(b, t, KV_HEADS, GROUP, 3), qb, fb, ib, gb, mg)


def chunk_parts(kv, cmp_w):
    b, L = kv.shape[:2]
    n_ch = L // CMP_STRIDE
    ch = kv[:, :n_ch * CMP_STRIDE].reshape(b, n_ch, CMP_STRIDE, 2, KV_HEADS, HEAD_DIM)
    w = cmp_w.reshape(2, CMP_LEN // CMP_STRIDE, CMP_STRIDE, HEAD_DIM, HEAD_DIM)
    return jnp.einsum('bnlcgd,cplde->bnpcge', ch, w)


def blocks_from_parts(parts, cmp_w, cmp_pos):
    bias = jnp.einsum('cld,clde->ce', cmp_pos, cmp_w)
    return parts[:, :-1, 0] + parts[:, 1:, 1] + bias[None, None, :, None, :]


def compressed_branch(qg, pos_q, kv_cmp, slopes):
    n = kv_cmp.shape[1]
    end = jnp.arange(n) * CMP_STRIDE + (CMP_LEN - 1)
    dist = (pos_q[:, None] - end[None, :]).astype(jnp.float32)
    s = jnp.einsum('bqgrd,bngd->bqgrn', qg, kv_cmp[:, :, 0]).astype(jnp.float32) * ATTN_SCALE
    s = s - slopes[:, :, None] * dist[None, :, None, None, :]
    p = masked_softmax(s, (dist >= 0)[None, :, None, None, :])
    o = jnp.einsum('bqgrn,bngd->bqgrd', p.astype(kv_cmp.dtype), kv_cmp[:, :, 1])
    return o, p


def select_blocks(p_cmp, pos_q, n_sel):
    imp = jnp.sum(p_cmp, axis=3)
    ratio = SEL_BLOCK // CMP_STRIDE
    imp = jnp.pad(imp, ((0, 0), (0, 0), (0, 0), (0, n_sel * ratio - imp.shape[-1])))
    imp = jnp.sum(imp.reshape(*imp.shape[:-1], n_sel, ratio), axis=-1)
    blk = jnp.arange(n_sel)
    cur = (pos_q // SEL_BLOCK)[:, None]
    forced = (blk[None, :] == 0) | (blk[None, :] == cur) | (blk[None, :] == cur - 1)
    allowed = blk[None, :] * SEL_BLOCK <= pos_q[:, None]
    score = jnp.where(forced[None, :, None, :], FORCE, imp)
    score = jnp.where(allowed[None, :, None, :], score, -FORCE)
    vals, idx = lax.top_k(score, min(N_SELECT, n_sel))
    return idx, vals > -0.5 * FORCE


def selected_branch(qg, pos_q, kv_g, idx, valid, slopes):
    b, q, g = qg.shape[:3]
    nk = idx.shape[-1] * SEL_BLOCK
    pos_k = (idx[..., None] * SEL_BLOCK + jnp.arange(SEL_BLOCK)).reshape(b, q, g, nk)
    dist = (pos_q[None, :, None, None] - pos_k).astype(jnp.float32)
    mask = jnp.repeat(valid, SEL_BLOCK, axis=-1) & (dist >= 0)
    k = kv_g[..., 0, :].reshape(b, q, g, nk, HEAD_DIM)
    v = kv_g[..., 1, :].reshape(b, q, g, nk, HEAD_DIM)
    s = jnp.einsum('bqgrd,bqgmd->bqgrm', qg, k).astype(jnp.float32) * ATTN_SCALE
    s = s - slopes[:, :, None] * dist[:, :, :, None, :]
    p = masked_softmax(s, mask[:, :, :, None, :])
    return jnp.einsum('bqgrm,bqgmd->bqgrd', p.astype(v.dtype), v)


def window_branch(qg, pos_q, kv_w, pos_k, slopes):
    dist = pos_q[:, None] - pos_k[None, :]
    mask = (dist >= 0) & (dist < WINDOW) & (pos_k[None, :] >= 0)
    s = jnp.einsum('bqgrd,bkgd->bqgrk', qg, kv_w[:, :, 0]).astype(jnp.float32) * ATTN_SCALE
    s = s - slopes[:, :, None] * dist.astype(jnp.float32)[None, :, None, None, :]
    p = masked_softmax(s, mask[None, :, None, None, :])
    return jnp.einsum('bqgrk,bkgd->bqgrd', p.astype(kv_w.dtype), kv_w[:, :, 1])


def gate_branches(gl, o_c, o_s, o_w):
    g = jax.nn.sigmoid(gl.astype(jnp.float32))
    o = g[..., 0:1] * o_c + g[..., 1:2] * o_s + g[..., 2:3] * o_w
    return o.astype(o_c.dtype)


def nsa_prompt(qg, kvc, kvs, kvw, gl, cmp_w, cmp_pos):
    b, t = qg.shape[:2]
    slopes = alibi_slopes()
    kv_cmp = blocks_from_parts(chunk_parts(kvc, cmp_w), cmp_w, cmp_pos)
    n_sel = -(-t // SEL_BLOCK)
    kv_sel_blk = kvs.reshape(b, n_sel, SEL_BLOCK, 2, KV_HEADS, HEAD_DIM)
    kv_w_pad = jnp.pad(kvw, ((0, 0), (WINDOW, 0), (0, 0), (0, 0), (0, 0)))
    b_ix = jnp.arange(b)[:, None, None, None]
    g_ix = jnp.arange(KV_HEADS)[None, None, :, None]

    def query_block(c):
        t0 = c * Q_BLOCK
        pos_q = t0 + jnp.arange(Q_BLOCK)
        qb = lax.dynamic_slice_in_dim(qg, t0, Q_BLOCK, axis=1)
        gb = lax.dynamic_slice_in_dim(gl, t0, Q_BLOCK, axis=1)
        o_c, p_c = compressed_branch(qb, pos_q, kv_cmp, slopes)
        idx, valid = select_blocks(p_c, pos_q, n_sel)
        kv_g = kv_sel_blk[b_ix, idx, :, :, g_ix]
        o_s = selected_branch(qb, pos_q, kv_g, idx, valid, slopes)
        kv_wb = lax.dynamic_slice_in_dim(kv_w_pad, t0, WINDOW + Q_BLOCK, axis=1)
        pos_k = t0 - WINDOW + jnp.arange(WINDOW + Q_BLOCK)
        o_w = window_branch(qb, pos_q, kv_wb, pos_k, slopes)
        return gate_branches(gb, o_c, o_s, o_w)

    out = lax.map(query_block, jnp.arange(t // Q_BLOCK))
    out = jnp.swapaxes(out, 0, 1).reshape(b, t, Q_A)
    new_win = kvw[:, -min(WINDOW, t):]
    return out, new_win


def nsa_sample(qg, kvc, kvs, kvw, gl, cache_cmp, cache_sel, cache_win, page_table, cmp_w, cmp_pos):
    b, t = qg.shape[:2]
    slopes = alibi_slopes()
    n_pages = page_table.shape[1]
    past = n_pages * PAGE_SIZE
    pos_q = past + jnp.arange(t)
    b_ix = jnp.arange(b)[:, None, None, None]
    g_ix = jnp.arange(KV_HEADS)[None, None, :, None]
    past_c = cache_cmp[page_table].reshape(b, past, 2, KV_HEADS, HEAD_DIM)
    parts = jnp.concatenate([chunk_parts(past_c, cmp_w), chunk_parts(kvc, cmp_w)], axis=1)
    kv_cmp = blocks_from_parts(parts, cmp_w, cmp_pos)
    o_c, p_c = compressed_branch(qg, pos_q, kv_cmp, slopes)
    n_sel = -(-(past + t) // SEL_BLOCK)
    idx, valid = select_blocks(p_c, pos_q, n_sel)
    n_past_blk = past // SEL_BLOCK
    blk_per_page = PAGE_SIZE // SEL_BLOCK
    in_past = idx < n_past_blk
    pblk = jnp.minimum(idx, n_past_blk - 1)
    phys = page_table[b_ix, pblk // blk_per_page]
    rows = (pblk % blk_per_page)[..., None] * SEL_BLOCK + jnp.arange(SEL_BLOCK)
    from_pool = cache_sel[phys[..., None], rows, :, g_ix[..., None]]
    n_new_blk = -(-t // SEL_BLOCK)
    tail = jnp.pad(kvs, ((0, 0), (0, n_new_blk * SEL_BLOCK - t), (0, 0), (0, 0), (0, 0)))
    tail = tail.reshape(b, n_new_blk, SEL_BLOCK, 2, KV_HEADS, HEAD_DIM)
    nblk = jnp.clip(idx - n_past_blk, 0, n_new_blk - 1)
    from_tail = tail[b_ix, nblk, :, :, g_ix]
    kv_g = jnp.where(in_past[..., None, None, None], from_pool, from_tail)
    o_s = selected_branch(qg, pos_q, kv_g, idx, valid, slopes)
    w_buf = cache_win.shape[1]
    kv_w = jnp.concatenate([cache_win.astype(kvw.dtype), kvw], axis=1)
    pos_k = past - w_buf + jnp.arange(w_buf + t)
    o_w = window_branch(qg, pos_q, kv_w, pos_k, slopes)
    out = gate_branches(gl, o_c, o_s, o_w).reshape(b, t, Q_A)
    new_win = kv_w[:, -min(WINDOW, w_buf + t):]
    return out, new_win


def hgrn_chunked(q, k, v, log_f, s0):
    b, t = q.shape[:2]
    nc = t // HGRN_CHUNK
    to_chunks = lambda a: jnp.swapaxes(a.reshape(b, nc, HGRN_CHUNK, *a.shape[2:]), 0, 1)
    tril = jnp.tril(jnp.ones((HGRN_CHUNK, HGRN_CHUNK), dtype=bool))

    def step(s, inp):
        qc, kc, vc, lf = inp
        lc = jnp.cumsum(lf, axis=1)
        qt = qc * jnp.exp(lc)
        kt = kc * jnp.exp(-lc)
        a = jnp.where(tril, jnp.einsum('bchk,bshk->bhcs', qt, kt), 0.0)
        o = jnp.einsum('bhcs,bshv->bchv', a, vc) + jnp.einsum('bchk,bhkv->bchv', qt, s)
        lend = lc[:, -1]
        s = jnp.exp(lend)[..., None] * s + jnp.einsum('bshk,bshv->bhkv', kc * jnp.exp(lend[:, None] - lc), vc)
        return s, o

    s, o = lax.scan(step, s0, (to_chunks(q), to_chunks(k), to_chunks(v), to_chunks(log_f)))
    return jnp.swapaxes(o, 0, 1).reshape(b, t, B_HEADS, B_DV), s


def hgrn_recurrent(q, k, v, log_f, s0):
    def step(s, inp):
        qt, kt, vt, lft = inp
        s = jnp.exp(lft)[..., None] * s + kt[..., None] * vt[..., None, :]
        return s, jnp.einsum('bhk,bhkv->bhv', qt, s)

    s, o = lax.scan(step, s0, (jnp.swapaxes(q, 0, 1), jnp.swapaxes(k, 0, 1),
                              jnp.swapaxes(v, 0, 1), jnp.swapaxes(log_f, 0, 1)))
    return jnp.swapaxes(o, 0, 1), s


def hgrn_mixer(qb, fb, ib, gb, lb, norm_g, s0, chunked):
    b, t = qb.shape[:2]
    f32 = jnp.float32
    q = qb.reshape(b, t, B_HEADS, B_DK).astype(f32)
    lbh = lb.reshape(B_HEADS, B_DK)
    f = lbh + (1.0 - lbh) * jax.nn.sigmoid(fb.reshape(b, t, B_HEADS, B_DK).astype(f32))
    log_f = jnp.log(f)
    k = 1.0 - f
    v = ib.reshape(b, t, B_HEADS, B_DV).astype(f32)
    if chunked:
        o, s = hgrn_chunked(q, k, v, log_f, s0.astype(f32))
    else:
        o, s = hgrn_recurrent(q, k, v, log_f, s0.astype(f32))
    o = o * lax.rsqrt(jnp.mean(jnp.square(o), axis=-1, keepdims=True) + LN_EPS) * norm_g.astype(f32)
    o = o.reshape(b, t, I_B) * jax.nn.silu(gb.astype(f32))
    return o.astype(qb.dtype), s


def merge_and_mlp(x, o_a, o_b, mg, w_br_a, w_br_b, w_out, ln1_g, ln1_b, w_up, w_down, ln2_g, ln2_b):
    br_a = jnp.einsum('bse,ed->bsd', o_a, w_br_a)
    br_b = jnp.einsum('bse,ed->bsd', o_b, w_br_b)
    merged = jax.nn.sigmoid(mg[..., :D_MODEL]) * br_a + jax.nn.sigmoid(mg[..., D_MODEL:]) * br_b
    mix = jnp.einsum('bsd,de->bse', merged, w_out)
    x1 = layer_norm(DEEPNORM_ALPHA * x + mix, ln1_g, ln1_b)
    h = jnp.einsum('bsf,fd->bsd', jnp.square(jax.nn.relu(jnp.einsum('bsd,df->bsf', x1, w_up))), w_down)
    return layer_norm(DEEPNORM_ALPHA * x1 + h, ln2_g, ln2_b)


def setup_inputs(seed: int = 0) -> dict:
    key = jax.random.key(seed)
    ks = jax.random.split(key, 24)
    f32 = jnp.float32
    nrm = lambda k, shape, scale: scale * jax.random.normal(k, shape, f32)
    n_pages = PAST_LEN // PAGE_SIZE
    n_pool = (5 * DEC_BATCH * n_pages) // 4
    win_buf = min(WINDOW, PAST_LEN)
    page_table = jax.random.permutation(ks[0], n_pool)[:DEC_BATCH * n_pages]
    page_table = page_table.reshape(DEC_BATCH, n_pages).astype(jnp.int32)
    return {
        'x_prompt': nrm(ks[1], (BATCH, SEQ, D_MODEL), 1.0),
        'x_sample': nrm(ks[2], (DEC_BATCH, DEC_SEQ, D_MODEL), 1.0),
        'cache_cmp_kv': nrm(ks[3], (DEPTH, n_pool, PAGE_SIZE, 2, KV_HEADS, HEAD_DIM), 1.0),
        'cache_sel_kv': nrm(ks[4], (DEPTH, n_pool, PAGE_SIZE, 2, KV_HEADS, HEAD_DIM), 1.0),
        'cache_win_kv': nrm(ks[5], (DEPTH, DEC_BATCH, win_buf, 2, KV_HEADS, HEAD_DIM), 1.0),
        'state_hgrn': nrm(ks[6], (DEPTH, DEC_BATCH, B_HEADS, B_DK, B_DV), 0.1),
        'page_table': page_table,
        'w_in': nrm(ks[7], (DEPTH, D_MODEL, D_IN), D_MODEL ** -0.5),
        'cmp_w': nrm(ks[8], (DEPTH, 2, CMP_LEN, HEAD_DIM, HEAD_DIM), (CMP_LEN * HEAD_DIM) ** -0.5),
        'cmp_pos': nrm(ks[9], (DEPTH, 2, CMP_LEN, HEAD_DIM), 0.5),
        'hgrn_lb_logits': nrm(ks[10], (DEPTH + 1, B_HEADS * B_DK), 0.5),
        'hgrn_norm_g': 1.0 + nrm(ks[11], (DEPTH, B_DV), 0.02),
        'w_br_a': nrm(ks[12], (DEPTH, Q_A, D_MODEL), DEEPNORM_BETA * Q_A ** -0.5),
        'w_br_b': nrm(ks[13], (DEPTH, I_B, D_MODEL), DEEPNORM_BETA * I_B ** -0.5),
        'w_out': nrm(ks[14], (DEPTH, D_MODEL, D_MODEL), DEEPNORM_BETA * D_MODEL ** -0.5),
        'ln1_g': 1.0 + nrm(ks[15], (DEPTH, D_MODEL), 0.02),
        'ln1_b': nrm(ks[16], (DEPTH, D_MODEL), 0.02),
        'w_up': nrm(ks[17], (DEPTH, D_MODEL, D_FF), DEEPNORM_BETA * D_MODEL ** -0.5),
        'w_down': nrm(ks[18], (DEPTH, D_FF, D_MODEL), DEEPNORM_BETA * D_FF ** -0.5),
        'ln2_g': 1.0 + nrm(ks[19], (DEPTH, D_MODEL), 0.02),
        'ln2_b': nrm(ks[20], (DEPTH, D_MODEL), 0.02),
    }


def reference(x_prompt, x_sample, cache_cmp_kv, cache_sel_kv, cache_win_kv, state_hgrn, page_table,
              w_in, cmp_w, cmp_pos, hgrn_lb_logits, hgrn_norm_g, w_br_a, w_br_b, w_out,
              ln1_g, ln1_b, w_up, w_down, ln2_g, ln2_b):
    lb_all = jnp.cumsum(jax.nn.softmax(hgrn_lb_logits.astype(jnp.float32), axis=0), axis=0)
    xp, xs = x_prompt, x_sample
    cmp_p, sel_p, win_p, hg_p = [], [], [], []
    cmp_s, sel_s, win_s, hg_s = [], [], [], []
    for l in range(DEPTH):
        qa, kvc, kvs, kvw, gla, qb, fb, ib, gb, mg = split_projection(xp, w_in[l])
        o_a, nw = nsa_prompt(qa, kvc, kvs, kvw, gla, cmp_w[l], cmp_pos[l])
        s0 = jnp.zeros((xp.shape[0], B_HEADS, B_DK, B_DV), jnp.float32)
        o_b, s_end = hgrn_mixer(qb, fb, ib, gb, lb_all[l], hgrn_norm_g[l], s0, True)
        xp = merge_and_mlp(xp, o_a, o_b, mg, w_br_a[l], w_br_b[l], w_out[l], ln1_g[l], ln1_b[l],
                           w_up[l], w_down[l], ln2_g[l], ln2_b[l])
        cmp_p.append(kvc)
        sel_p.append(kvs)
        win_p.append(nw)
        hg_p.append(s_end.astype(x_prompt.dtype))
        qa, kvc, kvs, kvw, gla, qb, fb, ib, gb, mg = split_projection(xs, w_in[l])
        o_a, nw = nsa_sample(qa, kvc, kvs, kvw, gla, cache_cmp_kv[l], cache_sel_kv[l], cache_win_kv[l],
                             page_table, cmp_w[l], cmp_pos[l])
        o_b, s_end = hgrn_mixer(qb, fb, ib, gb, lb_all[l], hgrn_norm_g[l], state_hgrn[l], False)
        xs = merge_and_mlp(xs, o_a, o_b, mg, w_br_a[l], w_br_b[l], w_out[l], ln1_g[l], ln1_b[l],
                           w_up[l], w_down[l], ln2_g[l], ln2_b[l])
        cmp_s.append(kvc)
        sel_s.append(kvs)
        win_s.append(nw)
        hg_s.append(s_end.astype(x_sample.dtype))
    return (xp, xs,
            jnp.stack(cmp_p), jnp.stack(sel_p), jnp.stack(win_p), jnp.stack(hg_p),
            jnp.stack(cmp_s), jnp.stack(sel_s), jnp.stack(win_s), jnp.stack(hg_s))
```

```cpp
#include <hip/hip_runtime.h>
#include <cstdio>
#include <cstdint>
namespace pg8 {
#define PG8_LAS __attribute__((address_space(3)))
typedef unsigned short bf16_t;
typedef short bf16x8 __attribute__((ext_vector_type(8)));
typedef float f32x4 __attribute__((ext_vector_type(4)));
typedef unsigned u32x4 __attribute__((ext_vector_type(4)));
constexpr int BM = 256, BK = 64, HALF = 128, HTB = HALF * BK * 2  , STAGE_BYTES = 8 * HTB, NXCD = 8, WGM = 8;

__host__ __device__ __forceinline__ int lds_byte(int r, int c) { const int st = (r >> 4) * 2 + (c >> 5), rr = r & 15, cc = c & 31, ob = rr * 64 + cc * 2; return st * 1024 + (ob ^ (((ob >> 9) & 1) << 5)); }
__host__ __device__ __forceinline__ void stage_rc(int b, int& R, int& C) { const int st = b / 1024, sb = b % 1024, swz = sb ^ (((sb >> 9) & 1) << 5); R = (st >> 1) * 16 + swz / 64; C = (st & 1) * 32 + (swz % 64) / 2; }
__host__ __device__ __forceinline__ int perm32(int rho) { const int n = rho >> 4, i = rho & 15; return 8 * (i >> 2) + 4 * n + (i & 3); }

struct Unit { int pm, pn; };
struct Gemm { const bf16_t* A; const bf16_t* Bt; int M, N, K; };

struct StaticOrder {
    int nM, nN, nwg, G, c;
    __host__ __device__ void init(int M, int N, int G_, int c_) { nM = M / BM; nN = N / BM; nwg = nM * nN; G = G_; c = c_; }
    __host__ __device__ bool next(int i, Unit& u) const {
        const long L = (long)i * G + c; if (L >= nwg) return false;
        int wgid = (int)L; { const int q = nwg / NXCD, r = nwg % NXCD, xcd = wgid % NXCD, off = wgid / NXCD; wgid = (xcd < r ? xcd * (q + 1) : r * (q + 1) + (xcd - r) * q) + off; }
        const int nig = WGM * nN, gid = wgid / nig, fm = gid * WGM, gsz = (nM - fm) < WGM ? (nM - fm) : WGM;
        u.pm = fm + ((wgid % nig) % gsz); u.pn = (wgid % nig) / gsz; return true;
    }
    __device__ __forceinline__ void a_ready(const Unit&) const {}
    __device__ __forceinline__ void done(const Unit&) const {}
};

__device__ __forceinline__ unsigned cvt_pk_bf16(float lo, float hi) { unsigned r; asm volatile("v_cvt_pk_bf16_f32 %0, %1, %2" : "=v"(r) : "v"(lo), "v"(hi)); return r; }
typedef float f32x2 __attribute__((ext_vector_type(2)));
__device__ __forceinline__ f32x2 gelu_pk(f32x2 v) {
    const f32x2 av = __builtin_elementwise_abs(v), d = av * 0.2316418882f + 1.0f;
    f32x2 t; t.x = __builtin_amdgcn_rcpf(d.x); t.y = __builtin_amdgcn_rcpf(d.y);
    f32x2 q = t * 0.5307027145f + (-0.7265760135f); q = q * t + 0.7107068705f; q = q * t + (-0.142248368f); q = q * t + 0.127414796f; q = q * t;
    const f32x2 s = (v * v) * (-0.72134752044f);
    f32x2 e; e.x = __builtin_amdgcn_exp2f(s.x); e.y = __builtin_amdgcn_exp2f(s.y);
    const f32x2 m = v * (q * e), r = v - m;
    f32x2 o; o.x = v.x < 0.f ? m.x : r.x; o.y = v.y < 0.f ? m.y : r.y; return o;
}

template <int ACT  > struct EpiBf16 {
    static constexpr bool PERM = true, AFTER_DRAIN = false; static_assert(ACT == 0 || ACT == 1, "EpiBf16: ACT is 0 (none) or 1 (gelu_pk)");
    bf16_t* O; int ldc; const float* bias; int split_cols; size_t split_stride; float scale0;
    __device__ __forceinline__ void operator()(const f32x4 (&acc)[2][2][4][2], const Unit& u, int wr, int wc, int fr, int fq) const {
        const int row0 = u.pm * BM + wr * 64 + fr; int colt = u.pn * BM; bf16_t* base = O;
        float sc = 1.f; if (split_cols) { const int t = colt / split_cols; base += (size_t)t * split_stride; colt -= t * split_cols; if (t == 0) sc = scale0; }
        const int col0 = colt + wc * 32 + 8 * fq, bcol0 = u.pn * BM + wc * 32 + 8 * fq;
        f32x4 bv[2][2];
#pragma unroll
        for (int bj = 0; bj < 2; ++bj)
#pragma unroll
            for (int n = 0; n < 2; ++n) bv[bj][n] = bias ? *(const f32x4*)(bias + bcol0 + bj * HALF + 4 * n) : (f32x4){0.f, 0.f, 0.f, 0.f};
#pragma unroll
        for (int ai = 0; ai < 2; ++ai)
#pragma unroll
            for (int m = 0; m < 4; ++m) { bf16_t* rowp = base + (size_t)(row0 + ai * HALF + m * 16) * ldc + col0;
#pragma unroll
                for (int bj = 0; bj < 2; ++bj) { f32x4 v0 = acc[ai][bj][m][0] + bv[bj][0], v1 = acc[ai][bj][m][1] + bv[bj][1];
                    if (ACT == 1) { f32x2 a = gelu_pk((f32x2){v0[0], v0[1]}), b = gelu_pk((f32x2){v0[2], v0[3]}), c = gelu_pk((f32x2){v1[0], v1[1]}), d = gelu_pk((f32x2){v1[2], v1[3]});
                        v0 = (f32x4){a.x, a.y, b.x, b.y}; v1 = (f32x4){c.x, c.y, d.x, d.y}; }
                    v0 = v0 * sc; v1 = v1 * sc; u32x4 w; w.x = cvt_pk_bf16(v0[0], v0[1]); w.y = cvt_pk_bf16(v0[2], v0[3]); w.z = cvt_pk_bf16(v1[0], v1[1]); w.w = cvt_pk_bf16(v1[2], v1[3]);
                    *(u32x4*)(rowp + bj * HALF) = w; } }
    }
};

struct PanelStats {
    unsigned* xbuf;
    unsigned* cnt;
    unsigned* tmo;
    int ntn; float eps;
    unsigned code;
    __device__ __forceinline__ bool run(const f32x4 (&v)[2][2][4][2], const Unit& u, int wr, int wc, int fr, int fq, PG8_LAS unsigned char* lds, int wid, int lane) const {
        typedef float f32x2v __attribute__((ext_vector_type(2)));
        PG8_LAS f32x2v* P = (PG8_LAS f32x2v*)lds;
        PG8_LAS f32x2v* S = (PG8_LAS f32x2v*)(lds + 8192);
        PG8_LAS unsigned* flag = (PG8_LAS unsigned*)(lds + 8192 + 2048);
#pragma unroll
        for (int ai = 0; ai < 2; ++ai)
#pragma unroll
            for (int m = 0; m < 4; ++m) {
                float s = 0.f;
#pragma unroll
                for (int bj = 0; bj < 2; ++bj)
#pragma unroll
                    for (int n = 0; n < 2; ++n) { const f32x4 x = v[ai][bj][m][n]; s += (x[0] + x[1]) + (x[2] + x[3]); }
                s += __shfl_xor(s, 16); s += __shfl_xor(s, 32);
                const float mw = s * (1.0f / 64.0f); float q = 0.f;
#pragma unroll
                for (int bj = 0; bj < 2; ++bj)
#pragma unroll
                    for (int n = 0; n < 2; ++n) { const f32x4 d = v[ai][bj][m][n] - mw; q += (d[0] * d[0] + d[1] * d[1]) + (d[2] * d[2] + d[3] * d[3]); }
                q += __shfl_xor(q, 16); q += __shfl_xor(q, 32);
                if (fq == 0) P[(ai * HALF + wr * 64 + m * 16 + fr) * 4 + wc] = (f32x2v){mw, q};
            }
        asm volatile("s_waitcnt lgkmcnt(0)" ::: "memory"); __builtin_amdgcn_s_barrier(); asm volatile("" ::: "memory");
#if defined(BROKEN_EXCHANGE_NO_WAIT)
#warning BROKEN CONTROL BUILD: the row-statistics exchange does not wait; results are wrong by design
        if (blockIdx.x >= 64) { const long long t0_ = clock64(); while (clock64() - t0_ < 60000) __builtin_amdgcn_s_sleep(8); }
#endif
        const int row = wid * 32 + (lane & 31);
        if (lane < 32) {
            const f32x2v a = P[row * 4 + 0], b = P[row * 4 + 1], c = P[row * 4 + 2], d = P[row * 4 + 3];
            const float mt = (a.x + b.x + c.x + d.x) * 0.25f;
            const float da = a.x - mt, db = b.x - mt, dc = c.x - mt, dd = d.x - mt;
            const float m2 = (a.y + b.y) + (c.y + d.y) + 64.0f * ((da * da + db * db) + (dc * dc + dd * dd));
            unsigned long long* slot = (unsigned long long*)xbuf + ((size_t)(u.pm * BM + row) * 4 + u.pn);
            __hip_atomic_store(slot, ((unsigned long long)__float_as_uint(m2) << 32) | __float_as_uint(mt), __ATOMIC_RELAXED, __HIP_MEMORY_SCOPE_AGENT);
        }
        asm volatile("s_waitcnt vmcnt(0)" ::: "memory");
        if (lane == 0) __hip_atomic_fetch_add(cnt + 64 * u.pm, 1u, __ATOMIC_RELAXED, __HIP_MEMORY_SCOPE_AGENT);
        if (wid == 0) {
            bool dead = false; const unsigned long long t0 = __builtin_amdgcn_s_memrealtime(); const unsigned want = 8u * (unsigned)ntn;
            for (;;) {
#if defined(BROKEN_EXCHANGE_NO_WAIT)
                break;
#endif
                if ((unsigned)__builtin_amdgcn_readfirstlane(__hip_atomic_load(cnt + 64 * u.pm, __ATOMIC_RELAXED, __HIP_MEMORY_SCOPE_AGENT)) >= want) break;
                if (__builtin_amdgcn_s_memrealtime() - t0 > 2000000ull) {
                    if (lane == 0) { unsigned expect = 0u; __hip_atomic_compare_exchange_strong(tmo + 1, &expect, code | (unsigned)(u.pm & 0xff), __ATOMIC_RELAXED, __ATOMIC_RELAXED, __HIP_MEMORY_SCOPE_AGENT);
                                     __hip_atomic_store(tmo, 1u, __ATOMIC_RELAXED, __HIP_MEMORY_SCOPE_AGENT); }
                    dead = true; break; }
                __builtin_amdgcn_s_sleep(2);
            }
            __builtin_amdgcn_fence(__ATOMIC_ACQUIRE, "agent");
            if (lane == 0) flag[0] = dead ? 1u : 0u;
        }
        asm volatile("s_waitcnt vmcnt(0) lgkmcnt(0)" ::: "memory"); __builtin_amdgcn_s_barrier(); asm volatile("" ::: "memory");
        const bool bad = flag[0] != 0u;
        if (lane < 32) {
            const unsigned long long* slot = (const unsigned long long*)xbuf + (size_t)(u.pm * BM + row) * 4; float mt[4], m2[4]; float ms = 0.f;
#pragma unroll
            for (int t = 0; t < 4; ++t) { if (t < ntn) { const unsigned long long w = __hip_atomic_load(slot + t, __ATOMIC_RELAXED, __HIP_MEMORY_SCOPE_AGENT); mt[t] = __uint_as_float((unsigned)w); m2[t] = __uint_as_float((unsigned)(w >> 32)); } else { mt[t] = 0.f; m2[t] = 0.f; } ms += mt[t]; }
            const float mean = ms / (float)ntn; float q = 0.f;
#pragma unroll
            for (int t = 0; t < 4; ++t) if (t < ntn) { const float dm = mt[t] - mean; q += m2[t] + 256.0f * dm * dm; }
            S[row] = (f32x2v){mean, 1.0f / sqrtf(q / (256.0f * (float)ntn) + eps)};
        }
        asm volatile("s_waitcnt lgkmcnt(0)" ::: "memory"); __builtin_amdgcn_s_barrier(); asm volatile("" ::: "memory");
        return bad;
    }
};
struct EpiLnRes {
    static constexpr bool PERM = false, AFTER_DRAIN = true;
    const float* base; float* out; int ldc; const float* bias; PanelStats st; unsigned poison;
    __device__ __forceinline__ void fused(f32x4 (&acc)[2][2][4][2], const Unit& u, int wr, int wc, int fr, int fq, PG8_LAS unsigned char* lds, int wid, int lane) const {
        typedef float f32x2v __attribute__((ext_vector_type(2)));
        const PG8_LAS f32x2v* S = (const PG8_LAS f32x2v*)(lds + 8192);
        const int col0 = u.pn * BM + wc * 32 + 4 * fq;
#pragma unroll
        for (int bj = 0; bj < 2; ++bj)
#pragma unroll
            for (int n = 0; n < 2; ++n) { const f32x4 bv = bias ? *(const f32x4*)(bias + col0 + bj * HALF + n * 16) : (f32x4){0.f, 0.f, 0.f, 0.f};
#pragma unroll
                for (int ai = 0; ai < 2; ++ai)
#pragma unroll
                    for (int m = 0; m < 4; ++m) acc[ai][bj][m][n] += bv; }
        f32x4 pre[4][2][2];
#pragma unroll
        for (int m = 0; m < 4; ++m) { const size_t off = (size_t)(u.pm * BM + wr * 64 + m * 16 + fr) * ldc + col0;
#pragma unroll
            for (int bj = 0; bj < 2; ++bj)
#pragma unroll
                for (int n = 0; n < 2; ++n) pre[m][bj][n] = *(const f32x4*)(base + off + bj * HALF + n * 16); }
        const bool bad = st.run(acc, u, wr, wc, fr, fq, lds, wid, lane) || poison != 0u;
        const float qnan = __builtin_nanf("");
#pragma unroll
        for (int ai = 0; ai < 2; ++ai)
#pragma unroll
            for (int m = 0; m < 4; ++m) { const int r = ai * HALF + wr * 64 + m * 16 + fr; const f32x2v sr = S[r]; const size_t off = (size_t)(u.pm * BM + r) * ldc + col0;
#pragma unroll
                for (int bj = 0; bj < 2; ++bj)
#pragma unroll
                    for (int n = 0; n < 2; ++n) { const f32x4 bs = ai == 0 ? pre[m][bj][n] : *(const f32x4*)(base + off + bj * HALF + n * 16); f32x4 o = bs + (acc[ai][bj][m][n] - sr.x) * sr.y;
                        if (bad) o = (f32x4){qnan, qnan, qnan, qnan}; *(f32x4*)(out + off + bj * HALF + n * 16) = o; }
                if (m & 1) asm volatile("" ::: "memory"); }
    }
};
struct EpiLnResLn {
    static constexpr bool PERM = false, AFTER_DRAIN = true;
    const float* base; float* out; bf16_t* xn; int ldc; const float* bias; PanelStats st1, st2; unsigned poison;
    __device__ __forceinline__ void fused(f32x4 (&acc)[2][2][4][2], const Unit& u, int wr, int wc, int fr, int fq, PG8_LAS unsigned char* lds, int wid, int lane) const {
        typedef float f32x2v __attribute__((ext_vector_type(2))); typedef unsigned u32x2v __attribute__((ext_vector_type(2)));
        const PG8_LAS f32x2v* S = (const PG8_LAS f32x2v*)(lds + 8192);
        const int col0 = u.pn * BM + wc * 32 + 4 * fq;
#pragma unroll
        for (int bj = 0; bj < 2; ++bj)
#pragma unroll
            for (int n = 0; n < 2; ++n) { const f32x4 bv = bias ? *(const f32x4*)(bias + col0 + bj * HALF + n * 16) : (f32x4){0.f, 0.f, 0.f, 0.f};
#pragma unroll
                for (int ai = 0; ai < 2; ++ai)
#pragma unroll
                    for (int m = 0; m < 4; ++m) acc[ai][bj][m][n] += bv; }
        bool bad = st1.run(acc, u, wr, wc, fr, fq, lds, wid, lane) || poison != 0u;
        const float qnan = __builtin_nanf("");
#pragma unroll
        for (int ai = 0; ai < 2; ++ai)
#pragma unroll
            for (int m = 0; m < 4; ++m) { const int r = ai * HALF + wr * 64 + m * 16 + fr; const f32x2v sr = S[r]; const size_t off = (size_t)(u.pm * BM + r) * ldc + col0;
#pragma unroll
                for (int bj = 0; bj < 2; ++bj)
#pragma unroll
                    for (int n = 0; n < 2; ++n) { const f32x4 bs = *(const f32x4*)(base + off + bj * HALF + n * 16); acc[ai][bj][m][n] = bs + (acc[ai][bj][m][n] - sr.x) * sr.y; }
                asm volatile("" : "+v"(acc[ai][0][m][0]), "+v"(acc[ai][0][m][1]), "+v"(acc[ai][1][m][0]), "+v"(acc[ai][1][m][1]));
                if (m & 1) asm volatile("" ::: "memory"); }
        const bool bad1 = bad;
        bad = st2.run(acc, u, wr, wc, fr, fq, lds, wid, lane) || bad;
#pragma unroll
        for (int ai = 0; ai < 2; ++ai)
#pragma unroll
            for (int m = 0; m < 4; ++m) { const int r = ai * HALF + wr * 64 + m * 16 + fr; const f32x2v sr = S[r]; const size_t off = (size_t)(u.pm * BM + r) * ldc + col0;
#pragma unroll
                for (int bj = 0; bj < 2; ++bj)
#pragma unroll
                    for (int n = 0; n < 2; ++n) { const f32x4 x1 = acc[ai][bj][m][n]; *(f32x4*)(out + off + bj * HALF + n * 16) = bad1 ? (f32x4){qnan, qnan, qnan, qnan} : x1;
                        const f32x4 o = (x1 - sr.x) * sr.y; u32x2v w; w.x = cvt_pk_bf16(o[0], o[1]); w.y = cvt_pk_bf16(o[2], o[3]);
                        if (bad) { w.x = 0x7fc07fc0u; w.y = 0x7fc07fc0u; } *(u32x2v*)(xn + off + bj * HALF + n * 16) = w; }
                asm volatile("" ::: "memory"); }
    }
};

template <class Epi, class Sched, bool ALIGN_EPI = false, bool SP2 = false>
__device__ __forceinline__ void gemm_phase(PG8_LAS unsigned char* lds, const Gemm g, const Sched& S, const Epi& E) {
    const int tid = threadIdx.x, wid = __builtin_amdgcn_readfirstlane(tid >> 6), lane = tid & 63, wr = wid >> 2, wc = wid & 3, fr = lane & 15, fq = lane >> 4;
    const int K = g.K, nt = K / BK;
    unsigned voffA[2], voffB[2];
#pragma unroll
    for (int i = 0; i < 2; ++i) { int R, C; stage_rc(tid * 16 + i * 8192, R, C); const int Rb = Epi::PERM ? ((R & ~31) + perm32(R & 31)) : R;
        voffA[i] = (unsigned)(R * K + C) * 2u; voffB[i] = (unsigned)(Rb * K + C) * 2u; }
    const size_t kstep = (size_t)(BK * 2);
    const size_t hstep = (size_t)HALF * K * 2;
    const size_t tstep = 2 * hstep;
    const unsigned ldsw = (unsigned)wid * 1024u;
    const int aoff = lds_byte(wr * 64 + fr, fq * 8), boff = lds_byte(wc * 32 + fr, fq * 8);
#define PG8_SA(b, h) (((b) * 2 + (h)) * HTB)
#define PG8_SB(b, h) ((4 + (b) * 2 + (h)) * HTB)
#define PG8_STAGE(bufoff, gbase, voff) do { _Pragma("unroll") for (int _i = 0; _i < 2; ++_i) \
        __builtin_amdgcn_global_load_lds((const unsigned*)((const char*)(gbase) + (voff)[_i]), (PG8_LAS unsigned*)(lds + (bufoff) + ldsw + _i * 8192), 16, 0, 0); } while (0)
#define PG8_LDA(dst, b, h) do { _Pragma("unroll") for (int m = 0; m < 4; ++m) _Pragma("unroll") for (int k = 0; k < 2; ++k) dst[m][k] = *(const PG8_LAS bf16x8*)(lds + PG8_SA(b, h) + aoff + m * 2048 + k * 1024); } while (0)
#define PG8_LDB(dst, b, h) do { _Pragma("unroll") for (int n = 0; n < 2; ++n) _Pragma("unroll") for (int k = 0; k < 2; ++k) dst[n][k] = *(const PG8_LAS bf16x8*)(lds + PG8_SB(b, h) + boff + n * 2048 + k * 1024); } while (0)
#define PG8_MMA(ai, bj, At, Bt) do { __builtin_amdgcn_s_setprio(1); _Pragma("unroll") for (int m = 0; m < 4; ++m) _Pragma("unroll") for (int n = 0; n < 2; ++n) _Pragma("unroll") for (int k = 0; k < 2; ++k) \
        acc[ai][bj][m][n] = __builtin_amdgcn_mfma_f32_16x16x32_bf16(Bt[n][k], At[m][k], acc[ai][bj][m][n], 0, 0, 0); __builtin_amdgcn_s_setprio(0); } while (0)
#define PG8_WAIT_V(n) asm volatile("s_waitcnt vmcnt(" #n ")" ::: "memory")
#define PG8_WAIT_L(n) asm volatile("s_waitcnt lgkmcnt(" #n ")" ::: "memory")
#define PG8_BAR __builtin_amdgcn_s_barrier()
#define PG8_SCHED __builtin_amdgcn_sched_barrier(0)
    Unit cur, nxt; int ui = 0;
    if (!S.next(0, cur)) return;
    f32x4 acc[2][2][4][2];
#pragma unroll
    for (int a = 0; a < 2; ++a)
#pragma unroll
        for (int b = 0; b < 2; ++b)
#pragma unroll
            for (int m = 0; m < 4; ++m)
#pragma unroll
                for (int n = 0; n < 2; ++n) acc[a][b][m][n] = (f32x4){0.f, 0.f, 0.f, 0.f};
    bf16x8 At[4][2], B0[2][2], B1[2][2];
    const char* cA = (const char*)g.A + (size_t)cur.pm * tstep; const char* cB = (const char*)g.Bt + (size_t)cur.pn * tstep;
    S.a_ready(cur);
    if constexpr (SP2) {
        PG8_STAGE(PG8_SB(0, 0), cB, voffB); PG8_STAGE(PG8_SB(0, 1), cB + hstep, voffB); PG8_STAGE(PG8_SA(0, 0), cA, voffA); PG8_STAGE(PG8_SA(0, 1), cA + hstep, voffA);
        if (wr == 1) PG8_BAR;
        PG8_WAIT_V(2); PG8_BAR;
        PG8_STAGE(PG8_SB(1, 0), cB + kstep, voffB); PG8_STAGE(PG8_SA(1, 0), cA + kstep, voffA); PG8_STAGE(PG8_SB(1, 1), cB + hstep + kstep, voffB);
        PG8_WAIT_V(6); PG8_BAR;
    } else {
        PG8_STAGE(PG8_SB(0, 0), cB, voffB); PG8_STAGE(PG8_SA(0, 0), cA, voffA); PG8_STAGE(PG8_SB(0, 1), cB + hstep, voffB); PG8_STAGE(PG8_SA(0, 1), cA + hstep, voffA);
        if (wr == 1) PG8_BAR;
        PG8_WAIT_V(4); PG8_BAR;
        PG8_STAGE(PG8_SB(1, 0), cB + kstep, voffB); PG8_STAGE(PG8_SA(1, 0), cA + kstep, voffA); PG8_STAGE(PG8_SB(1, 1), cB + hstep + kstep, voffB);
        PG8_WAIT_V(6); PG8_BAR;
    }
    for (;;) {
        const bool has_next = S.next(ui + 1, nxt);
        const char* nA = has_next ? (const char*)g.A + (size_t)nxt.pm * tstep : cA; const char* nB = has_next ? (const char*)g.Bt + (size_t)nxt.pn * tstep : cB;
        for (int t = 0; t < nt; t += 2) {
            const bool last = (t == nt - 2);
            const char* a1 = cA + (size_t)(t + 1) * kstep;
            const char* a2 = last ? nA : cA + (size_t)(t + 2) * kstep; const char* b2 = last ? nB : cB + (size_t)(t + 2) * kstep;
            const char* a3 = a2 + kstep; const char* b3 = b2 + kstep;
            if (last && has_next) S.a_ready(nxt);
            if constexpr (SP2) {
            PG8_LDB(B0, 0, 0); PG8_LDB(B1, 0, 1); PG8_SCHED; PG8_LDA(At, 0, 0); PG8_STAGE(PG8_SA(1, 1), a1 + hstep, voffA);
            PG8_WAIT_V(8); PG8_WAIT_L(0); PG8_BAR; PG8_MMA(0, 0, At, B0); PG8_MMA(0, 1, At, B1); PG8_BAR; PG8_SCHED;
            PG8_LDA(At, 0, 1); PG8_STAGE(PG8_SB(0, 0), b2, voffB); PG8_STAGE(PG8_SB(0, 1), b2 + hstep, voffB); PG8_STAGE(PG8_SA(0, 0), a2, voffA);
            PG8_WAIT_V(8); PG8_WAIT_L(0); PG8_BAR; PG8_MMA(1, 0, At, B0); PG8_MMA(1, 1, At, B1); PG8_BAR; PG8_SCHED;
            PG8_LDB(B0, 1, 0); PG8_LDB(B1, 1, 1); PG8_SCHED; PG8_LDA(At, 1, 0); PG8_STAGE(PG8_SA(0, 1), a2 + hstep, voffA);
            PG8_WAIT_V(8); PG8_WAIT_L(0); PG8_BAR; PG8_MMA(0, 0, At, B0); PG8_MMA(0, 1, At, B1); PG8_BAR; PG8_SCHED;
            PG8_LDA(At, 1, 1); PG8_STAGE(PG8_SB(1, 0), b3, voffB); PG8_STAGE(PG8_SB(1, 1), b3 + hstep, voffB); PG8_STAGE(PG8_SA(1, 0), a3, voffA);
            PG8_WAIT_V(8); PG8_WAIT_L(0); PG8_BAR; PG8_MMA(1, 0, At, B0); PG8_MMA(1, 1, At, B1); PG8_BAR; PG8_SCHED;
            } else {
            PG8_LDB(B0, 0, 0); PG8_SCHED; PG8_LDA(At, 0, 0); PG8_STAGE(PG8_SA(1, 1), a1 + hstep, voffA);
            PG8_WAIT_L(8); PG8_BAR; PG8_WAIT_L(0); PG8_MMA(0, 0, At, B0); PG8_BAR; PG8_SCHED;
            PG8_LDB(B1, 0, 1); PG8_STAGE(PG8_SB(0, 0), b2, voffB);
            PG8_BAR; PG8_WAIT_L(0); PG8_MMA(0, 1, At, B1); PG8_BAR;
            PG8_LDA(At, 0, 1); PG8_STAGE(PG8_SA(0, 0), a2, voffA);
            PG8_BAR; PG8_WAIT_L(0); PG8_MMA(1, 0, At, B0); PG8_BAR; PG8_SCHED;
            PG8_STAGE(PG8_SB(0, 1), b2 + hstep, voffB);
            PG8_WAIT_V(6); PG8_BAR; PG8_MMA(1, 1, At, B1); PG8_BAR;
            PG8_LDB(B0, 1, 0); PG8_SCHED; PG8_LDA(At, 1, 0); PG8_STAGE(PG8_SA(0, 1), a2 + hstep, voffA);
            PG8_WAIT_L(8); PG8_BAR; PG8_WAIT_L(0); PG8_MMA(0, 0, At, B0); PG8_BAR; PG8_SCHED;
            PG8_LDB(B1, 1, 1); PG8_STAGE(PG8_SB(1, 0), b3, voffB);
            PG8_BAR; PG8_WAIT_L(0); PG8_MMA(0, 1, At, B1); PG8_BAR;
            PG8_LDA(At, 1, 1); PG8_STAGE(PG8_SA(1, 0), a3, voffA);
            PG8_BAR; PG8_WAIT_L(0); PG8_MMA(1, 0, At, B0); PG8_BAR; PG8_SCHED;
            PG8_STAGE(PG8_SB(1, 1), b3 + hstep, voffB);
            PG8_WAIT_V(6); PG8_BAR; PG8_MMA(1, 1, At, B1); PG8_BAR;
            }
        }
        if constexpr (ALIGN_EPI) { if (wr == 0) PG8_BAR; }
        if constexpr (!Epi::AFTER_DRAIN) { E(acc, cur, wr, wc, fr, fq); S.done(cur); }
        if (!has_next) break;
#pragma unroll
        for (int a = 0; a < 2; ++a)
#pragma unroll
            for (int b = 0; b < 2; ++b)
#pragma unroll
                for (int m = 0; m < 4; ++m)
#pragma unroll
                    for (int n = 0; n < 2; ++n) acc[a][b][m][n] = (f32x4){0.f, 0.f, 0.f, 0.f};
        cur = nxt; cA = nA; cB = nB; ++ui;
        if constexpr (ALIGN_EPI) { if (wr == 1) PG8_BAR; }
    }
    PG8_WAIT_V(0);
    if constexpr (!ALIGN_EPI) { if (wr == 0) PG8_BAR; }
    PG8_BAR;
    if constexpr (Epi::AFTER_DRAIN) { E.fused(acc, cur, wr, wc, fr, fq, lds, wid, lane); S.done(cur); }
#undef PG8_SA
#undef PG8_SB
#undef PG8_STAGE
#undef PG8_LDA
#undef PG8_LDB
#undef PG8_MMA
#undef PG8_WAIT_V
#undef PG8_WAIT_L
#undef PG8_BAR
#undef PG8_SCHED
}
}
#define GAS __attribute__((address_space(1)))
#define LAS __attribute__((address_space(3)))
typedef unsigned short bf16;
typedef unsigned v4u __attribute__((ext_vector_type(4)));
typedef float f32x4 __attribute__((ext_vector_type(4)));
typedef short bf16x8 __attribute__((ext_vector_type(8)));
typedef GAS unsigned gu32;
typedef GAS unsigned long long gu64;
#define RLX_AGENT __ATOMIC_RELAXED, __HIP_MEMORY_SCOPE_AGENT
#define LDS_WAIT() asm volatile("s_waitcnt lgkmcnt(0)" ::: "memory")
#define VM_WAIT() asm volatile("s_waitcnt vmcnt(0)" ::: "memory")
__device__ __forceinline__ unsigned long long rt() { return __builtin_amdgcn_s_memrealtime(); }
__device__ __forceinline__ unsigned f2bf(float f) { unsigned u = __builtin_bit_cast(unsigned, f); return (u + 0x7fffu + ((u >> 16) & 1u)) >> 16; }
__device__ __forceinline__ unsigned pk2(float lo, float hi) { return f2bf(lo) | (f2bf(hi) << 16); }

#define XB_TMO      128
#define XB_XCNT(j)  (256  + 64 * (j))
#define XB_XSUB(j)  (1280 + 64 * (j))
#define XB_XGEN(j)  (2304 + 64 * (j))
#define XB_TOP      3328
#define XB_TOPGEN   3392
#define XCD_BAR_WORDS 3456
#define XB_SPIN_CAP (1u << 18)

__device__ __forceinline__ unsigned xb_ld(unsigned* p)              { return __hip_atomic_load(p, __ATOMIC_RELAXED, __HIP_MEMORY_SCOPE_AGENT); }
__device__ __forceinline__ unsigned xb_add(unsigned* p, unsigned v) { return __hip_atomic_fetch_add(p, v, __ATOMIC_RELAXED, __HIP_MEMORY_SCOPE_AGENT); }
__device__ __forceinline__ unsigned xb_xcc_id() { return (unsigned)__builtin_amdgcn_s_getreg((3 << 11) | 20) & 0xFu; }
#define XB_SPIN(cond, bar) do { unsigned _sp = 0; while (cond) { __builtin_amdgcn_s_sleep(1); \
    if ((++_sp & 255u) == 0u) { if (xb_ld(&(bar)[XB_TMO])) break; if (_sp > XB_SPIN_CAP) { atomicAdd(&(bar)[XB_TMO], 1u); break; } } } } while (0)

struct XcdBarrier {
    unsigned* bar; unsigned x;
    volatile LAS unsigned* st;
};

__device__ __forceinline__ XcdBarrier xcd_barrier_post(unsigned* bar, volatile LAS unsigned* st) {
    XcdBarrier b; b.bar = bar; b.x = xb_xcc_id(); b.st = st;
    if (threadIdx.x == 0) (void)xb_add(&bar[XB_XCNT(b.x)], 1u);
    return b;
}
__device__ __forceinline__ void xcd_barrier_complete(unsigned* bar, unsigned x, unsigned& nloc, unsigned& nx) {
    const unsigned G = gridDim.x * gridDim.y * gridDim.z;
    unsigned sum, cnt, mine, sp = 0u;
    for (;;) {
        sum = 0u; cnt = 0u; mine = 0u;
#pragma unroll
        for (unsigned j = 0; j < 16; ++j) { const unsigned c = xb_ld(&bar[XB_XCNT(j)]); sum += c; cnt += (c > 0u) ? 1u : 0u; mine = (j == x) ? c : mine; }
        if (sum == G) break;
        __builtin_amdgcn_s_sleep(1);
        if ((++sp & 255u) == 0u) { if (xb_ld(&bar[XB_TMO])) break; if (sp > XB_SPIN_CAP) { atomicAdd(&bar[XB_TMO], 1u); break; } }
    }
    nloc = mine > 0u ? mine : 1u; nx = cnt > 0u ? cnt : 1u;
}

__device__ __forceinline__ void xcd_barrier(const XcdBarrier& b) {
    asm volatile("s_waitcnt vmcnt(0)" ::: "memory");
    __syncthreads();
    if (threadIdx.x == 0) {
        unsigned* bar = b.bar;
        __builtin_amdgcn_s_waitcnt(0);
        unsigned nloc = b.st[0], nx = b.st[1];
        if (nloc == 0u) { xcd_barrier_complete(bar, b.x, nloc, nx); b.st[0] = nloc; b.st[1] = nx; }
        const unsigned old = xb_add(&bar[XB_XSUB(b.x)], 1u);
        const unsigned gen = old / nloc;
        if (old + 1u == (gen + 1u) * nloc) {
            __builtin_amdgcn_fence(__ATOMIC_RELEASE, "agent");
            asm volatile("s_waitcnt vmcnt(0)" ::: "memory");
            const unsigned og = xb_add(&bar[XB_TOP], 1u);
            const unsigned tg = og / nx;
            if (og + 1u == (tg + 1u) * nx) xb_add(&bar[XB_TOPGEN], 1u);
            else XB_SPIN(xb_ld(&bar[XB_TOPGEN]) == tg, bar);
            __builtin_amdgcn_fence(__ATOMIC_ACQUIRE, "agent");
            xb_add(&bar[XB_XGEN(b.x)], 1u);
            asm volatile("s_waitcnt vmcnt(0)" ::: "memory");
        } else {
            XB_SPIN(xb_ld(&bar[XB_XGEN(b.x)]) == gen, bar);
            __builtin_amdgcn_fence(__ATOMIC_ACQUIRE, "agent");
            asm volatile("s_waitcnt vmcnt(0)" ::: "memory");
        }
    }
    __syncthreads();
}
constexpr int NWAVES = 8;
constexpr int T = 8192, NBATCH = 2, MP = NBATCH * T, MS = 32, MALL = 16640, D = 1024, NIN = 6656, FF = 4096;
constexpr int C_QA = 0, C_KVC = 512, C_KVS = 768, C_KVW = 1024, C_QB = 1280, C_FB = 2304, C_IB = 3328, C_GB = 3840, C_MG = 4352, C_GLA = 6400;
constexpr int PAST = 16384, NPAGES = 128, NCMP_S = 1023, NCMP_P = 511;
constexpr float LN_EPS = 1e-5f;
constexpr float DN_ALPHA = 1.189207115002721f;
constexpr size_t OFF0 = 0, OFF1 = OFF0 + (size_t)MP * D, OFF2 = OFF1 + (size_t)MS * D, OFF3 = OFF2 + (size_t)MP * 256, OFF4 = OFF3 + (size_t)MP * 256,
                 OFF5 = OFF4 + (size_t)NBATCH * 512 * 256, OFF6 = OFF5 + (size_t)NBATCH * 8 * 128 * 64, OFF7 = OFF6 + (size_t)MS * 256, OFF8 = OFF7 + (size_t)MS * 256,
                 OFF9 = OFF8 + (size_t)MS * 512 * 256, OUT_TOTAL = OFF9 + (size_t)MS * 8 * 128 * 64;
constexpr size_t MiB = 1u << 20;
constexpr size_t al(size_t x) { return (x + MiB - 1) / MiB * MiB; }
constexpr size_t WS_CTL = 0, CTL_ZERO_BYTES = 1 * MiB;
constexpr size_t WS_WIN = 2 * MiB;
constexpr size_t WS_WA = WS_WIN + al((size_t)NIN * D * 2);
constexpr size_t WS_WB = WS_WA + al((size_t)D * 512 * 2);
constexpr size_t WS_WO = WS_WB + al((size_t)D * 512 * 2);
constexpr size_t WS_WUP = WS_WO + al((size_t)D * D * 2);
constexpr size_t WS_WDN = WS_WUP + al((size_t)FF * D * 2);
constexpr size_t WS_WC = WS_WDN + al((size_t)FF * D * 2);
constexpr size_t WS_SMALL = WS_WC + al((size_t)2 * 64 * 2048 * 2);
constexpr size_t WS_XB = WS_SMALL + MiB;
constexpr size_t WS_HB = WS_XB + al((size_t)MALL * D * 2);
constexpr size_t WS_KCP = WS_HB + al((size_t)MALL * NIN * 2);
constexpr size_t WS_VCTP = WS_KCP + MiB;
constexpr size_t WS_KCVS = WS_VCTP + MiB;
constexpr size_t WS_VST = WS_KCVS + al((size_t)MS * 1024 * 256 * 4);
constexpr size_t WS_VWT = WS_VST + al((size_t)4 * 64 * T * 2);
constexpr size_t WS_OA = WS_VWT + al((size_t)4 * 64 * T * 2);
constexpr size_t WS_OB = WS_OA + al((size_t)MALL * 512 * 2);
constexpr size_t WS_HGL = WS_OB + al((size_t)MALL * 512 * 2);
constexpr size_t WS_HGD = WS_HGL + al((size_t)16 * 16 * 8192 * 4);
constexpr size_t WS_TB = WS_HGD + MiB;
constexpr size_t WS_MG = WS_TB + al((size_t)MALL * D * 4);
constexpr size_t WS_Z1 = WS_MG + al((size_t)MALL * D * 2);
constexpr size_t WS_X1F = WS_Z1 + al((size_t)MALL * D * 4);
constexpr size_t WS_X1B = WS_X1F + al((size_t)MALL * D * 4);
constexpr size_t WS_UB = WS_X1B + al((size_t)MALL * D * 2);
constexpr size_t WS_Z2 = WS_UB + al((size_t)MALL * FF * 2);
constexpr size_t WS_END = WS_Z2 + al((size_t)MALL * D * 4);
constexpr int CW_TMO = 0, CW_CODE = 1, CW_BAR = 4096;
constexpr int RING_OFF = 0, RING_BYTES = 131072;
constexpr int LDSCTL_OFF = RING_BYTES, MISC_OFF = LDSCTL_OFF + 320;
constexpr int LDS_BYTES = 147456;

namespace pg8 {
struct EpiInProj {
    static constexpr bool PERM = true, AFTER_DRAIN = false;
    bf16_t* HB; float* out;
    __device__ __forceinline__ void operator()(const f32x4 (&acc)[2][2][4][2], const Unit& u, int wr, int wc, int fr, int fq) const {
        const int row0 = u.pm * BM + wr * 64 + fr, cc0 = wc * 32 + 8 * fq, col0 = u.pn * BM + cc0;
#pragma unroll
        for (int ai = 0; ai < 2; ++ai)
#pragma unroll
            for (int m = 0; m < 4; ++m) {
                const int r = row0 + ai * HALF + m * 16;
                bf16_t* rowp = HB + (size_t)r * NIN + col0;
                float* fdst = nullptr;
                if (u.pn == 2) { if (r < MP) fdst = out + OFF2 + (size_t)r * 256; else if (r < MP + MS) fdst = out + OFF6 + (size_t)(r - MP) * 256; }
                else if (u.pn == 3) { if (r < MP) fdst = out + OFF3 + (size_t)r * 256; else if (r < MP + MS) fdst = out + OFF7 + (size_t)(r - MP) * 256; }
                else if (u.pn == 4) { if (r < MP) { const int t = r & (T - 1), b = r >> 13; if (t >= T - 512) fdst = out + OFF4 + (size_t)(b * 512 + t - (T - 512)) * 256; }
                                      else if (r < MP + MS) fdst = out + OFF8 + ((size_t)(r - MP) * 512 + 511) * 256; }
#pragma unroll
                for (int bj = 0; bj < 2; ++bj) { const f32x4 v0 = acc[ai][bj][m][0], v1 = acc[ai][bj][m][1];
                    u32x4 w; w.x = cvt_pk_bf16(v0[0], v0[1]); w.y = cvt_pk_bf16(v0[2], v0[3]); w.z = cvt_pk_bf16(v1[0], v1[1]); w.w = cvt_pk_bf16(v1[2], v1[3]);
                    *(u32x4*)(rowp + bj * HALF) = w;
                    if (fdst) { *(f32x4*)(fdst + cc0 + bj * HALF) = v0; *(f32x4*)(fdst + cc0 + bj * HALF + 4) = v1; } }
            }
    }
};
}

struct Frame {
    LAS unsigned char* lds;
    volatile LAS unsigned* MISC;
    gu32* ctl;
    int tid, lane, wave;
    int vcu, G;
    const float* in[21]; float* out; unsigned char* ws;
};
__device__ __forceinline__ float bf2f(unsigned short b) { return __uint_as_float(((unsigned)b) << 16); }
typedef float f32x2_t __attribute__((ext_vector_type(2))); typedef __bf16 bf16x2_t __attribute__((ext_vector_type(2)));
__device__ __forceinline__ unsigned cvtpk(float lo, float hi) { f32x2_t v = {lo, hi}; bf16x2_t b = __builtin_convertvector(v, bf16x2_t); return __builtin_bit_cast(unsigned, b); }
__device__ __forceinline__ float wave_sum(float v) {
#pragma unroll
    for (int o = 1; o < 64; o <<= 1) v += __shfl_xor(v, o);
    return v;
}
__device__ __forceinline__ float sigmoidf_(float x) { return 1.0f / (1.0f + __expf(-x)); }

__device__ __forceinline__ void p0_transpose_item(const float* W, int K, int Nsrc, bf16* WT, int k0, int n0, int s0, int nvalid, LAS float* scr, int lane) {
#pragma unroll 8
    for (int i = 0; i < 32; ++i) { const int kk = 2 * i + (lane >> 5), c = lane & 31; scr[kk * 33 + c] = (c < nvalid) ? W[(size_t)(k0 + kk) * Nsrc + s0 + c] : 0.f; }
    LDS_WAIT(); asm volatile("" ::: "memory");
    const int c = lane & 7;
#pragma unroll
    for (int j = 0; j < 4; ++j) { const int n = (lane >> 3) + 8 * j; const LAS float* s = scr + (8 * c) * 33 + n;
        v4u o; o.x = pk2(s[0 * 33], s[1 * 33]); o.y = pk2(s[2 * 33], s[3 * 33]); o.z = pk2(s[4 * 33], s[5 * 33]); o.w = pk2(s[6 * 33], s[7 * 33]);
        *(GAS v4u*)(WT + (size_t)(n0 + n) * K + k0 + 8 * c) = o; }
    LDS_WAIT(); asm volatile("" ::: "memory");
}
__device__ __forceinline__ void p0_prologue(Frame& F) {
    LAS float* scr = (LAS float*)(F.lds + RING_OFF + F.wave * 16384);
    const int gw = F.vcu * NWAVES + F.wave, NGW = F.G * NWAVES, lane = F.lane;
    bf16* WinT = (bf16*)(F.ws + WS_WIN); bf16* WaT = (bf16*)(F.ws + WS_WA); bf16* WbT = (bf16*)(F.ws + WS_WB); bf16* WoT = (bf16*)(F.ws + WS_WO);
    bf16* WupT = (bf16*)(F.ws + WS_WUP); bf16* WdnT = (bf16*)(F.ws + WS_WDN); bf16* WcT = (bf16*)(F.ws + WS_WC);
    float* small = (float*)(F.ws + WS_SMALL);
    constexpr int I_IN = (D / 64) * (NIN / 32), I_A = (512 / 64) * (D / 32), I_O = (D / 64) * (D / 32), I_UP = (D / 64) * (FF / 32), I_DN = (FF / 64) * (D / 32), I_C = 2 * (2048 / 64) * 2;
    constexpr int I_T = I_IN + 2 * I_A + I_O + I_UP + I_DN + I_C;
    constexpr int I_X = MALL;
    constexpr int I_CB = 64;
    constexpr int I_LB = 16;
    constexpr int I_W8 = MS * 511;
    constexpr int I_Z = 2 * (MALL - MP - MS);
    constexpr int NITEMS = I_T + I_X + I_CB + I_LB + I_W8 + I_Z;
    for (int it = gw; it < NITEMS; it += NGW) {
        int r = it;
        if (r < I_T) {
            if (r < I_IN) { const int nblk = NIN / 32, kb = r / nblk, nb = r % nblk, n0 = 32 * nb; int s0, nv;
                if (n0 < 1280) { s0 = n0; nv = 32; } else if (n0 < 6400) { s0 = n0 + 24; nv = 32; } else if (n0 == 6400) { s0 = 1280; nv = 24; } else { s0 = 0; nv = 0; }
                p0_transpose_item(F.in[7], D, 6424, WinT, 64 * kb, n0, s0, nv, scr, lane); continue; } r -= I_IN;
            if (r < I_A) { const int nblk = D / 32, kb = r / nblk, nb = r % nblk; p0_transpose_item(F.in[12], 512, D, WaT, 64 * kb, 32 * nb, 32 * nb, 32, scr, lane); continue; } r -= I_A;
            if (r < I_A) { const int nblk = D / 32, kb = r / nblk, nb = r % nblk; p0_transpose_item(F.in[13], 512, D, WbT, 64 * kb, 32 * nb, 32 * nb, 32, scr, lane); continue; } r -= I_A;
            if (r < I_O) { const int nblk = D / 32, kb = r / nblk, nb = r % nblk; p0_transpose_item(F.in[14], D, D, WoT, 64 * kb, 32 * nb, 32 * nb, 32, scr, lane); continue; } r -= I_O;
            if (r < I_UP) { const int nblk = FF / 32, kb = r / nblk, nb = r % nblk; p0_transpose_item(F.in[17], D, FF, WupT, 64 * kb, 32 * nb, 32 * nb, 32, scr, lane); continue; } r -= I_UP;
            if (r < I_DN) { const int nblk = D / 32, kb = r / nblk, nb = r % nblk; p0_transpose_item(F.in[18], FF, D, WdnT, 64 * kb, 32 * nb, 32 * nb, 32, scr, lane); continue; } r -= I_DN;
            { const int c = r / 64, q = r % 64, kb = q / 2, nb = q % 2;
              p0_transpose_item(F.in[8] + (size_t)c * 2048 * 64, 2048, 64, WcT + (size_t)c * 64 * 2048, 64 * kb, 32 * nb, 32 * nb, 32, scr, lane); continue; }
        }
        r -= I_T;
        if (r < I_X) {
            const float* src = r < MP ? F.in[0] + (size_t)r * D : (r < MP + MS ? F.in[1] + (size_t)(r - MP) * D : nullptr);
            bf16* dst = (bf16*)(F.ws + WS_XB) + (size_t)r * D;
#pragma unroll
            for (int j = 0; j < 4; ++j) { f32x4 v = src ? *((const GAS f32x4*)src + lane + 64 * j) : (f32x4){0.f, 0.f, 0.f, 0.f};
                *((GAS unsigned long long*)dst + lane + 64 * j) = (unsigned long long)pk2(v.x, v.y) | ((unsigned long long)pk2(v.z, v.w) << 32); }
            continue;
        }
        r -= I_X;
        if (r < I_CB) {
            const int c = r >> 5, l = r & 31; const float* pos = F.in[9] + ((size_t)c * 32 + l) * 64; const float* w = F.in[8] + (((size_t)c * 32 + l) * 64) * 64;
            float s = 0.f;
            for (int d = 0; d < 64; ++d) s += pos[d] * w[(size_t)d * 64 + lane];
            small[(c * 32 + l) * 64 + lane] = s; continue;
        }
        r -= I_CB;
        if (r < I_LB) { const int i = r * 64 + lane; const float l0 = F.in[10][i], l1 = F.in[10][1024 + i]; small[4096 + i] = 1.0f / (1.0f + expf(l1 - l0)); continue; }
        r -= I_LB;
        if (r < I_W8) { const int b = r / 511, i = r % 511;
            const GAS f32x4* s = (const GAS f32x4*)(F.in[4] + ((size_t)b * 512 + i + 1) * 256); GAS f32x4* d = (GAS f32x4*)(F.out + OFF8 + ((size_t)b * 512 + i) * 256);
            d[lane] = s[lane]; continue; }
        r -= I_W8;
        { const int half = I_Z / 2, which = r / half, row = MP + MS + r % half; bf16* o = (bf16*)(F.ws + (which ? WS_OB : WS_OA)) + (size_t)row * 512;
          *((GAS v4u*)o + lane) = (v4u){0u, 0u, 0u, 0u}; }
    }
}
typedef float f32x16 __attribute__((ext_vector_type(16)));
typedef short s16x4 __attribute__((ext_vector_type(4)));
typedef unsigned u32x2 __attribute__((ext_vector_type(2)));
#define MFMA32(a, b, c) __builtin_amdgcn_mfma_f32_32x32x16_bf16((a), (b), (c), 0, 0, 0)
__device__ __forceinline__ int crow(int reg, int h) { return (reg & 3) + 8 * (reg >> 2) + 4 * h; }
__device__ __forceinline__ bf16x8 pack8(f32x4 a, f32x4 b) { v4u p; p.x = cvtpk(a.x, a.y); p.y = cvtpk(a.z, a.w); p.z = cvtpk(b.x, b.y); p.w = cvtpk(b.z, b.w); return __builtin_bit_cast(bf16x8, p); }
#define PACK_STEP(x, s) pack8((f32x4){(x)[8 * (s)], (x)[8 * (s) + 1], (x)[8 * (s) + 2], (x)[8 * (s) + 3]}, (f32x4){(x)[8 * (s) + 4], (x)[8 * (s) + 5], (x)[8 * (s) + 6], (x)[8 * (s) + 7]})
__device__ __forceinline__ bf16x8 join44(s16x4 lo, s16x4 hi) { return __builtin_shufflevector(lo, hi, 0, 1, 2, 3, 4, 5, 6, 7); }

constexpr int CT_PROMPT = NBATCH * 2 * 32, CT_SAMPLE = MS * 2 * 64, CT_ALL = CT_PROMPT + CT_SAMPLE;
__device__ __forceinline__ void compress_task(Frame& F, int task) {
    const int lane = F.lane, m = lane & 31, h = lane >> 5, ii = m & 15, g = m >> 4;
    const bool prompt = task < CT_PROMPT;
    int b, c, ig, nblk, tsrc;
    if (prompt) { b = task >> 6; c = (task >> 5) & 1; ig = task & 31; nblk = NCMP_P; tsrc = T; }
    else { const int t2 = task - CT_PROMPT; b = t2 >> 7; c = (t2 >> 6) & 1; ig = t2 & 63; nblk = NCMP_S; tsrc = PAST; }
    const int* pt = (const int*)F.in[6] + b * NPAGES;
    const bf16* WcT = (const bf16*)(F.ws + WS_WC) + (size_t)c * 64 * 2048;
    const float* small = (const float*)(F.ws + WS_SMALL);
    f32x16 acc0, acc1;
#pragma unroll
    for (int i = 0; i < 16; ++i) { acc0[i] = 0.f; acc1[i] = 0.f; }
    const int blk = ig * 16 + ii;
    for (int l = 0; l < 32; ++l) {
        int t = 16 * blk + l; t = t < tsrc ? t : tsrc - 1;
        const float* rowp = prompt ? F.out + OFF2 + ((size_t)b * T + t) * 256 : F.in[2] + ((size_t)pt[t >> 7] * 128 + (t & 127)) * 256;
        const float* ap = rowp + c * 128 + g * 64 + 8 * h;
        const bf16* bp = WcT + (size_t)m * 2048 + l * 64 + 8 * h;
#pragma unroll
        for (int dc = 0; dc < 4; ++dc) {
            const f32x4 a0 = *(const GAS f32x4*)(ap + dc * 16), a1 = *(const GAS f32x4*)(ap + dc * 16 + 4);
            const bf16x8 A = pack8(a0, a1);
            const bf16x8 B0 = *(const GAS bf16x8*)(bp + dc * 16), B1 = *(const GAS bf16x8*)(bp + 32 * 2048 + dc * 16);
            acc0 = MFMA32(A, B0, acc0); acc1 = MFMA32(A, B1, acc1);
        }
    }
    float be0 = 0.f, be1 = 0.f;
    for (int l = 0; l < 32; ++l) { be0 += small[(c * 32 + l) * 64 + m]; be1 += small[(c * 32 + l) * 64 + 32 + m]; }
#pragma unroll
    for (int v = 0; v < 16; ++v) {
        const int mr = crow(v, h), oi = mr & 15, og = mr >> 4, ob = ig * 16 + oi;
        if (ob < nblk) {
            const float v0 = acc0[v] + be0, v1 = acc1[v] + be1;
            if (prompt) {
                if (c == 0) { bf16* kc = (bf16*)(F.ws + WS_KCP) + ((size_t)(b * 2 + og) * 512 + ob) * 64; kc[m] = (bf16)f2bf(v0); kc[32 + m] = (bf16)f2bf(v1); }
                else { bf16* vc = (bf16*)(F.ws + WS_VCTP) + (size_t)(b * 2 + og) * 64 * 512 + ob; vc[(size_t)m * 512] = (bf16)f2bf(v0); vc[(size_t)(32 + m) * 512] = (bf16)f2bf(v1); }
            } else {
                float* o = (float*)(F.ws + WS_KCVS) + ((size_t)b * 1024 + ob) * 256 + c * 128 + og * 64; o[m] = v0; o[32 + m] = v1;
            }
        }
    }
}
constexpr int VT_ITEMS = 2 * 2 * 2 * 128;
__device__ __forceinline__ void vt_item(Frame& F, int it) {
    const int tensor = it >> 9, b = (it >> 8) & 1, g = (it >> 7) & 1, tb = it & 127, lane = F.lane;
    const bf16* src = (const bf16*)(F.ws + WS_HB) + (size_t)(b * T + tb * 64 + lane) * NIN + (tensor ? C_KVW : C_KVS) + 128 + g * 64;
    bf16* dst = (bf16*)(F.ws + (tensor ? WS_VWT : WS_VST)) + (size_t)(b * 2 + g) * 64 * T + tb * 64 + lane;
    v4u r[8];
#pragma unroll
    for (int i = 0; i < 8; ++i) r[i] = *((const GAS v4u*)src + i);
#pragma unroll
    for (int i = 0; i < 8; ++i) {
        const unsigned w[4] = {r[i].x, r[i].y, r[i].z, r[i].w};
#pragma unroll
        for (int j = 0; j < 4; ++j) { dst[(size_t)(i * 8 + 2 * j) * T] = (bf16)(w[j] & 0xffffu); dst[(size_t)(i * 8 + 2 * j + 1) * T] = (bf16)(w[j] >> 16); }
    }
}

constexpr int HG_SEG = 512, HG_NSEG = T / HG_SEG, HG_CH = 32;
constexpr int HL_QT = 0, HL_KT = 8704, HL_KD = 17408, HL_VT = 27648, HL_DEC = 32768, HL_PSUM = 33280, HL_SLAB = 35328, HL_END = HL_SLAB + 4 * 32 * 272;
static_assert(HL_END <= RING_BYTES, "hgrn lds");
template <int MODE> __device__ __forceinline__ void hgrn_segment(Frame& F, int bh, int seg) {
    int tid = F.tid; asm volatile("" : "+v"(tid));
    const int lane = tid & 63, w = F.wave, kt = w >> 1, vt = w & 1, h5 = lane >> 5, l31 = lane & 31;
    const int b = bh >> 3, hh = bh & 7;
    LAS unsigned char* L = F.lds + RING_OFF;
    const bf16* HB = (const bf16*)(F.ws + WS_HB);
    const float* small = (const float*)(F.ws + WS_SMALL);
    float* HGL = (float*)(F.ws + WS_HGL); float* HGD = (float*)(F.ws + WS_HGD);
    f32x16 S;
#pragma unroll
    for (int i = 0; i < 16; ++i) S[i] = 0.f;
    if (MODE == 1) {
        for (int i = 0; i < seg; ++i) {
            const float* Lp = HGL + ((size_t)(bh * HG_NSEG + i)) * 8192 + w * 1024 + lane; const float* Dp = HGD + (size_t)(bh * HG_NSEG + i) * 128 + 32 * kt;
#pragma unroll
            for (int v = 0; v < 16; ++v) S[v] = S[v] * Dp[crow(v, h5)] + Lp[v * 64];
        }
    }
    const int k = tid & 127, q4 = tid >> 7;
    const float lb = small[4096 + hh * 128 + k];
    float lcsum = 0.f;
    for (int ch = 0; ch < HG_SEG / HG_CH; ++ch) {
        const int row0 = b * T + seg * HG_SEG + ch * HG_CH;
        float kk[8], cs[8]; float run = 0.f;
#pragma unroll
        for (int j = 0; j < 8; ++j) {
            const float x = bf2f(HB[(size_t)(row0 + 8 * q4 + j) * NIN + C_FB + hh * 128 + k]);
            const float e = __expf(-x), sg = 1.0f / (1.0f + e), om = e / (1.0f + e);
            const float f = lb + (1.0f - lb) * sg; kk[j] = (1.0f - lb) * om; run += __logf(f); cs[j] = run;
        }
        ((LAS float*)(L + HL_PSUM))[q4 * 128 + k] = run;
        __syncthreads();
        float off = 0.f, tot = 0.f;
#pragma unroll
        for (int q = 0; q < 4; ++q) { const float p = ((LAS float*)(L + HL_PSUM))[q * 128 + k]; tot += p; if (q < q4) off += p; }
#pragma unroll
        for (int j = 0; j < 8; ++j) {
            const int s = 8 * q4 + j; const float lc = off + cs[j];
            if (MODE == 1) {
                const float qv = bf2f(HB[(size_t)(row0 + s) * NIN + C_QB + hh * 128 + k]);
                ((LAS bf16*)(L + HL_QT))[s * 136 + k] = (bf16)f2bf(qv * __expf(lc));
                ((LAS bf16*)(L + HL_KT))[s * 136 + k] = (bf16)f2bf(kk[j] * __expf(-lc));
            }
            ((LAS bf16*)(L + HL_KD))[k * 40 + s] = (bf16)f2bf(kk[j] * __expf(tot - lc));
        }
        if (q4 == 0) { ((LAS float*)(L + HL_DEC))[k] = __expf(tot); lcsum += tot; }
        { const int s = tid >> 4, vq = tid & 15;
          const u32x2 vv = *(const GAS u32x2*)(HB + (size_t)(row0 + s) * NIN + C_IB + hh * 64 + 4 * vq);
          LAS bf16* vtp = (LAS bf16*)(L + HL_VT);
          vtp[(4 * vq + 0) * 40 + s] = (bf16)(vv.x & 0xffffu); vtp[(4 * vq + 1) * 40 + s] = (bf16)(vv.x >> 16);
          vtp[(4 * vq + 2) * 40 + s] = (bf16)(vv.y & 0xffffu); vtp[(4 * vq + 3) * 40 + s] = (bf16)(vv.y >> 16); }
        __syncthreads();
        if (MODE == 1) {
            f32x16 oacc;
#pragma unroll
            for (int i = 0; i < 16; ++i) oacc[i] = 0.f;
            if (kt == 0) {
                f32x16 at;
#pragma unroll
                for (int i = 0; i < 16; ++i) at[i] = 0.f;
#pragma unroll
                for (int ks = 0; ks < 8; ++ks) {
                    const bf16x8 a = *(const LAS bf16x8*)(L + HL_KT + l31 * 272 + (16 * ks + 8 * h5) * 2);
                    const bf16x8 bq = *(const LAS bf16x8*)(L + HL_QT + l31 * 272 + (16 * ks + 8 * h5) * 2);
                    at = MFMA32(a, bq, at);
                }
#pragma unroll
                for (int i = 0; i < 16; ++i) at[i] = (crow(i, h5) <= l31) ? at[i] : 0.f;
#pragma unroll
                for (int kq = 0; kq < 2; ++kq) {
                    const s16x4 lo = *(const LAS s16x4*)(L + HL_VT + (32 * vt + l31) * 80 + (16 * kq + 4 * h5) * 2);
                    const s16x4 hi = *(const LAS s16x4*)(L + HL_VT + (32 * vt + l31) * 80 + (16 * kq + 8 + 4 * h5) * 2);
                    oacc = MFMA32(join44(lo, hi), PACK_STEP(at, kq), oacc);
                }
            }
#pragma unroll
            for (int kq = 0; kq < 2; ++kq) {
                const s16x4 lo = *(const LAS s16x4*)(L + HL_QT + l31 * 272 + (32 * kt + 16 * kq + 4 * h5) * 2);
                const s16x4 hi = *(const LAS s16x4*)(L + HL_QT + l31 * 272 + (32 * kt + 16 * kq + 8 + 4 * h5) * 2);
                oacc = MFMA32(PACK_STEP(S, kq), join44(lo, hi), oacc);
            }
#pragma unroll
            for (int a = 0; a < 4; ++a)
                *(LAS f32x4*)(L + HL_SLAB + (kt * 32 + l31) * 272 + (32 * vt + 8 * a + 4 * h5) * 4) = (f32x4){oacc[4 * a], oacc[4 * a + 1], oacc[4 * a + 2], oacc[4 * a + 3]};
        }
        {
#pragma unroll
            for (int a = 0; a < 4; ++a) { const f32x4 d = *(const LAS f32x4*)(L + HL_DEC + (32 * kt + 8 * a + 4 * h5) * 4);
                S[4 * a] *= d.x; S[4 * a + 1] *= d.y; S[4 * a + 2] *= d.z; S[4 * a + 3] *= d.w; }
#pragma unroll
            for (int kq = 0; kq < 2; ++kq) {
                const bf16x8 a = *(const LAS bf16x8*)(L + HL_KD + (32 * kt + l31) * 80 + (16 * kq + 8 * h5) * 2);
                const bf16x8 bv = *(const LAS bf16x8*)(L + HL_VT + (32 * vt + l31) * 80 + (16 * kq + 8 * h5) * 2);
                S = MFMA32(a, bv, S);
            }
        }
        __syncthreads();
        if (MODE == 1) {
            const int t = tid >> 4, vq = tid & 15;
            f32x4 o = (f32x4){0.f, 0.f, 0.f, 0.f};
#pragma unroll
            for (int q = 0; q < 4; ++q) o += *(const LAS f32x4*)(L + HL_SLAB + (q * 32 + t) * 272 + 16 * vq);
            float ss = (o.x * o.x + o.y * o.y) + (o.z * o.z + o.w * o.w);
            ss += __shfl_xor(ss, 1); ss += __shfl_xor(ss, 2); ss += __shfl_xor(ss, 4); ss += __shfl_xor(ss, 8);
            const float rs = 1.0f / sqrtf(ss * (1.0f / 64.0f) + LN_EPS);
            const f32x4 ng = *(const GAS f32x4*)(F.in[11] + 4 * vq);
            const u32x2 gv = *(const GAS u32x2*)(HB + (size_t)(row0 + t) * NIN + C_GB + hh * 64 + 4 * vq);
            const float g0 = bf2f(gv.x & 0xffffu), g1 = bf2f(gv.x >> 16), g2 = bf2f(gv.y & 0xffffu), g3 = bf2f(gv.y >> 16);
            u32x2 ow; ow.x = cvtpk(o.x * rs * ng.x * g0 * sigmoidf_(g0), o.y * rs * ng.y * g1 * sigmoidf_(g1)); ow.y = cvtpk(o.z * rs * ng.z * g2 * sigmoidf_(g2), o.w * rs * ng.w * g3 * sigmoidf_(g3));
            *(GAS u32x2*)((bf16*)(F.ws + WS_OB) + (size_t)(row0 + t) * 512 + hh * 64 + 4 * vq) = ow;
        }
    }
    if (MODE == 0) {
        float* Lp = HGL + ((size_t)(bh * HG_NSEG + seg)) * 8192 + w * 1024 + lane;
#pragma unroll
        for (int v = 0; v < 16; ++v) Lp[v * 64] = S[v];
        if (q4 == 0) HGD[(size_t)(bh * HG_NSEG + seg) * 128 + k] = __expf(lcsum);
    } else if (seg == HG_NSEG - 1) {
        float* o = F.out + OFF5 + (size_t)bh * 8192;
#pragma unroll
        for (int v = 0; v < 16; ++v) o[(32 * kt + crow(v, h5)) * 64 + 32 * vt + l31] = S[v];
    }
    __syncthreads();
}
__device__ __forceinline__ void hgrn_sample_unit(Frame& F, int unit) {
    const int b = unit >> 3, hh = unit & 7, tid = F.tid, v = tid & 63, kq = tid >> 6;
    const bf16* HB = (const bf16*)(F.ws + WS_HB) + (size_t)(MP + b) * NIN;
    const float* small = (const float*)(F.ws + WS_SMALL);
    const float* st = F.in[5] + (size_t)(b * 8 + hh) * 8192; float* so = F.out + OFF9 + (size_t)(b * 8 + hh) * 8192;
    const float vv = bf2f(HB[C_IB + hh * 64 + v]);
    float po = 0.f;
#pragma unroll 4
    for (int j = 0; j < 16; ++j) {
        const int k = kq * 16 + j; const float x = bf2f(HB[C_FB + hh * 128 + k]), lb = small[4096 + hh * 128 + k];
        const float e = __expf(-x), sg = 1.0f / (1.0f + e), om = e / (1.0f + e);
        const float f = lb + (1.0f - lb) * sg, kx = (1.0f - lb) * om;
        const float sn = f * st[k * 64 + v] + kx * vv; so[k * 64 + v] = sn;
        po += bf2f(HB[C_QB + hh * 128 + k]) * sn;
    }
    LAS float* red = (LAS float*)(F.lds + RING_OFF);
    red[kq * 64 + v] = po;
    __syncthreads();
    if (tid < 64) {
        float o = 0.f;
#pragma unroll
        for (int q = 0; q < 8; ++q) o += red[q * 64 + v];
        const float ss = wave_sum(o * o), rs = 1.0f / sqrtf(ss * (1.0f / 64.0f) + LN_EPS);
        const float g = bf2f(HB[C_GB + hh * 64 + v]);
        ((bf16*)(F.ws + WS_OB))[(size_t)(MP + b) * 512 + hh * 64 + v] = (bf16)f2bf(o * rs * F.in[11][v] * g * sigmoidf_(g));
    }
    __syncthreads();
}
__device__ __forceinline__ void p2_phase(Frame& F) {
    for (int u = blockIdx.x; u < 16 * (HG_NSEG - 1); u += F.G) hgrn_segment<0>(F, u / (HG_NSEG - 1), u % (HG_NSEG - 1));
    for (int u = blockIdx.x; u < MS * 8; u += F.G) hgrn_sample_unit(F, u);
    const int gw = F.vcu * NWAVES + F.wave, NGW = F.G * NWAVES;
    for (int it = gw; it < CT_ALL + VT_ITEMS; it += NGW) { if (it < CT_ALL) compress_task(F, it); else vt_item(F, it - CT_ALL); }
}
constexpr int AL_K = 0, AL_V = 9216, AL_IMP = 18432, AL_SELM = AL_IMP + 64 * 128 * 4, AL_UNI = AL_SELM + 64 * 4 * 4, AL_END = AL_UNI + 16, AL_OT = 52480, AL_OT_END = AL_OT + 8 * 32 * 272;
static_assert(AL_END <= AL_OT && AL_OT_END <= RING_BYTES, "attn lds");
constexpr float LOG2E = 1.4426950408889634f;
#define NEG_INF (-__builtin_inff())

__device__ __forceinline__ void stage_k(LAS unsigned char* L, const bf16* src, size_t pitch, int tid) {
    const int key = tid >> 3, ch = tid & 7;
    *(LAS v4u*)(L + AL_K + key * 144 + ch * 16) = *(const GAS v4u*)(src + (size_t)key * pitch + ch * 8);
}
__device__ __forceinline__ void stage_v(LAS unsigned char* L, const bf16* src, size_t pitch, int tid) {
    const int d = tid >> 3, ch = tid & 7;
    *(LAS v4u*)(L + AL_V + d * 144 + ch * 16) = *(const GAS v4u*)(src + (size_t)d * pitch + ch * 8);
}
__device__ __forceinline__ f32x16 qk_sub(const LAS unsigned char* L, int sub, const bf16x8 (&qf)[4], int l31, int h5) {
    f32x16 acc;
#pragma unroll
    for (int i = 0; i < 16; ++i) acc[i] = 0.f;
#pragma unroll
    for (int s = 0; s < 4; ++s) { const bf16x8 a = *(const LAS bf16x8*)(L + AL_K + (sub * 32 + l31) * 144 + (16 * s + 8 * h5) * 2); acc = MFMA32(a, qf[s], acc); }
    return acc;
}
__device__ __forceinline__ void pv_sub(const LAS unsigned char* L, int sub, const f32x16& p, f32x16 (&O)[2], int l31, int h5) {
#pragma unroll
    for (int kq = 0; kq < 2; ++kq) {
        const bf16x8 pb = PACK_STEP(p, kq);
#pragma unroll
        for (int dt = 0; dt < 2; ++dt) {
            const s16x4 lo = *(const LAS s16x4*)(L + AL_V + (dt * 32 + l31) * 144 + (sub * 32 + 16 * kq + 4 * h5) * 2);
            const s16x4 hi = *(const LAS s16x4*)(L + AL_V + (dt * 32 + l31) * 144 + (sub * 32 + 16 * kq + 8 + 4 * h5) * 2);
            O[dt] = MFMA32(join44(lo, hi), pb, O[dt]);
        }
    }
}
__device__ __forceinline__ void online_update(const LAS unsigned char* L, int sub, f32x16& sc, float& m, float& l, f32x16 (&O)[2], int l31, int h5) {
    float tmax = sc[0];
#pragma unroll
    for (int i = 1; i < 16; ++i) tmax = fmaxf(tmax, sc[i]);
    tmax = fmaxf(tmax, __shfl_xor(tmax, 32));
    const float mnew = fmaxf(m, tmax), ms = (mnew == NEG_INF) ? 0.f : mnew;
    const float alpha = __builtin_amdgcn_exp2f(m - ms);
    float ps = 0.f;
#pragma unroll
    for (int i = 0; i < 16; ++i) { sc[i] = __builtin_amdgcn_exp2f(sc[i] - ms); ps += sc[i]; }
    l = l * alpha + ps; m = mnew;
#pragma unroll
    for (int i = 0; i < 16; ++i) { O[0][i] *= alpha; O[1][i] *= alpha; }
    pv_sub(L, sub, sc, O, l31, h5);
}

__device__ __forceinline__ void nsa_prompt_unit(Frame& F, int unit) {
    const int b = unit >> 8, g = (unit >> 7) & 1, qt = unit & 127, t0 = qt * 64;
    int tid = F.tid; asm volatile("" : "+v"(tid));
    const int lane = tid & 63, w = F.wave, l31 = lane & 31, h5 = lane >> 5, ql = l31 >> 2, r = l31 & 3;
    LAS unsigned char* L = F.lds + RING_OFF;
    const bf16* HB = (const bf16*)(F.ws + WS_HB);
    const int pos = t0 + 8 * w + ql;
    const size_t qrow = (size_t)(b * T + pos);
    const float slope2 = __builtin_amdgcn_exp2f(-(float)(g * 4 + r + 1)) * LOG2E, scale2 = 0.125f * LOG2E;
    bf16x8 qf[4];
#pragma unroll
    for (int s = 0; s < 4; ++s) qf[s] = *(const GAS bf16x8*)(HB + qrow * NIN + C_QA + (g * 4 + r) * 64 + 16 * s + 8 * h5);
    float gate[3];
#pragma unroll
    for (int i = 0; i < 3; ++i) gate[i] = sigmoidf_(bf2f(HB[qrow * NIN + C_GLA + (g * 4 + r) * 3 + i]));
    for (int i = tid; i < (AL_END - AL_IMP) / 4; i += NWAVES * 64) ((LAS unsigned*)(L + AL_IMP))[i] = 0u;
    f32x16 O[2];
    LAS unsigned char* otp = L + AL_OT + (w * 32 + l31) * 272 + 16 * h5;
    const bf16* KCP = (const bf16*)(F.ws + WS_KCP) + (size_t)(b * 2 + g) * 512 * 64;
    const bf16* VCTP = (const bf16*)(F.ws + WS_VCTP) + (size_t)(b * 2 + g) * 64 * 512;
    const int nmax_u = (t0 + 63 - 31) >> 4, ntile_c = (nmax_u >> 6) + 1;
    const int nmax_w = (t0 + 8 * w + 7 - 31) >> 4;
    float m = NEG_INF, l = 0.f;
    for (int tl = 0; tl < ntile_c; ++tl) {
        __syncthreads();
        stage_k(L, KCP + (size_t)tl * 64 * 64, 64, tid);
        __syncthreads();
#pragma unroll
        for (int sub = 0; sub < 2; ++sub) {
            const int n0 = tl * 64 + sub * 32;
            if (n0 > nmax_w) continue;
            f32x16 sc = qk_sub(L, sub, qf, l31, h5);
#pragma unroll
            for (int i = 0; i < 16; ++i) { const int dist = pos - (16 * (n0 + crow(i, h5)) + 31); sc[i] = dist >= 0 ? sc[i] * scale2 - slope2 * (float)dist : NEG_INF; }
            float tmax = sc[0];
#pragma unroll
            for (int i = 1; i < 16; ++i) tmax = fmaxf(tmax, sc[i]);
            tmax = fmaxf(tmax, __shfl_xor(tmax, 32));
            const float mnew = fmaxf(m, tmax), ms = (mnew == NEG_INF) ? 0.f : mnew;
            float ps = 0.f;
#pragma unroll
            for (int i = 0; i < 16; ++i) ps += __builtin_amdgcn_exp2f(sc[i] - ms);
            l = l * __builtin_amdgcn_exp2f(m - ms) + ps; m = mnew;
        }
    }
    l += __shfl_xor(l, 32);
    const float inv_l = l > 0.f ? 1.0f / l : 0.f, mfin = (m == NEG_INF) ? 0.f : m;
#pragma unroll
    for (int i = 0; i < 16; ++i) { O[0][i] = 0.f; O[1][i] = 0.f; }
    for (int tl = 0; tl < ntile_c; ++tl) {
        __syncthreads();
        stage_k(L, KCP + (size_t)tl * 64 * 64, 64, tid);
        stage_v(L, VCTP + tl * 64, 512, tid);
        __syncthreads();
#pragma unroll
        for (int sub = 0; sub < 2; ++sub) {
            const int n0 = tl * 64 + sub * 32;
            if (n0 > nmax_w) continue;
            f32x16 sc = qk_sub(L, sub, qf, l31, h5);
#pragma unroll
            for (int i = 0; i < 16; ++i) { const int dist = pos - (16 * (n0 + crow(i, h5)) + 31); sc[i] = dist >= 0 ? __builtin_amdgcn_exp2f(sc[i] * scale2 - slope2 * (float)dist - mfin) * inv_l : 0.f; }
#pragma unroll
            for (int a = 0; a < 4; ++a) {
                float sm = (sc[4 * a] + sc[4 * a + 1]) + (sc[4 * a + 2] + sc[4 * a + 3]);
                sm += __shfl_xor(sm, 1); sm += __shfl_xor(sm, 2);
                if (r == 0) ((LAS float*)(L + AL_IMP))[(8 * w + ql) * 128 + (n0 >> 2) + 2 * a + h5] = sm;
            }
            pv_sub(L, sub, sc, O, l31, h5);
        }
    }
#pragma unroll
    for (int dt = 0; dt < 2; ++dt)
#pragma unroll
        for (int a = 0; a < 4; ++a) *(LAS f32x4*)(otp + dt * 128 + a * 32) = (f32x4){gate[0] * O[dt][4 * a], gate[0] * O[dt][4 * a + 1], gate[0] * O[dt][4 * a + 2], gate[0] * O[dt][4 * a + 3]};
    __syncthreads();
    {
        const int q = tid >> 3, sub = tid & 7, qpos = t0 + q, cur = qpos >> 6;
        float vals[16]; unsigned avail = 0u, bits = 0u;
#pragma unroll
        for (int i = 0; i < 16; ++i) { const int j = sub * 16 + i; vals[i] = ((LAS float*)(L + AL_IMP))[q * 128 + j];
            if (j <= cur) { if (cur < 16 || j == 0 || j == cur || j == cur - 1) bits |= 1u << i; else avail |= 1u << i; } }
        if (cur >= 16) {
            for (int round = 0; round < 13; ++round) {
                float bv = -1.0f; int bi = 1 << 20;
#pragma unroll
                for (int i = 0; i < 16; ++i) if (((avail >> i) & 1u) && vals[i] > bv) { bv = vals[i]; bi = sub * 16 + i; }
#pragma unroll
                for (int o = 1; o < 8; o <<= 1) { const float ov = __shfl_xor(bv, o); const int oi = __shfl_xor(bi, o); if (ov > bv || (ov == bv && oi < bi)) { bv = ov; bi = oi; } }
                if ((bi >> 4) == sub) { avail &= ~(1u << (bi & 15)); bits |= 1u << (bi & 15); }
            }
        }
        if (bits) { __hip_atomic_fetch_or((LAS unsigned*)(L + AL_SELM) + q * 4 + (sub >> 1), bits << (16 * (sub & 1)), __ATOMIC_RELAXED, __HIP_MEMORY_SCOPE_WORKGROUP); __hip_atomic_fetch_or((LAS unsigned*)(L + AL_UNI) + (sub >> 1), bits << (16 * (sub & 1)), __ATOMIC_RELAXED, __HIP_MEMORY_SCOPE_WORKGROUP); }
    }
    __syncthreads();
    {
        m = NEG_INF; l = 0.f;
#pragma unroll
        for (int i = 0; i < 16; ++i) { O[0][i] = 0.f; O[1][i] = 0.f; }
        const bf16* Ks = HB + (size_t)(b * T) * NIN + C_KVS + g * 64;
        const bf16* Vs = (const bf16*)(F.ws + WS_VST) + (size_t)(b * 2 + g) * 64 * T;
        for (int jw = 0; jw < 4; ++jw) {
            unsigned ub = __builtin_amdgcn_readfirstlane(((LAS unsigned*)(L + AL_UNI))[jw]);
            const unsigned mysel = ((LAS unsigned*)(L + AL_SELM))[(8 * w + ql) * 4 + jw];
            while (ub) {
                const int jb = __builtin_ctz(ub); ub &= ub - 1u;
                const int j = jw * 32 + jb, pos0 = j * 64;
                __syncthreads();
                stage_k(L, Ks + (size_t)pos0 * NIN, NIN, tid);
                stage_v(L, Vs + pos0, T, tid);
                __syncthreads();
                const bool sel = (mysel >> jb) & 1u;
                if (!__any(sel && pos >= pos0)) continue;
#pragma unroll
                for (int sub = 0; sub < 2; ++sub) {
                    f32x16 sc = qk_sub(L, sub, qf, l31, h5);
#pragma unroll
                    for (int i = 0; i < 16; ++i) { const int dist = pos - (pos0 + sub * 32 + crow(i, h5)); sc[i] = (sel && dist >= 0) ? sc[i] * scale2 - slope2 * (float)dist : NEG_INF; }
                    online_update(L, sub, sc, m, l, O, l31, h5);
                }
            }
        }
        l += __shfl_xor(l, 32);
        const float sc_ = l > 0.f ? gate[1] / l : 0.f;
#pragma unroll
        for (int dt = 0; dt < 2; ++dt)
#pragma unroll
            for (int a = 0; a < 4; ++a) { f32x4 t = *(LAS f32x4*)(otp + dt * 128 + a * 32); t += (f32x4){sc_ * O[dt][4 * a], sc_ * O[dt][4 * a + 1], sc_ * O[dt][4 * a + 2], sc_ * O[dt][4 * a + 3]}; *(LAS f32x4*)(otp + dt * 128 + a * 32) = t; }
    }
    {
        m = NEG_INF; l = 0.f;
#pragma unroll
        for (int i = 0; i < 16; ++i) { O[0][i] = 0.f; O[1][i] = 0.f; }
        const bf16* Kw = HB + (size_t)(b * T) * NIN + C_KVW + g * 64;
        const bf16* Vw = (const bf16*)(F.ws + WS_VWT) + (size_t)(b * 2 + g) * 64 * T;
        const int kb_lo = qt >= 8 ? qt - 8 : 0;
        for (int kb = kb_lo; kb <= qt; ++kb) {
            const int pos0 = kb * 64;
            __syncthreads();
            stage_k(L, Kw + (size_t)pos0 * NIN, NIN, tid);
            stage_v(L, Vw + pos0, T, tid);
            __syncthreads();
#pragma unroll
            for (int sub = 0; sub < 2; ++sub) {
                f32x16 sc = qk_sub(L, sub, qf, l31, h5);
#pragma unroll
                for (int i = 0; i < 16; ++i) { const int dist = pos - (pos0 + sub * 32 + crow(i, h5)); sc[i] = (dist >= 0 && dist < 512) ? sc[i] * scale2 - slope2 * (float)dist : NEG_INF; }
                online_update(L, sub, sc, m, l, O, l31, h5);
            }
        }
        l += __shfl_xor(l, 32);
        const float sc_ = l > 0.f ? gate[2] / l : 0.f;
#pragma unroll
        for (int i = 0; i < 16; ++i) { O[0][i] *= sc_; O[1][i] *= sc_; }
    }
    bf16* oa = (bf16*)(F.ws + WS_OA) + qrow * 512 + (g * 4 + r) * 64;
#pragma unroll
    for (int dt = 0; dt < 2; ++dt)
#pragma unroll
        for (int a = 0; a < 4; ++a) { const f32x4 t = *(LAS f32x4*)(otp + dt * 128 + a * 32); u32x2 ow; ow.x = cvtpk(t.x + O[dt][4 * a], t.y + O[dt][4 * a + 1]); ow.y = cvtpk(t.z + O[dt][4 * a + 2], t.w + O[dt][4 * a + 3]);
            *(GAS u32x2*)(oa + dt * 32 + 8 * a + 4 * h5) = ow; }
    __syncthreads();
}

constexpr int SL_SC = 0, SL_Q = 16384, SL_RED = SL_Q + 1024, SL_IMP = SL_RED + 4096, SL_SEL = SL_IMP + 2048, SL_OUT = SL_SEL + 128, SL_END = SL_OUT + 3 * 1024;
__device__ __forceinline__ void block_max4(LAS float* red, float (&v)[4], int wave, int lane) {
#pragma unroll
    for (int r = 0; r < 4; ++r) { float x = v[r];
#pragma unroll
        for (int o = 1; o < 64; o <<= 1) x = fmaxf(x, __shfl_xor(x, o));
        if (lane == 0) red[wave * 4 + r] = x; }
    __syncthreads();
#pragma unroll
    for (int r = 0; r < 4; ++r) { float x = red[r];
#pragma unroll
        for (int q = 1; q < 8; ++q) x = fmaxf(x, red[q * 4 + r]);
        v[r] = x; }
    __syncthreads();
}
__device__ __forceinline__ void block_sum4(LAS float* red, float (&v)[4], int wave, int lane) {
#pragma unroll
    for (int r = 0; r < 4; ++r) { const float x = wave_sum(v[r]); if (lane == 0) red[wave * 4 + r] = x; }
    __syncthreads();
#pragma unroll
    for (int r = 0; r < 4; ++r) { float x = 0.f;
#pragma unroll
        for (int q = 0; q < 8; ++q) x += red[q * 4 + r];
        v[r] = x; }
    __syncthreads();
}
template <int KIND> __device__ __forceinline__ bool key_row(const float* kcvs, const float* csel, const float* cwin, const float* out7, const float* out8, const int* pt, const LAS int* SEL, int b, int g, int kidx, const float*& kp, const float*& vp, int& dist) {
    if (KIND == 0) { const float* base = kcvs + ((size_t)b * 1024 + kidx) * 256 + g * 64; kp = base; vp = base + 128; dist = PAST - (16 * kidx + 31); return true; }
    if (KIND == 1) { const int slot = kidx >> 6, i = kidx & 63, jb = SEL[slot];
        if (jb < 256) { const float* base = csel + ((size_t)pt[jb >> 1] * 128 + (jb & 1) * 64 + i) * 256 + g * 64; kp = base; vp = base + 128; dist = PAST - (jb * 64 + i); return true; }
        const float* base = out7 + (size_t)b * 256 + g * 64; kp = base; vp = base + 128; dist = 0; return i == 0; }
    if (kidx == 0) { kp = vp = cwin; dist = 512; return false; }
    const float* base = kidx < 512 ? cwin + ((size_t)b * 512 + kidx) * 256 + g * 64 : out8 + ((size_t)b * 512 + 511) * 256 + g * 64;
    kp = base; vp = base + 128; dist = 512 - kidx; return true;
}
template <int KIND> __device__ __forceinline__ void sample_branch(Frame& F, int b, int g, int branch_slot) {
    const int tid = F.tid, lane = F.lane, wave = F.wave;
    LAS unsigned char* L = F.lds + RING_OFF;
    LAS float* SC = (LAS float*)(L + SL_SC); LAS float* Q = (LAS float*)(L + SL_Q); LAS float* red = (LAS float*)(L + SL_RED);
    LAS int* SEL = (LAS int*)(L + SL_SEL);
    const int* pt = (const int*)F.in[6] + b * NPAGES;
    const int nkeys = KIND == 0 ? NCMP_S : (KIND == 1 ? 1024 : 513);
    const float* kcvs = (const float*)(F.ws + WS_KCVS); const float* csel = F.in[3]; const float* cwin = F.in[4]; const float* out7 = F.out + OFF7; const float* out8 = F.out + OFF8;
    float mx[4] = {NEG_INF, NEG_INF, NEG_INF, NEG_INF};
    for (int kidx = tid; kidx < 1024; kidx += 512) {
        float s[4] = {NEG_INF, NEG_INF, NEG_INF, NEG_INF};
        if (kidx < nkeys) { const float* kp; const float* vp; int dist;
            if (key_row<KIND>(kcvs, csel, cwin, out7, out8, pt, SEL, b, g, kidx, kp, vp, dist)) {
                float acc[4] = {0.f, 0.f, 0.f, 0.f};
#pragma unroll 4
                for (int d4 = 0; d4 < 16; ++d4) { const f32x4 kv = *(const GAS f32x4*)(kp + 4 * d4);
#pragma unroll
                    for (int r = 0; r < 4; ++r) { const f32x4 qv = *(const LAS f32x4*)(Q + r * 64 + 4 * d4); acc[r] += (kv.x * qv.x + kv.y * qv.y) + (kv.z * qv.z + kv.w * qv.w); } }
#pragma unroll
                for (int r = 0; r < 4; ++r) s[r] = acc[r] * 0.125f - __builtin_amdgcn_exp2f(-(float)(g * 4 + r + 1)) * (float)dist;
            } }
#pragma unroll
        for (int r = 0; r < 4; ++r) { SC[r * 1024 + kidx] = s[r]; mx[r] = fmaxf(mx[r], s[r]); }
    }
    block_max4(red, mx, wave, lane);
    float sm[4] = {0.f, 0.f, 0.f, 0.f};
    for (int kidx = tid; kidx < 1024; kidx += 512)
#pragma unroll
        for (int r = 0; r < 4; ++r) { const float s = SC[r * 1024 + kidx]; const float p = s == NEG_INF ? 0.f : __expf(s - mx[r]); SC[r * 1024 + kidx] = p; sm[r] += p; }
    block_sum4(red, sm, wave, lane);
    for (int kidx = tid; kidx < 1024; kidx += 512)
#pragma unroll
        for (int r = 0; r < 4; ++r) SC[r * 1024 + kidx] *= (sm[r] > 0.f ? 1.0f / sm[r] : 0.f);
    __syncthreads();
    { const int half = tid >> 8, r = (tid >> 6) & 3, d = tid & 63; float o = 0.f;
      for (int kidx = half * 512; kidx < half * 512 + 512; ++kidx) { if (kidx >= nkeys) break; const float p = SC[r * 1024 + kidx]; if (p != 0.f) { const float* kp; const float* vp; int dist; key_row<KIND>(kcvs, csel, cwin, out7, out8, pt, SEL, b, g, kidx, kp, vp, dist); o += p * vp[d]; } }
      red[tid] = o; }
    __syncthreads();
    if (tid < 256) { const int r = tid >> 6; const float gt = sigmoidf_(bf2f(((const bf16*)(F.ws + WS_HB))[(size_t)(MP + b) * NIN + C_GLA + (g * 4 + r) * 3 + branch_slot]));
        ((LAS float*)(L + SL_OUT))[tid] += gt * (red[tid] + red[256 + tid]); }
    __syncthreads();
}
__device__ __forceinline__ void nsa_sample_unit(Frame& F, int unit) {
    const int b = unit >> 1, g = unit & 1, tid = F.tid;
    LAS unsigned char* L = F.lds + RING_OFF;
    LAS float* SC = (LAS float*)(L + SL_SC); LAS float* Q = (LAS float*)(L + SL_Q); LAS float* IMP = (LAS float*)(L + SL_IMP); LAS int* SEL = (LAS int*)(L + SL_SEL);
    __syncthreads();
    if (tid < 256) { Q[tid] = bf2f(((const bf16*)(F.ws + WS_HB))[(size_t)(MP + b) * NIN + C_QA + g * 256 + tid]); ((LAS float*)(L + SL_OUT))[tid] = 0.f; }
    __syncthreads();
    sample_branch<0>(F, b, g, 0);
    if (tid < 257) { float s = 0.f;
#pragma unroll
        for (int c = 0; c < 4; ++c) { const int n = 4 * tid + c; if (n < NCMP_S) s += (SC[n] + SC[1024 + n]) + (SC[2048 + n] + SC[3072 + n]); }
        IMP[tid] = (tid == 0 || tid >= 255) ? -1.0f : s; }
    __syncthreads();
    if (tid < 64) {
        if (tid == 0) { SEL[0] = 0; SEL[1] = 255; SEL[2] = 256; }
        float vals[4]; unsigned avail = 0xfu;
#pragma unroll
        for (int i = 0; i < 4; ++i) { const int j = tid * 4 + i; vals[i] = IMP[j]; if (vals[i] < 0.f) avail &= ~(1u << i); }
        for (int round = 0; round < 13; ++round) {
            float bv = -1.0f; int bi = 1 << 20;
#pragma unroll
            for (int i = 0; i < 4; ++i) if (((avail >> i) & 1u) && vals[i] > bv) { bv = vals[i]; bi = tid * 4 + i; }
#pragma unroll
            for (int o = 1; o < 64; o <<= 1) { const float ov = __shfl_xor(bv, o); const int oi = __shfl_xor(bi, o); if (ov > bv || (ov == bv && oi < bi)) { bv = ov; bi = oi; } }
            if ((bi >> 2) == tid) avail &= ~(1u << (bi & 3));
            if (tid == 0) SEL[3 + round] = bi;
        }
    }
    __syncthreads();
    sample_branch<1>(F, b, g, 1);
    sample_branch<2>(F, b, g, 2);
    if (tid < 256) ((bf16*)(F.ws + WS_OA))[(size_t)(MP + b) * 512 + g * 256 + tid] = (bf16)f2bf(((LAS float*)(L + SL_OUT))[tid]);
    __syncthreads();
}
__device__ __forceinline__ void p3_phase(Frame& F) {
    for (int u = blockIdx.x; u < 16 * HG_NSEG; u += F.G) hgrn_segment<1>(F, u / HG_NSEG, u % HG_NSEG);
    for (int u = blockIdx.x; u < 512; u += F.G) nsa_prompt_unit(F, u);
    for (int u = blockIdx.x; u < 2 * MS; u += F.G) nsa_sample_unit(F, u);
}
namespace pg8 {
typedef unsigned u32x2e __attribute__((ext_vector_type(2)));
__device__ __forceinline__ float bfl(unsigned w) { return __uint_as_float(w << 16); }
__device__ __forceinline__ float bfh(unsigned w) { return __uint_as_float(w & 0xffff0000u); }
__device__ __forceinline__ float sgm(float x) { return 1.0f / (1.0f + __expf(-x)); }
struct EpiGateA {
    static constexpr bool PERM = false, AFTER_DRAIN = false;
    const bf16_t* HBp; float* TB;
    __device__ __forceinline__ void operator()(const f32x4 (&acc)[2][2][4][2], const Unit& u, int wr, int wc, int fr, int fq) const {
        const int row0 = u.pm * BM + wr * 64 + fr, col0 = u.pn * BM + wc * 32 + 4 * fq;
#pragma unroll
        for (int ai = 0; ai < 2; ++ai)
#pragma unroll
            for (int m = 0; m < 4; ++m) { const size_t r = (size_t)(row0 + ai * HALF + m * 16);
#pragma unroll
                for (int bj = 0; bj < 2; ++bj)
#pragma unroll
                    for (int n = 0; n < 2; ++n) { const int c = col0 + bj * HALF + n * 16; const u32x2e gw = *(const u32x2e*)(HBp + r * NIN + C_MG + c); const f32x4 a = acc[ai][bj][m][n];
                        *(f32x4*)(TB + r * D + c) = (f32x4){sgm(bfl(gw.x)) * a[0], sgm(bfh(gw.x)) * a[1], sgm(bfl(gw.y)) * a[2], sgm(bfh(gw.y)) * a[3]}; } }
    }
};
struct EpiGateB {
    static constexpr bool PERM = false, AFTER_DRAIN = false;
    const bf16_t* HBp; const float* TB; bf16_t* MG;
    __device__ __forceinline__ void operator()(const f32x4 (&acc)[2][2][4][2], const Unit& u, int wr, int wc, int fr, int fq) const {
        const int row0 = u.pm * BM + wr * 64 + fr, col0 = u.pn * BM + wc * 32 + 4 * fq;
#pragma unroll
        for (int ai = 0; ai < 2; ++ai)
#pragma unroll
            for (int m = 0; m < 4; ++m) { const size_t r = (size_t)(row0 + ai * HALF + m * 16);
#pragma unroll
                for (int bj = 0; bj < 2; ++bj)
#pragma unroll
                    for (int n = 0; n < 2; ++n) { const int c = col0 + bj * HALF + n * 16; const u32x2e gw = *(const u32x2e*)(HBp + r * NIN + C_MG + D + c); const f32x4 a = acc[ai][bj][m][n]; const f32x4 t = *(const f32x4*)(TB + r * D + c);
                        u32x2e o; o.x = cvt_pk_bf16(t[0] + sgm(bfl(gw.x)) * a[0], t[1] + sgm(bfh(gw.x)) * a[1]); o.y = cvt_pk_bf16(t[2] + sgm(bfl(gw.y)) * a[2], t[3] + sgm(bfh(gw.y)) * a[3]);
                        *(u32x2e*)(MG + r * D + c) = o; } }
    }
};
struct EpiResid {
    static constexpr bool PERM = false, AFTER_DRAIN = false;
    const float* rp; const float* rs; float* Z;
    __device__ __forceinline__ void operator()(const f32x4 (&acc)[2][2][4][2], const Unit& u, int wr, int wc, int fr, int fq) const {
        const int row0 = u.pm * BM + wr * 64 + fr, col0 = u.pn * BM + wc * 32 + 4 * fq;
#pragma unroll
        for (int ai = 0; ai < 2; ++ai)
#pragma unroll
            for (int m = 0; m < 4; ++m) { const int r = row0 + ai * HALF + m * 16; const float* xr = r < MP ? rp + (size_t)r * D : (r < MP + MS ? rs + (size_t)(r - MP) * D : nullptr);
#pragma unroll
                for (int bj = 0; bj < 2; ++bj)
#pragma unroll
                    for (int n = 0; n < 2; ++n) { const int c = col0 + bj * HALF + n * 16; const f32x4 x = xr ? *(const f32x4*)(xr + c) : (f32x4){0.f, 0.f, 0.f, 0.f};
                        *(f32x4*)(Z + (size_t)r * D + c) = x * DN_ALPHA + acc[ai][bj][m][n]; } }
    }
};
struct EpiRelu2 {
    static constexpr bool PERM = true, AFTER_DRAIN = false;
    bf16_t* U;
    __device__ __forceinline__ void operator()(const f32x4 (&acc)[2][2][4][2], const Unit& u, int wr, int wc, int fr, int fq) const {
        const int row0 = u.pm * BM + wr * 64 + fr, col0 = u.pn * BM + wc * 32 + 8 * fq;
#pragma unroll
        for (int ai = 0; ai < 2; ++ai)
#pragma unroll
            for (int m = 0; m < 4; ++m) { bf16_t* rowp = U + (size_t)(row0 + ai * HALF + m * 16) * FF + col0;
#pragma unroll
                for (int bj = 0; bj < 2; ++bj) { f32x4 v0 = acc[ai][bj][m][0], v1 = acc[ai][bj][m][1];
#pragma unroll
                    for (int j = 0; j < 4; ++j) { const float a = fmaxf(v0[j], 0.f), b = fmaxf(v1[j], 0.f); v0[j] = a * a; v1[j] = b * b; }
                    u32x4 w; w.x = cvt_pk_bf16(v0[0], v0[1]); w.y = cvt_pk_bf16(v0[2], v0[3]); w.z = cvt_pk_bf16(v1[0], v1[1]); w.w = cvt_pk_bf16(v1[2], v1[3]);
                    *(u32x4*)(rowp + bj * HALF) = w; } }
    }
};
}
__device__ __forceinline__ void ln_phase(Frame& F, const float* Z, const float* gam, const float* bet, int which) {
    const int gw = F.vcu * NWAVES + F.wave, NGW = F.G * NWAVES, lane = F.lane;
    const int nrows = which ? MP + MS : MALL;
    for (int r = gw; r < nrows; r += NGW) {
        const GAS f32x4* zr = (const GAS f32x4*)(Z + (size_t)r * D) + lane;
        f32x4 v[4]; float s = 0.f;
#pragma unroll
        for (int j = 0; j < 4; ++j) { v[j] = zr[64 * j]; s += (v[j].x + v[j].y) + (v[j].z + v[j].w); }
        const float mean = wave_sum(s) * (1.f / D); float s2 = 0.f;
#pragma unroll
        for (int j = 0; j < 4; ++j) { v[j] = v[j] - mean; s2 += (v[j].x * v[j].x + v[j].y * v[j].y) + (v[j].z * v[j].z + v[j].w * v[j].w); }
        const float rstd = 1.f / sqrtf(wave_sum(s2) * (1.f / D) + LN_EPS);
        float* of = which ? (r < MP ? F.out + OFF0 + (size_t)r * D : F.out + OFF1 + (size_t)(r - MP) * D) : (float*)(F.ws + WS_X1F) + (size_t)r * D;
#pragma unroll
        for (int j = 0; j < 4; ++j) { const f32x4 gg = *((const GAS f32x4*)gam + lane + 64 * j), bb = *((const GAS f32x4*)bet + lane + 64 * j);
            v[j] = v[j] * rstd * gg + bb; *((GAS f32x4*)of + lane + 64 * j) = v[j]; }
        if (!which) { GAS unsigned long long* o8 = (GAS unsigned long long*)((bf16*)(F.ws + WS_X1B) + (size_t)r * D) + lane;
#pragma unroll
            for (int j = 0; j < 4; ++j) o8[64 * j] = (unsigned long long)pk2(v[j].x, v[j].y) | ((unsigned long long)pk2(v[j].z, v[j].w) << 32); }
    }
}

#ifdef PROBE_LAST
#ifndef PROBE_BASE
#define PROBE_BASE WS_KCP
#endif
#ifndef PROBE_BYTES
#define PROBE_BYTES (WS_TB - WS_KCP)
#endif
__device__ __forceinline__ void probe_digest(Frame& F, const XcdBarrier& bar) {
    const size_t i0 = (size_t)blockIdx.x * 512 + F.tid, st = (size_t)F.G * 512;
    for (size_t i = i0; i < OUT_TOTAL; i += st) F.out[i] = 0.f;
    xcd_barrier(bar);
    const unsigned* w = (const unsigned*)(F.ws + PROBE_BASE); const size_t nw = (size_t)(PROBE_BYTES) / 4;
    unsigned h = 0u;
    for (size_t i = i0; i < nw; i += st) h += (w[i] ^ (unsigned)i) * 2654435761u;
#pragma unroll
    for (int o = 1; o < 64; o <<= 1) h += __shfl_xor(h, o);
    if (F.lane == 0) F.out[(size_t)blockIdx.x * 8 + F.wave] = (float)(h & 0xFFFFFu);
}
#endif
struct Args { const float* in[21]; float* out; unsigned char* ws; int ph_lo, ph_hi; };
__global__ void __launch_bounds__(NWAVES * 64, 2) nsa_fwd(Args args) {
    extern __shared__ __attribute__((aligned(16))) unsigned char lds[];
    Frame F;
    F.lds = (LAS unsigned char*)lds;
    F.MISC = (volatile LAS unsigned*)(F.lds + MISC_OFF);
    F.tid = threadIdx.x; F.lane = F.tid & 63; F.wave = __builtin_amdgcn_readfirstlane(F.tid >> 6);
    F.G = gridDim.x; { const int bx = blockIdx.x; F.vcu = (F.G % 8 == 0) ? (bx % 8) * (F.G / 8) + bx / 8 : bx; }
    F.ws = args.ws; F.out = args.out;
#pragma unroll
    for (int i = 0; i < 21; ++i) F.in[i] = args.in[i];
    F.ctl = (gu32*)(F.ws + WS_CTL);
    for (int u = F.tid; u < (LDS_BYTES - LDSCTL_OFF) / 4; u += NWAVES * 64) ((LAS unsigned*)(F.lds + LDSCTL_OFF))[u] = 0u;
    __syncthreads();
    XcdBarrier bar = xcd_barrier_post((unsigned*)(F.ctl + CW_BAR), F.MISC + 8);
    const int lo = args.ph_lo, hi = args.ph_hi;
#define IN(k) (lo <= (k) && (k) < hi)
#define BOTH(k) (IN(k) && IN((k) + 1))
#define GRID_BAR() xcd_barrier(bar)


#ifdef PROBE_LAST
#define PROBE_AFTER(k) if ((k) == PROBE_LAST) { probe_digest(F, bar); return; }
#else
#define PROBE_AFTER(k)
#endif
    if (IN(0)) { p0_prologue(F); if (BOTH(0)) GRID_BAR(); }
    PROBE_AFTER(0)
    if (IN(1)) {
        pg8::Gemm g{(const pg8::bf16_t*)(F.ws + WS_XB), (const pg8::bf16_t*)(F.ws + WS_WIN), MALL, NIN, D}; pg8::StaticOrder S; S.init(MALL, NIN, F.G, (int)blockIdx.x);
        pg8::EpiInProj E{(pg8::bf16_t*)(F.ws + WS_HB), F.out};
        pg8::gemm_phase<pg8::EpiInProj, pg8::StaticOrder, true, true>(F.lds + RING_OFF, g, S, E);
        if (BOTH(1)) GRID_BAR();
    }
    PROBE_AFTER(1)

    if (IN(2)) { p2_phase(F); if (BOTH(2)) GRID_BAR(); }
    PROBE_AFTER(2)
    if (IN(3)) { p3_phase(F); if (BOTH(3)) GRID_BAR(); }
    PROBE_AFTER(3)
    if (IN(4)) {
        { pg8::Gemm g{(const pg8::bf16_t*)(F.ws + WS_OA), (const pg8::bf16_t*)(F.ws + WS_WA), MALL, D, 512}; pg8::StaticOrder S; S.init(MALL, D, F.G, (int)blockIdx.x);
          pg8::EpiGateA E{(const pg8::bf16_t*)(F.ws + WS_HB), (float*)(F.ws + WS_TB)};
          pg8::gemm_phase<pg8::EpiGateA, pg8::StaticOrder, true, true>(F.lds + RING_OFF, g, S, E); }
        { pg8::Gemm g{(const pg8::bf16_t*)(F.ws + WS_OB), (const pg8::bf16_t*)(F.ws + WS_WB), MALL, D, 512}; pg8::StaticOrder S; S.init(MALL, D, F.G, (int)blockIdx.x);
          pg8::EpiGateB E{(const pg8::bf16_t*)(F.ws + WS_HB), (const float*)(F.ws + WS_TB), (pg8::bf16_t*)(F.ws + WS_MG)};
          pg8::gemm_phase<pg8::EpiGateB, pg8::StaticOrder, true, true>(F.lds + RING_OFF, g, S, E); }
        if (BOTH(4)) GRID_BAR();
    }
    PROBE_AFTER(4)
    if (IN(5)) {
        pg8::Gemm g{(const pg8::bf16_t*)(F.ws + WS_MG), (const pg8::bf16_t*)(F.ws + WS_WO), MALL, D, D}; pg8::StaticOrder S; S.init(MALL, D, F.G, (int)blockIdx.x);
        pg8::EpiResid E{F.in[0], F.in[1], (float*)(F.ws + WS_Z1)};
        pg8::gemm_phase<pg8::EpiResid, pg8::StaticOrder, true, true>(F.lds + RING_OFF, g, S, E);
        if (BOTH(5)) GRID_BAR();
    }
    PROBE_AFTER(5)
    if (IN(6)) { ln_phase(F, (const float*)(F.ws + WS_Z1), F.in[15], F.in[16], 0); if (BOTH(6)) GRID_BAR(); }
    PROBE_AFTER(6)
    if (IN(7)) {
        pg8::Gemm g{(const pg8::bf16_t*)(F.ws + WS_X1B), (const pg8::bf16_t*)(F.ws + WS_WUP), MALL, FF, D}; pg8::StaticOrder S; S.init(MALL, FF, F.G, (int)blockIdx.x);
        pg8::EpiRelu2 E{(pg8::bf16_t*)(F.ws + WS_UB)};
        pg8::gemm_phase<pg8::EpiRelu2, pg8::StaticOrder, true, true>(F.lds + RING_OFF, g, S, E);
        if (BOTH(7)) GRID_BAR();
    }
    PROBE_AFTER(7)
    if (IN(8)) {
        pg8::Gemm g{(const pg8::bf16_t*)(F.ws + WS_UB), (const pg8::bf16_t*)(F.ws + WS_WDN), MALL, D, FF}; pg8::StaticOrder S; S.init(MALL, D, F.G, (int)blockIdx.x);
        pg8::EpiResid E{(const float*)(F.ws + WS_X1F), (const float*)(F.ws + WS_X1F) + (size_t)MP * D, (float*)(F.ws + WS_Z2)};
        pg8::gemm_phase<pg8::EpiResid, pg8::StaticOrder, true, true>(F.lds + RING_OFF, g, S, E);
        if (BOTH(8)) GRID_BAR();
    }
    PROBE_AFTER(8)
    if (IN(9)) { ln_phase(F, (const float*)(F.ws + WS_Z2), F.in[19], F.in[20], 1); }
#ifdef PROBE_SANITIZE
    GRID_BAR();
    { const size_t i0 = (size_t)blockIdx.x * 512 + F.tid, st = (size_t)F.G * 512;
      for (size_t i = i0; i < OUT_TOTAL; i += st) { const float v = F.out[i]; if (!(v - v == 0.f)) F.out[i] = 0.f; } }
#endif
#undef IN
#undef BOTH
}

extern "C" void kernel_launch(void* const* d_in, const int* in_sizes, int n_in, void* d_out, int out_size, void* d_ws, size_t ws_size, hipStream_t stream) {
    static int grid = 0;
    if (grid == 0) {
        if (n_in != 21 || (size_t)out_size != OUT_TOTAL || ws_size < WS_END) { fprintf(stderr, "kernel_launch: unexpected shapes: n_in %d out %d ws %zu (need %zu)\n", n_in, out_size, ws_size, (size_t)WS_END); grid = -1; return; }
        int dev = 0, cus = 0, per_cu = 0;
        if (hipGetDevice(&dev) != hipSuccess || hipDeviceGetAttribute(&cus, hipDeviceAttributeMultiprocessorCount, dev) != hipSuccess) { grid = -1; return; }
        if (hipFuncSetAttribute((const void*)nsa_fwd, hipFuncAttributeMaxDynamicSharedMemorySize, LDS_BYTES) != hipSuccess) { fprintf(stderr, "kernel_launch: hipFuncSetAttribute failed\n"); grid = -1; return; }
        if (hipOccupancyMaxActiveBlocksPerMultiprocessor(&per_cu, (const void*)nsa_fwd, NWAVES * 64, LDS_BYTES) != hipSuccess || per_cu < 1) { fprintf(stderr, "kernel_launch: occupancy query says %d\n", per_cu); }
        (void)hipGetLastError();
        grid = cus;
    }
    if (grid < 0) return;
    if (hipMemsetAsync((char*)d_ws + WS_CTL, 0, CTL_ZERO_BYTES, stream) != hipSuccess) return;
    Args a{};
    for (int i = 0; i < 21; ++i) a.in[i] = (const float*)d_in[i];
    a.out = (float*)d_out; a.ws = (unsigned char*)d_ws; a.ph_lo = 0; a.ph_hi = 100;
    hipLaunchKernelGGL(nsa_fwd, dim3(grid), dim3(NWAVES * 64), LDS_BYTES, stream, a);
}
```

```cpp
#include <hip/hip_runtime.h>
#include <cstdio>
#include <cstdint>
namespace pg8 {
#define PG8_LAS __attribute__((address_space(3)))
typedef unsigned short bf16_t;
typedef short bf16x8 __attribute__((ext_vector_type(8)));
typedef float f32x4 __attribute__((ext_vector_type(4)));
typedef unsigned u32x4 __attribute__((ext_vector_type(4)));
constexpr int BM = 256, BK = 64, HALF = 128, HTB = HALF * BK * 2  , STAGE_BYTES = 8 * HTB, NXCD = 8, WGM = 8;

__host__ __device__ __forceinline__ int lds_byte(int r, int c) { const int st = (r >> 4) * 2 + (c >> 5), rr = r & 15, cc = c & 31, ob = rr * 64 + cc * 2; return st * 1024 + (ob ^ (((ob >> 9) & 1) << 5)); }
__host__ __device__ __forceinline__ void stage_rc(int b, int& R, int& C) { const int st = b / 1024, sb = b % 1024, swz = sb ^ (((sb >> 9) & 1) << 5); R = (st >> 1) * 16 + swz / 64; C = (st & 1) * 32 + (swz % 64) / 2; }
__host__ __device__ __forceinline__ int perm32(int rho) { const int n = rho >> 4, i = rho & 15; return 8 * (i >> 2) + 4 * n + (i & 3); }

struct Unit { int pm, pn; };
struct Gemm { const bf16_t* A; const bf16_t* Bt; int M, N, K; };

struct StaticOrder {
    int nM, nN, nwg, G, c;
    __host__ __device__ void init(int M, int N, int G_, int c_) { nM = M / BM; nN = N / BM; nwg = nM * nN; G = G_; c = c_; }
    __host__ __device__ bool next(int i, Unit& u) const {
        const long L = (long)i * G + c; if (L >= nwg) return false;
        int wgid = (int)L; { const int q = nwg / NXCD, r = nwg % NXCD, xcd = wgid % NXCD, off = wgid / NXCD; wgid = (xcd < r ? xcd * (q + 1) : r * (q + 1) + (xcd - r) * q) + off; }
        const int nig = WGM * nN, gid = wgid / nig, fm = gid * WGM, gsz = (nM - fm) < WGM ? (nM - fm) : WGM;
        u.pm = fm + ((wgid % nig) % gsz); u.pn = (wgid % nig) / gsz; return true;
    }
    __device__ __forceinline__ void a_ready(const Unit&) const {}
    __device__ __forceinline__ void done(const Unit&) const {}
};

__device__ __forceinline__ unsigned cvt_pk_bf16(float lo, float hi) { unsigned r; asm volatile("v_cvt_pk_bf16_f32 %0, %1, %2" : "=v"(r) : "v"(lo), "v"(hi)); return r; }
typedef float f32x2 __attribute__((ext_vector_type(2)));
__device__ __forceinline__ f32x2 gelu_pk(f32x2 v) {
    const f32x2 av = __builtin_elementwise_abs(v), d = av * 0.2316418882f + 1.0f;
    f32x2 t; t.x = __builtin_amdgcn_rcpf(d.x); t.y = __builtin_amdgcn_rcpf(d.y);
    f32x2 q = t * 0.5307027145f + (-0.7265760135f); q = q * t + 0.7107068705f; q = q * t + (-0.142248368f); q = q * t + 0.127414796f; q = q * t;
    const f32x2 s = (v * v) * (-0.72134752044f);
    f32x2 e; e.x = __builtin_amdgcn_exp2f(s.x); e.y = __builtin_amdgcn_exp2f(s.y);
    const f32x2 m = v * (q * e), r = v - m;
    f32x2 o; o.x = v.x < 0.f ? m.x : r.x; o.y = v.y < 0.f ? m.y : r.y; return o;
}

template <int ACT  > struct EpiBf16 {
    static constexpr bool PERM = true, AFTER_DRAIN = false; static_assert(ACT == 0 || ACT == 1, "EpiBf16: ACT is 0 (none) or 1 (gelu_pk)");
    bf16_t* O; int ldc; const float* bias; int split_cols; size_t split_stride; float scale0;
    __device__ __forceinline__ void operator()(const f32x4 (&acc)[2][2][4][2], const Unit& u, int wr, int wc, int fr, int fq) const {
        const int row0 = u.pm * BM + wr * 64 + fr; int colt = u.pn * BM; bf16_t* base = O;
        float sc = 1.f; if (split_cols) { const int t = colt / split_cols; base += (size_t)t * split_stride; colt -= t * split_cols; if (t == 0) sc = scale0; }
        const int col0 = colt + wc * 32 + 8 * fq, bcol0 = u.pn * BM + wc * 32 + 8 * fq;
        f32x4 bv[2][2];
#pragma unroll
        for (int bj = 0; bj < 2; ++bj)
#pragma unroll
            for (int n = 0; n < 2; ++n) bv[bj][n] = bias ? *(const f32x4*)(bias + bcol0 + bj * HALF + 4 * n) : (f32x4){0.f, 0.f, 0.f, 0.f};
#pragma unroll
        for (int ai = 0; ai < 2; ++ai)
#pragma unroll
            for (int m = 0; m < 4; ++m) { bf16_t* rowp = base + (size_t)(row0 + ai * HALF + m * 16) * ldc + col0;
#pragma unroll
                for (int bj = 0; bj < 2; ++bj) { f32x4 v0 = acc[ai][bj][m][0] + bv[bj][0], v1 = acc[ai][bj][m][1] + bv[bj][1];
                    if (ACT == 1) { f32x2 a = gelu_pk((f32x2){v0[0], v0[1]}), b = gelu_pk((f32x2){v0[2], v0[3]}), c = gelu_pk((f32x2){v1[0], v1[1]}), d = gelu_pk((f32x2){v1[2], v1[3]});
                        v0 = (f32x4){a.x, a.y, b.x, b.y}; v1 = (f32x4){c.x, c.y, d.x, d.y}; }
                    v0 = v0 * sc; v1 = v1 * sc; u32x4 w; w.x = cvt_pk_bf16(v0[0], v0[1]); w.y = cvt_pk_bf16(v0[2], v0[3]); w.z = cvt_pk_bf16(v1[0], v1[1]); w.w = cvt_pk_bf16(v1[2], v1[3]);
                    *(u32x4*)(rowp + bj * HALF) = w; } }
    }
};

struct PanelStats {
    unsigned* xbuf;
    unsigned* cnt;
    unsigned* tmo;
    int ntn; float eps;
    unsigned code;
    __device__ __forceinline__ bool run(const f32x4 (&v)[2][2][4][2], const Unit& u, int wr, int wc, int fr, int fq, PG8_LAS unsigned char* lds, int wid, int lane) const {
        typedef float f32x2v __attribute__((ext_vector_type(2)));
        PG8_LAS f32x2v* P = (PG8_LAS f32x2v*)lds;
        PG8_LAS f32x2v* S = (PG8_LAS f32x2v*)(lds + 8192);
        PG8_LAS unsigned* flag = (PG8_LAS unsigned*)(lds + 8192 + 2048);
#pragma unroll
        for (int ai = 0; ai < 2; ++ai)
#pragma unroll
            for (int m = 0; m < 4; ++m) {
                float s = 0.f;
#pragma unroll
                for (int bj = 0; bj < 2; ++bj)
#pragma unroll
                    for (int n = 0; n < 2; ++n) { const f32x4 x = v[ai][bj][m][n]; s += (x[0] + x[1]) + (x[2] + x[3]); }
                s += __shfl_xor(s, 16); s += __shfl_xor(s, 32);
                const float mw = s * (1.0f / 64.0f); float q = 0.f;
#pragma unroll
                for (int bj = 0; bj < 2; ++bj)
#pragma unroll
                    for (int n = 0; n < 2; ++n) { const f32x4 d = v[ai][bj][m][n] - mw; q += (d[0] * d[0] + d[1] * d[1]) + (d[2] * d[2] + d[3] * d[3]); }
                q += __shfl_xor(q, 16); q += __shfl_xor(q, 32);
                if (fq == 0) P[(ai * HALF + wr * 64 + m * 16 + fr) * 4 + wc] = (f32x2v){mw, q};
            }
        asm volatile("s_waitcnt lgkmcnt(0)" ::: "memory"); __builtin_amdgcn_s_barrier(); asm volatile("" ::: "memory");
#if defined(BROKEN_EXCHANGE_NO_WAIT)
#warning BROKEN CONTROL BUILD: the row-statistics exchange does not wait; results are wrong by design
        if (blockIdx.x >= 64) { const long long t0_ = clock64(); while (clock64() - t0_ < 60000) __builtin_amdgcn_s_sleep(8); }
#endif
        const int row = wid * 32 + (lane & 31);
        if (lane < 32) {
            const f32x2v a = P[row * 4 + 0], b = P[row * 4 + 1], c = P[row * 4 + 2], d = P[row * 4 + 3];
            const float mt = (a.x + b.x + c.x + d.x) * 0.25f;
            const float da = a.x - mt, db = b.x - mt, dc = c.x - mt, dd = d.x - mt;
            const float m2 = (a.y + b.y) + (c.y + d.y) + 64.0f * ((da * da + db * db) + (dc * dc + dd * dd));
            unsigned long long* slot = (unsigned long long*)xbuf + ((size_t)(u.pm * BM + row) * 4 + u.pn);
            __hip_atomic_store(slot, ((unsigned long long)__float_as_uint(m2) << 32) | __float_as_uint(mt), __ATOMIC_RELAXED, __HIP_MEMORY_SCOPE_AGENT);
        }
        asm volatile("s_waitcnt vmcnt(0)" ::: "memory");
        if (lane == 0) __hip_atomic_fetch_add(cnt + 64 * u.pm, 1u, __ATOMIC_RELAXED, __HIP_MEMORY_SCOPE_AGENT);
        if (wid == 0) {
            bool dead = false; const unsigned long long t0 = __builtin_amdgcn_s_memrealtime(); const unsigned want = 8u * (unsigned)ntn;
            for (;;) {
#if defined(BROKEN_EXCHANGE_NO_WAIT)
                break;
#endif
                if ((unsigned)__builtin_amdgcn_readfirstlane(__hip_atomic_load(cnt + 64 * u.pm, __ATOMIC_RELAXED, __HIP_MEMORY_SCOPE_AGENT)) >= want) break;
                if (__builtin_amdgcn_s_memrealtime() - t0 > 2000000ull) {
                    if (lane == 0) { unsigned expect = 0u; __hip_atomic_compare_exchange_strong(tmo + 1, &expect, code | (unsigned)(u.pm & 0xff), __ATOMIC_RELAXED, __ATOMIC_RELAXED, __HIP_MEMORY_SCOPE_AGENT);
                                     __hip_atomic_store(tmo, 1u, __ATOMIC_RELAXED, __HIP_MEMORY_SCOPE_AGENT); }
                    dead = true; break; }
                __builtin_amdgcn_s_sleep(2);
            }
            __builtin_amdgcn_fence(__ATOMIC_ACQUIRE, "agent");
            if (lane == 0) flag[0] = dead ? 1u : 0u;
        }
        asm volatile("s_waitcnt vmcnt(0) lgkmcnt(0)" ::: "memory"); __builtin_amdgcn_s_barrier(); asm volatile("" ::: "memory");
        const bool bad = flag[0] != 0u;
        if (lane < 32) {
            const unsigned long long* slot = (const unsigned long long*)xbuf + (size_t)(u.pm * BM + row) * 4; float mt[4], m2[4]; float ms = 0.f;
#pragma unroll
            for (int t = 0; t < 4; ++t) { if (t < ntn) { const unsigned long long w = __hip_atomic_load(slot + t, __ATOMIC_RELAXED, __HIP_MEMORY_SCOPE_AGENT); mt[t] = __uint_as_float((unsigned)w); m2[t] = __uint_as_float((unsigned)(w >> 32)); } else { mt[t] = 0.f; m2[t] = 0.f; } ms += mt[t]; }
            const float mean = ms / (float)ntn; float q = 0.f;
#pragma unroll
            for (int t = 0; t < 4; ++t) if (t < ntn) { const float dm = mt[t] - mean; q += m2[t] + 256.0f * dm * dm; }
            S[row] = (f32x2v){mean, 1.0f / sqrtf(q / (256.0f * (float)ntn) + eps)};
        }
        asm volatile("s_waitcnt lgkmcnt(0)" ::: "memory"); __builtin_amdgcn_s_barrier(); asm volatile("" ::: "memory");
        return bad;
    }
};
struct EpiLnRes {
    static constexpr bool PERM = false, AFTER_DRAIN = true;
    const float* base; float* out; int ldc; const float* bias; PanelStats st; unsigned poison;
    __device__ __forceinline__ void fused(f32x4 (&acc)[2][2][4][2], const Unit& u, int wr, int wc, int fr, int fq, PG8_LAS unsigned char* lds, int wid, int lane) const {
        typedef float f32x2v __attribute__((ext_vector_type(2)));
        const PG8_LAS f32x2v* S = (const PG8_LAS f32x2v*)(lds + 8192);
        const int col0 = u.pn * BM + wc * 32 + 4 * fq;
#pragma unroll
        for (int bj = 0; bj < 2; ++bj)
#pragma unroll
            for (int n = 0; n < 2; ++n) { const f32x4 bv = bias ? *(const f32x4*)(bias + col0 + bj * HALF + n * 16) : (f32x4){0.f, 0.f, 0.f, 0.f};
#pragma unroll
                for (int ai = 0; ai < 2; ++ai)
#pragma unroll
                    for (int m = 0; m < 4; ++m) acc[ai][bj][m][n] += bv; }
        f32x4 pre[4][2][2];
#pragma unroll
        for (int m = 0; m < 4; ++m) { const size_t off = (size_t)(u.pm * BM + wr * 64 + m * 16 + fr) * ldc + col0;
#pragma unroll
            for (int bj = 0; bj < 2; ++bj)
#pragma unroll
                for (int n = 0; n < 2; ++n) pre[m][bj][n] = *(const f32x4*)(base + off + bj * HALF + n * 16); }
        const bool bad = st.run(acc, u, wr, wc, fr, fq, lds, wid, lane) || poison != 0u;
        const float qnan = __builtin_nanf("");
#pragma unroll
        for (int ai = 0; ai < 2; ++ai)
#pragma unroll
            for (int m = 0; m < 4; ++m) { const int r = ai * HALF + wr * 64 + m * 16 + fr; const f32x2v sr = S[r]; const size_t off = (size_t)(u.pm * BM + r) * ldc + col0;
#pragma unroll
                for (int bj = 0; bj < 2; ++bj)
#pragma unroll
                    for (int n = 0; n < 2; ++n) { const f32x4 bs = ai == 0 ? pre[m][bj][n] : *(const f32x4*)(base + off + bj * HALF + n * 16); f32x4 o = bs + (acc[ai][bj][m][n] - sr.x) * sr.y;
                        if (bad) o = (f32x4){qnan, qnan, qnan, qnan}; *(f32x4*)(out + off + bj * HALF + n * 16) = o; }
                if (m & 1) asm volatile("" ::: "memory"); }
    }
};
struct EpiLnResLn {
    static constexpr bool PERM = false, AFTER_DRAIN = true;
    const float* base; float* out; bf16_t* xn; int ldc; const float* bias; PanelStats st1, st2; unsigned poison;
    __device__ __forceinline__ void fused(f32x4 (&acc)[2][2][4][2], const Unit& u, int wr, int wc, int fr, int fq, PG8_LAS unsigned char* lds, int wid, int lane) const {
        typedef float f32x2v __attribute__((ext_vector_type(2))); typedef unsigned u32x2v __attribute__((ext_vector_type(2)));
        const PG8_LAS f32x2v* S = (const PG8_LAS f32x2v*)(lds + 8192);
        const int col0 = u.pn * BM + wc * 32 + 4 * fq;
#pragma unroll
        for (int bj = 0; bj < 2; ++bj)
#pragma unroll
            for (int n = 0; n < 2; ++n) { const f32x4 bv = bias ? *(const f32x4*)(bias + col0 + bj * HALF + n * 16) : (f32x4){0.f, 0.f, 0.f, 0.f};
#pragma unroll
                for (int ai = 0; ai < 2; ++ai)
#pragma unroll
                    for (int m = 0; m < 4; ++m) acc[ai][bj][m][n] += bv; }
        bool bad = st1.run(acc, u, wr, wc, fr, fq, lds, wid, lane) || poison != 0u;
        const float qnan = __builtin_nanf("");
#pragma unroll
        for (int ai = 0; ai < 2; ++ai)
#pragma unroll
            for (int m = 0; m < 4; ++m) { const int r = ai * HALF + wr * 64 + m * 16 + fr; const f32x2v sr = S[r]; const size_t off = (size_t)(u.pm * BM + r) * ldc + col0;
#pragma unroll
                for (int bj = 0; bj < 2; ++bj)
#pragma unroll
                    for (int n = 0; n < 2; ++n) { const f32x4 bs = *(const f32x4*)(base + off + bj * HALF + n * 16); acc[ai][bj][m][n] = bs + (acc[ai][bj][m][n] - sr.x) * sr.y; }
                asm volatile("" : "+v"(acc[ai][0][m][0]), "+v"(acc[ai][0][m][1]), "+v"(acc[ai][1][m][0]), "+v"(acc[ai][1][m][1]));
                if (m & 1) asm volatile("" ::: "memory"); }
        const bool bad1 = bad;
        bad = st2.run(acc, u, wr, wc, fr, fq, lds, wid, lane) || bad;
#pragma unroll
        for (int ai = 0; ai < 2; ++ai)
#pragma unroll
            for (int m = 0; m < 4; ++m) { const int r = ai * HALF + wr * 64 + m * 16 + fr; const f32x2v sr = S[r]; const size_t off = (size_t)(u.pm * BM + r) * ldc + col0;
#pragma unroll
                for (int bj = 0; bj < 2; ++bj)
#pragma unroll
                    for (int n = 0; n < 2; ++n) { const f32x4 x1 = acc[ai][bj][m][n]; *(f32x4*)(out + off + bj * HALF + n * 16) = bad1 ? (f32x4){qnan, qnan, qnan, qnan} : x1;
                        const f32x4 o = (x1 - sr.x) * sr.y; u32x2v w; w.x = cvt_pk_bf16(o[0], o[1]); w.y = cvt_pk_bf16(o[2], o[3]);
                        if (bad) { w.x = 0x7fc07fc0u; w.y = 0x7fc07fc0u; } *(u32x2v*)(xn + off + bj * HALF + n * 16) = w; }
                asm volatile("" ::: "memory"); }
    }
};

template <class Epi, class Sched, bool ALIGN_EPI = false, bool SP2 = false>
__device__ __forceinline__ void gemm_phase(PG8_LAS unsigned char* lds, const Gemm g, const Sched& S, const Epi& E) {
    const int tid = threadIdx.x, wid = __builtin_amdgcn_readfirstlane(tid >> 6), lane = tid & 63, wr = wid >> 2, wc = wid & 3, fr = lane & 15, fq = lane >> 4;
    const int K = g.K, nt = K / BK;
    unsigned voffA[2], voffB[2];
#pragma unroll
    for (int i = 0; i < 2; ++i) { int R, C; stage_rc(tid * 16 + i * 8192, R, C); const int Rb = Epi::PERM ? ((R & ~31) + perm32(R & 31)) : R;
        voffA[i] = (unsigned)(R * K + C) * 2u; voffB[i] = (unsigned)(Rb * K + C) * 2u; }
    const size_t kstep = (size_t)(BK * 2);
    const size_t hstep = (size_t)HALF * K * 2;
    const size_t tstep = 2 * hstep;
    const unsigned ldsw = (unsigned)wid * 1024u;
    const int aoff = lds_byte(wr * 64 + fr, fq * 8), boff = lds_byte(wc * 32 + fr, fq * 8);
#define PG8_SA(b, h) (((b) * 2 + (h)) * HTB)
#define PG8_SB(b, h) ((4 + (b) * 2 + (h)) * HTB)
#define PG8_STAGE(bufoff, gbase, voff) do { _Pragma("unroll") for (int _i = 0; _i < 2; ++_i) \
        __builtin_amdgcn_global_load_lds((const unsigned*)((const char*)(gbase) + (voff)[_i]), (PG8_LAS unsigned*)(lds + (bufoff) + ldsw + _i * 8192), 16, 0, 0); } while (0)
#define PG8_LDA(dst, b, h) do { _Pragma("unroll") for (int m = 0; m < 4; ++m) _Pragma("unroll") for (int k = 0; k < 2; ++k) dst[m][k] = *(const PG8_LAS bf16x8*)(lds + PG8_SA(b, h) + aoff + m * 2048 + k * 1024); } while (0)
#define PG8_LDB(dst, b, h) do { _Pragma("unroll") for (int n = 0; n < 2; ++n) _Pragma("unroll") for (int k = 0; k < 2; ++k) dst[n][k] = *(const PG8_LAS bf16x8*)(lds + PG8_SB(b, h) + boff + n * 2048 + k * 1024); } while (0)
#define PG8_MMA(ai, bj, At, Bt) do { __builtin_amdgcn_s_setprio(1); _Pragma("unroll") for (int m = 0; m < 4; ++m) _Pragma("unroll") for (int n = 0; n < 2; ++n) _Pragma("unroll") for (int k = 0; k < 2; ++k) \
        acc[ai][bj][m][n] = __builtin_amdgcn_mfma_f32_16x16x32_bf16(Bt[n][k], At[m][k], acc[ai][bj][m][n], 0, 0, 0); __builtin_amdgcn_s_setprio(0); } while (0)
#define PG8_WAIT_V(n) asm volatile("s_waitcnt vmcnt(" #n ")" ::: "memory")
#define PG8_WAIT_L(n) asm volatile("s_waitcnt lgkmcnt(" #n ")" ::: "memory")
#define PG8_BAR __builtin_amdgcn_s_barrier()
#define PG8_SCHED __builtin_amdgcn_sched_barrier(0)
    Unit cur, nxt; int ui = 0;
    if (!S.next(0, cur)) return;
    f32x4 acc[2][2][4][2];
#pragma unroll
    for (int a = 0; a < 2; ++a)
#pragma unroll
        for (int b = 0; b < 2; ++b)
#pragma unroll
            for (int m = 0; m < 4; ++m)
#pragma unroll
                for (int n = 0; n < 2; ++n) acc[a][b][m][n] = (f32x4){0.f, 0.f, 0.f, 0.f};
    bf16x8 At[4][2], B0[2][2], B1[2][2];
    const char* cA = (const char*)g.A + (size_t)cur.pm * tstep; const char* cB = (const char*)g.Bt + (size_t)cur.pn * tstep;
    S.a_ready(cur);
    if constexpr (SP2) {
        PG8_STAGE(PG8_SB(0, 0), cB, voffB); PG8_STAGE(PG8_SB(0, 1), cB + hstep, voffB); PG8_STAGE(PG8_SA(0, 0), cA, voffA); PG8_STAGE(PG8_SA(0, 1), cA + hstep, voffA);
        if (wr == 1) PG8_BAR;
        PG8_WAIT_V(2); PG8_BAR;
        PG8_STAGE(PG8_SB(1, 0), cB + kstep, voffB); PG8_STAGE(PG8_SA(1, 0), cA + kstep, voffA); PG8_STAGE(PG8_SB(1, 1), cB + hstep + kstep, voffB);
        PG8_WAIT_V(6); PG8_BAR;
    } else {
        PG8_STAGE(PG8_SB(0, 0), cB, voffB); PG8_STAGE(PG8_SA(0, 0), cA, voffA); PG8_STAGE(PG8_SB(0, 1), cB + hstep, voffB); PG8_STAGE(PG8_SA(0, 1), cA + hstep, voffA);
        if (wr == 1) PG8_BAR;
        PG8_WAIT_V(4); PG8_BAR;
        PG8_STAGE(PG8_SB(1, 0), cB + kstep, voffB); PG8_STAGE(PG8_SA(1, 0), cA + kstep, voffA); PG8_STAGE(PG8_SB(1, 1), cB + hstep + kstep, voffB);
        PG8_WAIT_V(6); PG8_BAR;
    }
    for (;;) {
        const bool has_next = S.next(ui + 1, nxt);
        const char* nA = has_next ? (const char*)g.A + (size_t)nxt.pm * tstep : cA; const char* nB = has_next ? (const char*)g.Bt + (size_t)nxt.pn * tstep : cB;
        for (int t = 0; t < nt; t += 2) {
            const bool last = (t == nt - 2);
            const char* a1 = cA + (size_t)(t + 1) * kstep;
            const char* a2 = last ? nA : cA + (size_t)(t + 2) * kstep; const char* b2 = last ? nB : cB + (size_t)(t + 2) * kstep;
            const char* a3 = a2 + kstep; const char* b3 = b2 + kstep;
            if (last && has_next) S.a_ready(nxt);
            if constexpr (SP2) {
            PG8_LDB(B0, 0, 0); PG8_LDB(B1, 0, 1); PG8_SCHED; PG8_LDA(At, 0, 0); PG8_STAGE(PG8_SA(1, 1), a1 + hstep, voffA);
            PG8_WAIT_V(8); PG8_WAIT_L(0); PG8_BAR; PG8_MMA(0, 0, At, B0); PG8_MMA(0, 1, At, B1); PG8_BAR; PG8_SCHED;
            PG8_LDA(At, 0, 1); PG8_STAGE(PG8_SB(0, 0), b2, voffB); PG8_STAGE(PG8_SB(0, 1), b2 + hstep, voffB); PG8_STAGE(PG8_SA(0, 0), a2, voffA);
            PG8_WAIT_V(8); PG8_WAIT_L(0); PG8_BAR; PG8_MMA(1, 0, At, B0); PG8_MMA(1, 1, At, B1); PG8_BAR; PG8_SCHED;
            PG8_LDB(B0, 1, 0); PG8_LDB(B1, 1, 1); PG8_SCHED; PG8_LDA(At, 1, 0); PG8_STAGE(PG8_SA(0, 1), a2 + hstep, voffA);
            PG8_WAIT_V(8); PG8_WAIT_L(0); PG8_BAR; PG8_MMA(0, 0, At, B0); PG8_MMA(0, 1, At, B1); PG8_BAR; PG8_SCHED;
            PG8_LDA(At, 1, 1); PG8_STAGE(PG8_SB(1, 0), b3, voffB); PG8_STAGE(PG8_SB(1, 1), b3 + hstep, voffB); PG8_STAGE(PG8_SA(1, 0), a3, voffA);
            PG8_WAIT_V(8); PG8_WAIT_L(0); PG8_BAR; PG8_MMA(1, 0, At, B0); PG8_MMA(1, 1, At, B1); PG8_BAR; PG8_SCHED;
            } else {
            PG8_LDB(B0, 0, 0); PG8_SCHED; PG8_LDA(At, 0, 0); PG8_STAGE(PG8_SA(1, 1), a1 + hstep, voffA);
            PG8_WAIT_L(8); PG8_BAR; PG8_WAIT_L(0); PG8_MMA(0, 0, At, B0); PG8_BAR; PG8_SCHED;
            PG8_LDB(B1, 0, 1); PG8_STAGE(PG8_SB(0, 0), b2, voffB);
            PG8_BAR; PG8_WAIT_L(0); PG8_MMA(0, 1, At, B1); PG8_BAR;
            PG8_LDA(At, 0, 1); PG8_STAGE(PG8_SA(0, 0), a2, voffA);
            PG8_BAR; PG8_WAIT_L(0); PG8_MMA(1, 0, At, B0); PG8_BAR; PG8_SCHED;
            PG8_STAGE(PG8_SB(0, 1), b2 + hstep, voffB);
            PG8_WAIT_V(6); PG8_BAR; PG8_MMA(1, 1, At, B1); PG8_BAR;
            PG8_LDB(B0, 1, 0); PG8_SCHED; PG8_LDA(At, 1, 0); PG8_STAGE(PG8_SA(0, 1), a2 + hstep, voffA);
            PG8_WAIT_L(8); PG8_BAR; PG8_WAIT_L(0); PG8_MMA(0, 0, At, B0); PG8_BAR; PG8_SCHED;
            PG8_LDB(B1, 1, 1); PG8_STAGE(PG8_SB(1, 0), b3, voffB);
            PG8_BAR; PG8_WAIT_L(0); PG8_MMA(0, 1, At, B1); PG8_BAR;
            PG8_LDA(At, 1, 1); PG8_STAGE(PG8_SA(1, 0), a3, voffA);
            PG8_BAR; PG8_WAIT_L(0); PG8_MMA(1, 0, At, B0); PG8_BAR; PG8_SCHED;
            PG8_STAGE(PG8_SB(1, 1), b3 + hstep, voffB);
            PG8_WAIT_V(6); PG8_BAR; PG8_MMA(1, 1, At, B1); PG8_BAR;
            }
        }
        if constexpr (ALIGN_EPI) { if (wr == 0) PG8_BAR; }
        if constexpr (!Epi::AFTER_DRAIN) { E(acc, cur, wr, wc, fr, fq); S.done(cur); }
        if (!has_next) break;
#pragma unroll
        for (int a = 0; a < 2; ++a)
#pragma unroll
            for (int b = 0; b < 2; ++b)
#pragma unroll
                for (int m = 0; m < 4; ++m)
#pragma unroll
                    for (int n = 0; n < 2; ++n) acc[a][b][m][n] = (f32x4){0.f, 0.f, 0.f, 0.f};
        cur = nxt; cA = nA; cB = nB; ++ui;
        if constexpr (ALIGN_EPI) { if (wr == 1) PG8_BAR; }
    }
    PG8_WAIT_V(0);
    if constexpr (!ALIGN_EPI) { if (wr == 0) PG8_BAR; }
    PG8_BAR;
    if constexpr (Epi::AFTER_DRAIN) { E.fused(acc, cur, wr, wc, fr, fq, lds, wid, lane); S.done(cur); }
#undef PG8_SA
#undef PG8_SB
#undef PG8_STAGE
#undef PG8_LDA
#undef PG8_LDB
#undef PG8_MMA
#undef PG8_WAIT_V
#undef PG8_WAIT_L
#undef PG8_BAR
#undef PG8_SCHED
}
}
#define GAS __attribute__((address_space(1)))
#define LAS __attribute__((address_space(3)))
typedef unsigned short bf16;
typedef unsigned v4u __attribute__((ext_vector_type(4)));
typedef float f32x4 __attribute__((ext_vector_type(4)));
typedef short bf16x8 __attribute__((ext_vector_type(8)));
typedef GAS unsigned gu32;
typedef GAS unsigned long long gu64;
#define RLX_AGENT __ATOMIC_RELAXED, __HIP_MEMORY_SCOPE_AGENT
#define LDS_WAIT() asm volatile("s_waitcnt lgkmcnt(0)" ::: "memory")
#define VM_WAIT() asm volatile("s_waitcnt vmcnt(0)" ::: "memory")
__device__ __forceinline__ unsigned long long rt() { return __builtin_amdgcn_s_memrealtime(); }
__device__ __forceinline__ unsigned f2bf(float f) { unsigned u = __builtin_bit_cast(unsigned, f); return (u + 0x7fffu + ((u >> 16) & 1u)) >> 16; }
__device__ __forceinline__ unsigned pk2(float lo, float hi) { return f2bf(lo) | (f2bf(hi) << 16); }

#define XB_TMO      128
#define XB_XCNT(j)  (256  + 64 * (j))
#define XB_XSUB(j)  (1280 + 64 * (j))
#define XB_XGEN(j)  (2304 + 64 * (j))
#define XB_TOP      3328
#define XB_TOPGEN   3392
#define XCD_BAR_WORDS 3456
#define XB_SPIN_CAP (1u << 18)

__device__ __forceinline__ unsigned xb_ld(unsigned* p)              { return __hip_atomic_load(p, __ATOMIC_RELAXED, __HIP_MEMORY_SCOPE_AGENT); }
__device__ __forceinline__ unsigned xb_add(unsigned* p, unsigned v) { return __hip_atomic_fetch_add(p, v, __ATOMIC_RELAXED, __HIP_MEMORY_SCOPE_AGENT); }
__device__ __forceinline__ unsigned xb_xcc_id() { return (unsigned)__builtin_amdgcn_s_getreg((3 << 11) | 20) & 0xFu; }
#define XB_SPIN(cond, bar) do { unsigned _sp = 0; while (cond) { __builtin_amdgcn_s_sleep(1); \
    if ((++_sp & 255u) == 0u) { if (xb_ld(&(bar)[XB_TMO])) break; if (_sp > XB_SPIN_CAP) { atomicAdd(&(bar)[XB_TMO], 1u); break; } } } } while (0)

struct XcdBarrier {
    unsigned* bar; unsigned x;
    volatile LAS unsigned* st;
};

__device__ __forceinline__ XcdBarrier xcd_barrier_post(unsigned* bar, volatile LAS unsigned* st) {
    XcdBarrier b; b.bar = bar; b.x = xb_xcc_id(); b.st = st;
    if (threadIdx.x == 0) (void)xb_add(&bar[XB_XCNT(b.x)], 1u);
    return b;
}
__device__ __forceinline__ void xcd_barrier_complete(unsigned* bar, unsigned x, unsigned& nloc, unsigned& nx) {
    const unsigned G = gridDim.x * gridDim.y * gridDim.z;
    unsigned sum, cnt, mine, sp = 0u;
    for (;;) {
        sum = 0u; cnt = 0u; mine = 0u;
#pragma unroll
        for (unsigned j = 0; j < 16; ++j) { const unsigned c = xb_ld(&bar[XB_XCNT(j)]); sum += c; cnt += (c > 0u) ? 1u : 0u; mine = (j == x) ? c : mine; }
        if (sum == G) break;
        __builtin_amdgcn_s_sleep(1);
        if ((++sp & 255u) == 0u) { if (xb_ld(&bar[XB_TMO])) break; if (sp > XB_SPIN_CAP) { atomicAdd(&bar[XB_TMO], 1u); break; } }
    }
    nloc = mine > 0u ? mine : 1u; nx = cnt > 0u ? cnt : 1u;
}

__device__ __forceinline__ void xcd_barrier(const XcdBarrier& b) {
    asm volatile("s_waitcnt vmcnt(0)" ::: "memory");
    __syncthreads();
    if (threadIdx.x == 0) {
        unsigned* bar = b.bar;
        __builtin_amdgcn_s_waitcnt(0);
        unsigned nloc = b.st[0], nx = b.st[1];
        if (nloc == 0u) { xcd_barrier_complete(bar, b.x, nloc, nx); b.st[0] = nloc; b.st[1] = nx; }
        const unsigned old = xb_add(&bar[XB_XSUB(b.x)], 1u);
        const unsigned gen = old / nloc;
        if (old + 1u == (gen + 1u) * nloc) {
            __builtin_amdgcn_fence(__ATOMIC_RELEASE, "agent");
            asm volatile("s_waitcnt vmcnt(0)" ::: "memory");
            const unsigned og = xb_add(&bar[XB_TOP], 1u);
            const unsigned tg = og / nx;
            if (og + 1u == (tg + 1u) * nx) xb_add(&bar[XB_TOPGEN], 1u);
            else XB_SPIN(xb_ld(&bar[XB_TOPGEN]) == tg, bar);
            __builtin_amdgcn_fence(__ATOMIC_ACQUIRE, "agent");
            xb_add(&bar[XB_XGEN(b.x)], 1u);
            asm volatile("s_waitcnt vmcnt(0)" ::: "memory");
        } else {
            XB_SPIN(xb_ld(&bar[XB_XGEN(b.x)]) == gen, bar);
            __builtin_amdgcn_fence(__ATOMIC_ACQUIRE, "agent");
            asm volatile("s_waitcnt vmcnt(0)" ::: "memory");
        }
    }
    __syncthreads();
}
constexpr int NWAVES = 8;
constexpr int T = 8192, NBATCH = 2, MP = NBATCH * T, MS = 32, MALL = 16640, D = 1024, NIN = 6656, FF = 4096;
constexpr int C_QA = 0, C_KVC = 512, C_KVS = 768, C_KVW = 1024, C_QB = 1280, C_FB = 2304, C_IB = 3328, C_GB = 3840, C_MG = 4352, C_GLA = 6400;
constexpr int PAST = 16384, NPAGES = 128, NCMP_S = 1023, NCMP_P = 511;
constexpr float LN_EPS = 1e-5f;
constexpr float DN_ALPHA = 1.189207115002721f;
constexpr size_t OFF0 = 0, OFF1 = OFF0 + (size_t)MP * D, OFF2 = OFF1 + (size_t)MS * D, OFF3 = OFF2 + (size_t)MP * 256, OFF4 = OFF3 + (size_t)MP * 256,
                 OFF5 = OFF4 + (size_t)NBATCH * 512 * 256, OFF6 = OFF5 + (size_t)NBATCH * 8 * 128 * 64, OFF7 = OFF6 + (size_t)MS * 256, OFF8 = OFF7 + (size_t)MS * 256,
                 OFF9 = OFF8 + (size_t)MS * 512 * 256, OUT_TOTAL = OFF9 + (size_t)MS * 8 * 128 * 64;
constexpr size_t MiB = 1u << 20;
constexpr size_t al(size_t x) { return (x + MiB - 1) / MiB * MiB; }
constexpr size_t WS_CTL = 0, CTL_ZERO_BYTES = 1 * MiB;
constexpr size_t WS_WIN = 2 * MiB;
constexpr size_t WS_WA = WS_WIN + al((size_t)NIN * D * 2);
constexpr size_t WS_WB = WS_WA + al((size_t)D * 512 * 2);
constexpr size_t WS_WO = WS_WB + al((size_t)D * 512 * 2);
constexpr size_t WS_WUP = WS_WO + al((size_t)D * D * 2);
constexpr size_t WS_WDN = WS_WUP + al((size_t)FF * D * 2);
constexpr size_t WS_WC = WS_WDN + al((size_t)FF * D * 2);
constexpr size_t WS_SMALL = WS_WC + al((size_t)2 * 64 * 2048 * 2);
constexpr size_t WS_XB = WS_SMALL + MiB;
constexpr size_t WS_HB = WS_XB + al((size_t)MALL * D * 2);
constexpr size_t WS_KCP = WS_HB + al((size_t)MALL * NIN * 2);
constexpr size_t WS_VCTP = WS_KCP + MiB;
constexpr size_t WS_KCVS = WS_VCTP + MiB;
constexpr size_t WS_VST = WS_KCVS + al((size_t)MS * 1024 * 256 * 4);
constexpr size_t WS_VWT = WS_VST + al((size_t)4 * 64 * T * 2);
constexpr size_t WS_OA = WS_VWT + al((size_t)4 * 64 * T * 2);
constexpr size_t WS_OB = WS_OA + al((size_t)MALL * 512 * 2);
constexpr size_t WS_HGL = WS_OB + al((size_t)MALL * 512 * 2);
constexpr size_t WS_HGD = WS_HGL + al((size_t)16 * 16 * 8192 * 4);
constexpr size_t WS_TB = WS_HGD + MiB;
constexpr size_t WS_MG = WS_TB + al((size_t)MALL * D * 4);
constexpr size_t WS_Z1 = WS_MG + al((size_t)MALL * D * 2);
constexpr size_t WS_X1F = WS_Z1 + al((size_t)MALL * D * 4);
constexpr size_t WS_X1B = WS_X1F + al((size_t)MALL * D * 4);
constexpr size_t WS_UB = WS_X1B + al((size_t)MALL * D * 2);
constexpr size_t WS_Z2 = WS_UB + al((size_t)MALL * FF * 2);
constexpr size_t WS_END = WS_Z2 + al((size_t)MALL * D * 4);
constexpr int CW_TMO = 0, CW_CODE = 1, CW_BAR = 4096;
constexpr int RING_OFF = 0, RING_BYTES = 131072;
constexpr int LDSCTL_OFF = RING_BYTES, MISC_OFF = LDSCTL_OFF + 320;
constexpr int LDS_BYTES = 147456;

namespace pg8 {
struct EpiInProj {
    static constexpr bool PERM = true, AFTER_DRAIN = false;
    bf16_t* HB; float* out;
    __device__ __forceinline__ void operator()(const f32x4 (&acc)[2][2][4][2], const Unit& u, int wr, int wc, int fr, int fq) const {
        const int row0 = u.pm * BM + wr * 64 + fr, cc0 = wc * 32 + 8 * fq, col0 = u.pn * BM + cc0;
#pragma unroll
        for (int ai = 0; ai < 2; ++ai)
#pragma unroll
            for (int m = 0; m < 4; ++m) {
                const int r = row0 + ai * HALF + m * 16;
                bf16_t* rowp = HB + (size_t)r * NIN + col0;
                float* fdst = nullptr;
                if (u.pn == 2) { if (r < MP) fdst = out + OFF2 + (size_t)r * 256; else if (r < MP + MS) fdst = out + OFF6 + (size_t)(r - MP) * 256; }
                else if (u.pn == 3) { if (r < MP) fdst = out + OFF3 + (size_t)r * 256; else if (r < MP + MS) fdst = out + OFF7 + (size_t)(r - MP) * 256; }
                else if (u.pn == 4) { if (r < MP) { const int t = r & (T - 1), b = r >> 13; if (t >= T - 512) fdst = out + OFF4 + (size_t)(b * 512 + t - (T - 512)) * 256; }
                                      else if (r < MP + MS) fdst = out + OFF8 + ((size_t)(r - MP) * 512 + 511) * 256; }
#pragma unroll
                for (int bj = 0; bj < 2; ++bj) { const f32x4 v0 = acc[ai][bj][m][0], v1 = acc[ai][bj][m][1];
                    u32x4 w; w.x = cvt_pk_bf16(v0[0], v0[1]); w.y = cvt_pk_bf16(v0[2], v0[3]); w.z = cvt_pk_bf16(v1[0], v1[1]); w.w = cvt_pk_bf16(v1[2], v1[3]);
                    *(u32x4*)(rowp + bj * HALF) = w;
                    if (fdst) { *(f32x4*)(fdst + cc0 + bj * HALF) = v0; *(f32x4*)(fdst + cc0 + bj * HALF + 4) = v1; } }
            }
    }
};
}

struct Frame {
    LAS unsigned char* lds;
    volatile LAS unsigned* MISC;
    gu32* ctl;
    int tid, lane, wave;
    int vcu, G;
    const float* in[21]; float* out; unsigned char* ws;
};
__device__ __forceinline__ float bf2f(unsigned short b) { return __uint_as_float(((unsigned)b) << 16); }
typedef float f32x2_t __attribute__((ext_vector_type(2))); typedef __bf16 bf16x2_t __attribute__((ext_vector_type(2)));
__device__ __forceinline__ unsigned cvtpk(float lo, float hi) { f32x2_t v = {lo, hi}; bf16x2_t b = __builtin_convertvector(v, bf16x2_t); return __builtin_bit_cast(unsigned, b); }
__device__ __forceinline__ float wave_sum(float v) {
#pragma unroll
    for (int o = 1; o < 64; o <<= 1) v += __shfl_xor(v, o);
    return v;
}
__device__ __forceinline__ float sigmoidf_(float x) { return 1.0f / (1.0f + __expf(-x)); }

__device__ __forceinline__ void p0_transpose_item(const float* W, int K, int Nsrc, bf16* WT, int k0, int n0, int s0, int nvalid, LAS float* scr, int lane) {
#pragma unroll 8
    for (int i = 0; i < 32; ++i) { const int kk = 2 * i + (lane >> 5), c = lane & 31; scr[kk * 33 + c] = (c < nvalid) ? W[(size_t)(k0 + kk) * Nsrc + s0 + c] : 0.f; }
    LDS_WAIT(); asm volatile("" ::: "memory");
    const int c = lane & 7;
#pragma unroll
    for (int j = 0; j < 4; ++j) { const int n = (lane >> 3) + 8 * j; const LAS float* s = scr + (8 * c) * 33 + n;
        v4u o; o.x = pk2(s[0 * 33], s[1 * 33]); o.y = pk2(s[2 * 33], s[3 * 33]); o.z = pk2(s[4 * 33], s[5 * 33]); o.w = pk2(s[6 * 33], s[7 * 33]);
        *(GAS v4u*)(WT + (size_t)(n0 + n) * K + k0 + 8 * c) = o; }
    LDS_WAIT(); asm volatile("" ::: "memory");
}
__device__ __forceinline__ void p0_prologue(Frame& F) {
    LAS float* scr = (LAS float*)(F.lds + RING_OFF + F.wave * 16384);
    const int gw = F.vcu * NWAVES + F.wave, NGW = F.G * NWAVES, lane = F.lane;
    bf16* WinT = (bf16*)(F.ws + WS_WIN); bf16* WaT = (bf16*)(F.ws + WS_WA); bf16* WbT = (bf16*)(F.ws + WS_WB); bf16* WoT = (bf16*)(F.ws + WS_WO);
    bf16* WupT = (bf16*)(F.ws + WS_WUP); bf16* WdnT = (bf16*)(F.ws + WS_WDN); bf16* WcT = (bf16*)(F.ws + WS_WC);
    float* small = (float*)(F.ws + WS_SMALL);
    constexpr int I_IN = (D / 64) * (NIN / 32), I_A = (512 / 64) * (D / 32), I_O = (D / 64) * (D / 32), I_UP = (D / 64) * (FF / 32), I_DN = (FF / 64) * (D / 32), I_C = 2 * (2048 / 64) * 2;
    constexpr int I_T = I_IN + 2 * I_A + I_O + I_UP + I_DN + I_C;
    constexpr int I_X = MALL;
    constexpr int I_CB = 64;
    constexpr int I_LB = 16;
    constexpr int I_W8 = MS * 511;
    constexpr int I_Z = 2 * (MALL - MP - MS);
    constexpr int NITEMS = I_T + I_X + I_CB + I_LB + I_W8 + I_Z;
    for (int it = gw; it < NITEMS; it += NGW) {
        int r = it;
        if (r < I_T) {
            if (r < I_IN) { const int nblk = NIN / 32, kb = r / nblk, nb = r % nblk, n0 = 32 * nb; int s0, nv;
                if (n0 < 1280) { s0 = n0; nv = 32; } else if (n0 < 6400) { s0 = n0 + 24; nv = 32; } else if (n0 == 6400) { s0 = 1280; nv = 24; } else { s0 = 0; nv = 0; }
                p0_transpose_item(F.in[7], D, 6424, WinT, 64 * kb, n0, s0, nv, scr, lane); continue; } r -= I_IN;
            if (r < I_A) { const int nblk = D / 32, kb = r / nblk, nb = r % nblk; p0_transpose_item(F.in[12], 512, D, WaT, 64 * kb, 32 * nb, 32 * nb, 32, scr, lane); continue; } r -= I_A;
            if (r < I_A) { const int nblk = D / 32, kb = r / nblk, nb = r % nblk; p0_transpose_item(F.in[13], 512, D, WbT, 64 * kb, 32 * nb, 32 * nb, 32, scr, lane); continue; } r -= I_A;
            if (r < I_O) { const int nblk = D / 32, kb = r / nblk, nb = r % nblk; p0_transpose_item(F.in[14], D, D, WoT, 64 * kb, 32 * nb, 32 * nb, 32, scr, lane); continue; } r -= I_O;
            if (r < I_UP) { const int nblk = FF / 32, kb = r / nblk, nb = r % nblk; p0_transpose_item(F.in[17], D, FF, WupT, 64 * kb, 32 * nb, 32 * nb, 32, scr, lane); continue; } r -= I_UP;
            if (r < I_DN) { const int nblk = D / 32, kb = r / nblk, nb = r % nblk; p0_transpose_item(F.in[18], FF, D, WdnT, 64 * kb, 32 * nb, 32 * nb, 32, scr, lane); continue; } r -= I_DN;
            { const int c = r / 64, q = r % 64, kb = q / 2, nb = q % 2;
              p0_transpose_item(F.in[8] + (size_t)c * 2048 * 64, 2048, 64, WcT + (size_t)c * 64 * 2048, 64 * kb, 32 * nb, 32 * nb, 32, scr, lane); continue; }
        }
        r -= I_T;
        if (r < I_X) {
            const float* src = r < MP ? F.in[0] + (size_t)r * D : (r < MP + MS ? F.in[1] + (size_t)(r - MP) * D : nullptr);
            bf16* dst = (bf16*)(F.ws + WS_XB) + (size_t)r * D;
#pragma unroll
            for (int j = 0; j < 4; ++j) { f32x4 v = src ? *((const GAS f32x4*)src + lane + 64 * j) : (f32x4){0.f, 0.f, 0.f, 0.f};
                *((GAS unsigned long long*)dst + lane + 64 * j) = (unsigned long long)pk2(v.x, v.y) | ((unsigned long long)pk2(v.z, v.w) << 32); }
            continue;
        }
        r -= I_X;
        if (r < I_CB) {
            const int c = r >> 5, l = r & 31; const float* pos = F.in[9] + ((size_t)c * 32 + l) * 64; const float* w = F.in[8] + (((size_t)c * 32 + l) * 64) * 64;
            float s = 0.f;
            for (int d = 0; d < 64; ++d) s += pos[d] * w[(size_t)d * 64 + lane];
            small[(c * 32 + l) * 64 + lane] = s; continue;
        }
        r -= I_CB;
        if (r < I_LB) { const int i = r * 64 + lane; const float l0 = F.in[10][i], l1 = F.in[10][1024 + i]; small[4096 + i] = 1.0f / (1.0f + expf(l1 - l0)); continue; }
        r -= I_LB;
        if (r < I_W8) { const int b = r / 511, i = r % 511;
            const GAS f32x4* s = (const GAS f32x4*)(F.in[4] + ((size_t)b * 512 + i + 1) * 256); GAS f32x4* d = (GAS f32x4*)(F.out + OFF8 + ((size_t)b * 512 + i) * 256);
            d[lane] = s[lane]; continue; }
        r -= I_W8;
        { const int half = I_Z / 2, which = r / half, row = MP + MS + r % half; bf16* o = (bf16*)(F.ws + (which ? WS_OB : WS_OA)) + (size_t)row * 512;
          *((GAS v4u*)o + lane) = (v4u){0u, 0u, 0u, 0u}; }
    }
}
typedef float f32x16 __attribute__((ext_vector_type(16)));
typedef short s16x4 __attribute__((ext_vector_type(4)));
typedef unsigned u32x2 __attribute__((ext_vector_type(2)));
#define MFMA32(a, b, c) __builtin_amdgcn_mfma_f32_32x32x16_bf16((a), (b), (c), 0, 0, 0)
__device__ __forceinline__ int crow(int reg, int h) { return (reg & 3) + 8 * (reg >> 2) + 4 * h; }
__device__ __forceinline__ bf16x8 pack8(f32x4 a, f32x4 b) { v4u p; p.x = cvtpk(a.x, a.y); p.y = cvtpk(a.z, a.w); p.z = cvtpk(b.x, b.y); p.w = cvtpk(b.z, b.w); return __builtin_bit_cast(bf16x8, p); }
#define PACK_STEP(x, s) pack8((f32x4){(x)[8 * (s)], (x)[8 * (s) + 1], (x)[8 * (s) + 2], (x)[8 * (s) + 3]}, (f32x4){(x)[8 * (s) + 4], (x)[8 * (s) + 5], (x)[8 * (s) + 6], (x)[8 * (s) + 7]})
__device__ __forceinline__ bf16x8 join44(s16x4 lo, s16x4 hi) { return __builtin_shufflevector(lo, hi, 0, 1, 2, 3, 4, 5, 6, 7); }

constexpr int CT_PROMPT = NBATCH * 2 * 32, CT_SAMPLE = MS * 2 * 64, CT_ALL = CT_PROMPT + CT_SAMPLE;
__device__ __forceinline__ void compress_task(Frame& F, int task) {
    const int lane = F.lane, m = lane & 31, h = lane >> 5, ii = m & 15, g = m >> 4;
    const bool prompt = task < CT_PROMPT;
    int b, c, ig, nblk, tsrc;
    if (prompt) { b = task >> 6; c = (task >> 5) & 1; ig = task & 31; nblk = NCMP_P; tsrc = T; }
    else { const int t2 = task - CT_PROMPT; b = t2 >> 7; c = (t2 >> 6) & 1; ig = t2 & 63; nblk = NCMP_S; tsrc = PAST; }
    const int* pt = (const int*)F.in[6] + b * NPAGES;
    const bf16* WcT = (const bf16*)(F.ws + WS_WC) + (size_t)c * 64 * 2048;
    const float* small = (const float*)(F.ws + WS_SMALL);
    f32x16 acc0, acc1;
#pragma unroll
    for (int i = 0; i < 16; ++i) { acc0[i] = 0.f; acc1[i] = 0.f; }
    const int blk = ig * 16 + ii;
    int tA = 16 * blk, tB = 16 * blk + 16; tA = tA <= tsrc - 16 ? tA : tsrc - 16; tB = tB <= tsrc - 16 ? tB : tsrc - 16;
    const float* baseA = (prompt ? F.out + OFF2 + ((size_t)b * T + tA) * 256 : F.in[2] + ((size_t)pt[tA >> 7] * 128 + (tA & 127)) * 256) + c * 128 + g * 64 + 8 * h;
    const float* baseB = (prompt ? F.out + OFF2 + ((size_t)b * T + tB) * 256 : F.in[2] + ((size_t)pt[tB >> 7] * 128 + (tB & 127)) * 256) + c * 128 + g * 64 + 8 * h;
    const bf16* bp0 = WcT + (size_t)m * 2048 + 8 * h;
#pragma unroll 2
    for (int l = 0; l < 32; ++l) {
        const float* ap = (l < 16 ? baseA : baseB) + (size_t)(l & 15) * 256;
        const bf16* bp = bp0 + l * 64;
        f32x4 a0[4], a1[4]; bf16x8 B0[4], B1[4];
#pragma unroll
        for (int dc = 0; dc < 4; ++dc) { a0[dc] = *(const GAS f32x4*)(ap + dc * 16); a1[dc] = *(const GAS f32x4*)(ap + dc * 16 + 4);
            B0[dc] = *(const GAS bf16x8*)(bp + dc * 16); B1[dc] = *(const GAS bf16x8*)(bp + 32 * 2048 + dc * 16); }
#pragma unroll
        for (int dc = 0; dc < 4; ++dc) { const bf16x8 A = pack8(a0[dc], a1[dc]); acc0 = MFMA32(A, B0[dc], acc0); acc1 = MFMA32(A, B1[dc], acc1); }
    }
    float be0 = 0.f, be1 = 0.f;
    for (int l = 0; l < 32; ++l) { be0 += small[(c * 32 + l) * 64 + m]; be1 += small[(c * 32 + l) * 64 + 32 + m]; }
#pragma unroll
    for (int v = 0; v < 16; ++v) {
        const int mr = crow(v, h), oi = mr & 15, og = mr >> 4, ob = ig * 16 + oi;
        if (ob < nblk) {
            const float v0 = acc0[v] + be0, v1 = acc1[v] + be1;
            if (prompt) {
                if (c == 0) { bf16* kc = (bf16*)(F.ws + WS_KCP) + ((size_t)(b * 2 + og) * 512 + ob) * 64; kc[m] = (bf16)f2bf(v0); kc[32 + m] = (bf16)f2bf(v1); }
                else { bf16* vc = (bf16*)(F.ws + WS_VCTP) + (size_t)(b * 2 + og) * 64 * 512 + ob; vc[(size_t)m * 512] = (bf16)f2bf(v0); vc[(size_t)(32 + m) * 512] = (bf16)f2bf(v1); }
            } else {
                float* o = (float*)(F.ws + WS_KCVS) + ((size_t)b * 1024 + ob) * 256 + c * 128 + og * 64; o[m] = v0; o[32 + m] = v1;
            }
        }
    }
}
constexpr int VT_ITEMS = 2 * 2 * 2 * 128;
__device__ __forceinline__ void vt_item(Frame& F, int it) {
    const int tensor = it >> 9, b = (it >> 8) & 1, g = (it >> 7) & 1, tb = it & 127, lane = F.lane;
    const bf16* src = (const bf16*)(F.ws + WS_HB) + (size_t)(b * T + tb * 64 + lane) * NIN + (tensor ? C_KVW : C_KVS) + 128 + g * 64;
    bf16* dst = (bf16*)(F.ws + (tensor ? WS_VWT : WS_VST)) + (size_t)(b * 2 + g) * 64 * T + tb * 64 + lane;
    v4u r[8];
#pragma unroll
    for (int i = 0; i < 8; ++i) r[i] = *((const GAS v4u*)src + i);
#pragma unroll
    for (int i = 0; i < 8; ++i) {
        const unsigned w[4] = {r[i].x, r[i].y, r[i].z, r[i].w};
#pragma unroll
        for (int j = 0; j < 4; ++j) { dst[(size_t)(i * 8 + 2 * j) * T] = (bf16)(w[j] & 0xffffu); dst[(size_t)(i * 8 + 2 * j + 1) * T] = (bf16)(w[j] >> 16); }
    }
}

constexpr int HG_SEG = 512, HG_NSEG = T / HG_SEG, HG_CH = 32;
constexpr int HL_QT = 0, HL_KT = 8704, HL_KD = 17408, HL_VT = 27648, HL_DEC = 32768, HL_PSUM = 33280, HL_SLAB = 35328, HL_END = HL_SLAB + 4 * 32 * 272;
static_assert(HL_END <= RING_BYTES, "hgrn lds");
template <int MODE> __device__ __forceinline__ void hgrn_segment(Frame& F, int bh, int seg) {
    int tid = F.tid; asm volatile("" : "+v"(tid));
    const int lane = tid & 63, w = F.wave, kt = w >> 1, vt = w & 1, h5 = lane >> 5, l31 = lane & 31;
    const int b = bh >> 3, hh = bh & 7;
    LAS unsigned char* L = F.lds + RING_OFF;
    const bf16* HB = (const bf16*)(F.ws + WS_HB);
    const float* small = (const float*)(F.ws + WS_SMALL);
    float* HGL = (float*)(F.ws + WS_HGL); float* HGD = (float*)(F.ws + WS_HGD);
    f32x16 S;
#pragma unroll
    for (int i = 0; i < 16; ++i) S[i] = 0.f;
    if (MODE == 1) {
        for (int i = 0; i < seg; ++i) {
            const float* Lp = HGL + ((size_t)(bh * HG_NSEG + i)) * 8192 + w * 1024 + lane; const float* Dp = HGD + (size_t)(bh * HG_NSEG + i) * 128 + 32 * kt;
#pragma unroll
            for (int v = 0; v < 16; ++v) S[v] = S[v] * Dp[crow(v, h5)] + Lp[v * 64];
        }
    }
    const int k = tid & 127, q4 = tid >> 7;
    const float lb = small[4096 + hh * 128 + k];
    float lcsum = 0.f;
    for (int ch = 0; ch < HG_SEG / HG_CH; ++ch) {
        const int row0 = b * T + seg * HG_SEG + ch * HG_CH;
        float kk[8], cs[8]; float run = 0.f;
#pragma unroll
        for (int j = 0; j < 8; ++j) {
            const float x = bf2f(HB[(size_t)(row0 + 8 * q4 + j) * NIN + C_FB + hh * 128 + k]);
            const float e = __expf(-x), sg = 1.0f / (1.0f + e), om = e / (1.0f + e);
            const float f = lb + (1.0f - lb) * sg; kk[j] = (1.0f - lb) * om; run += __logf(f); cs[j] = run;
        }
        ((LAS float*)(L + HL_PSUM))[q4 * 128 + k] = run;
        __syncthreads();
        float off = 0.f, tot = 0.f;
#pragma unroll
        for (int q = 0; q < 4; ++q) { const float p = ((LAS float*)(L + HL_PSUM))[q * 128 + k]; tot += p; if (q < q4) off += p; }
#pragma unroll
        for (int j = 0; j < 8; ++j) {
            const int s = 8 * q4 + j; const float lc = off + cs[j];
            if (MODE == 1) {
                const float qv = bf2f(HB[(size_t)(row0 + s) * NIN + C_QB + hh * 128 + k]);
                ((LAS bf16*)(L + HL_QT))[s * 136 + k] = (bf16)f2bf(qv * __expf(lc));
                ((LAS bf16*)(L + HL_KT))[s * 136 + k] = (bf16)f2bf(kk[j] * __expf(-lc));
            }
            ((LAS bf16*)(L + HL_KD))[k * 40 + s] = (bf16)f2bf(kk[j] * __expf(tot - lc));
        }
        if (q4 == 0) { ((LAS float*)(L + HL_DEC))[k] = __expf(tot); lcsum += tot; }
        { const int s = tid >> 4, vq = tid & 15;
          const u32x2 vv = *(const GAS u32x2*)(HB + (size_t)(row0 + s) * NIN + C_IB + hh * 64 + 4 * vq);
          LAS bf16* vtp = (LAS bf16*)(L + HL_VT);
          vtp[(4 * vq + 0) * 40 + s] = (bf16)(vv.x & 0xffffu); vtp[(4 * vq + 1) * 40 + s] = (bf16)(vv.x >> 16);
          vtp[(4 * vq + 2) * 40 + s] = (bf16)(vv.y & 0xffffu); vtp[(4 * vq + 3) * 40 + s] = (bf16)(vv.y >> 16); }
        __syncthreads();
        if (MODE == 1) {
            f32x16 oacc;
#pragma unroll
            for (int i = 0; i < 16; ++i) oacc[i] = 0.f;
            if (kt == 0) {
                f32x16 at;
#pragma unroll
                for (int i = 0; i < 16; ++i) at[i] = 0.f;
#pragma unroll
                for (int ks = 0; ks < 8; ++ks) {
                    const bf16x8 a = *(const LAS bf16x8*)(L + HL_KT + l31 * 272 + (16 * ks + 8 * h5) * 2);
                    const bf16x8 bq = *(const LAS bf16x8*)(L + HL_QT + l31 * 272 + (16 * ks + 8 * h5) * 2);
                    at = MFMA32(a, bq, at);
                }
#pragma unroll
                for (int i = 0; i < 16; ++i) at[i] = (crow(i, h5) <= l31) ? at[i] : 0.f;
#pragma unroll
                for (int kq = 0; kq < 2; ++kq) {
                    const s16x4 lo = *(const LAS s16x4*)(L + HL_VT + (32 * vt + l31) * 80 + (16 * kq + 4 * h5) * 2);
                    const s16x4 hi = *(const LAS s16x4*)(L + HL_VT + (32 * vt + l31) * 80 + (16 * kq + 8 + 4 * h5) * 2);
                    oacc = MFMA32(join44(lo, hi), PACK_STEP(at, kq), oacc);
                }
            }
#pragma unroll
            for (int kq = 0; kq < 2; ++kq) {
                const s16x4 lo = *(const LAS s16x4*)(L + HL_QT + l31 * 272 + (32 * kt + 16 * kq + 4 * h5) * 2);
                const s16x4 hi = *(const LAS s16x4*)(L + HL_QT + l31 * 272 + (32 * kt + 16 * kq + 8 + 4 * h5) * 2);
                oacc = MFMA32(PACK_STEP(S, kq), join44(lo, hi), oacc);
            }
#pragma unroll
            for (int a = 0; a < 4; ++a)
                *(LAS f32x4*)(L + HL_SLAB + (kt * 32 + l31) * 272 + (32 * vt + 8 * a + 4 * h5) * 4) = (f32x4){oacc[4 * a], oacc[4 * a + 1], oacc[4 * a + 2], oacc[4 * a + 3]};
        }
        {
#pragma unroll
            for (int a = 0; a < 4; ++a) { const f32x4 d = *(const LAS f32x4*)(L + HL_DEC + (32 * kt + 8 * a + 4 * h5) * 4);
                S[4 * a] *= d.x; S[4 * a + 1] *= d.y; S[4 * a + 2] *= d.z; S[4 * a + 3] *= d.w; }
#pragma unroll
            for (int kq = 0; kq < 2; ++kq) {
                const bf16x8 a = *(const LAS bf16x8*)(L + HL_KD + (32 * kt + l31) * 80 + (16 * kq + 8 * h5) * 2);
                const bf16x8 bv = *(const LAS bf16x8*)(L + HL_VT + (32 * vt + l31) * 80 + (16 * kq + 8 * h5) * 2);
                S = MFMA32(a, bv, S);
            }
        }
        __syncthreads();
        if (MODE == 1) {
            const int t = tid >> 4, vq = tid & 15;
            f32x4 o = (f32x4){0.f, 0.f, 0.f, 0.f};
#pragma unroll
            for (int q = 0; q < 4; ++q) o += *(const LAS f32x4*)(L + HL_SLAB + (q * 32 + t) * 272 + 16 * vq);
            float ss = (o.x * o.x + o.y * o.y) + (o.z * o.z + o.w * o.w);
            ss += __shfl_xor(ss, 1); ss += __shfl_xor(ss, 2); ss += __shfl_xor(ss, 4); ss += __shfl_xor(ss, 8);
            const float rs = 1.0f / sqrtf(ss * (1.0f / 64.0f) + LN_EPS);
            const f32x4 ng = *(const GAS f32x4*)(F.in[11] + 4 * vq);
            const u32x2 gv = *(const GAS u32x2*)(HB + (size_t)(row0 + t) * NIN + C_GB + hh * 64 + 4 * vq);
            const float g0 = bf2f(gv.x & 0xffffu), g1 = bf2f(gv.x >> 16), g2 = bf2f(gv.y & 0xffffu), g3 = bf2f(gv.y >> 16);
            u32x2 ow; ow.x = cvtpk(o.x * rs * ng.x * g0 * sigmoidf_(g0), o.y * rs * ng.y * g1 * sigmoidf_(g1)); ow.y = cvtpk(o.z * rs * ng.z * g2 * sigmoidf_(g2), o.w * rs * ng.w * g3 * sigmoidf_(g3));
            *(GAS u32x2*)((bf16*)(F.ws + WS_OB) + (size_t)(row0 + t) * 512 + hh * 64 + 4 * vq) = ow;
        }
    }
    if (MODE == 0) {
        float* Lp = HGL + ((size_t)(bh * HG_NSEG + seg)) * 8192 + w * 1024 + lane;
#pragma unroll
        for (int v = 0; v < 16; ++v) Lp[v * 64] = S[v];
        if (q4 == 0) HGD[(size_t)(bh * HG_NSEG + seg) * 128 + k] = __expf(lcsum);
    } else if (seg == HG_NSEG - 1) {
        float* o = F.out + OFF5 + (size_t)bh * 8192;
#pragma unroll
        for (int v = 0; v < 16; ++v) o[(32 * kt + crow(v, h5)) * 64 + 32 * vt + l31] = S[v];
    }
    __syncthreads();
}
__device__ __forceinline__ void hgrn_sample_unit(Frame& F, int unit) {
    const int b = unit >> 3, hh = unit & 7, tid = F.tid, v = tid & 63, kq = tid >> 6;
    const bf16* HB = (const bf16*)(F.ws + WS_HB) + (size_t)(MP + b) * NIN;
    const float* small = (const float*)(F.ws + WS_SMALL);
    const float* st = F.in[5] + (size_t)(b * 8 + hh) * 8192; float* so = F.out + OFF9 + (size_t)(b * 8 + hh) * 8192;
    const float vv = bf2f(HB[C_IB + hh * 64 + v]);
    float po = 0.f;
#pragma unroll 4
    for (int j = 0; j < 16; ++j) {
        const int k = kq * 16 + j; const float x = bf2f(HB[C_FB + hh * 128 + k]), lb = small[4096 + hh * 128 + k];
        const float e = __expf(-x), sg = 1.0f / (1.0f + e), om = e / (1.0f + e);
        const float f = lb + (1.0f - lb) * sg, kx = (1.0f - lb) * om;
        const float sn = f * st[k * 64 + v] + kx * vv; so[k * 64 + v] = sn;
        po += bf2f(HB[C_QB + hh * 128 + k]) * sn;
    }
    LAS float* red = (LAS float*)(F.lds + RING_OFF);
    red[kq * 64 + v] = po;
    __syncthreads();
    if (tid < 64) {
        float o = 0.f;
#pragma unroll
        for (int q = 0; q < 8; ++q) o += red[q * 64 + v];
        const float ss = wave_sum(o * o), rs = 1.0f / sqrtf(ss * (1.0f / 64.0f) + LN_EPS);
        const float g = bf2f(HB[C_GB + hh * 64 + v]);
        ((bf16*)(F.ws + WS_OB))[(size_t)(MP + b) * 512 + hh * 64 + v] = (bf16)f2bf(o * rs * F.in[11][v] * g * sigmoidf_(g));
    }
    __syncthreads();
}
__device__ __forceinline__ void p2_phase(Frame& F) {
    for (int u = blockIdx.x; u < 16 * (HG_NSEG - 1); u += F.G) hgrn_segment<0>(F, u / (HG_NSEG - 1), u % (HG_NSEG - 1));
    for (int u = blockIdx.x; u < MS * 8; u += F.G) hgrn_sample_unit(F, u);
    const int gw = F.vcu * NWAVES + F.wave, NGW = F.G * NWAVES;
    for (int it = gw; it < CT_ALL + VT_ITEMS; it += NGW) { if (it < CT_ALL) compress_task(F, it); else vt_item(F, it - CT_ALL); }
}
constexpr int AL_K = 0, AL_V = 9216, AL_IMP = 18432, AL_SELM = AL_IMP + 64 * 128 * 4, AL_UNI = AL_SELM + 64 * 4 * 4, AL_END = AL_UNI + 16, AL_OT = 52480, AL_OT_END = AL_OT + 8 * 32 * 272;
static_assert(AL_END <= AL_OT && AL_OT_END <= RING_BYTES, "attn lds");
constexpr float LOG2E = 1.4426950408889634f;
#define NEG_INF (-__builtin_inff())

__device__ __forceinline__ void stage_k(LAS unsigned char* L, const bf16* src, size_t pitch, int tid) {
    const int key = tid >> 3, ch = tid & 7;
    *(LAS v4u*)(L + AL_K + key * 144 + ch * 16) = *(const GAS v4u*)(src + (size_t)key * pitch + ch * 8);
}
__device__ __forceinline__ void stage_v(LAS unsigned char* L, const bf16* src, size_t pitch, int tid) {
    const int d = tid >> 3, ch = tid & 7;
    *(LAS v4u*)(L + AL_V + d * 144 + ch * 16) = *(const GAS v4u*)(src + (size_t)d * pitch + ch * 8);
}
__device__ __forceinline__ f32x16 qk_sub(const LAS unsigned char* L, int sub, const bf16x8 (&qf)[4], int l31, int h5) {
    f32x16 acc;
#pragma unroll
    for (int i = 0; i < 16; ++i) acc[i] = 0.f;
#pragma unroll
    for (int s = 0; s < 4; ++s) { const bf16x8 a = *(const LAS bf16x8*)(L + AL_K + (sub * 32 + l31) * 144 + (16 * s + 8 * h5) * 2); acc = MFMA32(a, qf[s], acc); }
    return acc;
}
__device__ __forceinline__ void pv_sub(const LAS unsigned char* L, int sub, const f32x16& p, f32x16 (&O)[2], int l31, int h5) {
#pragma unroll
    for (int kq = 0; kq < 2; ++kq) {
        const bf16x8 pb = PACK_STEP(p, kq);
#pragma unroll
        for (int dt = 0; dt < 2; ++dt) {
            const s16x4 lo = *(const LAS s16x4*)(L + AL_V + (dt * 32 + l31) * 144 + (sub * 32 + 16 * kq + 4 * h5) * 2);
            const s16x4 hi = *(const LAS s16x4*)(L + AL_V + (dt * 32 + l31) * 144 + (sub * 32 + 16 * kq + 8 + 4 * h5) * 2);
            O[dt] = MFMA32(join44(lo, hi), pb, O[dt]);
        }
    }
}
__device__ __forceinline__ void online_update(const LAS unsigned char* L, int sub, f32x16& sc, float& m, float& l, f32x16 (&O)[2], int l31, int h5) {
    float tmax = sc[0];
#pragma unroll
    for (int i = 1; i < 16; ++i) tmax = fmaxf(tmax, sc[i]);
    tmax = fmaxf(tmax, __shfl_xor(tmax, 32));
    const float mnew = fmaxf(m, tmax), ms = (mnew == NEG_INF) ? 0.f : mnew;
    const float alpha = __builtin_amdgcn_exp2f(m - ms);
    float ps = 0.f;
#pragma unroll
    for (int i = 0; i < 16; ++i) { sc[i] = __builtin_amdgcn_exp2f(sc[i] - ms); ps += sc[i]; }
    l = l * alpha + ps; m = mnew;
#pragma unroll
    for (int i = 0; i < 16; ++i) { O[0][i] *= alpha; O[1][i] *= alpha; }
    pv_sub(L, sub, sc, O, l31, h5);
}

__device__ __forceinline__ void nsa_prompt_unit(Frame& F, int unit) {
    const int b = unit >> 8, g = (unit >> 7) & 1, qt = unit & 127, t0 = qt * 64;
    int tid = F.tid; asm volatile("" : "+v"(tid));
    const int lane = tid & 63, w = F.wave, l31 = lane & 31, h5 = lane >> 5, ql = l31 >> 2, r = l31 & 3;
    LAS unsigned char* L = F.lds + RING_OFF;
    const bf16* HB = (const bf16*)(F.ws + WS_HB);
    const int pos = t0 + 8 * w + ql;
    const size_t qrow = (size_t)(b * T + pos);
    const float slope2 = __builtin_amdgcn_exp2f(-(float)(g * 4 + r + 1)) * LOG2E, scale2 = 0.125f * LOG2E;
    bf16x8 qf[4];
#pragma unroll
    for (int s = 0; s < 4; ++s) qf[s] = *(const GAS bf16x8*)(HB + qrow * NIN + C_QA + (g * 4 + r) * 64 + 16 * s + 8 * h5);
    float gate[3];
#pragma unroll
    for (int i = 0; i < 3; ++i) gate[i] = sigmoidf_(bf2f(HB[qrow * NIN + C_GLA + (g * 4 + r) * 3 + i]));
    for (int i = tid; i < (AL_END - AL_IMP) / 4; i += NWAVES * 64) ((LAS unsigned*)(L + AL_IMP))[i] = 0u;
    f32x16 O[2];
    LAS unsigned char* otp = L + AL_OT + (w * 32 + l31) * 272 + 16 * h5;
    const bf16* KCP = (const bf16*)(F.ws + WS_KCP) + (size_t)(b * 2 + g) * 512 * 64;
    const bf16* VCTP = (const bf16*)(F.ws + WS_VCTP) + (size_t)(b * 2 + g) * 64 * 512;
    const int nmax_u = (t0 + 63 - 31) >> 4, ntile_c = (nmax_u >> 6) + 1;
    const int nmax_w = (t0 + 8 * w + 7 - 31) >> 4;
    float m = NEG_INF, l = 0.f;
    for (int tl = 0; tl < ntile_c; ++tl) {
        __syncthreads();
        stage_k(L, KCP + (size_t)tl * 64 * 64, 64, tid);
        __syncthreads();
#pragma unroll
        for (int sub = 0; sub < 2; ++sub) {
            const int n0 = tl * 64 + sub * 32;
            if (n0 > nmax_w) continue;
            f32x16 sc = qk_sub(L, sub, qf, l31, h5);
#pragma unroll
            for (int i = 0; i < 16; ++i) { const int dist = pos - (16 * (n0 + crow(i, h5)) + 31); sc[i] = dist >= 0 ? sc[i] * scale2 - slope2 * (float)dist : NEG_INF; }
            float tmax = sc[0];
#pragma unroll
            for (int i = 1; i < 16; ++i) tmax = fmaxf(tmax, sc[i]);
            tmax = fmaxf(tmax, __shfl_xor(tmax, 32));
            const float mnew = fmaxf(m, tmax), ms = (mnew == NEG_INF) ? 0.f : mnew;
            float ps = 0.f;
#pragma unroll
            for (int i = 0; i < 16; ++i) ps += __builtin_amdgcn_exp2f(sc[i] - ms);
            l = l * __builtin_amdgcn_exp2f(m - ms) + ps; m = mnew;
        }
    }
    l += __shfl_xor(l, 32);
    const float inv_l = l > 0.f ? 1.0f / l : 0.f, mfin = (m == NEG_INF) ? 0.f : m;
#pragma unroll
    for (int i = 0; i < 16; ++i) { O[0][i] = 0.f; O[1][i] = 0.f; }
    for (int tl = 0; tl < ntile_c; ++tl) {
        __syncthreads();
        stage_k(L, KCP + (size_t)tl * 64 * 64, 64, tid);
        stage_v(L, VCTP + tl * 64, 512, tid);
        __syncthreads();
#pragma unroll
        for (int sub = 0; sub < 2; ++sub) {
            const int n0 = tl * 64 + sub * 32;
            if (n0 > nmax_w) continue;
            f32x16 sc = qk_sub(L, sub, qf, l31, h5);
#pragma unroll
            for (int i = 0; i < 16; ++i) { const int dist = pos - (16 * (n0 + crow(i, h5)) + 31); sc[i] = dist >= 0 ? __builtin_amdgcn_exp2f(sc[i] * scale2 - slope2 * (float)dist - mfin) * inv_l : 0.f; }
#pragma unroll
            for (int a = 0; a < 4; ++a) {
                float sm = (sc[4 * a] + sc[4 * a + 1]) + (sc[4 * a + 2] + sc[4 * a + 3]);
                sm += __shfl_xor(sm, 1); sm += __shfl_xor(sm, 2);
                if (r == 0) ((LAS float*)(L + AL_IMP))[(8 * w + ql) * 128 + (n0 >> 2) + 2 * a + h5] = sm;
            }
            pv_sub(L, sub, sc, O, l31, h5);
        }
    }
#pragma unroll
    for (int dt = 0; dt < 2; ++dt)
#pragma unroll
        for (int a = 0; a < 4; ++a) *(LAS f32x4*)(otp + dt * 128 + a * 32) = (f32x4){gate[0] * O[dt][4 * a], gate[0] * O[dt][4 * a + 1], gate[0] * O[dt][4 * a + 2], gate[0] * O[dt][4 * a + 3]};
    __syncthreads();
    {
        const int q = tid >> 3, sub = tid & 7, qpos = t0 + q, cur = qpos >> 6;
        float vals[16]; unsigned avail = 0u, bits = 0u;
#pragma unroll
        for (int i = 0; i < 16; ++i) { const int j = sub * 16 + i; vals[i] = ((LAS float*)(L + AL_IMP))[q * 128 + j];
            if (j <= cur) { if (cur < 16 || j == 0 || j == cur || j == cur - 1) bits |= 1u << i; else avail |= 1u << i; } }
        if (cur >= 16) {
            for (int round = 0; round < 13; ++round) {
                float bv = -1.0f; int bi = 1 << 20;
#pragma unroll
                for (int i = 0; i < 16; ++i) if (((avail >> i) & 1u) && vals[i] > bv) { bv = vals[i]; bi = sub * 16 + i; }
#pragma unroll
                for (int o = 1; o < 8; o <<= 1) { const float ov = __shfl_xor(bv, o); const int oi = __shfl_xor(bi, o); if (ov > bv || (ov == bv && oi < bi)) { bv = ov; bi = oi; } }
                if ((bi >> 4) == sub) { avail &= ~(1u << (bi & 15)); bits |= 1u << (bi & 15); }
            }
        }
        if (bits) { __hip_atomic_fetch_or((LAS unsigned*)(L + AL_SELM) + q * 4 + (sub >> 1), bits << (16 * (sub & 1)), __ATOMIC_RELAXED, __HIP_MEMORY_SCOPE_WORKGROUP); __hip_atomic_fetch_or((LAS unsigned*)(L + AL_UNI) + (sub >> 1), bits << (16 * (sub & 1)), __ATOMIC_RELAXED, __HIP_MEMORY_SCOPE_WORKGROUP); }
    }
    __syncthreads();
    {
        m = NEG_INF; l = 0.f;
#pragma unroll
        for (int i = 0; i < 16; ++i) { O[0][i] = 0.f; O[1][i] = 0.f; }
        const bf16* Ks = HB + (size_t)(b * T) * NIN + C_KVS + g * 64;
        const bf16* Vs = (const bf16*)(F.ws + WS_VST) + (size_t)(b * 2 + g) * 64 * T;
        for (int jw = 0; jw < 4; ++jw) {
            unsigned ub = __builtin_amdgcn_readfirstlane(((LAS unsigned*)(L + AL_UNI))[jw]);
            const unsigned mysel = ((LAS unsigned*)(L + AL_SELM))[(8 * w + ql) * 4 + jw];
            while (ub) {
                const int jb = __builtin_ctz(ub); ub &= ub - 1u;
                const int j = jw * 32 + jb, pos0 = j * 64;
                __syncthreads();
                stage_k(L, Ks + (size_t)pos0 * NIN, NIN, tid);
                stage_v(L, Vs + pos0, T, tid);
                __syncthreads();
                const bool sel = (mysel >> jb) & 1u;
                if (!__any(sel && pos >= pos0)) continue;
#pragma unroll
                for (int sub = 0; sub < 2; ++sub) {
                    f32x16 sc = qk_sub(L, sub, qf, l31, h5);
#pragma unroll
                    for (int i = 0; i < 16; ++i) { const int dist = pos - (pos0 + sub * 32 + crow(i, h5)); sc[i] = (sel && dist >= 0) ? sc[i] * scale2 - slope2 * (float)dist : NEG_INF; }
                    online_update(L, sub, sc, m, l, O, l31, h5);
                }
            }
        }
        l += __shfl_xor(l, 32);
        const float sc_ = l > 0.f ? gate[1] / l : 0.f;
#pragma unroll
        for (int dt = 0; dt < 2; ++dt)
#pragma unroll
            for (int a = 0; a < 4; ++a) { f32x4 t = *(LAS f32x4*)(otp + dt * 128 + a * 32); t += (f32x4){sc_ * O[dt][4 * a], sc_ * O[dt][4 * a + 1], sc_ * O[dt][4 * a + 2], sc_ * O[dt][4 * a + 3]}; *(LAS f32x4*)(otp + dt * 128 + a * 32) = t; }
    }
    {
        m = NEG_INF; l = 0.f;
#pragma unroll
        for (int i = 0; i < 16; ++i) { O[0][i] = 0.f; O[1][i] = 0.f; }
        const bf16* Kw = HB + (size_t)(b * T) * NIN + C_KVW + g * 64;
        const bf16* Vw = (const bf16*)(F.ws + WS_VWT) + (size_t)(b * 2 + g) * 64 * T;
        const int kb_lo = qt >= 8 ? qt - 8 : 0;
        for (int kb = kb_lo; kb <= qt; ++kb) {
            const int pos0 = kb * 64;
            __syncthreads();
            stage_k(L, Kw + (size_t)pos0 * NIN, NIN, tid);
            stage_v(L, Vw + pos0, T, tid);
            __syncthreads();
#pragma unroll
            for (int sub = 0; sub < 2; ++sub) {
                f32x16 sc = qk_sub(L, sub, qf, l31, h5);
#pragma unroll
                for (int i = 0; i < 16; ++i) { const int dist = pos - (pos0 + sub * 32 + crow(i, h5)); sc[i] = (dist >= 0 && dist < 512) ? sc[i] * scale2 - slope2 * (float)dist : NEG_INF; }
                online_update(L, sub, sc, m, l, O, l31, h5);
            }
        }
        l += __shfl_xor(l, 32);
        const float sc_ = l > 0.f ? gate[2] / l : 0.f;
#pragma unroll
        for (int i = 0; i < 16; ++i) { O[0][i] *= sc_; O[1][i] *= sc_; }
    }
    bf16* oa = (bf16*)(F.ws + WS_OA) + qrow * 512 + (g * 4 + r) * 64;
#pragma unroll
    for (int dt = 0; dt < 2; ++dt)
#pragma unroll
        for (int a = 0; a < 4; ++a) { const f32x4 t = *(LAS f32x4*)(otp + dt * 128 + a * 32); u32x2 ow; ow.x = cvtpk(t.x + O[dt][4 * a], t.y + O[dt][4 * a + 1]); ow.y = cvtpk(t.z + O[dt][4 * a + 2], t.w + O[dt][4 * a + 3]);
            *(GAS u32x2*)(oa + dt * 32 + 8 * a + 4 * h5) = ow; }
    __syncthreads();
}

constexpr int SL_SC = 0, SL_Q = 16384, SL_RED = SL_Q + 1024, SL_IMP = SL_RED + 8192, SL_SEL = SL_IMP + 2048, SL_SELB = SL_SEL + 64, SL_OUT = SL_SELB + 128, SL_END = SL_OUT + 1024;
static_assert(SL_END <= RING_BYTES, "sample lds");
struct SampleCtx { const float* kcvs; const float* csel; const float* cwin; const float* new_sel; const float* new_win; };
template <int KIND> __device__ __forceinline__ const float* sample_key(const SampleCtx& c, const LAS int* SEL, const LAS unsigned long long* SELB, int kidx, int& dist, bool& valid) {
    if (KIND == 0) { valid = kidx < NCMP_S; dist = PAST - (16 * kidx + 31); return c.kcvs + (size_t)(valid ? kidx : 0) * 256; }
    if (KIND == 1) { const int slot = kidx >> 6, i = kidx & 63, jb = SEL[slot];
        if (jb < 256) { valid = true; dist = PAST - (jb * 64 + i); return c.csel + SELB[slot] + (size_t)i * 256; }
        valid = (i == 0); dist = 0; return c.new_sel; }
    valid = (kidx >= 1 && kidx <= 512); dist = 512 - kidx;
    return kidx == 512 ? c.new_win : c.cwin + (size_t)((kidx >= 1 && kidx < 512) ? kidx : 1) * 256;
}
__device__ __forceinline__ void block_max4(LAS float* red, float (&v)[4], int wave, int lane) {
#pragma unroll
    for (int r = 0; r < 4; ++r) { float x = v[r];
#pragma unroll
        for (int o = 1; o < 64; o <<= 1) x = fmaxf(x, __shfl_xor(x, o));
        if (lane == 0) red[wave * 4 + r] = x; }
    __syncthreads();
#pragma unroll
    for (int r = 0; r < 4; ++r) { float x = red[r];
#pragma unroll
        for (int q = 1; q < 8; ++q) x = fmaxf(x, red[q * 4 + r]);
        v[r] = x; }
    __syncthreads();
}
__device__ __forceinline__ void block_sum4(LAS float* red, float (&v)[4], int wave, int lane) {
#pragma unroll
    for (int r = 0; r < 4; ++r) { const float x = wave_sum(v[r]); if (lane == 0) red[wave * 4 + r] = x; }
    __syncthreads();
#pragma unroll
    for (int r = 0; r < 4; ++r) { float x = 0.f;
#pragma unroll
        for (int q = 0; q < 8; ++q) x += red[q * 4 + r];
        v[r] = x; }
    __syncthreads();
}
template <int KIND> __device__ __forceinline__ void sample_branch(Frame& F, const SampleCtx& c, int b, int g, int tid) {
    constexpr int NK = KIND == 2 ? 544 : 1024;
    const int lane = tid & 63, wave = F.wave, sub = lane & 15, kg = lane >> 4;
    LAS unsigned char* L = F.lds + RING_OFF;
    LAS float* SC = (LAS float*)(L + SL_SC); LAS float* Q = (LAS float*)(L + SL_Q); LAS float* red = (LAS float*)(L + SL_RED);
    const LAS int* SEL = (const LAS int*)(L + SL_SEL); const LAS unsigned long long* SELB = (const LAS unsigned long long*)(L + SL_SELB);
    f32x4 q4[4];
#pragma unroll
    for (int r = 0; r < 4; ++r) q4[r] = *(const LAS f32x4*)(Q + r * 64 + 4 * sub);
#pragma unroll 4
    for (int it = 0; it < NK / 32; ++it) {
        const int kidx = it * 32 + wave * 4 + kg; int dist; bool valid;
        const float* kp = sample_key<KIND>(c, SEL, SELB, kidx, dist, valid);
        const f32x4 kv = *(const GAS f32x4*)(kp + 4 * sub);
        float part[4];
#pragma unroll
        for (int r = 0; r < 4; ++r) { float p = (kv.x * q4[r].x + kv.y * q4[r].y) + (kv.z * q4[r].z + kv.w * q4[r].w);
            p += __shfl_xor(p, 1); p += __shfl_xor(p, 2); p += __shfl_xor(p, 4); p += __shfl_xor(p, 8); part[r] = p; }
        if (sub < 4) { const float pr = sub == 0 ? part[0] : (sub == 1 ? part[1] : (sub == 2 ? part[2] : part[3]));
            SC[sub * 1024 + kidx] = valid ? pr * 0.125f - __builtin_amdgcn_exp2f(-(float)(g * 4 + sub + 1)) * (float)dist : NEG_INF; }
    }
    __syncthreads();
    float mx[4] = {NEG_INF, NEG_INF, NEG_INF, NEG_INF};
    for (int kidx = tid; kidx < NK; kidx += 512)
#pragma unroll
        for (int r = 0; r < 4; ++r) mx[r] = fmaxf(mx[r], SC[r * 1024 + kidx]);
    block_max4(red, mx, wave, lane);
    float sm[4] = {0.f, 0.f, 0.f, 0.f};
    for (int kidx = tid; kidx < NK; kidx += 512)
#pragma unroll
        for (int r = 0; r < 4; ++r) { const float s = SC[r * 1024 + kidx]; const float p = s == NEG_INF ? 0.f : __expf(s - mx[r]); SC[r * 1024 + kidx] = p; sm[r] += p; }
    block_sum4(red, sm, wave, lane);
    for (int kidx = tid; kidx < NK; kidx += 512)
#pragma unroll
        for (int r = 0; r < 4; ++r) SC[r * 1024 + kidx] *= (sm[r] > 0.f ? 1.0f / sm[r] : 0.f);
    __syncthreads();
    f32x4 acc[4];
#pragma unroll
    for (int r = 0; r < 4; ++r) acc[r] = (f32x4){0.f, 0.f, 0.f, 0.f};
#pragma unroll 4
    for (int it = 0; it < NK / 32; ++it) {
        const int kidx = it * 32 + wave * 4 + kg; int dist; bool valid;
        const float* kp = sample_key<KIND>(c, SEL, SELB, kidx, dist, valid);
        const f32x4 vv = *(const GAS f32x4*)(kp + 128 + 4 * sub);
#pragma unroll
        for (int r = 0; r < 4; ++r) acc[r] += vv * SC[r * 1024 + kidx];
    }
#pragma unroll
    for (int r = 0; r < 4; ++r)
#pragma unroll
        for (int j = 0; j < 4; ++j) { float x = acc[r][j]; x += __shfl_xor(x, 16); x += __shfl_xor(x, 32); acc[r][j] = x; }
    if (lane < 16) {
#pragma unroll
        for (int r = 0; r < 4; ++r) *(LAS f32x4*)(red + wave * 256 + r * 64 + 4 * sub) = acc[r];
    }
    __syncthreads();
    if (tid < 256) { const int r = tid >> 6; float o = 0.f;
#pragma unroll
        for (int wv = 0; wv < 8; ++wv) o += red[wv * 256 + tid];
        const float gt = sigmoidf_(bf2f(((const bf16*)(F.ws + WS_HB))[(size_t)(MP + b) * NIN + C_GLA + (g * 4 + r) * 3 + KIND]));
        ((LAS float*)(L + SL_OUT))[tid] += gt * o; }
    __syncthreads();
}
__device__ __forceinline__ void nsa_sample_unit(Frame& F, int unit) {
    const int b = unit >> 1, g = unit & 1;
    int tid = F.tid; asm volatile("" : "+v"(tid));
    LAS unsigned char* L = F.lds + RING_OFF;
    LAS float* SC = (LAS float*)(L + SL_SC); LAS float* Q = (LAS float*)(L + SL_Q); LAS float* IMP = (LAS float*)(L + SL_IMP); LAS int* SEL = (LAS int*)(L + SL_SEL);
    LAS unsigned long long* SELB = (LAS unsigned long long*)(L + SL_SELB);
    SampleCtx c;
    c.kcvs = (const float*)(F.ws + WS_KCVS) + (size_t)b * 1024 * 256 + g * 64; c.csel = F.in[3] + g * 64; c.cwin = F.in[4] + (size_t)b * 512 * 256 + g * 64;
    c.new_sel = F.out + OFF7 + (size_t)b * 256 + g * 64; c.new_win = F.out + OFF8 + ((size_t)b * 512 + 511) * 256 + g * 64;
    __syncthreads();
    if (tid < 256) { Q[tid] = bf2f(((const bf16*)(F.ws + WS_HB))[(size_t)(MP + b) * NIN + C_QA + g * 256 + tid]); ((LAS float*)(L + SL_OUT))[tid] = 0.f; }
    __syncthreads();
    sample_branch<0>(F, c, b, g, tid);
    if (tid < 257) { float s = 0.f;
#pragma unroll
        for (int cc = 0; cc < 4; ++cc) { const int n = 4 * tid + cc; if (n < NCMP_S) s += (SC[n] + SC[1024 + n]) + (SC[2048 + n] + SC[3072 + n]); }
        IMP[tid] = (tid == 0 || tid >= 255) ? -1.0f : s; }
    __syncthreads();
    if (tid < 64) {
        if (tid == 0) { SEL[0] = 0; SEL[1] = 255; SEL[2] = 256; }
        float vals[4]; unsigned avail = 0xfu;
#pragma unroll
        for (int i = 0; i < 4; ++i) { const int j = tid * 4 + i; vals[i] = IMP[j]; if (vals[i] < 0.f) avail &= ~(1u << i); }
        for (int round = 0; round < 13; ++round) {
            float bv = -1.0f; int bi = 1 << 20;
#pragma unroll
            for (int i = 0; i < 4; ++i) if (((avail >> i) & 1u) && vals[i] > bv) { bv = vals[i]; bi = tid * 4 + i; }
#pragma unroll
            for (int o = 1; o < 64; o <<= 1) { const float ov = __shfl_xor(bv, o); const int oi = __shfl_xor(bi, o); if (ov > bv || (ov == bv && oi < bi)) { bv = ov; bi = oi; } }
            if ((bi >> 2) == tid) avail &= ~(1u << (bi & 3));
            if (tid == 0) SEL[3 + round] = bi;
        }
    }
    __syncthreads();
    if (tid < 16) { const int jb = SEL[tid]; const int* pt = (const int*)F.in[6] + b * NPAGES;
        SELB[tid] = jb < 256 ? ((unsigned long long)pt[jb >> 1] * 128ull + (unsigned long long)((jb & 1) * 64)) * 256ull : 0ull; }
    __syncthreads();
    sample_branch<1>(F, c, b, g, tid);
    sample_branch<2>(F, c, b, g, tid);
    if (tid < 256) ((bf16*)(F.ws + WS_OA))[(size_t)(MP + b) * 512 + g * 256 + tid] = (bf16)f2bf(((LAS float*)(L + SL_OUT))[tid]);
    __syncthreads();
}
__device__ __forceinline__ void p3_phase(Frame& F) {
    for (int u = blockIdx.x; u < 16 * HG_NSEG; u += F.G) hgrn_segment<1>(F, u / HG_NSEG, u % HG_NSEG);
    for (int p = blockIdx.x; p < 256; p += F.G) { const int bg = p >> 6, qq = p & 63; nsa_prompt_unit(F, bg * 128 + 127 - qq); nsa_prompt_unit(F, bg * 128 + qq); }
    for (int u = blockIdx.x; u < 2 * MS; u += F.G) nsa_sample_unit(F, u);
}
namespace pg8 {
typedef unsigned u32x2e __attribute__((ext_vector_type(2)));
__device__ __forceinline__ float bfl(unsigned w) { return __uint_as_float(w << 16); }
__device__ __forceinline__ float bfh(unsigned w) { return __uint_as_float(w & 0xffff0000u); }
__device__ __forceinline__ float sgm(float x) { return 1.0f / (1.0f + __expf(-x)); }
struct EpiGateA {
    static constexpr bool PERM = false, AFTER_DRAIN = false;
    const bf16_t* HBp; float* TB;
    __device__ __forceinline__ void operator()(const f32x4 (&acc)[2][2][4][2], const Unit& u, int wr, int wc, int fr, int fq) const {
        const int row0 = u.pm * BM + wr * 64 + fr, col0 = u.pn * BM + wc * 32 + 4 * fq;
#pragma unroll
        for (int ai = 0; ai < 2; ++ai)
#pragma unroll
            for (int m = 0; m < 4; ++m) { const size_t r = (size_t)(row0 + ai * HALF + m * 16);
#pragma unroll
                for (int bj = 0; bj < 2; ++bj)
#pragma unroll
                    for (int n = 0; n < 2; ++n) { const int c = col0 + bj * HALF + n * 16; const u32x2e gw = *(const u32x2e*)(HBp + r * NIN + C_MG + c); const f32x4 a = acc[ai][bj][m][n];
                        *(f32x4*)(TB + r * D + c) = (f32x4){sgm(bfl(gw.x)) * a[0], sgm(bfh(gw.x)) * a[1], sgm(bfl(gw.y)) * a[2], sgm(bfh(gw.y)) * a[3]}; } }
    }
};
struct EpiGateB {
    static constexpr bool PERM = false, AFTER_DRAIN = false;
    const bf16_t* HBp; const float* TB; bf16_t* MG;
    __device__ __forceinline__ void operator()(const f32x4 (&acc)[2][2][4][2], const Unit& u, int wr, int wc, int fr, int fq) const {
        const int row0 = u.pm * BM + wr * 64 + fr, col0 = u.pn * BM + wc * 32 + 4 * fq;
#pragma unroll
        for (int ai = 0; ai < 2; ++ai)
#pragma unroll
            for (int m = 0; m < 4; ++m) { const size_t r = (size_t)(row0 + ai * HALF + m * 16);
#pragma unroll
                for (int bj = 0; bj < 2; ++bj)
#pragma unroll
                    for (int n = 0; n < 2; ++n) { const int c = col0 + bj * HALF + n * 16; const u32x2e gw = *(const u32x2e*)(HBp + r * NIN + C_MG + D + c); const f32x4 a = acc[ai][bj][m][n]; const f32x4 t = *(const f32x4*)(TB + r * D + c);
                        u32x2e o; o.x = cvt_pk_bf16(t[0] + sgm(bfl(gw.x)) * a[0], t[1] + sgm(bfh(gw.x)) * a[1]); o.y = cvt_pk_bf16(t[2] + sgm(bfl(gw.y)) * a[2], t[3] + sgm(bfh(gw.y)) * a[3]);
                        *(u32x2e*)(MG + r * D + c) = o; } }
    }
};
struct EpiResid {
    static constexpr bool PERM = false, AFTER_DRAIN = false;
    const float* rp; const float* rs; float* Z;
    __device__ __forceinline__ void operator()(const f32x4 (&acc)[2][2][4][2], const Unit& u, int wr, int wc, int fr, int fq) const {
        const int row0 = u.pm * BM + wr * 64 + fr, col0 = u.pn * BM + wc * 32 + 4 * fq;
#pragma unroll
        for (int ai = 0; ai < 2; ++ai)
#pragma unroll
            for (int m = 0; m < 4; ++m) { const int r = row0 + ai * HALF + m * 16; const float* xr = r < MP ? rp + (size_t)r * D : (r < MP + MS ? rs + (size_t)(r - MP) * D : nullptr);
#pragma unroll
                for (int bj = 0; bj < 2; ++bj)
#pragma unroll
                    for (int n = 0; n < 2; ++n) { const int c = col0 + bj * HALF + n * 16; const f32x4 x = xr ? *(const f32x4*)(xr + c) : (f32x4){0.f, 0.f, 0.f, 0.f};
                        *(f32x4*)(Z + (size_t)r * D + c) = x * DN_ALPHA + acc[ai][bj][m][n]; } }
    }
};
struct EpiRelu2 {
    static constexpr bool PERM = true, AFTER_DRAIN = false;
    bf16_t* U;
    __device__ __forceinline__ void operator()(const f32x4 (&acc)[2][2][4][2], const Unit& u, int wr, int wc, int fr, int fq) const {
        const int row0 = u.pm * BM + wr * 64 + fr, col0 = u.pn * BM + wc * 32 + 8 * fq;
#pragma unroll
        for (int ai = 0; ai < 2; ++ai)
#pragma unroll
            for (int m = 0; m < 4; ++m) { bf16_t* rowp = U + (size_t)(row0 + ai * HALF + m * 16) * FF + col0;
#pragma unroll
                for (int bj = 0; bj < 2; ++bj) { f32x4 v0 = acc[ai][bj][m][0], v1 = acc[ai][bj][m][1];
#pragma unroll
                    for (int j = 0; j < 4; ++j) { const float a = fmaxf(v0[j], 0.f), b = fmaxf(v1[j], 0.f); v0[j] = a * a; v1[j] = b * b; }
                    u32x4 w; w.x = cvt_pk_bf16(v0[0], v0[1]); w.y = cvt_pk_bf16(v0[2], v0[3]); w.z = cvt_pk_bf16(v1[0], v1[1]); w.w = cvt_pk_bf16(v1[2], v1[3]);
                    *(u32x4*)(rowp + bj * HALF) = w; } }
    }
};
}
__device__ __forceinline__ void ln_phase(Frame& F, const float* Z, const float* gam, const float* bet, int which) {
    const int gw = F.vcu * NWAVES + F.wave, NGW = F.G * NWAVES, lane = F.lane;
    const int nrows = MP + MS;
    for (int r = gw; r < nrows; r += NGW) {
        const GAS f32x4* zr = (const GAS f32x4*)(Z + (size_t)r * D) + lane;
        f32x4 v[4]; float s = 0.f;
        if (which && r >= MP) {
            const GAS f32x4* x1r = (const GAS f32x4*)((const float*)(F.ws + WS_X1F) + (size_t)r * D) + lane;
#pragma unroll
            for (int j = 0; j < 4; ++j) { f32x4 t = x1r[64 * j] * DN_ALPHA;
#pragma unroll
                for (int kq = 0; kq < 4; ++kq) t += *((const GAS f32x4*)(Z + (size_t)(MP + 32 * kq + (r - MP)) * D) + lane + 64 * j);
                v[j] = t; s += (t.x + t.y) + (t.z + t.w); }
        } else {
#pragma unroll
        for (int j = 0; j < 4; ++j) { v[j] = zr[64 * j]; s += (v[j].x + v[j].y) + (v[j].z + v[j].w); }
        }
        const float mean = wave_sum(s) * (1.f / D); float s2 = 0.f;
#pragma unroll
        for (int j = 0; j < 4; ++j) { v[j] = v[j] - mean; s2 += (v[j].x * v[j].x + v[j].y * v[j].y) + (v[j].z * v[j].z + v[j].w * v[j].w); }
        const float rstd = 1.f / sqrtf(wave_sum(s2) * (1.f / D) + LN_EPS);
        float* of = which ? (r < MP ? F.out + OFF0 + (size_t)r * D : F.out + OFF1 + (size_t)(r - MP) * D) : (float*)(F.ws + WS_X1F) + (size_t)r * D;
#pragma unroll
        for (int j = 0; j < 4; ++j) { const f32x4 gg = *((const GAS f32x4*)gam + lane + 64 * j), bb = *((const GAS f32x4*)bet + lane + 64 * j);
            v[j] = v[j] * rstd * gg + bb; *((GAS f32x4*)of + lane + 64 * j) = v[j]; }
        if (!which) { GAS unsigned long long* o8 = (GAS unsigned long long*)((bf16*)(F.ws + WS_X1B) + (size_t)r * D) + lane;
#pragma unroll
            for (int j = 0; j < 4; ++j) o8[64 * j] = (unsigned long long)pk2(v[j].x, v[j].y) | ((unsigned long long)pk2(v[j].z, v[j].w) << 32); }
    }
}
__device__ __forceinline__ f32x16 small_gemm(const bf16* A, int lda, const bf16* Bt, int K, int n0, int k0, int k1, int l31, int h5, f32x16 acc) {
    const bf16* ap = A + (size_t)l31 * lda + 8 * h5; const bf16* bp = Bt + (size_t)(n0 + l31) * K + 8 * h5;
#pragma unroll 8
    for (int k = k0; k < k1; k += 16) acc = MFMA32(*(const GAS bf16x8*)(ap + k), *(const GAS bf16x8*)(bp + k), acc);
    return acc;
}
#define SMALL_TASK_LOOP(NT) for (int it = F.vcu + F.G * F.wave; it < (NT); it += F.G * NWAVES)
__device__ __forceinline__ f32x16 zero16() { f32x16 z;
#pragma unroll
    for (int i = 0; i < 16; ++i) z[i] = 0.f;
    return z; }
__device__ __forceinline__ void sample_merge_tasks(Frame& F) {
    const int l31 = F.lane & 31, h5 = F.lane >> 5; const bf16* HB = (const bf16*)(F.ws + WS_HB);
    SMALL_TASK_LOOP(32) { const int n0 = it * 32, n = n0 + l31;
        const f32x16 aa = small_gemm((const bf16*)(F.ws + WS_OA) + (size_t)MP * 512, 512, (const bf16*)(F.ws + WS_WA), 512, n0, 0, 512, l31, h5, zero16());
        const f32x16 ab = small_gemm((const bf16*)(F.ws + WS_OB) + (size_t)MP * 512, 512, (const bf16*)(F.ws + WS_WB), 512, n0, 0, 512, l31, h5, zero16());
#pragma unroll
        for (int v = 0; v < 16; ++v) { const size_t row = (size_t)(MP + crow(v, h5));
            const float g1 = sigmoidf_(bf2f(HB[row * NIN + C_MG + n])), g2 = sigmoidf_(bf2f(HB[row * NIN + C_MG + D + n]));
            ((bf16*)(F.ws + WS_MG))[row * D + n] = (bf16)f2bf(g1 * aa[v] + g2 * ab[v]); } }
}
__device__ __forceinline__ void sample_wout_tasks(Frame& F) {
    const int l31 = F.lane & 31, h5 = F.lane >> 5;
    SMALL_TASK_LOOP(32) { const int n0 = it * 32, n = n0 + l31;
        const f32x16 a = small_gemm((const bf16*)(F.ws + WS_MG) + (size_t)MP * D, D, (const bf16*)(F.ws + WS_WO), D, n0, 0, D, l31, h5, zero16());
#pragma unroll
        for (int v = 0; v < 16; ++v) { const int row = crow(v, h5); ((float*)(F.ws + WS_Z1))[(size_t)(MP + row) * D + n] = DN_ALPHA * F.in[1][(size_t)row * D + n] + a[v]; } }
}
__device__ __forceinline__ void sample_up_tasks(Frame& F) {
    const int l31 = F.lane & 31, h5 = F.lane >> 5;
    SMALL_TASK_LOOP(128) { const int n0 = it * 32, n = n0 + l31;
        const f32x16 a = small_gemm((const bf16*)(F.ws + WS_X1B) + (size_t)MP * D, D, (const bf16*)(F.ws + WS_WUP), D, n0, 0, D, l31, h5, zero16());
#pragma unroll
        for (int v = 0; v < 16; ++v) { const float x = fmaxf(a[v], 0.f); ((bf16*)(F.ws + WS_UB))[(size_t)(MP + crow(v, h5)) * FF + n] = (bf16)f2bf(x * x); } }
}
__device__ __forceinline__ void sample_down_tasks(Frame& F) {
    const int l31 = F.lane & 31, h5 = F.lane >> 5;
    SMALL_TASK_LOOP(128) { const int n0 = (it & 31) * 32, kq = it >> 5, n = n0 + l31;
        const f32x16 a = small_gemm((const bf16*)(F.ws + WS_UB) + (size_t)MP * FF, FF, (const bf16*)(F.ws + WS_WDN), FF, n0, kq * 1024, kq * 1024 + 1024, l31, h5, zero16());
#pragma unroll
        for (int v = 0; v < 16; ++v) ((float*)(F.ws + WS_Z2))[(size_t)(MP + 32 * kq + crow(v, h5)) * D + n] = a[v]; }
}

#ifdef PROBE_LAST
#ifndef PROBE_BASE
#define PROBE_BASE WS_KCP
#endif
#ifndef PROBE_BYTES
#define PROBE_BYTES (WS_TB - WS_KCP)
#endif
__device__ __forceinline__ void probe_digest(Frame& F, const XcdBarrier& bar) {
    const size_t i0 = (size_t)blockIdx.x * 512 + F.tid, st = (size_t)F.G * 512;
    for (size_t i = i0; i < OUT_TOTAL; i += st) F.out[i] = 0.f;
    xcd_barrier(bar);
    const unsigned* w = (const unsigned*)(F.ws + PROBE_BASE); const size_t nw = (size_t)(PROBE_BYTES) / 4;
    unsigned h = 0u;
    for (size_t i = i0; i < nw; i += st) h += (w[i] ^ (unsigned)i) * 2654435761u;
#pragma unroll
    for (int o = 1; o < 64; o <<= 1) h += __shfl_xor(h, o);
    if (F.lane == 0) F.out[(size_t)blockIdx.x * 8 + F.wave] = (float)(h & 0xFFFFFu);
}
#endif
struct Args { const float* in[21]; float* out; unsigned char* ws; int ph_lo, ph_hi; };
__global__ void __launch_bounds__(NWAVES * 64, 2) nsa_fwd(Args args) {
    extern __shared__ __attribute__((aligned(16))) unsigned char lds[];
    Frame F;
    F.lds = (LAS unsigned char*)lds;
    F.MISC = (volatile LAS unsigned*)(F.lds + MISC_OFF);
    F.tid = threadIdx.x; F.lane = F.tid & 63; F.wave = __builtin_amdgcn_readfirstlane(F.tid >> 6);
    F.G = gridDim.x; { const int bx = blockIdx.x; F.vcu = (F.G % 8 == 0) ? (bx % 8) * (F.G / 8) + bx / 8 : bx; }
    F.ws = args.ws; F.out = args.out;
#pragma unroll
    for (int i = 0; i < 21; ++i) F.in[i] = args.in[i];
    F.ctl = (gu32*)(F.ws + WS_CTL);
    for (int u = F.tid; u < (LDS_BYTES - LDSCTL_OFF) / 4; u += NWAVES * 64) ((LAS unsigned*)(F.lds + LDSCTL_OFF))[u] = 0u;
    __syncthreads();
    XcdBarrier bar = xcd_barrier_post((unsigned*)(F.ctl + CW_BAR), F.MISC + 8);
    const int lo = args.ph_lo, hi = args.ph_hi;
#ifdef PROBE_TIMING
    unsigned long long ts[11];
#define STAMP(k) ts[k] = rt();
#else
#define STAMP(k)
#endif
    STAMP(0)
#define IN(k) (lo <= (k) && (k) < hi)
#define BOTH(k) (IN(k) && IN((k) + 1))
#define GRID_BAR() xcd_barrier(bar)


#ifdef PROBE_LAST
#define PROBE_AFTER(k) if ((k) == PROBE_LAST) { probe_digest(F, bar); return; }
#else
#define PROBE_AFTER(k)
#endif
    if (IN(0)) { p0_prologue(F); if (BOTH(0)) GRID_BAR(); }
    PROBE_AFTER(0)
    STAMP(1)
    if (IN(1)) {
        pg8::Gemm g{(const pg8::bf16_t*)(F.ws + WS_XB), (const pg8::bf16_t*)(F.ws + WS_WIN), MALL, NIN, D}; pg8::StaticOrder S; S.init(MALL, NIN, F.G, (int)blockIdx.x);
        pg8::EpiInProj E{(pg8::bf16_t*)(F.ws + WS_HB), F.out};
        pg8::gemm_phase<pg8::EpiInProj, pg8::StaticOrder, true, true>(F.lds + RING_OFF, g, S, E);
        if (BOTH(1)) GRID_BAR();
    }
    PROBE_AFTER(1)
    STAMP(2)

    if (IN(2)) { p2_phase(F); if (BOTH(2)) GRID_BAR(); }
    PROBE_AFTER(2)
    STAMP(3)
    if (IN(3)) { p3_phase(F); if (BOTH(3)) GRID_BAR(); }
    PROBE_AFTER(3)
    STAMP(4)
    if (IN(4)) {
        { pg8::Gemm g{(const pg8::bf16_t*)(F.ws + WS_OA), (const pg8::bf16_t*)(F.ws + WS_WA), MP, D, 512}; pg8::StaticOrder S; S.init(MP, D, F.G, (int)blockIdx.x);
          pg8::EpiGateA E{(const pg8::bf16_t*)(F.ws + WS_HB), (float*)(F.ws + WS_TB)};
          pg8::gemm_phase<pg8::EpiGateA, pg8::StaticOrder, true, true>(F.lds + RING_OFF, g, S, E); }
        { pg8::Gemm g{(const pg8::bf16_t*)(F.ws + WS_OB), (const pg8::bf16_t*)(F.ws + WS_WB), MP, D, 512}; pg8::StaticOrder S; S.init(MP, D, F.G, (int)blockIdx.x);
          pg8::EpiGateB E{(const pg8::bf16_t*)(F.ws + WS_HB), (const float*)(F.ws + WS_TB), (pg8::bf16_t*)(F.ws + WS_MG)};
          pg8::gemm_phase<pg8::EpiGateB, pg8::StaticOrder, true, true>(F.lds + RING_OFF, g, S, E); }
        sample_merge_tasks(F);
        if (BOTH(4)) GRID_BAR();
    }
    PROBE_AFTER(4)
    STAMP(5)
    if (IN(5)) {
        pg8::Gemm g{(const pg8::bf16_t*)(F.ws + WS_MG), (const pg8::bf16_t*)(F.ws + WS_WO), MP, D, D}; pg8::StaticOrder S; S.init(MP, D, F.G, (int)blockIdx.x);
        pg8::EpiResid E{F.in[0], F.in[1], (float*)(F.ws + WS_Z1)};
        pg8::gemm_phase<pg8::EpiResid, pg8::StaticOrder, true, true>(F.lds + RING_OFF, g, S, E);
        sample_wout_tasks(F);
        if (BOTH(5)) GRID_BAR();
    }
    PROBE_AFTER(5)
    STAMP(6)
    if (IN(6)) { ln_phase(F, (const float*)(F.ws + WS_Z1), F.in[15], F.in[16], 0); if (BOTH(6)) GRID_BAR(); }
    PROBE_AFTER(6)
    STAMP(7)
    if (IN(7)) {
        pg8::Gemm g{(const pg8::bf16_t*)(F.ws + WS_X1B), (const pg8::bf16_t*)(F.ws + WS_WUP), MP, FF, D}; pg8::StaticOrder S; S.init(MP, FF, F.G, (int)blockIdx.x);
        pg8::EpiRelu2 E{(pg8::bf16_t*)(F.ws + WS_UB)};
        pg8::gemm_phase<pg8::EpiRelu2, pg8::StaticOrder, true, true>(F.lds + RING_OFF, g, S, E);
        sample_up_tasks(F);
        if (BOTH(7)) GRID_BAR();
    }
    PROBE_AFTER(7)
    STAMP(8)
    if (IN(8)) {
        pg8::Gemm g{(const pg8::bf16_t*)(F.ws + WS_UB), (const pg8::bf16_t*)(F.ws + WS_WDN), MP, D, FF}; pg8::StaticOrder S; S.init(MP, D, F.G, (int)blockIdx.x);
        pg8::EpiResid E{(const float*)(F.ws + WS_X1F), (const float*)(F.ws + WS_X1F) + (size_t)MP * D, (float*)(F.ws + WS_Z2)};
        pg8::gemm_phase<pg8::EpiResid, pg8::StaticOrder, true, true>(F.lds + RING_OFF, g, S, E);
        sample_down_tasks(F);
        if (BOTH(8)) GRID_BAR();
    }
    PROBE_AFTER(8)
    STAMP(9)
    if (IN(9)) { ln_phase(F, (const float*)(F.ws + WS_Z2), F.in[19], F.in[20], 1); }
#ifdef PROBE_TIMING
    GRID_BAR();
    STAMP(10)
    { const size_t i0 = (size_t)blockIdx.x * 512 + F.tid, st = (size_t)F.G * 512; for (size_t i = i0; i < OUT_TOTAL; i += st) ((unsigned*)F.out)[i] = 0xAAAAAAABu; }
    GRID_BAR();
    if (blockIdx.x == 0) {
        const size_t offs[10] = {OFF0, OFF1, OFF2, OFF3, OFF4, OFF5, OFF6, OFF7, OFF8, OFF9};
#pragma unroll
        for (int k = 0; k < 10; ++k) { const unsigned n = (unsigned)((ts[k + 1] - ts[k]) / 10ull); for (unsigned i = F.tid; i < n; i += 512) ((unsigned*)F.out)[offs[k] + i] = 0xAAAAAAAAu; }
    }
#endif
#ifdef PROBE_SANITIZE
    GRID_BAR();
    { const size_t i0 = (size_t)blockIdx.x * 512 + F.tid, st = (size_t)F.G * 512;
      for (size_t i = i0; i < OUT_TOTAL; i += st) { const float v = F.out[i]; if (!(v - v == 0.f)) F.out[i] = 0.f; } }
#endif
#undef IN
#undef BOTH
}

extern "C" void kernel_launch(void* const* d_in, const int* in_sizes, int n_in, void* d_out, int out_size, void* d_ws, size_t ws_size, hipStream_t stream) {
    static int grid = 0;
    if (grid == 0) {
        if (n_in != 21 || (size_t)out_size != OUT_TOTAL || ws_size < WS_END) { fprintf(stderr, "kernel_launch: unexpected shapes: n_in %d out %d ws %zu (need %zu)\n", n_in, out_size, ws_size, (size_t)WS_END); grid = -1; return; }
        int dev = 0, cus = 0, per_cu = 0;
        if (hipGetDevice(&dev) != hipSuccess || hipDeviceGetAttribute(&cus, hipDeviceAttributeMultiprocessorCount, dev) != hipSuccess) { grid = -1; return; }
        if (hipFuncSetAttribute((const void*)nsa_fwd, hipFuncAttributeMaxDynamicSharedMemorySize, LDS_BYTES) != hipSuccess) { fprintf(stderr, "kernel_launch: hipFuncSetAttribute failed\n"); grid = -1; return; }
        if (hipOccupancyMaxActiveBlocksPerMultiprocessor(&per_cu, (const void*)nsa_fwd, NWAVES * 64, LDS_BYTES) != hipSuccess || per_cu < 1) { fprintf(stderr, "kernel_launch: occupancy query says %d\n", per_cu); }
        (void)hipGetLastError();
        grid = cus;
    }
    if (grid < 0) return;
    if (hipMemsetAsync((char*)d_ws + WS_CTL, 0, CTL_ZERO_BYTES, stream) != hipSuccess) return;
    Args a{};
    for (int i = 0; i < 21; ++i) a.in[i] = (const float*)d_in[i];
    a.out = (float*)d_out; a.ws = (unsigned char*)d_ws; a.ph_lo = 0; a.ph_hi = 100;
    hipLaunchKernelGGL(nsa_fwd, dim3(grid), dim3(NWAVES * 64), LDS_BYTES, stream, a);
}
```

```cpp
#include <hip/hip_runtime.h>
#include <cstdio>
#include <cstdint>
namespace pg8 {
#define PG8_LAS __attribute__((address_space(3)))
typedef unsigned short bf16_t;
typedef short bf16x8 __attribute__((ext_vector_type(8)));
typedef float f32x4 __attribute__((ext_vector_type(4)));
typedef unsigned u32x4 __attribute__((ext_vector_type(4)));
constexpr int BM = 256, BK = 64, HALF = 128, HTB = HALF * BK * 2  , STAGE_BYTES = 8 * HTB, NXCD = 8, WGM = 8;

__host__ __device__ __forceinline__ int lds_byte(int r, int c) { const int st = (r >> 4) * 2 + (c >> 5), rr = r & 15, cc = c & 31, ob = rr * 64 + cc * 2; return st * 1024 + (ob ^ (((ob >> 9) & 1) << 5)); }
__host__ __device__ __forceinline__ void stage_rc(int b, int& R, int& C) { const int st = b / 1024, sb = b % 1024, swz = sb ^ (((sb >> 9) & 1) << 5); R = (st >> 1) * 16 + swz / 64; C = (st & 1) * 32 + (swz % 64) / 2; }
__host__ __device__ __forceinline__ int perm32(int rho) { const int n = rho >> 4, i = rho & 15; return 8 * (i >> 2) + 4 * n + (i & 3); }

struct Unit { int pm, pn; };
struct Gemm { const bf16_t* A; const bf16_t* Bt; int M, N, K; };

struct StaticOrder {
    int nM, nN, nwg, G, c;
    __host__ __device__ void init(int M, int N, int G_, int c_) { nM = M / BM; nN = N / BM; nwg = nM * nN; G = G_; c = c_; }
    __host__ __device__ bool next(int i, Unit& u) const {
        const long L = (long)i * G + c; if (L >= nwg) return false;
        int wgid = (int)L; { const int q = nwg / NXCD, r = nwg % NXCD, xcd = wgid % NXCD, off = wgid / NXCD; wgid = (xcd < r ? xcd * (q + 1) : r * (q + 1) + (xcd - r) * q) + off; }
        const int nig = WGM * nN, gid = wgid / nig, fm = gid * WGM, gsz = (nM - fm) < WGM ? (nM - fm) : WGM;
        u.pm = fm + ((wgid % nig) % gsz); u.pn = (wgid % nig) / gsz; return true;
    }
    __device__ __forceinline__ void a_ready(const Unit&) const {}
    __device__ __forceinline__ void done(const Unit&) const {}
};

__device__ __forceinline__ unsigned cvt_pk_bf16(float lo, float hi) { unsigned r; asm volatile("v_cvt_pk_bf16_f32 %0, %1, %2" : "=v"(r) : "v"(lo), "v"(hi)); return r; }
typedef float f32x2 __attribute__((ext_vector_type(2)));
__device__ __forceinline__ f32x2 gelu_pk(f32x2 v) {
    const f32x2 av = __builtin_elementwise_abs(v), d = av * 0.2316418882f + 1.0f;
    f32x2 t; t.x = __builtin_amdgcn_rcpf(d.x); t.y = __builtin_amdgcn_rcpf(d.y);
    f32x2 q = t * 0.5307027145f + (-0.7265760135f); q = q * t + 0.7107068705f; q = q * t + (-0.142248368f); q = q * t + 0.127414796f; q = q * t;
    const f32x2 s = (v * v) * (-0.72134752044f);
    f32x2 e; e.x = __builtin_amdgcn_exp2f(s.x); e.y = __builtin_amdgcn_exp2f(s.y);
    const f32x2 m = v * (q * e), r = v - m;
    f32x2 o; o.x = v.x < 0.f ? m.x : r.x; o.y = v.y < 0.f ? m.y : r.y; return o;
}

template <int ACT  > struct EpiBf16 {
    static constexpr bool PERM = true, AFTER_DRAIN = false; static_assert(ACT == 0 || ACT == 1, "EpiBf16: ACT is 0 (none) or 1 (gelu_pk)");
    bf16_t* O; int ldc; const float* bias; int split_cols; size_t split_stride; float scale0;
    __device__ __forceinline__ void operator()(const f32x4 (&acc)[2][2][4][2], const Unit& u, int wr, int wc, int fr, int fq) const {
        const int row0 = u.pm * BM + wr * 64 + fr; int colt = u.pn * BM; bf16_t* base = O;
        float sc = 1.f; if (split_cols) { const int t = colt / split_cols; base += (size_t)t * split_stride; colt -= t * split_cols; if (t == 0) sc = scale0; }
        const int col0 = colt + wc * 32 + 8 * fq, bcol0 = u.pn * BM + wc * 32 + 8 * fq;
        f32x4 bv[2][2];
#pragma unroll
        for (int bj = 0; bj < 2; ++bj)
#pragma unroll
            for (int n = 0; n < 2; ++n) bv[bj][n] = bias ? *(const f32x4*)(bias + bcol0 + bj * HALF + 4 * n) : (f32x4){0.f, 0.f, 0.f, 0.f};
#pragma unroll
        for (int ai = 0; ai < 2; ++ai)
#pragma unroll
            for (int m = 0; m < 4; ++m) { bf16_t* rowp = base + (size_t)(row0 + ai * HALF + m * 16) * ldc + col0;
#pragma unroll
                for (int bj = 0; bj < 2; ++bj) { f32x4 v0 = acc[ai][bj][m][0] + bv[bj][0], v1 = acc[ai][bj][m][1] + bv[bj][1];
                    if (ACT == 1) { f32x2 a = gelu_pk((f32x2){v0[0], v0[1]}), b = gelu_pk((f32x2){v0[2], v0[3]}), c = gelu_pk((f32x2){v1[0], v1[1]}), d = gelu_pk((f32x2){v1[2], v1[3]});
                        v0 = (f32x4){a.x, a.y, b.x, b.y}; v1 = (f32x4){c.x, c.y, d.x, d.y}; }
                    v0 = v0 * sc; v1 = v1 * sc; u32x4 w; w.x = cvt_pk_bf16(v0[0], v0[1]); w.y = cvt_pk_bf16(v0[2], v0[3]); w.z = cvt_pk_bf16(v1[0], v1[1]); w.w = cvt_pk_bf16(v1[2], v1[3]);
                    *(u32x4*)(rowp + bj * HALF) = w; } }
    }
};

struct PanelStats {
    unsigned* xbuf;
    unsigned* cnt;
    unsigned* tmo;
    int ntn; float eps;
    unsigned code;
    __device__ __forceinline__ bool run(const f32x4 (&v)[2][2][4][2], const Unit& u, int wr, int wc, int fr, int fq, PG8_LAS unsigned char* lds, int wid, int lane) const {
        typedef float f32x2v __attribute__((ext_vector_type(2)));
        PG8_LAS f32x2v* P = (PG8_LAS f32x2v*)lds;
        PG8_LAS f32x2v* S = (PG8_LAS f32x2v*)(lds + 8192);
        PG8_LAS unsigned* flag = (PG8_LAS unsigned*)(lds + 8192 + 2048);
#pragma unroll
        for (int ai = 0; ai < 2; ++ai)
#pragma unroll
            for (int m = 0; m < 4; ++m) {
                float s = 0.f;
#pragma unroll
                for (int bj = 0; bj < 2; ++bj)
#pragma unroll
                    for (int n = 0; n < 2; ++n) { const f32x4 x = v[ai][bj][m][n]; s += (x[0] + x[1]) + (x[2] + x[3]); }
                s += __shfl_xor(s, 16); s += __shfl_xor(s, 32);
                const float mw = s * (1.0f / 64.0f); float q = 0.f;
#pragma unroll
                for (int bj = 0; bj < 2; ++bj)
#pragma unroll
                    for (int n = 0; n < 2; ++n) { const f32x4 d = v[ai][bj][m][n] - mw; q += (d[0] * d[0] + d[1] * d[1]) + (d[2] * d[2] + d[3] * d[3]); }
                q += __shfl_xor(q, 16); q += __shfl_xor(q, 32);
                if (fq == 0) P[(ai * HALF + wr * 64 + m * 16 + fr) * 4 + wc] = (f32x2v){mw, q};
            }
        asm volatile("s_waitcnt lgkmcnt(0)" ::: "memory"); __builtin_amdgcn_s_barrier(); asm volatile("" ::: "memory");
#if defined(BROKEN_EXCHANGE_NO_WAIT)
#warning BROKEN CONTROL BUILD: the row-statistics exchange does not wait; results are wrong by design
        if (blockIdx.x >= 64) { const long long t0_ = clock64(); while (clock64() - t0_ < 60000) __builtin_amdgcn_s_sleep(8); }
#endif
        const int row = wid * 32 + (lane & 31);
        if (lane < 32) {
            const f32x2v a = P[row * 4 + 0], b = P[row * 4 + 1], c = P[row * 4 + 2], d = P[row * 4 + 3];
            const float mt = (a.x + b.x + c.x + d.x) * 0.25f;
            const float da = a.x - mt, db = b.x - mt, dc = c.x - mt, dd = d.x - mt;
            const float m2 = (a.y + b.y) + (c.y + d.y) + 64.0f * ((da * da + db * db) + (dc * dc + dd * dd));
            unsigned long long* slot = (unsigned long long*)xbuf + ((size_t)(u.pm * BM + row) * 4 + u.pn);
            __hip_atomic_store(slot, ((unsigned long long)__float_as_uint(m2) << 32) | __float_as_uint(mt), __ATOMIC_RELAXED, __HIP_MEMORY_SCOPE_AGENT);
        }
        asm volatile("s_waitcnt vmcnt(0)" ::: "memory");
        if (lane == 0) __hip_atomic_fetch_add(cnt + 64 * u.pm, 1u, __ATOMIC_RELAXED, __HIP_MEMORY_SCOPE_AGENT);
        if (wid == 0) {
            bool dead = false; const unsigned long long t0 = __builtin_amdgcn_s_memrealtime(); const unsigned want = 8u * (unsigned)ntn;
            for (;;) {
#if defined(BROKEN_EXCHANGE_NO_WAIT)
                break;
#endif
                if ((unsigned)__builtin_amdgcn_readfirstlane(__hip_atomic_load(cnt + 64 * u.pm, __ATOMIC_RELAXED, __HIP_MEMORY_SCOPE_AGENT)) >= want) break;
                if (__builtin_amdgcn_s_memrealtime() - t0 > 2000000ull) {
                    if (lane == 0) { unsigned expect = 0u; __hip_atomic_compare_exchange_strong(tmo + 1, &expect, code | (unsigned)(u.pm & 0xff), __ATOMIC_RELAXED, __ATOMIC_RELAXED, __HIP_MEMORY_SCOPE_AGENT);
                                     __hip_atomic_store(tmo, 1u, __ATOMIC_RELAXED, __HIP_MEMORY_SCOPE_AGENT); }
                    dead = true; break; }
                __builtin_amdgcn_s_sleep(2);
            }
            __builtin_amdgcn_fence(__ATOMIC_ACQUIRE, "agent");
            if (lane == 0) flag[0] = dead ? 1u : 0u;
        }
        asm volatile("s_waitcnt vmcnt(0) lgkmcnt(0)" ::: "memory"); __builtin_amdgcn_s_barrier(); asm volatile("" ::: "memory");
        const bool bad = flag[0] != 0u;
        if (lane < 32) {
            const unsigned long long* slot = (const unsigned long long*)xbuf + (size_t)(u.pm * BM + row) * 4; float mt[4], m2[4]; float ms = 0.f;
#pragma unroll
            for (int t = 0; t < 4; ++t) { if (t < ntn) { const unsigned long long w = __hip_atomic_load(slot + t, __ATOMIC_RELAXED, __HIP_MEMORY_SCOPE_AGENT); mt[t] = __uint_as_float((unsigned)w); m2[t] = __uint_as_float((unsigned)(w >> 32)); } else { mt[t] = 0.f; m2[t] = 0.f; } ms += mt[t]; }
            const float mean = ms / (float)ntn; float q = 0.f;
#pragma unroll
            for (int t = 0; t < 4; ++t) if (t < ntn) { const float dm = mt[t] - mean; q += m2[t] + 256.0f * dm * dm; }
            S[row] = (f32x2v){mean, 1.0f / sqrtf(q / (256.0f * (float)ntn) + eps)};
        }
        asm volatile("s_waitcnt lgkmcnt(0)" ::: "memory"); __builtin_amdgcn_s_barrier(); asm volatile("" ::: "memory");
        return bad;
    }
};
struct EpiLnRes {
    static constexpr bool PERM = false, AFTER_DRAIN = true;
    const float* base; float* out; int ldc; const float* bias; PanelStats st; unsigned poison;
    __device__ __forceinline__ void fused(f32x4 (&acc)[2][2][4][2], const Unit& u, int wr, int wc, int fr, int fq, PG8_LAS unsigned char* lds, int wid, int lane) const {
        typedef float f32x2v __attribute__((ext_vector_type(2)));
        const PG8_LAS f32x2v* S = (const PG8_LAS f32x2v*)(lds + 8192);
        const int col0 = u.pn * BM + wc * 32 + 4 * fq;
#pragma unroll
        for (int bj = 0; bj < 2; ++bj)
#pragma unroll
            for (int n = 0; n < 2; ++n) { const f32x4 bv = bias ? *(const f32x4*)(bias + col0 + bj * HALF + n * 16) : (f32x4){0.f, 0.f, 0.f, 0.f};
#pragma unroll
                for (int ai = 0; ai < 2; ++ai)
#pragma unroll
                    for (int m = 0; m < 4; ++m) acc[ai][bj][m][n] += bv; }
        f32x4 pre[4][2][2];
#pragma unroll
        for (int m = 0; m < 4; ++m) { const size_t off = (size_t)(u.pm * BM + wr * 64 + m * 16 + fr) * ldc + col0;
#pragma unroll
            for (int bj = 0; bj < 2; ++bj)
#pragma unroll
                for (int n = 0; n < 2; ++n) pre[m][bj][n] = *(const f32x4*)(base + off + bj * HALF + n * 16); }
        const bool bad = st.run(acc, u, wr, wc, fr, fq, lds, wid, lane) || poison != 0u;
        const float qnan = __builtin_nanf("");
#pragma unroll
        for (int ai = 0; ai < 2; ++ai)
#pragma unroll
            for (int m = 0; m < 4; ++m) { const int r = ai * HALF + wr * 64 + m * 16 + fr; const f32x2v sr = S[r]; const size_t off = (size_t)(u.pm * BM + r) * ldc + col0;
#pragma unroll
                for (int bj = 0; bj < 2; ++bj)
#pragma unroll
                    for (int n = 0; n < 2; ++n) { const f32x4 bs = ai == 0 ? pre[m][bj][n] : *(const f32x4*)(base + off + bj * HALF + n * 16); f32x4 o = bs + (acc[ai][bj][m][n] - sr.x) * sr.y;
                        if (bad) o = (f32x4){qnan, qnan, qnan, qnan}; *(f32x4*)(out + off + bj * HALF + n * 16) = o; }
                if (m & 1) asm volatile("" ::: "memory"); }
    }
};
struct EpiLnResLn {
    static constexpr bool PERM = false, AFTER_DRAIN = true;
    const float* base; float* out; bf16_t* xn; int ldc; const float* bias; PanelStats st1, st2; unsigned poison;
    __device__ __forceinline__ void fused(f32x4 (&acc)[2][2][4][2], const Unit& u, int wr, int wc, int fr, int fq, PG8_LAS unsigned char* lds, int wid, int lane) const {
        typedef float f32x2v __attribute__((ext_vector_type(2))); typedef unsigned u32x2v __attribute__((ext_vector_type(2)));
        const PG8_LAS f32x2v* S = (const PG8_LAS f32x2v*)(lds + 8192);
        const int col0 = u.pn * BM + wc * 32 + 4 * fq;
#pragma unroll
        for (int bj = 0; bj < 2; ++bj)
#pragma unroll
            for (int n = 0; n < 2; ++n) { const f32x4 bv = bias ? *(const f32x4*)(bias + col0 + bj * HALF + n * 16) : (f32x4){0.f, 0.f, 0.f, 0.f};
#pragma unroll
                for (int ai = 0; ai < 2; ++ai)
#pragma unroll
                    for (int m = 0; m < 4; ++m) acc[ai][bj][m][n] += bv; }
        bool bad = st1.run(acc, u, wr, wc, fr, fq, lds, wid, lane) || poison != 0u;
        const float qnan = __builtin_nanf("");
#pragma unroll
        for (int ai = 0; ai < 2; ++ai)
#pragma unroll
            for (int m = 0; m < 4; ++m) { const int r = ai * HALF + wr * 64 + m * 16 + fr; const f32x2v sr = S[r]; const size_t off = (size_t)(u.pm * BM + r) * ldc + col0;
#pragma unroll
                for (int bj = 0; bj < 2; ++bj)
#pragma unroll
                    for (int n = 0; n < 2; ++n) { const f32x4 bs = *(const f32x4*)(base + off + bj * HALF + n * 16); acc[ai][bj][m][n] = bs + (acc[ai][bj][m][n] - sr.x) * sr.y; }
                asm volatile("" : "+v"(acc[ai][0][m][0]), "+v"(acc[ai][0][m][1]), "+v"(acc[ai][1][m][0]), "+v"(acc[ai][1][m][1]));
                if (m & 1) asm volatile("" ::: "memory"); }
        const bool bad1 = bad;
        bad = st2.run(acc, u, wr, wc, fr, fq, lds, wid, lane) || bad;
#pragma unroll
        for (int ai = 0; ai < 2; ++ai)
#pragma unroll
            for (int m = 0; m < 4; ++m) { const int r = ai * HALF + wr * 64 + m * 16 + fr; const f32x2v sr = S[r]; const size_t off = (size_t)(u.pm * BM + r) * ldc + col0;
#pragma unroll
                for (int bj = 0; bj < 2; ++bj)
#pragma unroll
                    for (int n = 0; n < 2; ++n) { const f32x4 x1 = acc[ai][bj][m][n]; *(f32x4*)(out + off + bj * HALF + n * 16) = bad1 ? (f32x4){qnan, qnan, qnan, qnan} : x1;
                        const f32x4 o = (x1 - sr.x) * sr.y; u32x2v w; w.x = cvt_pk_bf16(o[0], o[1]); w.y = cvt_pk_bf16(o[2], o[3]);
                        if (bad) { w.x = 0x7fc07fc0u; w.y = 0x7fc07fc0u; } *(u32x2v*)(xn + off + bj * HALF + n * 16) = w; }
                asm volatile("" ::: "memory"); }
    }
};

template <class Epi, class Sched, bool ALIGN_EPI = false, bool SP2 = false>
__device__ __forceinline__ void gemm_phase(PG8_LAS unsigned char* lds, const Gemm g, const Sched& S, const Epi& E) {
    const int tid = threadIdx.x, wid = __builtin_amdgcn_readfirstlane(tid >> 6), lane = tid & 63, wr = wid >> 2, wc = wid & 3, fr = lane & 15, fq = lane >> 4;
    const int K = g.K, nt = K / BK;
    unsigned voffA[2], voffB[2];
#pragma unroll
    for (int i = 0; i < 2; ++i) { int R, C; stage_rc(tid * 16 + i * 8192, R, C); const int Rb = Epi::PERM ? ((R & ~31) + perm32(R & 31)) : R;
        voffA[i] = (unsigned)(R * K + C) * 2u; voffB[i] = (unsigned)(Rb * K + C) * 2u; }
    const size_t kstep = (size_t)(BK * 2);
    const size_t hstep = (size_t)HALF * K * 2;
    const size_t tstep = 2 * hstep;
    const unsigned ldsw = (unsigned)wid * 1024u;
    const int aoff = lds_byte(wr * 64 + fr, fq * 8), boff = lds_byte(wc * 32 + fr, fq * 8);
#define PG8_SA(b, h) (((b) * 2 + (h)) * HTB)
#define PG8_SB(b, h) ((4 + (b) * 2 + (h)) * HTB)
#define PG8_STAGE(bufoff, gbase, voff) do { _Pragma("unroll") for (int _i = 0; _i < 2; ++_i) \
        __builtin_amdgcn_global_load_lds((const unsigned*)((const char*)(gbase) + (voff)[_i]), (PG8_LAS unsigned*)(lds + (bufoff) + ldsw + _i * 8192), 16, 0, 0); } while (0)
#define PG8_LDA(dst, b, h) do { _Pragma("unroll") for (int m = 0; m < 4; ++m) _Pragma("unroll") for (int k = 0; k < 2; ++k) dst[m][k] = *(const PG8_LAS bf16x8*)(lds + PG8_SA(b, h) + aoff + m * 2048 + k * 1024); } while (0)
#define PG8_LDB(dst, b, h) do { _Pragma("unroll") for (int n = 0; n < 2; ++n) _Pragma("unroll") for (int k = 0; k < 2; ++k) dst[n][k] = *(const PG8_LAS bf16x8*)(lds + PG8_SB(b, h) + boff + n * 2048 + k * 1024); } while (0)
#define PG8_MMA(ai, bj, At, Bt) do { __builtin_amdgcn_s_setprio(1); _Pragma("unroll") for (int m = 0; m < 4; ++m) _Pragma("unroll") for (int n = 0; n < 2; ++n) _Pragma("unroll") for (int k = 0; k < 2; ++k) \
        acc[ai][bj][m][n] = __builtin_amdgcn_mfma_f32_16x16x32_bf16(Bt[n][k], At[m][k], acc[ai][bj][m][n], 0, 0, 0); __builtin_amdgcn_s_setprio(0); } while (0)
#define PG8_WAIT_V(n) asm volatile("s_waitcnt vmcnt(" #n ")" ::: "memory")
#define PG8_WAIT_L(n) asm volatile("s_waitcnt lgkmcnt(" #n ")" ::: "memory")
#define PG8_BAR __builtin_amdgcn_s_barrier()
#define PG8_SCHED __builtin_amdgcn_sched_barrier(0)
    Unit cur, nxt; int ui = 0;
    if (!S.next(0, cur)) return;
    f32x4 acc[2][2][4][2];
#pragma unroll
    for (int a = 0; a < 2; ++a)
#pragma unroll
        for (int b = 0; b < 2; ++b)
#pragma unroll
            for (int m = 0; m < 4; ++m)
#pragma unroll
                for (int n = 0; n < 2; ++n) acc[a][b][m][n] = (f32x4){0.f, 0.f, 0.f, 0.f};
    bf16x8 At[4][2], B0[2][2], B1[2][2];
    const char* cA = (const char*)g.A + (size_t)cur.pm * tstep; const char* cB = (const char*)g.Bt + (size_t)cur.pn * tstep;
    S.a_ready(cur);
    if constexpr (SP2) {
        PG8_STAGE(PG8_SB(0, 0), cB, voffB); PG8_STAGE(PG8_SB(0, 1), cB + hstep, voffB); PG8_STAGE(PG8_SA(0, 0), cA, voffA); PG8_STAGE(PG8_SA(0, 1), cA + hstep, voffA);
        if (wr == 1) PG8_BAR;
        PG8_WAIT_V(2); PG8_BAR;
        PG8_STAGE(PG8_SB(1, 0), cB + kstep, voffB); PG8_STAGE(PG8_SA(1, 0), cA + kstep, voffA); PG8_STAGE(PG8_SB(1, 1), cB + hstep + kstep, voffB);
        PG8_WAIT_V(6); PG8_BAR;
    } else {
        PG8_STAGE(PG8_SB(0, 0), cB, voffB); PG8_STAGE(PG8_SA(0, 0), cA, voffA); PG8_STAGE(PG8_SB(0, 1), cB + hstep, voffB); PG8_STAGE(PG8_SA(0, 1), cA + hstep, voffA);
        if (wr == 1) PG8_BAR;
        PG8_WAIT_V(4); PG8_BAR;
        PG8_STAGE(PG8_SB(1, 0), cB + kstep, voffB); PG8_STAGE(PG8_SA(1, 0), cA + kstep, voffA); PG8_STAGE(PG8_SB(1, 1), cB + hstep + kstep, voffB);
        PG8_WAIT_V(6); PG8_BAR;
    }
    for (;;) {
        const bool has_next = S.next(ui + 1, nxt);
        const char* nA = has_next ? (const char*)g.A + (size_t)nxt.pm * tstep : cA; const char* nB = has_next ? (const char*)g.Bt + (size_t)nxt.pn * tstep : cB;
        for (int t = 0; t < nt; t += 2) {
            const bool last = (t == nt - 2);
            const char* a1 = cA + (size_t)(t + 1) * kstep;
            const char* a2 = last ? nA : cA + (size_t)(t + 2) * kstep; const char* b2 = last ? nB : cB + (size_t)(t + 2) * kstep;
            const char* a3 = a2 + kstep; const char* b3 = b2 + kstep;
            if (last && has_next) S.a_ready(nxt);
            if constexpr (SP2) {
            PG8_LDB(B0, 0, 0); PG8_LDB(B1, 0, 1); PG8_SCHED; PG8_LDA(At, 0, 0); PG8_STAGE(PG8_SA(1, 1), a1 + hstep, voffA);
            PG8_WAIT_V(8); PG8_WAIT_L(0); PG8_BAR; PG8_MMA(0, 0, At, B0); PG8_MMA(0, 1, At, B1); PG8_BAR; PG8_SCHED;
            PG8_LDA(At, 0, 1); PG8_STAGE(PG8_SB(0, 0), b2, voffB); PG8_STAGE(PG8_SB(0, 1), b2 + hstep, voffB); PG8_STAGE(PG8_SA(0, 0), a2, voffA);
            PG8_WAIT_V(8); PG8_WAIT_L(0); PG8_BAR; PG8_MMA(1, 0, At, B0); PG8_MMA(1, 1, At, B1); PG8_BAR; PG8_SCHED;
            PG8_LDB(B0, 1, 0); PG8_LDB(B1, 1, 1); PG8_SCHED; PG8_LDA(At, 1, 0); PG8_STAGE(PG8_SA(0, 1), a2 + hstep, voffA);
            PG8_WAIT_V(8); PG8_WAIT_L(0); PG8_BAR; PG8_MMA(0, 0, At, B0); PG8_MMA(0, 1, At, B1); PG8_BAR; PG8_SCHED;
            PG8_LDA(At, 1, 1); PG8_STAGE(PG8_SB(1, 0), b3, voffB); PG8_STAGE(PG8_SB(1, 1), b3 + hstep, voffB); PG8_STAGE(PG8_SA(1, 0), a3, voffA);
            PG8_WAIT_V(8); PG8_WAIT_L(0); PG8_BAR; PG8_MMA(1, 0, At, B0); PG8_MMA(1, 1, At, B1); PG8_BAR; PG8_SCHED;
            } else {
            PG8_LDB(B0, 0, 0); PG8_SCHED; PG8_LDA(At, 0, 0); PG8_STAGE(PG8_SA(1, 1), a1 + hstep, voffA);
            PG8_WAIT_L(8); PG8_BAR; PG8_WAIT_L(0); PG8_MMA(0, 0, At, B0); PG8_BAR; PG8_SCHED;
            PG8_LDB(B1, 0, 1); PG8_STAGE(PG8_SB(0, 0), b2, voffB);
            PG8_BAR; PG8_WAIT_L(0); PG8_MMA(0, 1, At, B1); PG8_BAR;
            PG8_LDA(At, 0, 1); PG8_STAGE(PG8_SA(0, 0), a2, voffA);
            PG8_BAR; PG8_WAIT_L(0); PG8_MMA(1, 0, At, B0); PG8_BAR; PG8_SCHED;
            PG8_STAGE(PG8_SB(0, 1), b2 + hstep, voffB);
            PG8_WAIT_V(6); PG8_BAR; PG8_MMA(1, 1, At, B1); PG8_BAR;
            PG8_LDB(B0, 1, 0); PG8_SCHED; PG8_LDA(At, 1, 0); PG8_STAGE(PG8_SA(0, 1), a2 + hstep, voffA);
            PG8_WAIT_L(8); PG8_BAR; PG8_WAIT_L(0); PG8_MMA(0, 0, At, B0); PG8_BAR; PG8_SCHED;
            PG8_LDB(B1, 1, 1); PG8_STAGE(PG8_SB(1, 0), b3, voffB);
            PG8_BAR; PG8_WAIT_L(0); PG8_MMA(0, 1, At, B1); PG8_BAR;
            PG8_LDA(At, 1, 1); PG8_STAGE(PG8_SA(1, 0), a3, voffA);
            PG8_BAR; PG8_WAIT_L(0); PG8_MMA(1, 0, At, B0); PG8_BAR; PG8_SCHED;
            PG8_STAGE(PG8_SB(1, 1), b3 + hstep, voffB);
            PG8_WAIT_V(6); PG8_BAR; PG8_MMA(1, 1, At, B1); PG8_BAR;
            }
        }
        if constexpr (ALIGN_EPI) { if (wr == 0) PG8_BAR; }
        if constexpr (!Epi::AFTER_DRAIN) { E(acc, cur, wr, wc, fr, fq); S.done(cur); }
        if (!has_next) break;
#pragma unroll
        for (int a = 0; a < 2; ++a)
#pragma unroll
            for (int b = 0; b < 2; ++b)
#pragma unroll
                for (int m = 0; m < 4; ++m)
#pragma unroll
                    for (int n = 0; n < 2; ++n) acc[a][b][m][n] = (f32x4){0.f, 0.f, 0.f, 0.f};
        cur = nxt; cA = nA; cB = nB; ++ui;
        if constexpr (ALIGN_EPI) { if (wr == 1) PG8_BAR; }
    }
    PG8_WAIT_V(0);
    if constexpr (!ALIGN_EPI) { if (wr == 0) PG8_BAR; }
    PG8_BAR;
    if constexpr (Epi::AFTER_DRAIN) { E.fused(acc, cur, wr, wc, fr, fq, lds, wid, lane); S.done(cur); }
#undef PG8_SA
#undef PG8_SB
#undef PG8_STAGE
#undef PG8_LDA
#undef PG8_LDB
#undef PG8_MMA
#undef PG8_WAIT_V
#undef PG8_WAIT_L
#undef PG8_BAR
#undef PG8_SCHED
}
}
#define GAS __attribute__((address_space(1)))
#define LAS __attribute__((address_space(3)))
typedef unsigned short bf16;
typedef unsigned v4u __attribute__((ext_vector_type(4)));
typedef float f32x4 __attribute__((ext_vector_type(4)));
typedef short bf16x8 __attribute__((ext_vector_type(8)));
typedef GAS unsigned gu32;
typedef GAS unsigned long long gu64;
#define RLX_AGENT __ATOMIC_RELAXED, __HIP_MEMORY_SCOPE_AGENT
#define LDS_WAIT() asm volatile("s_waitcnt lgkmcnt(0)" ::: "memory")
#define VM_WAIT() asm volatile("s_waitcnt vmcnt(0)" ::: "memory")
__device__ __forceinline__ unsigned long long rt() { return __builtin_amdgcn_s_memrealtime(); }
__device__ __forceinline__ unsigned f2bf(float f) { unsigned u = __builtin_bit_cast(unsigned, f); return (u + 0x7fffu + ((u >> 16) & 1u)) >> 16; }
__device__ __forceinline__ unsigned pk2(float lo, float hi) { return f2bf(lo) | (f2bf(hi) << 16); }

#define XB_TMO      128
#define XB_XCNT(j)  (256  + 64 * (j))
#define XB_XSUB(j)  (1280 + 64 * (j))
#define XB_XGEN(j)  (2304 + 64 * (j))
#define XB_TOP      3328
#define XB_TOPGEN   3392
#define XCD_BAR_WORDS 3456
#define XB_SPIN_CAP (1u << 18)

__device__ __forceinline__ unsigned xb_ld(unsigned* p)              { return __hip_atomic_load(p, __ATOMIC_RELAXED, __HIP_MEMORY_SCOPE_AGENT); }
__device__ __forceinline__ unsigned xb_add(unsigned* p, unsigned v) { return __hip_atomic_fetch_add(p, v, __ATOMIC_RELAXED, __HIP_MEMORY_SCOPE_AGENT); }
__device__ __forceinline__ unsigned xb_xcc_id() { return (unsigned)__builtin_amdgcn_s_getreg((3 << 11) | 20) & 0xFu; }
#define XB_SPIN(cond, bar) do { unsigned _sp = 0; while (cond) { __builtin_amdgcn_s_sleep(1); \
    if ((++_sp & 255u) == 0u) { if (xb_ld(&(bar)[XB_TMO])) break; if (_sp > XB_SPIN_CAP) { atomicAdd(&(bar)[XB_TMO], 1u); break; } } } } while (0)

struct XcdBarrier {
    unsigned* bar; unsigned x;
    volatile LAS unsigned* st;
};

__device__ __forceinline__ XcdBarrier xcd_barrier_post(unsigned* bar, volatile LAS unsigned* st) {
    XcdBarrier b; b.bar = bar; b.x = xb_xcc_id(); b.st = st;
    if (threadIdx.x == 0) (void)xb_add(&bar[XB_XCNT(b.x)], 1u);
    return b;
}
__device__ __forceinline__ void xcd_barrier_complete(unsigned* bar, unsigned x, unsigned& nloc, unsigned& nx) {
    const unsigned G = gridDim.x * gridDim.y * gridDim.z;
    unsigned sum, cnt, mine, sp = 0u;
    for (;;) {
        sum = 0u; cnt = 0u; mine = 0u;
#pragma unroll
        for (unsigned j = 0; j < 16; ++j) { const unsigned c = xb_ld(&bar[XB_XCNT(j)]); sum += c; cnt += (c > 0u) ? 1u : 0u; mine = (j == x) ? c : mine; }
        if (sum == G) break;
        __builtin_amdgcn_s_sleep(1);
        if ((++sp & 255u) == 0u) { if (xb_ld(&bar[XB_TMO])) break; if (sp > XB_SPIN_CAP) { atomicAdd(&bar[XB_TMO], 1u); break; } }
    }
    nloc = mine > 0u ? mine : 1u; nx = cnt > 0u ? cnt : 1u;
}

__device__ __forceinline__ void xcd_barrier(const XcdBarrier& b) {
    asm volatile("s_waitcnt vmcnt(0)" ::: "memory");
    __syncthreads();
    if (threadIdx.x == 0) {
        unsigned* bar = b.bar;
        __builtin_amdgcn_s_waitcnt(0);
        unsigned nloc = b.st[0], nx = b.st[1];
        if (nloc == 0u) { xcd_barrier_complete(bar, b.x, nloc, nx); b.st[0] = nloc; b.st[1] = nx; }
        const unsigned old = xb_add(&bar[XB_XSUB(b.x)], 1u);
        const unsigned gen = old / nloc;
        if (old + 1u == (gen + 1u) * nloc) {
            __builtin_amdgcn_fence(__ATOMIC_RELEASE, "agent");
            asm volatile("s_waitcnt vmcnt(0)" ::: "memory");
            const unsigned og = xb_add(&bar[XB_TOP], 1u);
            const unsigned tg = og / nx;
            if (og + 1u == (tg + 1u) * nx) xb_add(&bar[XB_TOPGEN], 1u);
            else XB_SPIN(xb_ld(&bar[XB_TOPGEN]) == tg, bar);
            __builtin_amdgcn_fence(__ATOMIC_ACQUIRE, "agent");
            xb_add(&bar[XB_XGEN(b.x)], 1u);
            asm volatile("s_waitcnt vmcnt(0)" ::: "memory");
        } else {
            XB_SPIN(xb_ld(&bar[XB_XGEN(b.x)]) == gen, bar);
            __builtin_amdgcn_fence(__ATOMIC_ACQUIRE, "agent");
            asm volatile("s_waitcnt vmcnt(0)" ::: "memory");
        }
    }
    __syncthreads();
}
constexpr int NWAVES = 8;
constexpr int T = 8192, NBATCH = 2, MP = NBATCH * T, MS = 32, MALL = 16640, D = 1024, NIN = 6656, FF = 4096;
constexpr int C_QA = 0, C_KVC = 512, C_KVS = 768, C_KVW = 1024, C_QB = 1280, C_FB = 2304, C_IB = 3328, C_GB = 3840, C_MG = 4352, C_GLA = 6400;
constexpr int PAST = 16384, NPAGES = 128, NCMP_S = 1023, NCMP_P = 511;
constexpr float LN_EPS = 1e-5f;
constexpr float DN_ALPHA = 1.189207115002721f;
constexpr size_t OFF0 = 0, OFF1 = OFF0 + (size_t)MP * D, OFF2 = OFF1 + (size_t)MS * D, OFF3 = OFF2 + (size_t)MP * 256, OFF4 = OFF3 + (size_t)MP * 256,
                 OFF5 = OFF4 + (size_t)NBATCH * 512 * 256, OFF6 = OFF5 + (size_t)NBATCH * 8 * 128 * 64, OFF7 = OFF6 + (size_t)MS * 256, OFF8 = OFF7 + (size_t)MS * 256,
                 OFF9 = OFF8 + (size_t)MS * 512 * 256, OUT_TOTAL = OFF9 + (size_t)MS * 8 * 128 * 64;
constexpr size_t MiB = 1u << 20;
constexpr size_t al(size_t x) { return (x + MiB - 1) / MiB * MiB; }
constexpr size_t WS_CTL = 0, CTL_ZERO_BYTES = 1 * MiB;
constexpr size_t WS_WIN = 2 * MiB;
constexpr size_t WS_WA = WS_WIN + al((size_t)NIN * D * 2);
constexpr size_t WS_WB = WS_WA + al((size_t)D * 512 * 2);
constexpr size_t WS_WO = WS_WB + al((size_t)D * 512 * 2);
constexpr size_t WS_WUP = WS_WO + al((size_t)D * D * 2);
constexpr size_t WS_WDN = WS_WUP + al((size_t)FF * D * 2);
constexpr size_t WS_WC = WS_WDN + al((size_t)FF * D * 2);
constexpr size_t WS_SMALL = WS_WC + al((size_t)2 * 64 * 2048 * 2);
constexpr size_t WS_XB = WS_SMALL + MiB;
constexpr size_t WS_HB = WS_XB + al((size_t)MALL * D * 2);
constexpr size_t WS_KCP = WS_HB + al((size_t)MALL * NIN * 2);
constexpr size_t WS_VCTP = WS_KCP + MiB;
constexpr size_t WS_KCVS = WS_VCTP + MiB;
constexpr size_t WS_VST = WS_KCVS + al((size_t)MS * 1024 * 256 * 4);
constexpr size_t WS_VWT = WS_VST + al((size_t)4 * 64 * T * 2);
constexpr size_t WS_OA = WS_VWT + al((size_t)4 * 64 * T * 2);
constexpr size_t WS_OB = WS_OA + al((size_t)MALL * 512 * 2);
constexpr size_t WS_HGL = WS_OB + al((size_t)MALL * 512 * 2);
constexpr size_t WS_HGD = WS_HGL + al((size_t)16 * 16 * 8192 * 4);
constexpr size_t WS_TB = WS_HGD + MiB;
constexpr size_t WS_MG = WS_TB + al((size_t)MALL * D * 4);
constexpr size_t WS_Z1 = WS_MG + al((size_t)MALL * D * 2);
constexpr size_t WS_X1F = WS_Z1 + al((size_t)MALL * D * 4);
constexpr size_t WS_X1B = WS_X1F + al((size_t)MALL * D * 4);
constexpr size_t WS_UB = WS_X1B + al((size_t)MALL * D * 2);
constexpr size_t WS_Z2 = WS_UB + al((size_t)MALL * FF * 2);
constexpr size_t WS_OTS = WS_Z2 + al((size_t)MALL * D * 4);
constexpr size_t WS_END = WS_OTS + al((size_t)256 * 32 * 512 * 4);
constexpr int CW_TMO = 0, CW_CODE = 1, CW_BAR = 4096;
constexpr int RING_OFF = 0, RING_BYTES = 131072;
constexpr int LDSCTL_OFF = RING_BYTES, MISC_OFF = LDSCTL_OFF + 320;
constexpr int LDS_BYTES = 147456;

namespace pg8 {
struct EpiInProj {
    static constexpr bool PERM = true, AFTER_DRAIN = false;
    bf16_t* HB; float* out;
    __device__ __forceinline__ void operator()(const f32x4 (&acc)[2][2][4][2], const Unit& u, int wr, int wc, int fr, int fq) const {
        const int row0 = u.pm * BM + wr * 64 + fr, cc0 = wc * 32 + 8 * fq, col0 = u.pn * BM + cc0;
#pragma unroll
        for (int ai = 0; ai < 2; ++ai)
#pragma unroll
            for (int m = 0; m < 4; ++m) {
                const int r = row0 + ai * HALF + m * 16;
                bf16_t* rowp = HB + (size_t)r * NIN + col0;
                float* fdst = nullptr;
                if (u.pn == 2) { if (r < MP) fdst = out + OFF2 + (size_t)r * 256; else if (r < MP + MS) fdst = out + OFF6 + (size_t)(r - MP) * 256; }
                else if (u.pn == 3) { if (r < MP) fdst = out + OFF3 + (size_t)r * 256; else if (r < MP + MS) fdst = out + OFF7 + (size_t)(r - MP) * 256; }
                else if (u.pn == 4) { if (r < MP) { const int t = r & (T - 1), b = r >> 13; if (t >= T - 512) fdst = out + OFF4 + (size_t)(b * 512 + t - (T - 512)) * 256; }
                                      else if (r < MP + MS) fdst = out + OFF8 + ((size_t)(r - MP) * 512 + 511) * 256; }
#pragma unroll
                for (int bj = 0; bj < 2; ++bj) { const f32x4 v0 = acc[ai][bj][m][0], v1 = acc[ai][bj][m][1];
                    u32x4 w; w.x = cvt_pk_bf16(v0[0], v0[1]); w.y = cvt_pk_bf16(v0[2], v0[3]); w.z = cvt_pk_bf16(v1[0], v1[1]); w.w = cvt_pk_bf16(v1[2], v1[3]);
                    *(u32x4*)(rowp + bj * HALF) = w;
                    if (fdst) { *(f32x4*)(fdst + cc0 + bj * HALF) = v0; *(f32x4*)(fdst + cc0 + bj * HALF + 4) = v1; } }
            }
    }
};
}

struct Frame {
    LAS unsigned char* lds;
    volatile LAS unsigned* MISC;
    gu32* ctl;
    int tid, lane, wave;
    int vcu, G;
    const float* in[21]; float* out; unsigned char* ws;
};
__device__ __forceinline__ float bf2f(unsigned short b) { return __uint_as_float(((unsigned)b) << 16); }
typedef float f32x2_t __attribute__((ext_vector_type(2))); typedef __bf16 bf16x2_t __attribute__((ext_vector_type(2)));
__device__ __forceinline__ unsigned cvtpk(float lo, float hi) { f32x2_t v = {lo, hi}; bf16x2_t b = __builtin_convertvector(v, bf16x2_t); return __builtin_bit_cast(unsigned, b); }
__device__ __forceinline__ float wave_sum(float v) {
#pragma unroll
    for (int o = 1; o < 64; o <<= 1) v += __shfl_xor(v, o);
    return v;
}
__device__ __forceinline__ float sigmoidf_(float x) { return 1.0f / (1.0f + __expf(-x)); }

__device__ __forceinline__ void p0_transpose_item(const float* W, int K, int Nsrc, bf16* WT, int k0, int n0, int s0, int nvalid, LAS float* scr, int lane) {
#pragma unroll 8
    for (int i = 0; i < 32; ++i) { const int kk = 2 * i + (lane >> 5), c = lane & 31; scr[kk * 33 + c] = (c < nvalid) ? W[(size_t)(k0 + kk) * Nsrc + s0 + c] : 0.f; }
    LDS_WAIT(); asm volatile("" ::: "memory");
    const int c = lane & 7;
#pragma unroll
    for (int j = 0; j < 4; ++j) { const int n = (lane >> 3) + 8 * j; const LAS float* s = scr + (8 * c) * 33 + n;
        v4u o; o.x = pk2(s[0 * 33], s[1 * 33]); o.y = pk2(s[2 * 33], s[3 * 33]); o.z = pk2(s[4 * 33], s[5 * 33]); o.w = pk2(s[6 * 33], s[7 * 33]);
        *(GAS v4u*)(WT + (size_t)(n0 + n) * K + k0 + 8 * c) = o; }
    LDS_WAIT(); asm volatile("" ::: "memory");
}
__device__ __forceinline__ void p0_prologue(Frame& F) {
    LAS float* scr = (LAS float*)(F.lds + RING_OFF + F.wave * 16384);
    const int gw = F.vcu * NWAVES + F.wave, NGW = F.G * NWAVES, lane = F.lane;
    bf16* WinT = (bf16*)(F.ws + WS_WIN); bf16* WaT = (bf16*)(F.ws + WS_WA); bf16* WbT = (bf16*)(F.ws + WS_WB); bf16* WoT = (bf16*)(F.ws + WS_WO);
    bf16* WupT = (bf16*)(F.ws + WS_WUP); bf16* WdnT = (bf16*)(F.ws + WS_WDN); bf16* WcT = (bf16*)(F.ws + WS_WC);
    float* small = (float*)(F.ws + WS_SMALL);
    constexpr int I_IN = (D / 64) * (NIN / 32), I_A = (512 / 64) * (D / 32), I_O = (D / 64) * (D / 32), I_UP = (D / 64) * (FF / 32), I_DN = (FF / 64) * (D / 32), I_C = 2 * (2048 / 64) * 2;
    constexpr int I_T = I_IN + 2 * I_A + I_O + I_UP + I_DN + I_C;
    constexpr int I_X = MALL;
    constexpr int I_CB = 64;
    constexpr int I_LB = 16;
    constexpr int I_W8 = MS * 511;
    constexpr int I_Z = 2 * (MALL - MP - MS);
    constexpr int NITEMS = I_T + I_X + I_CB + I_LB + I_W8 + I_Z;
    for (int it = gw; it < NITEMS; it += NGW) {
        int r = it;
        if (r < I_T) {
            if (r < I_IN) { const int nblk = NIN / 32, kb = r / nblk, nb = r % nblk, n0 = 32 * nb; int s0, nv;
                if (n0 < 1280) { s0 = n0; nv = 32; } else if (n0 < 6400) { s0 = n0 + 24; nv = 32; } else if (n0 == 6400) { s0 = 1280; nv = 24; } else { s0 = 0; nv = 0; }
                p0_transpose_item(F.in[7], D, 6424, WinT, 64 * kb, n0, s0, nv, scr, lane); continue; } r -= I_IN;
            if (r < I_A) { const int nblk = D / 32, kb = r / nblk, nb = r % nblk; p0_transpose_item(F.in[12], 512, D, WaT, 64 * kb, 32 * nb, 32 * nb, 32, scr, lane); continue; } r -= I_A;
            if (r < I_A) { const int nblk = D / 32, kb = r / nblk, nb = r % nblk; p0_transpose_item(F.in[13], 512, D, WbT, 64 * kb, 32 * nb, 32 * nb, 32, scr, lane); continue; } r -= I_A;
            if (r < I_O) { const int nblk = D / 32, kb = r / nblk, nb = r % nblk; p0_transpose_item(F.in[14], D, D, WoT, 64 * kb, 32 * nb, 32 * nb, 32, scr, lane); continue; } r -= I_O;
            if (r < I_UP) { const int nblk = FF / 32, kb = r / nblk, nb = r % nblk; p0_transpose_item(F.in[17], D, FF, WupT, 64 * kb, 32 * nb, 32 * nb, 32, scr, lane); continue; } r -= I_UP;
            if (r < I_DN) { const int nblk = D / 32, kb = r / nblk, nb = r % nblk; p0_transpose_item(F.in[18], FF, D, WdnT, 64 * kb, 32 * nb, 32 * nb, 32, scr, lane); continue; } r -= I_DN;
            { const int c = r / 64, q = r % 64, kb = q / 2, nb = q % 2;
              p0_transpose_item(F.in[8] + (size_t)c * 2048 * 64, 2048, 64, WcT + (size_t)c * 64 * 2048, 64 * kb, 32 * nb, 32 * nb, 32, scr, lane); continue; }
        }
        r -= I_T;
        if (r < I_X) {
            const float* src = r < MP ? F.in[0] + (size_t)r * D : (r < MP + MS ? F.in[1] + (size_t)(r - MP) * D : nullptr);
            bf16* dst = (bf16*)(F.ws + WS_XB) + (size_t)r * D;
#pragma unroll
            for (int j = 0; j < 4; ++j) { f32x4 v = src ? *((const GAS f32x4*)src + lane + 64 * j) : (f32x4){0.f, 0.f, 0.f, 0.f};
                *((GAS unsigned long long*)dst + lane + 64 * j) = (unsigned long long)pk2(v.x, v.y) | ((unsigned long long)pk2(v.z, v.w) << 32); }
            continue;
        }
        r -= I_X;
        if (r < I_CB) {
            const int c = r >> 5, l = r & 31; const float* pos = F.in[9] + ((size_t)c * 32 + l) * 64; const float* w = F.in[8] + (((size_t)c * 32 + l) * 64) * 64;
            float s = 0.f;
            for (int d = 0; d < 64; ++d) s += pos[d] * w[(size_t)d * 64 + lane];
            small[(c * 32 + l) * 64 + lane] = s; continue;
        }
        r -= I_CB;
        if (r < I_LB) { const int i = r * 64 + lane; const float l0 = F.in[10][i], l1 = F.in[10][1024 + i]; small[4096 + i] = 1.0f / (1.0f + expf(l1 - l0)); continue; }
        r -= I_LB;
        if (r < I_W8) { const int b = r / 511, i = r % 511;
            const GAS f32x4* s = (const GAS f32x4*)(F.in[4] + ((size_t)b * 512 + i + 1) * 256); GAS f32x4* d = (GAS f32x4*)(F.out + OFF8 + ((size_t)b * 512 + i) * 256);
            d[lane] = s[lane]; continue; }
        r -= I_W8;
        { const int half = I_Z / 2, which = r / half, row = MP + MS + r % half; bf16* o = (bf16*)(F.ws + (which ? WS_OB : WS_OA)) + (size_t)row * 512;
          *((GAS v4u*)o + lane) = (v4u){0u, 0u, 0u, 0u}; }
    }
}
typedef float f32x16 __attribute__((ext_vector_type(16)));
typedef short s16x4 __attribute__((ext_vector_type(4)));
typedef unsigned u32x2 __attribute__((ext_vector_type(2)));
#define MFMA32(a, b, c) __builtin_amdgcn_mfma_f32_32x32x16_bf16((a), (b), (c), 0, 0, 0)
__device__ __forceinline__ int crow(int reg, int h) { return (reg & 3) + 8 * (reg >> 2) + 4 * h; }
__device__ __forceinline__ bf16x8 pack8(f32x4 a, f32x4 b) { v4u p; p.x = cvtpk(a.x, a.y); p.y = cvtpk(a.z, a.w); p.z = cvtpk(b.x, b.y); p.w = cvtpk(b.z, b.w); return __builtin_bit_cast(bf16x8, p); }
#define PACK_STEP(x, s) pack8((f32x4){(x)[8 * (s)], (x)[8 * (s) + 1], (x)[8 * (s) + 2], (x)[8 * (s) + 3]}, (f32x4){(x)[8 * (s) + 4], (x)[8 * (s) + 5], (x)[8 * (s) + 6], (x)[8 * (s) + 7]})
__device__ __forceinline__ bf16x8 join44(s16x4 lo, s16x4 hi) { return __builtin_shufflevector(lo, hi, 0, 1, 2, 3, 4, 5, 6, 7); }

constexpr int NRT = 3, CT_GP = (NCMP_P + NRT * 16 - 1) / (NRT * 16), CT_GS = (NCMP_S + NRT * 16 - 1) / (NRT * 16);
constexpr int CT_PROMPT = NBATCH * 2 * CT_GP, CT_SAMPLE = MS * 2 * CT_GS, CT_ALL = CT_PROMPT + CT_SAMPLE;
__device__ __forceinline__ void compress_task(Frame& F, int task) {
    const int lane = F.lane, m = lane & 31, h = lane >> 5, ii = m & 15, g = m >> 4;
    const bool prompt = task < CT_PROMPT;
    int b, c, ig, nblk, tsrc;
    if (prompt) { b = task / (2 * CT_GP); c = (task / CT_GP) & 1; ig = task % CT_GP; nblk = NCMP_P; tsrc = T; }
    else { const int t2 = task - CT_PROMPT; b = t2 / (2 * CT_GS); c = (t2 / CT_GS) & 1; ig = t2 % CT_GS; nblk = NCMP_S; tsrc = PAST; }
    const int* pt = (const int*)F.in[6] + b * NPAGES;
    const bf16* WcT = (const bf16*)(F.ws + WS_WC) + (size_t)c * 64 * 2048;
    const float* small = (const float*)(F.ws + WS_SMALL);
    f32x16 acc[NRT][2];
#pragma unroll
    for (int rt = 0; rt < NRT; ++rt)
#pragma unroll
        for (int i = 0; i < 16; ++i) { acc[rt][0][i] = 0.f; acc[rt][1][i] = 0.f; }
    const char* rbase = prompt ? (const char*)(F.out + OFF2 + (size_t)b * T * 256) : (const char*)F.in[2];
    unsigned offA[NRT], offB[NRT];
#pragma unroll
    for (int rt = 0; rt < NRT; ++rt) {
        const int blk = ig * (NRT * 16) + rt * 16 + ii;
        int tA = 16 * blk, tB = 16 * blk + 16; tA = tA <= tsrc - 16 ? tA : tsrc - 16; tB = tB <= tsrc - 16 ? tB : tsrc - 16;
        const unsigned rA = prompt ? (unsigned)tA : (unsigned)pt[tA >> 7] * 128u + (unsigned)(tA & 127), rB = prompt ? (unsigned)tB : (unsigned)pt[tB >> 7] * 128u + (unsigned)(tB & 127);
        offA[rt] = (rA * 256u + (unsigned)(c * 128 + g * 64 + 8 * h)) * 4u; offB[rt] = (rB * 256u + (unsigned)(c * 128 + g * 64 + 8 * h)) * 4u;
    }
    const bf16* bp0 = WcT + (size_t)m * 2048 + 8 * h;
    f32x4 a0[2][NRT], a1[2][NRT]; bf16x8 Bv[2][2];
#define CMP_LOAD(st, l_, dc_) do { const unsigned ro_ = (unsigned)(((l_) & 15) * 256 + (dc_) * 16) * 4u; const bf16* bp_ = bp0 + (l_) * 64 + (dc_) * 16; \
        Bv[st][0] = *(const GAS bf16x8*)bp_; Bv[st][1] = *(const GAS bf16x8*)(bp_ + 32 * 2048); \
        _Pragma("unroll") for (int rt = 0; rt < NRT; ++rt) { const char* ap_ = rbase + (((l_) < 16 ? offA[rt] : offB[rt]) + ro_); a0[st][rt] = *(const GAS f32x4*)ap_; a1[st][rt] = *(const GAS f32x4*)(ap_ + 16); } } while (0)
#define CMP_MMA(st) do { _Pragma("unroll") for (int rt = 0; rt < NRT; ++rt) { const bf16x8 A_ = pack8(a0[st][rt], a1[st][rt]); acc[rt][0] = MFMA32(A_, Bv[st][0], acc[rt][0]); acc[rt][1] = MFMA32(A_, Bv[st][1], acc[rt][1]); } } while (0)
    CMP_LOAD(0, 0, 0);
#pragma unroll 1
    for (int l = 0; l < 32; ++l) {
        CMP_LOAD(1, l, 1); __builtin_amdgcn_sched_barrier(0); CMP_MMA(0); __builtin_amdgcn_sched_barrier(0);
        CMP_LOAD(0, l, 2); __builtin_amdgcn_sched_barrier(0); CMP_MMA(1); __builtin_amdgcn_sched_barrier(0);
        CMP_LOAD(1, l, 3); __builtin_amdgcn_sched_barrier(0); CMP_MMA(0); __builtin_amdgcn_sched_barrier(0);
        { const int ln = l < 31 ? l + 1 : 31; CMP_LOAD(0, ln, 0); } __builtin_amdgcn_sched_barrier(0); CMP_MMA(1); __builtin_amdgcn_sched_barrier(0);
    }
#undef CMP_LOAD
#undef CMP_MMA
    float be0 = 0.f, be1 = 0.f;
    for (int l = 0; l < 32; ++l) { be0 += small[(c * 32 + l) * 64 + m]; be1 += small[(c * 32 + l) * 64 + 32 + m]; }
#pragma unroll
    for (int rt = 0; rt < NRT; ++rt)
#pragma unroll
    for (int v = 0; v < 16; ++v) {
        const int mr = crow(v, h), oi = mr & 15, og = mr >> 4, ob = ig * (NRT * 16) + rt * 16 + oi;
        if (ob < nblk) {
            const float v0 = acc[rt][0][v] + be0, v1 = acc[rt][1][v] + be1;
            if (prompt) {
                if (c == 0) { bf16* kc = (bf16*)(F.ws + WS_KCP) + ((size_t)(b * 2 + og) * 512 + ob) * 64; kc[m] = (bf16)f2bf(v0); kc[32 + m] = (bf16)f2bf(v1); }
                else { bf16* vc = (bf16*)(F.ws + WS_VCTP) + (size_t)(b * 2 + og) * 64 * 512 + ob; vc[(size_t)m * 512] = (bf16)f2bf(v0); vc[(size_t)(32 + m) * 512] = (bf16)f2bf(v1); }
            } else {
                float* o = (float*)(F.ws + WS_KCVS) + ((size_t)b * 1024 + ob) * 256 + c * 128 + og * 64; o[m] = v0; o[32 + m] = v1;
            }
        }
    }
}
constexpr int VT_ITEMS = 2 * 2 * 2 * 128;
__device__ __forceinline__ void vt_item(Frame& F, int it) {
    const int tensor = it >> 9, b = (it >> 8) & 1, g = (it >> 7) & 1, tb = it & 127, lane = F.lane;
    const bf16* src = (const bf16*)(F.ws + WS_HB) + (size_t)(b * T + tb * 64 + lane) * NIN + (tensor ? C_KVW : C_KVS) + 128 + g * 64;
    bf16* dst = (bf16*)(F.ws + (tensor ? WS_VWT : WS_VST)) + (size_t)(b * 2 + g) * 64 * T + tb * 64 + lane;
    v4u r[8];
#pragma unroll
    for (int i = 0; i < 8; ++i) r[i] = *((const GAS v4u*)src + i);
#pragma unroll
    for (int i = 0; i < 8; ++i) {
        const unsigned w[4] = {r[i].x, r[i].y, r[i].z, r[i].w};
#pragma unroll
        for (int j = 0; j < 4; ++j) { dst[(size_t)(i * 8 + 2 * j) * T] = (bf16)(w[j] & 0xffffu); dst[(size_t)(i * 8 + 2 * j + 1) * T] = (bf16)(w[j] >> 16); }
    }
}

constexpr int HG_SEG = 512, HG_NSEG = T / HG_SEG, HG_CH = 32;
constexpr int HL_QT = 0, HL_KT = 8704, HL_KD = 17408, HL_VT = 27648, HL_DEC = 32768, HL_PSUM = 33280, HL_SLAB = 35328, HL_END = HL_SLAB + 4 * 32 * 272;
static_assert(HL_END <= RING_BYTES, "hgrn lds");
template <int MODE> __device__ __forceinline__ void hgrn_segment(Frame& F, int bh, int seg) {
    int tid = F.tid; asm volatile("" : "+v"(tid));
    const int lane = tid & 63, w = F.wave, kt = w >> 1, vt = w & 1, h5 = lane >> 5, l31 = lane & 31;
    const int b = bh >> 3, hh = bh & 7;
    LAS unsigned char* L = F.lds + RING_OFF;
    const bf16* HB = (const bf16*)(F.ws + WS_HB);
    const float* small = (const float*)(F.ws + WS_SMALL);
    float* HGL = (float*)(F.ws + WS_HGL); float* HGD = (float*)(F.ws + WS_HGD);
    f32x16 S;
#pragma unroll
    for (int i = 0; i < 16; ++i) S[i] = 0.f;
    if (MODE == 1) {
        for (int i = 0; i < seg; ++i) {
            const float* Lp = HGL + ((size_t)(bh * HG_NSEG + i)) * 8192 + w * 1024 + lane; const float* Dp = HGD + (size_t)(bh * HG_NSEG + i) * 128 + 32 * kt;
#pragma unroll
            for (int v = 0; v < 16; ++v) S[v] = S[v] * Dp[crow(v, h5)] + Lp[v * 64];
        }
    }
    const int k = tid & 127, q4 = tid >> 7;
    const float lb = small[4096 + hh * 128 + k];
    float lcsum = 0.f;
    for (int ch = 0; ch < HG_SEG / HG_CH; ++ch) {
        const int row0 = b * T + seg * HG_SEG + ch * HG_CH;
        float kk[8], cs[8]; float run = 0.f;
#pragma unroll
        for (int j = 0; j < 8; ++j) {
            const float x = bf2f(HB[(size_t)(row0 + 8 * q4 + j) * NIN + C_FB + hh * 128 + k]);
            const float e = __expf(-x), sg = 1.0f / (1.0f + e), om = e / (1.0f + e);
            const float f = lb + (1.0f - lb) * sg; kk[j] = (1.0f - lb) * om; run += __logf(f); cs[j] = run;
        }
        ((LAS float*)(L + HL_PSUM))[q4 * 128 + k] = run;
        __syncthreads();
        float off = 0.f, tot = 0.f;
#pragma unroll
        for (int q = 0; q < 4; ++q) { const float p = ((LAS float*)(L + HL_PSUM))[q * 128 + k]; tot += p; if (q < q4) off += p; }
#pragma unroll
        for (int j = 0; j < 8; ++j) {
            const int s = 8 * q4 + j; const float lc = off + cs[j];
            if (MODE == 1) {
                const float qv = bf2f(HB[(size_t)(row0 + s) * NIN + C_QB + hh * 128 + k]);
                ((LAS bf16*)(L + HL_QT))[s * 136 + k] = (bf16)f2bf(qv * __expf(lc));
                ((LAS bf16*)(L + HL_KT))[s * 136 + k] = (bf16)f2bf(kk[j] * __expf(-lc));
            }
            ((LAS bf16*)(L + HL_KD))[k * 40 + s] = (bf16)f2bf(kk[j] * __expf(tot - lc));
        }
        if (q4 == 0) { ((LAS float*)(L + HL_DEC))[k] = __expf(tot); lcsum += tot; }
        { const int s = tid >> 4, vq = tid & 15;
          const u32x2 vv = *(const GAS u32x2*)(HB + (size_t)(row0 + s) * NIN + C_IB + hh * 64 + 4 * vq);
          LAS bf16* vtp = (LAS bf16*)(L + HL_VT);
          vtp[(4 * vq + 0) * 40 + s] = (bf16)(vv.x & 0xffffu); vtp[(4 * vq + 1) * 40 + s] = (bf16)(vv.x >> 16);
          vtp[(4 * vq + 2) * 40 + s] = (bf16)(vv.y & 0xffffu); vtp[(4 * vq + 3) * 40 + s] = (bf16)(vv.y >> 16); }
        __syncthreads();
        if (MODE == 1) {
            f32x16 oacc;
#pragma unroll
            for (int i = 0; i < 16; ++i) oacc[i] = 0.f;
            if (kt == 0) {
                f32x16 at;
#pragma unroll
                for (int i = 0; i < 16; ++i) at[i] = 0.f;
#pragma unroll
                for (int ks = 0; ks < 8; ++ks) {
                    const bf16x8 a = *(const LAS bf16x8*)(L + HL_KT + l31 * 272 + (16 * ks + 8 * h5) * 2);
                    const bf16x8 bq = *(const LAS bf16x8*)(L + HL_QT + l31 * 272 + (16 * ks + 8 * h5) * 2);
                    at = MFMA32(a, bq, at);
                }
#pragma unroll
                for (int i = 0; i < 16; ++i) at[i] = (crow(i, h5) <= l31) ? at[i] : 0.f;
#pragma unroll
                for (int kq = 0; kq < 2; ++kq) {
                    const s16x4 lo = *(const LAS s16x4*)(L + HL_VT + (32 * vt + l31) * 80 + (16 * kq + 4 * h5) * 2);
                    const s16x4 hi = *(const LAS s16x4*)(L + HL_VT + (32 * vt + l31) * 80 + (16 * kq + 8 + 4 * h5) * 2);
                    oacc = MFMA32(join44(lo, hi), PACK_STEP(at, kq), oacc);
                }
            }
#pragma unroll
            for (int kq = 0; kq < 2; ++kq) {
                const s16x4 lo = *(const LAS s16x4*)(L + HL_QT + l31 * 272 + (32 * kt + 16 * kq + 4 * h5) * 2);
                const s16x4 hi = *(const LAS s16x4*)(L + HL_QT + l31 * 272 + (32 * kt + 16 * kq + 8 + 4 * h5) * 2);
                oacc = MFMA32(PACK_STEP(S, kq), join44(lo, hi), oacc);
            }
#pragma unroll
            for (int a = 0; a < 4; ++a)
                *(LAS f32x4*)(L + HL_SLAB + (kt * 32 + l31) * 272 + (32 * vt + 8 * a + 4 * h5) * 4) = (f32x4){oacc[4 * a], oacc[4 * a + 1], oacc[4 * a + 2], oacc[4 * a + 3]};
        }
        {
#pragma unroll
            for (int a = 0; a < 4; ++a) { const f32x4 d = *(const LAS f32x4*)(L + HL_DEC + (32 * kt + 8 * a + 4 * h5) * 4);
                S[4 * a] *= d.x; S[4 * a + 1] *= d.y; S[4 * a + 2] *= d.z; S[4 * a + 3] *= d.w; }
#pragma unroll
            for (int kq = 0; kq < 2; ++kq) {
                const bf16x8 a = *(const LAS bf16x8*)(L + HL_KD + (32 * kt + l31) * 80 + (16 * kq + 8 * h5) * 2);
                const bf16x8 bv = *(const LAS bf16x8*)(L + HL_VT + (32 * vt + l31) * 80 + (16 * kq + 8 * h5) * 2);
                S = MFMA32(a, bv, S);
            }
        }
        __syncthreads();
        if (MODE == 1) {
            const int t = tid >> 4, vq = tid & 15;
            f32x4 o = (f32x4){0.f, 0.f, 0.f, 0.f};
#pragma unroll
            for (int q = 0; q < 4; ++q) o += *(const LAS f32x4*)(L + HL_SLAB + (q * 32 + t) * 272 + 16 * vq);
            float ss = (o.x * o.x + o.y * o.y) + (o.z * o.z + o.w * o.w);
            ss += __shfl_xor(ss, 1); ss += __shfl_xor(ss, 2); ss += __shfl_xor(ss, 4); ss += __shfl_xor(ss, 8);
            const float rs = 1.0f / sqrtf(ss * (1.0f / 64.0f) + LN_EPS);
            const f32x4 ng = *(const GAS f32x4*)(F.in[11] + 4 * vq);
            const u32x2 gv = *(const GAS u32x2*)(HB + (size_t)(row0 + t) * NIN + C_GB + hh * 64 + 4 * vq);
            const float g0 = bf2f(gv.x & 0xffffu), g1 = bf2f(gv.x >> 16), g2 = bf2f(gv.y & 0xffffu), g3 = bf2f(gv.y >> 16);
            u32x2 ow; ow.x = cvtpk(o.x * rs * ng.x * g0 * sigmoidf_(g0), o.y * rs * ng.y * g1 * sigmoidf_(g1)); ow.y = cvtpk(o.z * rs * ng.z * g2 * sigmoidf_(g2), o.w * rs * ng.w * g3 * sigmoidf_(g3));
            *(GAS u32x2*)((bf16*)(F.ws + WS_OB) + (size_t)(row0 + t) * 512 + hh * 64 + 4 * vq) = ow;
        }
    }
    if (MODE == 0) {
        float* Lp = HGL + ((size_t)(bh * HG_NSEG + seg)) * 8192 + w * 1024 + lane;
#pragma unroll
        for (int v = 0; v < 16; ++v) Lp[v * 64] = S[v];
        if (q4 == 0) HGD[(size_t)(bh * HG_NSEG + seg) * 128 + k] = __expf(lcsum);
    } else if (seg == HG_NSEG - 1) {
        float* o = F.out + OFF5 + (size_t)bh * 8192;
#pragma unroll
        for (int v = 0; v < 16; ++v) o[(32 * kt + crow(v, h5)) * 64 + 32 * vt + l31] = S[v];
    }
    __syncthreads();
}
__device__ __forceinline__ void hgrn_sample_unit(Frame& F, int unit) {
    const int b = unit >> 3, hh = unit & 7, tid = F.tid, v = tid & 63, kq = tid >> 6;
    const bf16* HB = (const bf16*)(F.ws + WS_HB) + (size_t)(MP + b) * NIN;
    const float* small = (const float*)(F.ws + WS_SMALL);
    const float* st = F.in[5] + (size_t)(b * 8 + hh) * 8192; float* so = F.out + OFF9 + (size_t)(b * 8 + hh) * 8192;
    const float vv = bf2f(HB[C_IB + hh * 64 + v]);
    float po = 0.f;
#pragma unroll 4
    for (int j = 0; j < 16; ++j) {
        const int k = kq * 16 + j; const float x = bf2f(HB[C_FB + hh * 128 + k]), lb = small[4096 + hh * 128 + k];
        const float e = __expf(-x), sg = 1.0f / (1.0f + e), om = e / (1.0f + e);
        const float f = lb + (1.0f - lb) * sg, kx = (1.0f - lb) * om;
        const float sn = f * st[k * 64 + v] + kx * vv; so[k * 64 + v] = sn;
        po += bf2f(HB[C_QB + hh * 128 + k]) * sn;
    }
    LAS float* red = (LAS float*)(F.lds + RING_OFF);
    red[kq * 64 + v] = po;
    __syncthreads();
    if (tid < 64) {
        float o = 0.f;
#pragma unroll
        for (int q = 0; q < 8; ++q) o += red[q * 64 + v];
        const float ss = wave_sum(o * o), rs = 1.0f / sqrtf(ss * (1.0f / 64.0f) + LN_EPS);
        const float g = bf2f(HB[C_GB + hh * 64 + v]);
        ((bf16*)(F.ws + WS_OB))[(size_t)(MP + b) * 512 + hh * 64 + v] = (bf16)f2bf(o * rs * F.in[11][v] * g * sigmoidf_(g));
    }
    __syncthreads();
}
__device__ __forceinline__ void p2_phase(Frame& F) {
    for (int u = blockIdx.x; u < 16 * (HG_NSEG - 1); u += F.G) hgrn_segment<0>(F, u / (HG_NSEG - 1), u % (HG_NSEG - 1));
    for (int u = blockIdx.x; u < MS * 8; u += F.G) hgrn_sample_unit(F, u);
    const int NGW = F.G * NWAVES;
    for (int it = F.wave * F.G + F.vcu; it < CT_ALL + VT_ITEMS; it += NGW) { if (it < CT_ALL) compress_task(F, it); else vt_item(F, it - CT_ALL); }
}
constexpr int AL_BUF = 18432  , AL_K = 0, AL_V = 9216, AL_IMP = 2 * AL_BUF, AL_SELM = AL_IMP + 64 * 128 * 4, AL_UNI = AL_SELM + 64 * 4 * 4, AL_TL = AL_UNI + 16, AL_END = AL_TL + 160 * 4;
static_assert(AL_END <= RING_BYTES, "attn lds");
constexpr float LOG2E = 1.4426950408889634f;
#define NEG_INF (-__builtin_inff())

__device__ __forceinline__ void stage_k(LAS unsigned char* L, const bf16* src, size_t pitch, int tid) {
    const int key = tid >> 3, ch = tid & 7;
    *(LAS v4u*)(L + AL_K + key * 144 + ch * 16) = *(const GAS v4u*)(src + (size_t)key * pitch + ch * 8);
}
__device__ __forceinline__ void stage_v(LAS unsigned char* L, const bf16* src, size_t pitch, int tid) {
    const int d = tid >> 3, ch = tid & 7;
    *(LAS v4u*)(L + AL_V + d * 144 + ch * 16) = *(const GAS v4u*)(src + (size_t)d * pitch + ch * 8);
}
__device__ __forceinline__ f32x16 qk_sub(const LAS unsigned char* L, int sub, const bf16x8 (&qf)[4], int l31, int h5) {
    f32x16 acc;
#pragma unroll
    for (int i = 0; i < 16; ++i) acc[i] = 0.f;
#pragma unroll
    for (int s = 0; s < 4; ++s) { const bf16x8 a = *(const LAS bf16x8*)(L + AL_K + (sub * 32 + l31) * 144 + (16 * s + 8 * h5) * 2); acc = MFMA32(a, qf[s], acc); }
    return acc;
}
__device__ __forceinline__ void pv_sub(const LAS unsigned char* L, int sub, const f32x16& p, f32x16 (&O)[2], int l31, int h5) {
#pragma unroll
    for (int kq = 0; kq < 2; ++kq) {
        const bf16x8 pb = PACK_STEP(p, kq);
#pragma unroll
        for (int dt = 0; dt < 2; ++dt) {
            const s16x4 lo = *(const LAS s16x4*)(L + AL_V + (dt * 32 + l31) * 144 + (sub * 32 + 16 * kq + 4 * h5) * 2);
            const s16x4 hi = *(const LAS s16x4*)(L + AL_V + (dt * 32 + l31) * 144 + (sub * 32 + 16 * kq + 8 + 4 * h5) * 2);
            O[dt] = MFMA32(join44(lo, hi), pb, O[dt]);
        }
    }
}
__device__ __forceinline__ void online_update(const LAS unsigned char* L, int sub, f32x16& sc, float& m, float& l, f32x16 (&O)[2], int l31, int h5) {
    float tmax = sc[0];
#pragma unroll
    for (int i = 1; i < 16; ++i) tmax = fmaxf(tmax, sc[i]);
    tmax = fmaxf(tmax, __shfl_xor(tmax, 32));
    const float mnew = fmaxf(m, tmax), ms = (mnew == NEG_INF) ? 0.f : mnew;
    const float alpha = __builtin_amdgcn_exp2f(m - ms);
    float ps = 0.f;
#pragma unroll
    for (int i = 0; i < 16; ++i) { sc[i] = __builtin_amdgcn_exp2f(sc[i] - ms); ps += sc[i]; }
    l = l * alpha + ps; m = mnew;
#pragma unroll
    for (int i = 0; i < 16; ++i) { O[0][i] *= alpha; O[1][i] *= alpha; }
    pv_sub(L, sub, sc, O, l31, h5);
}

struct AttnSrc { const bf16* KCP; const bf16* VCTP; const bf16* Ks; const bf16* Vs; const bf16* Kw; const bf16* Vw; };
__device__ __forceinline__ void tile_load(const AttnSrc& A, int e, int tid, v4u& kr, v4u& vr) {
    const int kind = e >> 24, idx = e & 0xffffff; const unsigned row = (unsigned)tid >> 3, ch = (unsigned)tid & 7u;
    const char* kb; const char* vb; unsigned ko, vo;
    if (kind <= 1) { kb = (const char*)(A.KCP + (size_t)idx * 64 * 64); vb = (const char*)(A.VCTP + idx * 64); ko = (row * 64u + ch * 8u) * 2u; vo = (row * 512u + ch * 8u) * 2u; }
    else if (kind == 2) { kb = (const char*)(A.Kw + (size_t)idx * 64 * NIN); vb = (const char*)(A.Vw + idx * 64); ko = (row * (unsigned)NIN + ch * 8u) * 2u; vo = (row * (unsigned)T + ch * 8u) * 2u; }
    else { kb = (const char*)(A.Ks + (size_t)idx * 64 * NIN); vb = (const char*)(A.Vs + idx * 64); ko = (row * (unsigned)NIN + ch * 8u) * 2u; vo = (row * (unsigned)T + ch * 8u) * 2u; }
    kr = *(const GAS v4u*)(kb + ko); vr = *(const GAS v4u*)(vb + vo);
}
__device__ __forceinline__ void tile_store(LAS unsigned char* Lb, int tid, const v4u& kr, const v4u& vr) {
    const int row = tid >> 3, ch = tid & 7;
    *(LAS v4u*)(Lb + AL_K + row * 144 + ch * 16) = kr; *(LAS v4u*)(Lb + AL_V + row * 144 + ch * 16) = vr;
}
__device__ __forceinline__ void nsa_prompt_unit(Frame& F, int unit) {
    const int b = unit >> 8, g = (unit >> 7) & 1, qt = unit & 127, t0 = qt * 64;
    int tid = F.tid; asm volatile("" : "+v"(tid));
    const int lane = tid & 63, w = F.wave, l31 = lane & 31, h5 = lane >> 5, ql = l31 >> 2, r = l31 & 3;
    LAS unsigned char* L = F.lds + RING_OFF;
    const bf16* HB = (const bf16*)(F.ws + WS_HB);
    const int pos = t0 + 8 * w + ql;
    const size_t qrow = (size_t)(b * T + pos);
    const float slope2 = __builtin_amdgcn_exp2f(-(float)(g * 4 + r + 1)) * LOG2E, scale2 = 0.125f * LOG2E;
    bf16x8 qf[4];
#pragma unroll
    for (int s = 0; s < 4; ++s) qf[s] = *(const GAS bf16x8*)(HB + qrow * NIN + C_QA + (g * 4 + r) * 64 + 16 * s + 8 * h5);
    float gate[3];
#pragma unroll
    for (int i = 0; i < 3; ++i) gate[i] = sigmoidf_(bf2f(HB[qrow * NIN + C_GLA + (g * 4 + r) * 3 + i]));
    AttnSrc A;
    A.KCP = (const bf16*)(F.ws + WS_KCP) + (size_t)(b * 2 + g) * 512 * 64; A.VCTP = (const bf16*)(F.ws + WS_VCTP) + (size_t)(b * 2 + g) * 64 * 512;
    A.Ks = HB + (size_t)(b * T) * NIN + C_KVS + g * 64; A.Vs = (const bf16*)(F.ws + WS_VST) + (size_t)(b * 2 + g) * 64 * T;
    A.Kw = HB + (size_t)(b * T) * NIN + C_KVW + g * 64; A.Vw = (const bf16*)(F.ws + WS_VWT) + (size_t)(b * 2 + g) * 64 * T;
    LAS int* TL = (LAS int*)(L + AL_TL);
    for (int i = tid; i < (AL_TL - AL_IMP) / 4; i += NWAVES * 64) ((LAS unsigned*)(L + AL_IMP))[i] = 0u;
    const int nmax_u = (t0 + 63 - 31) >> 4, nc = (nmax_u >> 6) + 1;
    const int nmax_w = (t0 + 8 * w + 7 - 31) >> 4;
    const int kb_lo = qt >= 8 ? qt - 8 : 0, nw = qt - kb_lo + 1;
    if (tid < 2 * nc + nw) TL[tid] = tid < nc ? tid : (tid < 2 * nc ? (1 << 24) | (tid - nc) : (2 << 24) | (kb_lo + tid - 2 * nc));
    __syncthreads();
    f32x16 O[2];
#pragma unroll
    for (int i = 0; i < 16; ++i) { O[0][i] = 0.f; O[1][i] = 0.f; }
    float* ots = (float*)(F.ws + WS_OTS) + ((size_t)blockIdx.x * 512 + tid) * 32;
    float m = NEG_INF, l = 0.f, inv_l = 0.f, mfin = 0.f;
    unsigned mysel[4] = {0u, 0u, 0u, 0u};
    int n = 2 * nc + nw;
#define NSA_TILE_LOOP(stream) \
    { \
    v4u kr, vr; \
    tile_load(A, TL[0], tid, kr, vr); tile_store(L, tid, kr, vr); \
    __syncthreads(); \
    if (n > 1) tile_load(A, TL[1], tid, kr, vr); \
_Pragma("unroll 1") \
    for (int i = 0; i < n; ++i) { \
        const int e = TL[i], kind = (stream) == 1 ? 3 : (e >> 24), idx = e & 0xffffff; \
        const LAS unsigned char* Lb = L + (i & 1) * AL_BUF; \
        if (stream == 0 && i == nc) { l += __shfl_xor(l, 32); inv_l = l > 0.f ? 1.0f / l : 0.f; mfin = (m == NEG_INF) ? 0.f : m; } \
        if (stream == 0 && i == 2 * nc) { \
_Pragma("unroll") \
            for (int k = 0; k < 16; ++k) { ots[k] = gate[0] * O[0][k]; ots[16 + k] = gate[0] * O[1][k]; O[0][k] = 0.f; O[1][k] = 0.f; } \
            m = NEG_INF; l = 0.f; } \
        if ((stream) == 0 && kind <= 1) { \
_Pragma("unroll") \
            for (int sub = 0; sub < 2; ++sub) { \
                const int n0 = idx * 64 + sub * 32; \
                if (n0 > nmax_w) continue; \
                f32x16 sc = qk_sub(Lb, sub, qf, l31, h5); \
                if (kind == 0) { \
_Pragma("unroll") \
                    for (int k = 0; k < 16; ++k) { const int dist = pos - (16 * (n0 + crow(k, h5)) + 31); sc[k] = dist >= 0 ? sc[k] * scale2 - slope2 * (float)dist : NEG_INF; } \
                    float tmax = sc[0]; \
_Pragma("unroll") \
                    for (int k = 1; k < 16; ++k) tmax = fmaxf(tmax, sc[k]); \
                    tmax = fmaxf(tmax, __shfl_xor(tmax, 32)); \
                    const float mnew = fmaxf(m, tmax), ms = (mnew == NEG_INF) ? 0.f : mnew; \
                    float ps = 0.f; \
_Pragma("unroll") \
                    for (int k = 0; k < 16; ++k) ps += __builtin_amdgcn_exp2f(sc[k] - ms); \
                    l = l * __builtin_amdgcn_exp2f(m - ms) + ps; m = mnew; \
                } else { \
_Pragma("unroll") \
                    for (int k = 0; k < 16; ++k) { const int dist = pos - (16 * (n0 + crow(k, h5)) + 31); sc[k] = dist >= 0 ? __builtin_amdgcn_exp2f(sc[k] * scale2 - slope2 * (float)dist - mfin) * inv_l : 0.f; } \
_Pragma("unroll") \
                    for (int a = 0; a < 4; ++a) { \
                        float sm = (sc[4 * a] + sc[4 * a + 1]) + (sc[4 * a + 2] + sc[4 * a + 3]); \
                        sm += __shfl_xor(sm, 1); sm += __shfl_xor(sm, 2); \
                        if (r == 0) ((LAS float*)(L + AL_IMP))[(8 * w + ql) * 128 + (n0 >> 2) + 2 * a + h5] = sm; \
                    } \
                    pv_sub(Lb, sub, sc, O, l31, h5); \
                } \
            } \
        } else { \
            const int pos0 = idx * 64; \
            const bool sel = (stream) == 0 ? true : (((idx < 32 ? mysel[0] : (idx < 64 ? mysel[1] : (idx < 96 ? mysel[2] : mysel[3]))) >> (idx & 31)) & 1u) != 0u; \
            if (__any(sel && pos >= pos0)) { \
_Pragma("unroll") \
                for (int sub = 0; sub < 2; ++sub) { \
                    f32x16 sc = qk_sub(Lb, sub, qf, l31, h5); \
_Pragma("unroll") \
                    for (int k = 0; k < 16; ++k) { const int dist = pos - (pos0 + sub * 32 + crow(k, h5)); sc[k] = (sel && dist >= 0 && ((stream) == 1 || dist < 512)) ? sc[k] * scale2 - slope2 * (float)dist : NEG_INF; } \
                    online_update(Lb, sub, sc, m, l, O, l31, h5); \
                } \
            } \
        } \
        if (i + 1 < n) tile_store(L + ((i + 1) & 1) * AL_BUF, tid, kr, vr); \
        __syncthreads(); \
        if (i + 2 < n) tile_load(A, TL[i + 2], tid, kr, vr); \
    } \
    l += __shfl_xor(l, 32); \
    const float sc_ = l > 0.f ? gate[stream == 0 ? 2 : 1] / l : 0.f; \
    if (stream == 0) { \
_Pragma("unroll") \
        for (int k = 0; k < 16; ++k) { ots[k] += sc_ * O[0][k]; ots[16 + k] += sc_ * O[1][k]; } \
    } else { \
_Pragma("unroll") \
        for (int k = 0; k < 16; ++k) { O[0][k] = ots[k] + sc_ * O[0][k]; O[1][k] = ots[16 + k] + sc_ * O[1][k]; } \
    } \
    }
    NSA_TILE_LOOP(0)
    {
        const int q = tid >> 3, sub = tid & 7, cur = qt;
        float vals[16]; unsigned avail = 0u, bits = 0u;
#pragma unroll
        for (int i = 0; i < 16; ++i) { const int j = sub * 16 + i; vals[i] = ((LAS float*)(L + AL_IMP))[q * 128 + j];
            if (j <= cur) { if (cur < 16 || j == 0 || j == cur || j == cur - 1) bits |= 1u << i; else avail |= 1u << i; } }
        if (cur >= 16) {
            for (int round = 0; round < 13; ++round) {
                float bv = -1.0f; int bi = 1 << 20;
#pragma unroll
                for (int i = 0; i < 16; ++i) if (((avail >> i) & 1u) && vals[i] > bv) { bv = vals[i]; bi = sub * 16 + i; }
#pragma unroll
                for (int o = 1; o < 8; o <<= 1) { const float ov = __shfl_xor(bv, o); const int oi = __shfl_xor(bi, o); if (ov > bv || (ov == bv && oi < bi)) { bv = ov; bi = oi; } }
                if ((bi >> 4) == sub) { avail &= ~(1u << (bi & 15)); bits |= 1u << (bi & 15); }
            }
        }
        if (bits) { __hip_atomic_fetch_or((LAS unsigned*)(L + AL_SELM) + q * 4 + (sub >> 1), bits << (16 * (sub & 1)), __ATOMIC_RELAXED, __HIP_MEMORY_SCOPE_WORKGROUP); __hip_atomic_fetch_or((LAS unsigned*)(L + AL_UNI) + (sub >> 1), bits << (16 * (sub & 1)), __ATOMIC_RELAXED, __HIP_MEMORY_SCOPE_WORKGROUP); }
        __syncthreads();
        const unsigned u0 = ((LAS unsigned*)(L + AL_UNI))[0], u1 = ((LAS unsigned*)(L + AL_UNI))[1], u2 = ((LAS unsigned*)(L + AL_UNI))[2], u3 = ((LAS unsigned*)(L + AL_UNI))[3];
        n = __builtin_popcount(u0) + __builtin_popcount(u1) + __builtin_popcount(u2) + __builtin_popcount(u3);
        n = __builtin_amdgcn_readfirstlane(n);
        if (tid < 128) { const int wq = tid >> 5, bq = tid & 31; const unsigned uw = wq == 0 ? u0 : (wq == 1 ? u1 : (wq == 2 ? u2 : u3));
            if ((uw >> bq) & 1u) { const int rank = __builtin_popcount(uw & ((1u << bq) - 1u)) + (wq > 0 ? __builtin_popcount(u0) : 0) + (wq > 1 ? __builtin_popcount(u1) : 0) + (wq > 2 ? __builtin_popcount(u2) : 0);
                TL[rank] = (3 << 24) | tid; } }
#pragma unroll
        for (int jw = 0; jw < 4; ++jw) mysel[jw] = ((LAS unsigned*)(L + AL_SELM))[(8 * w + ql) * 4 + jw];
        __syncthreads();
        m = NEG_INF; l = 0.f;
#pragma unroll
        for (int i = 0; i < 16; ++i) { O[0][i] = 0.f; O[1][i] = 0.f; }
    }
    NSA_TILE_LOOP(1)
#undef NSA_TILE_LOOP
    bf16* oa = (bf16*)(F.ws + WS_OA) + qrow * 512 + (g * 4 + r) * 64;
#pragma unroll
    for (int dt = 0; dt < 2; ++dt)
#pragma unroll
        for (int a = 0; a < 4; ++a) { u32x2 ow; ow.x = cvtpk(O[dt][4 * a], O[dt][4 * a + 1]); ow.y = cvtpk(O[dt][4 * a + 2], O[dt][4 * a + 3]);
            *(GAS u32x2*)(oa + dt * 32 + 8 * a + 4 * h5) = ow; }
    __syncthreads();
}

constexpr int SL_SC = 0, SL_Q = 16384, SL_RED = SL_Q + 1024, SL_IMP = SL_RED + 8192, SL_SEL = SL_IMP + 2048, SL_SELB = SL_SEL + 64, SL_OUT = SL_SELB + 128, SL_END = SL_OUT + 1024;
static_assert(SL_END <= RING_BYTES, "sample lds");
struct SampleCtx { const float* kcvs; const float* csel; const float* cwin; const float* new_sel; const float* new_win; };
template <int KIND> __device__ __forceinline__ const float* sample_key(const SampleCtx& c, const LAS int* SEL, const LAS unsigned long long* SELB, int kidx, int& dist, bool& valid) {
    if (KIND == 0) { valid = kidx < NCMP_S; dist = PAST - (16 * kidx + 31); return c.kcvs + (size_t)(valid ? kidx : 0) * 256; }
    if (KIND == 1) { const int slot = kidx >> 6, i = kidx & 63, jb = SEL[slot];
        if (jb < 256) { valid = true; dist = PAST - (jb * 64 + i); return c.csel + SELB[slot] + (size_t)i * 256; }
        valid = (i == 0); dist = 0; return c.new_sel; }
    valid = (kidx >= 1 && kidx <= 512); dist = 512 - kidx;
    return kidx == 512 ? c.new_win : c.cwin + (size_t)((kidx >= 1 && kidx < 512) ? kidx : 1) * 256;
}
__device__ __forceinline__ void block_max4(LAS float* red, float (&v)[4], int wave, int lane) {
#pragma unroll
    for (int r = 0; r < 4; ++r) { float x = v[r];
#pragma unroll
        for (int o = 1; o < 64; o <<= 1) x = fmaxf(x, __shfl_xor(x, o));
        if (lane == 0) red[wave * 4 + r] = x; }
    __syncthreads();
#pragma unroll
    for (int r = 0; r < 4; ++r) { float x = red[r];
#pragma unroll
        for (int q = 1; q < 8; ++q) x = fmaxf(x, red[q * 4 + r]);
        v[r] = x; }
    __syncthreads();
}
__device__ __forceinline__ void block_sum4(LAS float* red, float (&v)[4], int wave, int lane) {
#pragma unroll
    for (int r = 0; r < 4; ++r) { const float x = wave_sum(v[r]); if (lane == 0) red[wave * 4 + r] = x; }
    __syncthreads();
#pragma unroll
    for (int r = 0; r < 4; ++r) { float x = 0.f;
#pragma unroll
        for (int q = 0; q < 8; ++q) x += red[q * 4 + r];
        v[r] = x; }
    __syncthreads();
}
template <int KIND> __device__ __forceinline__ void sample_branch(Frame& F, const SampleCtx& c, int b, int g, int tid) {
    constexpr int NK = KIND == 2 ? 544 : 1024;
    const int lane = tid & 63, wave = F.wave, sub = lane & 15, kg = lane >> 4;
    LAS unsigned char* L = F.lds + RING_OFF;
    LAS float* SC = (LAS float*)(L + SL_SC); LAS float* Q = (LAS float*)(L + SL_Q); LAS float* red = (LAS float*)(L + SL_RED);
    const LAS int* SEL = (const LAS int*)(L + SL_SEL); const LAS unsigned long long* SELB = (const LAS unsigned long long*)(L + SL_SELB);
    f32x4 q4[4];
#pragma unroll
    for (int r = 0; r < 4; ++r) q4[r] = *(const LAS f32x4*)(Q + r * 64 + 4 * sub);
    constexpr int NIT = NK / 32, NBATCH_S = (NIT % 4 == 0) ? 4 : 1;
#pragma unroll 1
    for (int it0 = 0; it0 < NIT; it0 += NBATCH_S) {
        f32x4 kv[NBATCH_S]; int dist[NBATCH_S]; bool valid[NBATCH_S];
#pragma unroll
        for (int u = 0; u < NBATCH_S; ++u) { const int kidx = (it0 + u) * 32 + wave * 4 + kg; const float* kp = sample_key<KIND>(c, SEL, SELB, kidx, dist[u], valid[u]); kv[u] = *(const GAS f32x4*)(kp + 4 * sub); }
#pragma unroll
        for (int u = 0; u < NBATCH_S; ++u) {
            const int kidx = (it0 + u) * 32 + wave * 4 + kg;
            float part[4];
#pragma unroll
            for (int r = 0; r < 4; ++r) { float p = (kv[u].x * q4[r].x + kv[u].y * q4[r].y) + (kv[u].z * q4[r].z + kv[u].w * q4[r].w);
                p += __shfl_xor(p, 1); p += __shfl_xor(p, 2); p += __shfl_xor(p, 4); p += __shfl_xor(p, 8); part[r] = p; }
            if (sub < 4) { const float pr = sub == 0 ? part[0] : (sub == 1 ? part[1] : (sub == 2 ? part[2] : part[3]));
                SC[sub * 1024 + kidx] = valid[u] ? pr * 0.125f - __builtin_amdgcn_exp2f(-(float)(g * 4 + sub + 1)) * (float)dist[u] : NEG_INF; }
        }
    }
    __syncthreads();
    float mx[4] = {NEG_INF, NEG_INF, NEG_INF, NEG_INF};
    for (int kidx = tid; kidx < NK; kidx += 512)
#pragma unroll
        for (int r = 0; r < 4; ++r) mx[r] = fmaxf(mx[r], SC[r * 1024 + kidx]);
    block_max4(red, mx, wave, lane);
    float sm[4] = {0.f, 0.f, 0.f, 0.f};
    for (int kidx = tid; kidx < NK; kidx += 512)
#pragma unroll
        for (int r = 0; r < 4; ++r) { const float s = SC[r * 1024 + kidx]; const float p = s == NEG_INF ? 0.f : __expf(s - mx[r]); SC[r * 1024 + kidx] = p; sm[r] += p; }
    block_sum4(red, sm, wave, lane);
    for (int kidx = tid; kidx < NK; kidx += 512)
#pragma unroll
        for (int r = 0; r < 4; ++r) SC[r * 1024 + kidx] *= (sm[r] > 0.f ? 1.0f / sm[r] : 0.f);
    __syncthreads();
    f32x4 acc[4];
#pragma unroll
    for (int r = 0; r < 4; ++r) acc[r] = (f32x4){0.f, 0.f, 0.f, 0.f};
#pragma unroll 1
    for (int it0 = 0; it0 < NIT; it0 += NBATCH_S) {
        f32x4 vv[NBATCH_S];
#pragma unroll
        for (int u = 0; u < NBATCH_S; ++u) { const int kidx = (it0 + u) * 32 + wave * 4 + kg; int dist; bool valid; const float* kp = sample_key<KIND>(c, SEL, SELB, kidx, dist, valid); vv[u] = *(const GAS f32x4*)(kp + 128 + 4 * sub); }
#pragma unroll
        for (int u = 0; u < NBATCH_S; ++u) { const int kidx = (it0 + u) * 32 + wave * 4 + kg;
#pragma unroll
            for (int r = 0; r < 4; ++r) acc[r] += vv[u] * SC[r * 1024 + kidx]; }
    }
#pragma unroll
    for (int r = 0; r < 4; ++r)
#pragma unroll
        for (int j = 0; j < 4; ++j) { float x = acc[r][j]; x += __shfl_xor(x, 16); x += __shfl_xor(x, 32); acc[r][j] = x; }
    if (lane < 16) {
#pragma unroll
        for (int r = 0; r < 4; ++r) *(LAS f32x4*)(red + wave * 256 + r * 64 + 4 * sub) = acc[r];
    }
    __syncthreads();
    if (tid < 256) { const int r = tid >> 6; float o = 0.f;
#pragma unroll
        for (int wv = 0; wv < 8; ++wv) o += red[wv * 256 + tid];
        const float gt = sigmoidf_(bf2f(((const bf16*)(F.ws + WS_HB))[(size_t)(MP + b) * NIN + C_GLA + (g * 4 + r) * 3 + KIND]));
        ((LAS float*)(L + SL_OUT))[tid] += gt * o; }
    __syncthreads();
}
__device__ __forceinline__ void nsa_sample_unit(Frame& F, int unit) {
    const int b = unit >> 1, g = unit & 1;
    int tid = F.tid; asm volatile("" : "+v"(tid));
    LAS unsigned char* L = F.lds + RING_OFF;
    LAS float* SC = (LAS float*)(L + SL_SC); LAS float* Q = (LAS float*)(L + SL_Q); LAS float* IMP = (LAS float*)(L + SL_IMP); LAS int* SEL = (LAS int*)(L + SL_SEL);
    LAS unsigned long long* SELB = (LAS unsigned long long*)(L + SL_SELB);
    SampleCtx c;
    c.kcvs = (const float*)(F.ws + WS_KCVS) + (size_t)b * 1024 * 256 + g * 64; c.csel = F.in[3] + g * 64; c.cwin = F.in[4] + (size_t)b * 512 * 256 + g * 64;
    c.new_sel = F.out + OFF7 + (size_t)b * 256 + g * 64; c.new_win = F.out + OFF8 + ((size_t)b * 512 + 511) * 256 + g * 64;
    __syncthreads();
    if (tid < 256) { Q[tid] = bf2f(((const bf16*)(F.ws + WS_HB))[(size_t)(MP + b) * NIN + C_QA + g * 256 + tid]); ((LAS float*)(L + SL_OUT))[tid] = 0.f; }
    __syncthreads();
    sample_branch<0>(F, c, b, g, tid);
    if (tid < 257) { float s = 0.f;
#pragma unroll
        for (int cc = 0; cc < 4; ++cc) { const int n = 4 * tid + cc; if (n < NCMP_S) s += (SC[n] + SC[1024 + n]) + (SC[2048 + n] + SC[3072 + n]); }
        IMP[tid] = (tid == 0 || tid >= 255) ? -1.0f : s; }
    __syncthreads();
    if (tid < 64) {
        if (tid == 0) { SEL[0] = 0; SEL[1] = 255; SEL[2] = 256; }
        float vals[4]; unsigned avail = 0xfu;
#pragma unroll
        for (int i = 0; i < 4; ++i) { const int j = tid * 4 + i; vals[i] = IMP[j]; if (vals[i] < 0.f) avail &= ~(1u << i); }
        for (int round = 0; round < 13; ++round) {
            float bv = -1.0f; int bi = 1 << 20;
#pragma unroll
            for (int i = 0; i < 4; ++i) if (((avail >> i) & 1u) && vals[i] > bv) { bv = vals[i]; bi = tid * 4 + i; }
#pragma unroll
            for (int o = 1; o < 64; o <<= 1) { const float ov = __shfl_xor(bv, o); const int oi = __shfl_xor(bi, o); if (ov > bv || (ov == bv && oi < bi)) { bv = ov; bi = oi; } }
            if ((bi >> 2) == tid) avail &= ~(1u << (bi & 3));
            if (tid == 0) SEL[3 + round] = bi;
        }
    }
    __syncthreads();
    if (tid < 16) { const int jb = SEL[tid]; const int* pt = (const int*)F.in[6] + b * NPAGES;
        SELB[tid] = jb < 256 ? ((unsigned long long)pt[jb >> 1] * 128ull + (unsigned long long)((jb & 1) * 64)) * 256ull : 0ull; }
    __syncthreads();
    sample_branch<1>(F, c, b, g, tid);
    sample_branch<2>(F, c, b, g, tid);
    if (tid < 256) ((bf16*)(F.ws + WS_OA))[(size_t)(MP + b) * 512 + g * 256 + tid] = (bf16)f2bf(((LAS float*)(L + SL_OUT))[tid]);
    __syncthreads();
}
__device__ __forceinline__ void p3_phase(Frame& F) {
    for (int u = blockIdx.x; u < 16 * HG_NSEG; u += F.G) hgrn_segment<1>(F, u / HG_NSEG, u % HG_NSEG);
#pragma unroll 1
    for (int u2 = 2 * blockIdx.x; u2 < 512; u2 += 2 * F.G) {
#pragma unroll 1
        for (int which = 0; which < 2; ++which) { const int p = u2 >> 1, bg = p >> 6, qq = p & 63; nsa_prompt_unit(F, bg * 128 + (which ? qq : 127 - qq)); } }
    for (int u = blockIdx.x; u < 2 * MS; u += F.G) nsa_sample_unit(F, u);
}
namespace pg8 {
typedef unsigned u32x2e __attribute__((ext_vector_type(2)));
__device__ __forceinline__ float bfl(unsigned w) { return __uint_as_float(w << 16); }
__device__ __forceinline__ float bfh(unsigned w) { return __uint_as_float(w & 0xffff0000u); }
__device__ __forceinline__ float sgm(float x) { return 1.0f / (1.0f + __expf(-x)); }
struct EpiGateA {
    static constexpr bool PERM = false, AFTER_DRAIN = false;
    const bf16_t* HBp; float* TB;
    __device__ __forceinline__ void operator()(const f32x4 (&acc)[2][2][4][2], const Unit& u, int wr, int wc, int fr, int fq) const {
        const int row0 = u.pm * BM + wr * 64 + fr, col0 = u.pn * BM + wc * 32 + 4 * fq;
#pragma unroll
        for (int ai = 0; ai < 2; ++ai)
#pragma unroll
            for (int m = 0; m < 4; ++m) { const size_t r = (size_t)(row0 + ai * HALF + m * 16);
#pragma unroll
                for (int bj = 0; bj < 2; ++bj)
#pragma unroll
                    for (int n = 0; n < 2; ++n) { const int c = col0 + bj * HALF + n * 16; const u32x2e gw = *(const u32x2e*)(HBp + r * NIN + C_MG + c); const f32x4 a = acc[ai][bj][m][n];
                        *(f32x4*)(TB + r * D + c) = (f32x4){sgm(bfl(gw.x)) * a[0], sgm(bfh(gw.x)) * a[1], sgm(bfl(gw.y)) * a[2], sgm(bfh(gw.y)) * a[3]}; } }
    }
};
struct EpiGateB {
    static constexpr bool PERM = false, AFTER_DRAIN = false;
    const bf16_t* HBp; const float* TB; bf16_t* MG;
    __device__ __forceinline__ void operator()(const f32x4 (&acc)[2][2][4][2], const Unit& u, int wr, int wc, int fr, int fq) const {
        const int row0 = u.pm * BM + wr * 64 + fr, col0 = u.pn * BM + wc * 32 + 4 * fq;
#pragma unroll
        for (int ai = 0; ai < 2; ++ai)
#pragma unroll
            for (int m = 0; m < 4; ++m) { const size_t r = (size_t)(row0 + ai * HALF + m * 16);
#pragma unroll
                for (int bj = 0; bj < 2; ++bj)
#pragma unroll
                    for (int n = 0; n < 2; ++n) { const int c = col0 + bj * HALF + n * 16; const u32x2e gw = *(const u32x2e*)(HBp + r * NIN + C_MG + D + c); const f32x4 a = acc[ai][bj][m][n]; const f32x4 t = *(const f32x4*)(TB + r * D + c);
                        u32x2e o; o.x = cvt_pk_bf16(t[0] + sgm(bfl(gw.x)) * a[0], t[1] + sgm(bfh(gw.x)) * a[1]); o.y = cvt_pk_bf16(t[2] + sgm(bfl(gw.y)) * a[2], t[3] + sgm(bfh(gw.y)) * a[3]);
                        *(u32x2e*)(MG + r * D + c) = o; } }
    }
};
struct EpiResid {
    static constexpr bool PERM = false, AFTER_DRAIN = false;
    const float* rp; const float* rs; float* Z;
    __device__ __forceinline__ void operator()(const f32x4 (&acc)[2][2][4][2], const Unit& u, int wr, int wc, int fr, int fq) const {
        const int row0 = u.pm * BM + wr * 64 + fr, col0 = u.pn * BM + wc * 32 + 4 * fq;
#pragma unroll
        for (int ai = 0; ai < 2; ++ai)
#pragma unroll
            for (int m = 0; m < 4; ++m) { const int r = row0 + ai * HALF + m * 16; const float* xr = r < MP ? rp + (size_t)r * D : (r < MP + MS ? rs + (size_t)(r - MP) * D : nullptr);
#pragma unroll
                for (int bj = 0; bj < 2; ++bj)
#pragma unroll
                    for (int n = 0; n < 2; ++n) { const int c = col0 + bj * HALF + n * 16; const f32x4 x = xr ? *(const f32x4*)(xr + c) : (f32x4){0.f, 0.f, 0.f, 0.f};
                        *(f32x4*)(Z + (size_t)r * D + c) = x * DN_ALPHA + acc[ai][bj][m][n]; } }
    }
};
struct EpiRelu2 {
    static constexpr bool PERM = true, AFTER_DRAIN = false;
    bf16_t* U;
    __device__ __forceinline__ void operator()(const f32x4 (&acc)[2][2][4][2], const Unit& u, int wr, int wc, int fr, int fq) const {
        const int row0 = u.pm * BM + wr * 64 + fr, col0 = u.pn * BM + wc * 32 + 8 * fq;
#pragma unroll
        for (int ai = 0; ai < 2; ++ai)
#pragma unroll
            for (int m = 0; m < 4; ++m) { bf16_t* rowp = U + (size_t)(row0 + ai * HALF + m * 16) * FF + col0;
#pragma unroll
                for (int bj = 0; bj < 2; ++bj) { f32x4 v0 = acc[ai][bj][m][0], v1 = acc[ai][bj][m][1];
#pragma unroll
                    for (int j = 0; j < 4; ++j) { const float a = fmaxf(v0[j], 0.f), b = fmaxf(v1[j], 0.f); v0[j] = a * a; v1[j] = b * b; }
                    u32x4 w; w.x = cvt_pk_bf16(v0[0], v0[1]); w.y = cvt_pk_bf16(v0[2], v0[3]); w.z = cvt_pk_bf16(v1[0], v1[1]); w.w = cvt_pk_bf16(v1[2], v1[3]);
                    *(u32x4*)(rowp + bj * HALF) = w; } }
    }
};
}
__device__ __forceinline__ void ln_phase(Frame& F, const float* Z, const float* gam, const float* bet, int which) {
    const int gw = F.vcu * NWAVES + F.wave, NGW = F.G * NWAVES, lane = F.lane;
    const int nrows = MP + MS;
    for (int r = gw; r < nrows; r += NGW) {
        const GAS f32x4* zr = (const GAS f32x4*)(Z + (size_t)r * D) + lane;
        f32x4 v[4]; float s = 0.f;
        if (which && r >= MP) {
            const GAS f32x4* x1r = (const GAS f32x4*)((const float*)(F.ws + WS_X1F) + (size_t)r * D) + lane;
#pragma unroll
            for (int j = 0; j < 4; ++j) { f32x4 t = x1r[64 * j] * DN_ALPHA;
#pragma unroll
                for (int kq = 0; kq < 4; ++kq) t += *((const GAS f32x4*)(Z + (size_t)(MP + 32 * kq + (r - MP)) * D) + lane + 64 * j);
                v[j] = t; s += (t.x + t.y) + (t.z + t.w); }
        } else {
#pragma unroll
        for (int j = 0; j < 4; ++j) { v[j] = zr[64 * j]; s += (v[j].x + v[j].y) + (v[j].z + v[j].w); }
        }
        const float mean = wave_sum(s) * (1.f / D); float s2 = 0.f;
#pragma unroll
        for (int j = 0; j < 4; ++j) { v[j] = v[j] - mean; s2 += (v[j].x * v[j].x + v[j].y * v[j].y) + (v[j].z * v[j].z + v[j].w * v[j].w); }
        const float rstd = 1.f / sqrtf(wave_sum(s2) * (1.f / D) + LN_EPS);
        float* of = which ? (r < MP ? F.out + OFF0 + (size_t)r * D : F.out + OFF1 + (size_t)(r - MP) * D) : (float*)(F.ws + WS_X1F) + (size_t)r * D;
#pragma unroll
        for (int j = 0; j < 4; ++j) { const f32x4 gg = *((const GAS f32x4*)gam + lane + 64 * j), bb = *((const GAS f32x4*)bet + lane + 64 * j);
            v[j] = v[j] * rstd * gg + bb; *((GAS f32x4*)of + lane + 64 * j) = v[j]; }
        if (!which) { GAS unsigned long long* o8 = (GAS unsigned long long*)((bf16*)(F.ws + WS_X1B) + (size_t)r * D) + lane;
#pragma unroll
            for (int j = 0; j < 4; ++j) o8[64 * j] = (unsigned long long)pk2(v[j].x, v[j].y) | ((unsigned long long)pk2(v[j].z, v[j].w) << 32); }
    }
}
__device__ __forceinline__ f32x16 small_gemm(const bf16* A, int lda, const bf16* Bt, int K, int n0, int k0, int k1, int l31, int h5, f32x16 acc) {
    const bf16* ap = A + (size_t)l31 * lda + 8 * h5; const bf16* bp = Bt + (size_t)(n0 + l31) * K + 8 * h5;
#pragma unroll 1
    for (int k = k0; k < k1; k += 128) {
        bf16x8 av[8], bv[8];
#pragma unroll
        for (int j = 0; j < 8; ++j) { av[j] = *(const GAS bf16x8*)(ap + k + 16 * j); bv[j] = *(const GAS bf16x8*)(bp + k + 16 * j); }
#pragma unroll
        for (int j = 0; j < 8; ++j) acc = MFMA32(av[j], bv[j], acc);
    }
    return acc;
}
#define SMALL_TASK_LOOP(NT) for (int it = F.vcu + F.G * F.wave; it < (NT); it += F.G * NWAVES)
__device__ __forceinline__ f32x16 zero16() { f32x16 z;
#pragma unroll
    for (int i = 0; i < 16; ++i) z[i] = 0.f;
    return z; }
__device__ __forceinline__ void sample_merge_tasks(Frame& F) {
    const int l31 = F.lane & 31, h5 = F.lane >> 5; const bf16* HB = (const bf16*)(F.ws + WS_HB);
    SMALL_TASK_LOOP(32) { const int n0 = it * 32, n = n0 + l31;
        const f32x16 aa = small_gemm((const bf16*)(F.ws + WS_OA) + (size_t)MP * 512, 512, (const bf16*)(F.ws + WS_WA), 512, n0, 0, 512, l31, h5, zero16());
        const f32x16 ab = small_gemm((const bf16*)(F.ws + WS_OB) + (size_t)MP * 512, 512, (const bf16*)(F.ws + WS_WB), 512, n0, 0, 512, l31, h5, zero16());
#pragma unroll
        for (int v = 0; v < 16; ++v) { const size_t row = (size_t)(MP + crow(v, h5));
            const float g1 = sigmoidf_(bf2f(HB[row * NIN + C_MG + n])), g2 = sigmoidf_(bf2f(HB[row * NIN + C_MG + D + n]));
            ((bf16*)(F.ws + WS_MG))[row * D + n] = (bf16)f2bf(g1 * aa[v] + g2 * ab[v]); } }
}
__device__ __forceinline__ void sample_wout_tasks(Frame& F) {
    const int l31 = F.lane & 31, h5 = F.lane >> 5;
    SMALL_TASK_LOOP(32) { const int n0 = it * 32, n = n0 + l31;
        const f32x16 a = small_gemm((const bf16*)(F.ws + WS_MG) + (size_t)MP * D, D, (const bf16*)(F.ws + WS_WO), D, n0, 0, D, l31, h5, zero16());
#pragma unroll
        for (int v = 0; v < 16; ++v) { const int row = crow(v, h5); ((float*)(F.ws + WS_Z1))[(size_t)(MP + row) * D + n] = DN_ALPHA * F.in[1][(size_t)row * D + n] + a[v]; } }
}
__device__ __forceinline__ void sample_up_tasks(Frame& F) {
    const int l31 = F.lane & 31, h5 = F.lane >> 5;
    SMALL_TASK_LOOP(128) { const int n0 = it * 32, n = n0 + l31;
        const f32x16 a = small_gemm((const bf16*)(F.ws + WS_X1B) + (size_t)MP * D, D, (const bf16*)(F.ws + WS_WUP), D, n0, 0, D, l31, h5, zero16());
#pragma unroll
        for (int v = 0; v < 16; ++v) { const float x = fmaxf(a[v], 0.f); ((bf16*)(F.ws + WS_UB))[(size_t)(MP + crow(v, h5)) * FF + n] = (bf16)f2bf(x * x); } }
}
__device__ __forceinline__ void sample_down_tasks(Frame& F) {
    const int l31 = F.lane & 31, h5 = F.lane >> 5;
    SMALL_TASK_LOOP(128) { const int n0 = (it & 31) * 32, kq = it >> 5, n = n0 + l31;
        const f32x16 a = small_gemm((const bf16*)(F.ws + WS_UB) + (size_t)MP * FF, FF, (const bf16*)(F.ws + WS_WDN), FF, n0, kq * 1024, kq * 1024 + 1024, l31, h5, zero16());
#pragma unroll
        for (int v = 0; v < 16; ++v) ((float*)(F.ws + WS_Z2))[(size_t)(MP + 32 * kq + crow(v, h5)) * D + n] = a[v]; }
}

#ifdef PROBE_LAST
#ifndef PROBE_BASE
#define PROBE_BASE WS_KCP
#endif
#ifndef PROBE_BYTES
#define PROBE_BYTES (WS_TB - WS_KCP)
#endif
__device__ __forceinline__ void probe_digest(Frame& F, const XcdBarrier& bar) {
    const size_t i0 = (size_t)blockIdx.x * 512 + F.tid, st = (size_t)F.G * 512;
    for (size_t i = i0; i < OUT_TOTAL; i += st) F.out[i] = 0.f;
    xcd_barrier(bar);
    const unsigned* w = (const unsigned*)(F.ws + PROBE_BASE); const size_t nw = (size_t)(PROBE_BYTES) / 4;
    unsigned h = 0u;
    for (size_t i = i0; i < nw; i += st) h += (w[i] ^ (unsigned)i) * 2654435761u;
#pragma unroll
    for (int o = 1; o < 64; o <<= 1) h += __shfl_xor(h, o);
    if (F.lane == 0) F.out[(size_t)blockIdx.x * 8 + F.wave] = (float)(h & 0xFFFFFu);
}
#endif
struct Args { const float* in[21]; float* out; unsigned char* ws; int ph_lo, ph_hi; };
__global__ void __launch_bounds__(NWAVES * 64, 2) nsa_fwd(Args args) {
    extern __shared__ __attribute__((aligned(16))) unsigned char lds[];
    Frame F;
    F.lds = (LAS unsigned char*)lds;
    F.MISC = (volatile LAS unsigned*)(F.lds + MISC_OFF);
    F.tid = threadIdx.x; F.lane = F.tid & 63; F.wave = __builtin_amdgcn_readfirstlane(F.tid >> 6);
    F.G = gridDim.x; { const int bx = blockIdx.x; F.vcu = (F.G % 8 == 0) ? (bx % 8) * (F.G / 8) + bx / 8 : bx; }
    F.ws = args.ws; F.out = args.out;
#pragma unroll
    for (int i = 0; i < 21; ++i) F.in[i] = args.in[i];
    F.ctl = (gu32*)(F.ws + WS_CTL);
    for (int u = F.tid; u < (LDS_BYTES - LDSCTL_OFF) / 4; u += NWAVES * 64) ((LAS unsigned*)(F.lds + LDSCTL_OFF))[u] = 0u;
    __syncthreads();
    XcdBarrier bar = xcd_barrier_post((unsigned*)(F.ctl + CW_BAR), F.MISC + 8);
    const int lo = args.ph_lo, hi = args.ph_hi;
#ifdef PROBE_TIMING
    unsigned long long ts[11];
#define STAMP(k) ts[k] = rt();
#else
#define STAMP(k)
#endif
    STAMP(0)
#define IN(k) (lo <= (k) && (k) < hi)
#define BOTH(k) (IN(k) && IN((k) + 1))
#define GRID_BAR() xcd_barrier(bar)


#ifdef PROBE_LAST
#define PROBE_AFTER(k) if ((k) == PROBE_LAST) { probe_digest(F, bar); return; }
#else
#define PROBE_AFTER(k)
#endif
    if (IN(0)) { p0_prologue(F); if (BOTH(0)) GRID_BAR(); }
    PROBE_AFTER(0)
    STAMP(1)
    if (IN(1)) {
        pg8::Gemm g{(const pg8::bf16_t*)(F.ws + WS_XB), (const pg8::bf16_t*)(F.ws + WS_WIN), MALL, NIN, D}; pg8::StaticOrder S; S.init(MALL, NIN, F.G, (int)blockIdx.x);
        pg8::EpiInProj E{(pg8::bf16_t*)(F.ws + WS_HB), F.out};
        pg8::gemm_phase<pg8::EpiInProj, pg8::StaticOrder, true, true>(F.lds + RING_OFF, g, S, E);
        if (BOTH(1)) GRID_BAR();
    }
    PROBE_AFTER(1)
    STAMP(2)

    if (IN(2)) { p2_phase(F); if (BOTH(2)) GRID_BAR(); }
    PROBE_AFTER(2)
    STAMP(3)
    if (IN(3)) { p3_phase(F); if (BOTH(3)) GRID_BAR(); }
    PROBE_AFTER(3)
    STAMP(4)
    if (IN(4)) {
        { pg8::Gemm g{(const pg8::bf16_t*)(F.ws + WS_OA), (const pg8::bf16_t*)(F.ws + WS_WA), MP, D, 512}; pg8::StaticOrder S; S.init(MP, D, F.G, (int)blockIdx.x);
          pg8::EpiGateA E{(const pg8::bf16_t*)(F.ws + WS_HB), (float*)(F.ws + WS_TB)};
          pg8::gemm_phase<pg8::EpiGateA, pg8::StaticOrder, true, true>(F.lds + RING_OFF, g, S, E); }
        { pg8::Gemm g{(const pg8::bf16_t*)(F.ws + WS_OB), (const pg8::bf16_t*)(F.ws + WS_WB), MP, D, 512}; pg8::StaticOrder S; S.init(MP, D, F.G, (int)blockIdx.x);
          pg8::EpiGateB E{(const pg8::bf16_t*)(F.ws + WS_HB), (const float*)(F.ws + WS_TB), (pg8::bf16_t*)(F.ws + WS_MG)};
          pg8::gemm_phase<pg8::EpiGateB, pg8::StaticOrder, true, true>(F.lds + RING_OFF, g, S, E); }
        sample_merge_tasks(F);
        if (BOTH(4)) GRID_BAR();
    }
    PROBE_AFTER(4)
    STAMP(5)
    if (IN(5)) {
        pg8::Gemm g{(const pg8::bf16_t*)(F.ws + WS_MG), (const pg8::bf16_t*)(F.ws + WS_WO), MP, D, D}; pg8::StaticOrder S; S.init(MP, D, F.G, (int)blockIdx.x);
        pg8::EpiResid E{F.in[0], F.in[1], (float*)(F.ws + WS_Z1)};
        pg8::gemm_phase<pg8::EpiResid, pg8::StaticOrder, true, true>(F.lds + RING_OFF, g, S, E);
        sample_wout_tasks(F);
        if (BOTH(5)) GRID_BAR();
    }
    PROBE_AFTER(5)
    STAMP(6)
    if (IN(6)) { ln_phase(F, (const float*)(F.ws + WS_Z1), F.in[15], F.in[16], 0); if (BOTH(6)) GRID_BAR(); }
    PROBE_AFTER(6)
    STAMP(7)
    if (IN(7)) {
        pg8::Gemm g{(const pg8::bf16_t*)(F.ws + WS_X1B), (const pg8::bf16_t*)(F.ws + WS_WUP), MP, FF, D}; pg8::StaticOrder S; S.init(MP, FF, F.G, (int)blockIdx.x);
        pg8::EpiRelu2 E{(pg8::bf16_t*)(F.ws + WS_UB)};
        pg8::gemm_phase<pg8::EpiRelu2, pg8::StaticOrder, true, true>(F.lds + RING_OFF, g, S, E);
        sample_up_tasks(F);
        if (BOTH(7)) GRID_BAR();
    }
    PROBE_AFTER(7)
    STAMP(8)
    if (IN(8)) {
        pg8::Gemm g{(const pg8::bf16_t*)(F.ws + WS_UB), (const pg8::bf16_t*)(F.ws + WS_WDN), MP, D, FF}; pg8::StaticOrder S; S.init(MP, D, F.G, (int)blockIdx.x);
        pg8::EpiResid E{(const float*)(F.ws + WS_X1F), (const float*)(F.ws + WS_X1F) + (size_t)MP * D, (float*)(F.ws + WS_Z2)};
        pg8::gemm_phase<pg8::EpiResid, pg8::StaticOrder, true, true>(F.lds + RING_OFF, g, S, E);
        sample_down_tasks(F);
        if (BOTH(8)) GRID_BAR();
    }
    PROBE_AFTER(8)
    STAMP(9)
    if (IN(9)) { ln_phase(F, (const float*)(F.ws + WS_Z2), F.in[19], F.in[20], 1); }
#ifdef PROBE_TIMING
    GRID_BAR();
    STAMP(10)
    { const size_t i0 = (size_t)blockIdx.x * 512 + F.tid, st = (size_t)F.G * 512; for (size_t i = i0; i < OUT_TOTAL; i += st) ((unsigned*)F.out)[i] = 0xAAAAAAABu; }
    GRID_BAR();
    if (blockIdx.x == 0) {
        const size_t offs[10] = {OFF0, OFF1, OFF2, OFF3, OFF4, OFF5, OFF6, OFF7, OFF8, OFF9};
#pragma unroll
        for (int k = 0; k < 10; ++k) { const unsigned n = (unsigned)((ts[k + 1] - ts[k]) / 10ull); for (unsigned i = F.tid; i < n; i += 512) ((unsigned*)F.out)[offs[k] + i] = 0xAAAAAAAAu; }
    }
#endif
#ifdef PROBE_SANITIZE
    GRID_BAR();
    { const size_t i0 = (size_t)blockIdx.x * 512 + F.tid, st = (size_t)F.G * 512;
      for (size_t i = i0; i < OUT_TOTAL; i += st) { const float v = F.out[i]; if (!(v - v == 0.f)) F.out[i] = 0.f; } }
#endif
#undef IN
#undef BOTH
}

extern "C" void kernel_launch(void* const* d_in, const int* in_sizes, int n_in, void* d_out, int out_size, void* d_ws, size_t ws_size, hipStream_t stream) {
    static int grid = 0;
    if (grid == 0) {
        if (n_in != 21 || (size_t)out_size != OUT_TOTAL || ws_size < WS_END) { fprintf(stderr, "kernel_launch: unexpected shapes: n_in %d out %d ws %zu (need %zu)\n", n_in, out_size, ws_size, (size_t)WS_END); grid = -1; return; }
        int dev = 0, cus = 0, per_cu = 0;
        if (hipGetDevice(&dev) != hipSuccess || hipDeviceGetAttribute(&cus, hipDeviceAttributeMultiprocessorCount, dev) != hipSuccess) { grid = -1; return; }
        if (hipFuncSetAttribute((const void*)nsa_fwd, hipFuncAttributeMaxDynamicSharedMemorySize, LDS_BYTES) != hipSuccess) { fprintf(stderr, "kernel_launch: hipFuncSetAttribute failed\n"); grid = -1; return; }
        if (hipOccupancyMaxActiveBlocksPerMultiprocessor(&per_cu, (const void*)nsa_fwd, NWAVES * 64, LDS_BYTES) != hipSuccess || per_cu < 1) { fprintf(stderr, "kernel_launch: occupancy query says %d\n", per_cu); }
        (void)hipGetLastError();
        grid = cus;
    }
    if (grid < 0) return;
    if (hipMemsetAsync((char*)d_ws + WS_CTL, 0, CTL_ZERO_BYTES, stream) != hipSuccess) return;
    Args a{};
    for (int i = 0; i < 21; ++i) a.in[i] = (const float*)d_in[i];
    a.out = (float*)d_out; a.ws = (unsigned char*)d_ws; a.ph_lo = 0; a.ph_hi = 100;
    hipLaunchKernelGGL(nsa_fwd, dim3(grid), dim3(NWAVES * 64), LDS_BYTES, stream, a);
}
```

```cpp
#include <hip/hip_runtime.h>
#include <cstdio>
#include <cstdint>
namespace pg8 {
#define PG8_LAS __attribute__((address_space(3)))
typedef unsigned short bf16_t;
typedef short bf16x8 __attribute__((ext_vector_type(8)));
typedef float f32x4 __attribute__((ext_vector_type(4)));
typedef unsigned u32x4 __attribute__((ext_vector_type(4)));
constexpr int BM = 256, BK = 64, HALF = 128, HTB = HALF * BK * 2  , STAGE_BYTES = 8 * HTB, NXCD = 8, WGM = 8;

__host__ __device__ __forceinline__ int lds_byte(int r, int c) { const int st = (r >> 4) * 2 + (c >> 5), rr = r & 15, cc = c & 31, ob = rr * 64 + cc * 2; return st * 1024 + (ob ^ (((ob >> 9) & 1) << 5)); }
__host__ __device__ __forceinline__ void stage_rc(int b, int& R, int& C) { const int st = b / 1024, sb = b % 1024, swz = sb ^ (((sb >> 9) & 1) << 5); R = (st >> 1) * 16 + swz / 64; C = (st & 1) * 32 + (swz % 64) / 2; }
__host__ __device__ __forceinline__ int perm32(int rho) { const int n = rho >> 4, i = rho & 15; return 8 * (i >> 2) + 4 * n + (i & 3); }

struct Unit { int pm, pn; };
struct Gemm { const bf16_t* A; const bf16_t* Bt; int M, N, K; };

struct StaticOrder {
    int nM, nN, nwg, G, c;
    __host__ __device__ void init(int M, int N, int G_, int c_) { nM = M / BM; nN = N / BM; nwg = nM * nN; G = G_; c = c_; }
    __host__ __device__ bool next(int i, Unit& u) const {
        const long L = (long)i * G + c; if (L >= nwg) return false;
        int wgid = (int)L; { const int q = nwg / NXCD, r = nwg % NXCD, xcd = wgid % NXCD, off = wgid / NXCD; wgid = (xcd < r ? xcd * (q + 1) : r * (q + 1) + (xcd - r) * q) + off; }
        const int nig = WGM * nN, gid = wgid / nig, fm = gid * WGM, gsz = (nM - fm) < WGM ? (nM - fm) : WGM;
        u.pm = fm + ((wgid % nig) % gsz); u.pn = (wgid % nig) / gsz; return true;
    }
    __device__ __forceinline__ void a_ready(const Unit&) const {}
    __device__ __forceinline__ void done(const Unit&) const {}
};

__device__ __forceinline__ unsigned cvt_pk_bf16(float lo, float hi) { unsigned r; asm volatile("v_cvt_pk_bf16_f32 %0, %1, %2" : "=v"(r) : "v"(lo), "v"(hi)); return r; }
typedef float f32x2 __attribute__((ext_vector_type(2)));
__device__ __forceinline__ f32x2 gelu_pk(f32x2 v) {
    const f32x2 av = __builtin_elementwise_abs(v), d = av * 0.2316418882f + 1.0f;
    f32x2 t; t.x = __builtin_amdgcn_rcpf(d.x); t.y = __builtin_amdgcn_rcpf(d.y);
    f32x2 q = t * 0.5307027145f + (-0.7265760135f); q = q * t + 0.7107068705f; q = q * t + (-0.142248368f); q = q * t + 0.127414796f; q = q * t;
    const f32x2 s = (v * v) * (-0.72134752044f);
    f32x2 e; e.x = __builtin_amdgcn_exp2f(s.x); e.y = __builtin_amdgcn_exp2f(s.y);
    const f32x2 m = v * (q * e), r = v - m;
    f32x2 o; o.x = v.x < 0.f ? m.x : r.x; o.y = v.y < 0.f ? m.y : r.y; return o;
}

template <int ACT  > struct EpiBf16 {
    static constexpr bool PERM = true, AFTER_DRAIN = false; static_assert(ACT == 0 || ACT == 1, "EpiBf16: ACT is 0 (none) or 1 (gelu_pk)");
    bf16_t* O; int ldc; const float* bias; int split_cols; size_t split_stride; float scale0;
    __device__ __forceinline__ void operator()(const f32x4 (&acc)[2][2][4][2], const Unit& u, int wr, int wc, int fr, int fq) const {
        const int row0 = u.pm * BM + wr * 64 + fr; int colt = u.pn * BM; bf16_t* base = O;
        float sc = 1.f; if (split_cols) { const int t = colt / split_cols; base += (size_t)t * split_stride; colt -= t * split_cols; if (t == 0) sc = scale0; }
        const int col0 = colt + wc * 32 + 8 * fq, bcol0 = u.pn * BM + wc * 32 + 8 * fq;
        f32x4 bv[2][2];
#pragma unroll
        for (int bj = 0; bj < 2; ++bj)
#pragma unroll
            for (int n = 0; n < 2; ++n) bv[bj][n] = bias ? *(const f32x4*)(bias + bcol0 + bj * HALF + 4 * n) : (f32x4){0.f, 0.f, 0.f, 0.f};
#pragma unroll
        for (int ai = 0; ai < 2; ++ai)
#pragma unroll
            for (int m = 0; m < 4; ++m) { bf16_t* rowp = base + (size_t)(row0 + ai * HALF + m * 16) * ldc + col0;
#pragma unroll
                for (int bj = 0; bj < 2; ++bj) { f32x4 v0 = acc[ai][bj][m][0] + bv[bj][0], v1 = acc[ai][bj][m][1] + bv[bj][1];
                    if (ACT == 1) { f32x2 a = gelu_pk((f32x2){v0[0], v0[1]}), b = gelu_pk((f32x2){v0[2], v0[3]}), c = gelu_pk((f32x2){v1[0], v1[1]}), d = gelu_pk((f32x2){v1[2], v1[3]});
                        v0 = (f32x4){a.x, a.y, b.x, b.y}; v1 = (f32x4){c.x, c.y, d.x, d.y}; }
                    v0 = v0 * sc; v1 = v1 * sc; u32x4 w; w.x = cvt_pk_bf16(v0[0], v0[1]); w.y = cvt_pk_bf16(v0[2], v0[3]); w.z = cvt_pk_bf16(v1[0], v1[1]); w.w = cvt_pk_bf16(v1[2], v1[3]);
                    *(u32x4*)(rowp + bj * HALF) = w; } }
    }
};

struct PanelStats {
    unsigned* xbuf;
    unsigned* cnt;
    unsigned* tmo;
    int ntn; float eps;
    unsigned code;
    __device__ __forceinline__ bool run(const f32x4 (&v)[2][2][4][2], const Unit& u, int wr, int wc, int fr, int fq, PG8_LAS unsigned char* lds, int wid, int lane) const {
        typedef float f32x2v __attribute__((ext_vector_type(2)));
        PG8_LAS f32x2v* P = (PG8_LAS f32x2v*)lds;
        PG8_LAS f32x2v* S = (PG8_LAS f32x2v*)(lds + 8192);
        PG8_LAS unsigned* flag = (PG8_LAS unsigned*)(lds + 8192 + 2048);
#pragma unroll
        for (int ai = 0; ai < 2; ++ai)
#pragma unroll
            for (int m = 0; m < 4; ++m) {
                float s = 0.f;
#pragma unroll
                for (int bj = 0; bj < 2; ++bj)
#pragma unroll
                    for (int n = 0; n < 2; ++n) { const f32x4 x = v[ai][bj][m][n]; s += (x[0] + x[1]) + (x[2] + x[3]); }
                s += __shfl_xor(s, 16); s += __shfl_xor(s, 32);
                const float mw = s * (1.0f / 64.0f); float q = 0.f;
#pragma unroll
                for (int bj = 0; bj < 2; ++bj)
#pragma unroll
                    for (int n = 0; n < 2; ++n) { const f32x4 d = v[ai][bj][m][n] - mw; q += (d[0] * d[0] + d[1] * d[1]) + (d[2] * d[2] + d[3] * d[3]); }
                q += __shfl_xor(q, 16); q += __shfl_xor(q, 32);
                if (fq == 0) P[(ai * HALF + wr * 64 + m * 16 + fr) * 4 + wc] = (f32x2v){mw, q};
            }
        asm volatile("s_waitcnt lgkmcnt(0)" ::: "memory"); __builtin_amdgcn_s_barrier(); asm volatile("" ::: "memory");
#if defined(BROKEN_EXCHANGE_NO_WAIT)
#warning BROKEN CONTROL BUILD: the row-statistics exchange does not wait; results are wrong by design
        if (blockIdx.x >= 64) { const long long t0_ = clock64(); while (clock64() - t0_ < 60000) __builtin_amdgcn_s_sleep(8); }
#endif
        const int row = wid * 32 + (lane & 31);
        if (lane < 32) {
            const f32x2v a = P[row * 4 + 0], b = P[row * 4 + 1], c = P[row * 4 + 2], d = P[row * 4 + 3];
            const float mt = (a.x + b.x + c.x + d.x) * 0.25f;
            const float da = a.x - mt, db = b.x - mt, dc = c.x - mt, dd = d.x - mt;
            const float m2 = (a.y + b.y) + (c.y + d.y) + 64.0f * ((da * da + db * db) + (dc * dc + dd * dd));
            unsigned long long* slot = (unsigned long long*)xbuf + ((size_t)(u.pm * BM + row) * 4 + u.pn);
            __hip_atomic_store(slot, ((unsigned long long)__float_as_uint(m2) << 32) | __float_as_uint(mt), __ATOMIC_RELAXED, __HIP_MEMORY_SCOPE_AGENT);
        }
        asm volatile("s_waitcnt vmcnt(0)" ::: "memory");
        if (lane == 0) __hip_atomic_fetch_add(cnt + 64 * u.pm, 1u, __ATOMIC_RELAXED, __HIP_MEMORY_SCOPE_AGENT);
        if (wid == 0) {
            bool dead = false; const unsigned long long t0 = __builtin_amdgcn_s_memrealtime(); const unsigned want = 8u * (unsigned)ntn;
            for (;;) {
#if defined(BROKEN_EXCHANGE_NO_WAIT)
                break;
#endif
                if ((unsigned)__builtin_amdgcn_readfirstlane(__hip_atomic_load(cnt + 64 * u.pm, __ATOMIC_RELAXED, __HIP_MEMORY_SCOPE_AGENT)) >= want) break;
                if (__builtin_amdgcn_s_memrealtime() - t0 > 2000000ull) {
                    if (lane == 0) { unsigned expect = 0u; __hip_atomic_compare_exchange_strong(tmo + 1, &expect, code | (unsigned)(u.pm & 0xff), __ATOMIC_RELAXED, __ATOMIC_RELAXED, __HIP_MEMORY_SCOPE_AGENT);
                                     __hip_atomic_store(tmo, 1u, __ATOMIC_RELAXED, __HIP_MEMORY_SCOPE_AGENT); }
                    dead = true; break; }
                __builtin_amdgcn_s_sleep(2);
            }
            __builtin_amdgcn_fence(__ATOMIC_ACQUIRE, "agent");
            if (lane == 0) flag[0] = dead ? 1u : 0u;
        }
        asm volatile("s_waitcnt vmcnt(0) lgkmcnt(0)" ::: "memory"); __builtin_amdgcn_s_barrier(); asm volatile("" ::: "memory");
        const bool bad = flag[0] != 0u;
        if (lane < 32) {
            const unsigned long long* slot = (const unsigned long long*)xbuf + (size_t)(u.pm * BM + row) * 4; float mt[4], m2[4]; float ms = 0.f;
#pragma unroll
            for (int t = 0; t < 4; ++t) { if (t < ntn) { const unsigned long long w = __hip_atomic_load(slot + t, __ATOMIC_RELAXED, __HIP_MEMORY_SCOPE_AGENT); mt[t] = __uint_as_float((unsigned)w); m2[t] = __uint_as_float((unsigned)(w >> 32)); } else { mt[t] = 0.f; m2[t] = 0.f; } ms += mt[t]; }
            const float mean = ms / (float)ntn; float q = 0.f;
#pragma unroll
            for (int t = 0; t < 4; ++t) if (t < ntn) { const float dm = mt[t] - mean; q += m2[t] + 256.0f * dm * dm; }
            S[row] = (f32x2v){mean, 1.0f / sqrtf(q / (256.0f * (float)ntn) + eps)};
        }
        asm volatile("s_waitcnt lgkmcnt(0)" ::: "memory"); __builtin_amdgcn_s_barrier(); asm volatile("" ::: "memory");
        return bad;
    }
};
struct EpiLnRes {
    static constexpr bool PERM = false, AFTER_DRAIN = true;
    const float* base; float* out; int ldc; const float* bias; PanelStats st; unsigned poison;
    __device__ __forceinline__ void fused(f32x4 (&acc)[2][2][4][2], const Unit& u, int wr, int wc, int fr, int fq, PG8_LAS unsigned char* lds, int wid, int lane) const {
        typedef float f32x2v __attribute__((ext_vector_type(2)));
        const PG8_LAS f32x2v* S = (const PG8_LAS f32x2v*)(lds + 8192);
        const int col0 = u.pn * BM + wc * 32 + 4 * fq;
#pragma unroll
        for (int bj = 0; bj < 2; ++bj)
#pragma unroll
            for (int n = 0; n < 2; ++n) { const f32x4 bv = bias ? *(const f32x4*)(bias + col0 + bj * HALF + n * 16) : (f32x4){0.f, 0.f, 0.f, 0.f};
#pragma unroll
                for (int ai = 0; ai < 2; ++ai)
#pragma unroll
                    for (int m = 0; m < 4; ++m) acc[ai][bj][m][n] += bv; }
        f32x4 pre[4][2][2];
#pragma unroll
        for (int m = 0; m < 4; ++m) { const size_t off = (size_t)(u.pm * BM + wr * 64 + m * 16 + fr) * ldc + col0;
#pragma unroll
            for (int bj = 0; bj < 2; ++bj)
#pragma unroll
                for (int n = 0; n < 2; ++n) pre[m][bj][n] = *(const f32x4*)(base + off + bj * HALF + n * 16); }
        const bool bad = st.run(acc, u, wr, wc, fr, fq, lds, wid, lane) || poison != 0u;
        const float qnan = __builtin_nanf("");
#pragma unroll
        for (int ai = 0; ai < 2; ++ai)
#pragma unroll
            for (int m = 0; m < 4; ++m) { const int r = ai * HALF + wr * 64 + m * 16 + fr; const f32x2v sr = S[r]; const size_t off = (size_t)(u.pm * BM + r) * ldc + col0;
#pragma unroll
                for (int bj = 0; bj < 2; ++bj)
#pragma unroll
                    for (int n = 0; n < 2; ++n) { const f32x4 bs = ai == 0 ? pre[m][bj][n] : *(const f32x4*)(base + off + bj * HALF + n * 16); f32x4 o = bs + (acc[ai][bj][m][n] - sr.x) * sr.y;
                        if (bad) o = (f32x4){qnan, qnan, qnan, qnan}; *(f32x4*)(out + off + bj * HALF + n * 16) = o; }
                if (m & 1) asm volatile("" ::: "memory"); }
    }
};
struct EpiLnResLn {
    static constexpr bool PERM = false, AFTER_DRAIN = true;
    const float* base; float* out; bf16_t* xn; int ldc; const float* bias; PanelStats st1, st2; unsigned poison;
    __device__ __forceinline__ void fused(f32x4 (&acc)[2][2][4][2], const Unit& u, int wr, int wc, int fr, int fq, PG8_LAS unsigned char* lds, int wid, int lane) const {
        typedef float f32x2v __attribute__((ext_vector_type(2))); typedef unsigned u32x2v __attribute__((ext_vector_type(2)));
        const PG8_LAS f32x2v* S = (const PG8_LAS f32x2v*)(lds + 8192);
        const int col0 = u.pn * BM + wc * 32 + 4 * fq;
#pragma unroll
        for (int bj = 0; bj < 2; ++bj)
#pragma unroll
            for (int n = 0; n < 2; ++n) { const f32x4 bv = bias ? *(const f32x4*)(bias + col0 + bj * HALF + n * 16) : (f32x4){0.f, 0.f, 0.f, 0.f};
#pragma unroll
                for (int ai = 0; ai < 2; ++ai)
#pragma unroll
                    for (int m = 0; m < 4; ++m) acc[ai][bj][m][n] += bv; }
        bool bad = st1.run(acc, u, wr, wc, fr, fq, lds, wid, lane) || poison != 0u;
        const float qnan = __builtin_nanf("");
#pragma unroll
        for (int ai = 0; ai < 2; ++ai)
#pragma unroll
            for (int m = 0; m < 4; ++m) { const int r = ai * HALF + wr * 64 + m * 16 + fr; const f32x2v sr = S[r]; const size_t off = (size_t)(u.pm * BM + r) * ldc + col0;
#pragma unroll
                for (int bj = 0; bj < 2; ++bj)
#pragma unroll
                    for (int n = 0; n < 2; ++n) { const f32x4 bs = *(const f32x4*)(base + off + bj * HALF + n * 16); acc[ai][bj][m][n] = bs + (acc[ai][bj][m][n] - sr.x) * sr.y; }
                asm volatile("" : "+v"(acc[ai][0][m][0]), "+v"(acc[ai][0][m][1]), "+v"(acc[ai][1][m][0]), "+v"(acc[ai][1][m][1]));
                if (m & 1) asm volatile("" ::: "memory"); }
        const bool bad1 = bad;
        bad = st2.run(acc, u, wr, wc, fr, fq, lds, wid, lane) || bad;
#pragma unroll
        for (int ai = 0; ai < 2; ++ai)
#pragma unroll
            for (int m = 0; m < 4; ++m) { const int r = ai * HALF + wr * 64 + m * 16 + fr; const f32x2v sr = S[r]; const size_t off = (size_t)(u.pm * BM + r) * ldc + col0;
#pragma unroll
                for (int bj = 0; bj < 2; ++bj)
#pragma unroll
                    for (int n = 0; n < 2; ++n) { const f32x4 x1 = acc[ai][bj][m][n]; *(f32x4*)(out + off + bj * HALF + n * 16) = bad1 ? (f32x4){qnan, qnan, qnan, qnan} : x1;
                        const f32x4 o = (x1 - sr.x) * sr.y; u32x2v w; w.x = cvt_pk_bf16(o[0], o[1]); w.y = cvt_pk_bf16(o[2], o[3]);
                        if (bad) { w.x = 0x7fc07fc0u; w.y = 0x7fc07fc0u; } *(u32x2v*)(xn + off + bj * HALF + n * 16) = w; }
                asm volatile("" ::: "memory"); }
    }
};

template <class Epi, class Sched, bool ALIGN_EPI = false, bool SP2 = false>
__device__ __forceinline__ void gemm_phase(PG8_LAS unsigned char* lds, const Gemm g, const Sched& S, const Epi& E) {
    const int tid = threadIdx.x, wid = __builtin_amdgcn_readfirstlane(tid >> 6), lane = tid & 63, wr = wid >> 2, wc = wid & 3, fr = lane & 15, fq = lane >> 4;
    const int K = g.K, nt = K / BK;
    unsigned voffA[2], voffB[2];
#pragma unroll
    for (int i = 0; i < 2; ++i) { int R, C; stage_rc(tid * 16 + i * 8192, R, C); const int Rb = Epi::PERM ? ((R & ~31) + perm32(R & 31)) : R;
        voffA[i] = (unsigned)(R * K + C) * 2u; voffB[i] = (unsigned)(Rb * K + C) * 2u; }
    const size_t kstep = (size_t)(BK * 2);
    const size_t hstep = (size_t)HALF * K * 2;
    const size_t tstep = 2 * hstep;
    const unsigned ldsw = (unsigned)wid * 1024u;
    const int aoff = lds_byte(wr * 64 + fr, fq * 8), boff = lds_byte(wc * 32 + fr, fq * 8);
#define PG8_SA(b, h) (((b) * 2 + (h)) * HTB)
#define PG8_SB(b, h) ((4 + (b) * 2 + (h)) * HTB)
#define PG8_STAGE(bufoff, gbase, voff) do { _Pragma("unroll") for (int _i = 0; _i < 2; ++_i) \
        __builtin_amdgcn_global_load_lds((const unsigned*)((const char*)(gbase) + (voff)[_i]), (PG8_LAS unsigned*)(lds + (bufoff) + ldsw + _i * 8192), 16, 0, 0); } while (0)
#define PG8_LDA(dst, b, h) do { _Pragma("unroll") for (int m = 0; m < 4; ++m) _Pragma("unroll") for (int k = 0; k < 2; ++k) dst[m][k] = *(const PG8_LAS bf16x8*)(lds + PG8_SA(b, h) + aoff + m * 2048 + k * 1024); } while (0)
#define PG8_LDB(dst, b, h) do { _Pragma("unroll") for (int n = 0; n < 2; ++n) _Pragma("unroll") for (int k = 0; k < 2; ++k) dst[n][k] = *(const PG8_LAS bf16x8*)(lds + PG8_SB(b, h) + boff + n * 2048 + k * 1024); } while (0)
#define PG8_MMA(ai, bj, At, Bt) do { __builtin_amdgcn_s_setprio(1); _Pragma("unroll") for (int m = 0; m < 4; ++m) _Pragma("unroll") for (int n = 0; n < 2; ++n) _Pragma("unroll") for (int k = 0; k < 2; ++k) \
        acc[ai][bj][m][n] = __builtin_amdgcn_mfma_f32_16x16x32_bf16(Bt[n][k], At[m][k], acc[ai][bj][m][n], 0, 0, 0); __builtin_amdgcn_s_setprio(0); } while (0)
#define PG8_WAIT_V(n) asm volatile("s_waitcnt vmcnt(" #n ")" ::: "memory")
#define PG8_WAIT_L(n) asm volatile("s_waitcnt lgkmcnt(" #n ")" ::: "memory")
#define PG8_BAR __builtin_amdgcn_s_barrier()
#define PG8_SCHED __builtin_amdgcn_sched_barrier(0)
    Unit cur, nxt; int ui = 0;
    if (!S.next(0, cur)) return;
    f32x4 acc[2][2][4][2];
#pragma unroll
    for (int a = 0; a < 2; ++a)
#pragma unroll
        for (int b = 0; b < 2; ++b)
#pragma unroll
            for (int m = 0; m < 4; ++m)
#pragma unroll
                for (int n = 0; n < 2; ++n) acc[a][b][m][n] = (f32x4){0.f, 0.f, 0.f, 0.f};
    bf16x8 At[4][2], B0[2][2], B1[2][2];
    const char* cA = (const char*)g.A + (size_t)cur.pm * tstep; const char* cB = (const char*)g.Bt + (size_t)cur.pn * tstep;
    S.a_ready(cur);
    if constexpr (SP2) {
        PG8_STAGE(PG8_SB(0, 0), cB, voffB); PG8_STAGE(PG8_SB(0, 1), cB + hstep, voffB); PG8_STAGE(PG8_SA(0, 0), cA, voffA); PG8_STAGE(PG8_SA(0, 1), cA + hstep, voffA);
        if (wr == 1) PG8_BAR;
        PG8_WAIT_V(2); PG8_BAR;
        PG8_STAGE(PG8_SB(1, 0), cB + kstep, voffB); PG8_STAGE(PG8_SA(1, 0), cA + kstep, voffA); PG8_STAGE(PG8_SB(1, 1), cB + hstep + kstep, voffB);
        PG8_WAIT_V(6); PG8_BAR;
    } else {
        PG8_STAGE(PG8_SB(0, 0), cB, voffB); PG8_STAGE(PG8_SA(0, 0), cA, voffA); PG8_STAGE(PG8_SB(0, 1), cB + hstep, voffB); PG8_STAGE(PG8_SA(0, 1), cA + hstep, voffA);
        if (wr == 1) PG8_BAR;
        PG8_WAIT_V(4); PG8_BAR;
        PG8_STAGE(PG8_SB(1, 0), cB + kstep, voffB); PG8_STAGE(PG8_SA(1, 0), cA + kstep, voffA); PG8_STAGE(PG8_SB(1, 1), cB + hstep + kstep, voffB);
        PG8_WAIT_V(6); PG8_BAR;
    }
    for (;;) {
        const bool has_next = S.next(ui + 1, nxt);
        const char* nA = has_next ? (const char*)g.A + (size_t)nxt.pm * tstep : cA; const char* nB = has_next ? (const char*)g.Bt + (size_t)nxt.pn * tstep : cB;
        for (int t = 0; t < nt; t += 2) {
            const bool last = (t == nt - 2);
            const char* a1 = cA + (size_t)(t + 1) * kstep;
            const char* a2 = last ? nA : cA + (size_t)(t + 2) * kstep; const char* b2 = last ? nB : cB + (size_t)(t + 2) * kstep;
            const char* a3 = a2 + kstep; const char* b3 = b2 + kstep;
            if (last && has_next) S.a_ready(nxt);
            if constexpr (SP2) {
            PG8_LDB(B0, 0, 0); PG8_LDB(B1, 0, 1); PG8_SCHED; PG8_LDA(At, 0, 0); PG8_STAGE(PG8_SA(1, 1), a1 + hstep, voffA);
            PG8_WAIT_V(8); PG8_WAIT_L(0); PG8_BAR; PG8_MMA(0, 0, At, B0); PG8_MMA(0, 1, At, B1); PG8_BAR; PG8_SCHED;
            PG8_LDA(At, 0, 1); PG8_STAGE(PG8_SB(0, 0), b2, voffB); PG8_STAGE(PG8_SB(0, 1), b2 + hstep, voffB); PG8_STAGE(PG8_SA(0, 0), a2, voffA);
            PG8_WAIT_V(8); PG8_WAIT_L(0); PG8_BAR; PG8_MMA(1, 0, At, B0); PG8_MMA(1, 1, At, B1); PG8_BAR; PG8_SCHED;
            PG8_LDB(B0, 1, 0); PG8_LDB(B1, 1, 1); PG8_SCHED; PG8_LDA(At, 1, 0); PG8_STAGE(PG8_SA(0, 1), a2 + hstep, voffA);
            PG8_WAIT_V(8); PG8_WAIT_L(0); PG8_BAR; PG8_MMA(0, 0, At, B0); PG8_MMA(0, 1, At, B1); PG8_BAR; PG8_SCHED;
            PG8_LDA(At, 1, 1); PG8_STAGE(PG8_SB(1, 0), b3, voffB); PG8_STAGE(PG8_SB(1, 1), b3 + hstep, voffB); PG8_STAGE(PG8_SA(1, 0), a3, voffA);
            PG8_WAIT_V(8); PG8_WAIT_L(0); PG8_BAR; PG8_MMA(1, 0, At, B0); PG8_MMA(1, 1, At, B1); PG8_BAR; PG8_SCHED;
            } else {
            PG8_LDB(B0, 0, 0); PG8_SCHED; PG8_LDA(At, 0, 0); PG8_STAGE(PG8_SA(1, 1), a1 + hstep, voffA);
            PG8_WAIT_L(8); PG8_BAR; PG8_WAIT_L(0); PG8_MMA(0, 0, At, B0); PG8_BAR; PG8_SCHED;
            PG8_LDB(B1, 0, 1); PG8_STAGE(PG8_SB(0, 0), b2, voffB);
            PG8_BAR; PG8_WAIT_L(0); PG8_MMA(0, 1, At, B1); PG8_BAR;
            PG8_LDA(At, 0, 1); PG8_STAGE(PG8_SA(0, 0), a2, voffA);
            PG8_BAR; PG8_WAIT_L(0); PG8_MMA(1, 0, At, B0); PG8_BAR; PG8_SCHED;
            PG8_STAGE(PG8_SB(0, 1), b2 + hstep, voffB);
            PG8_WAIT_V(6); PG8_BAR; PG8_MMA(1, 1, At, B1); PG8_BAR;
            PG8_LDB(B0, 1, 0); PG8_SCHED; PG8_LDA(At, 1, 0); PG8_STAGE(PG8_SA(0, 1), a2 + hstep, voffA);
            PG8_WAIT_L(8); PG8_BAR; PG8_WAIT_L(0); PG8_MMA(0, 0, At, B0); PG8_BAR; PG8_SCHED;
            PG8_LDB(B1, 1, 1); PG8_STAGE(PG8_SB(1, 0), b3, voffB);
            PG8_BAR; PG8_WAIT_L(0); PG8_MMA(0, 1, At, B1); PG8_BAR;
            PG8_LDA(At, 1, 1); PG8_STAGE(PG8_SA(1, 0), a3, voffA);
            PG8_BAR; PG8_WAIT_L(0); PG8_MMA(1, 0, At, B0); PG8_BAR; PG8_SCHED;
            PG8_STAGE(PG8_SB(1, 1), b3 + hstep, voffB);
            PG8_WAIT_V(6); PG8_BAR; PG8_MMA(1, 1, At, B1); PG8_BAR;
            }
        }
        if constexpr (ALIGN_EPI) { if (wr == 0) PG8_BAR; }
        if constexpr (!Epi::AFTER_DRAIN) { E(acc, cur, wr, wc, fr, fq); S.done(cur); }
        if (!has_next) break;
#pragma unroll
        for (int a = 0; a < 2; ++a)
#pragma unroll
            for (int b = 0; b < 2; ++b)
#pragma unroll
                for (int m = 0; m < 4; ++m)
#pragma unroll
                    for (int n = 0; n < 2; ++n) acc[a][b][m][n] = (f32x4){0.f, 0.f, 0.f, 0.f};
        cur = nxt; cA = nA; cB = nB; ++ui;
        if constexpr (ALIGN_EPI) { if (wr == 1) PG8_BAR; }
    }
    PG8_WAIT_V(0);
    if constexpr (!ALIGN_EPI) { if (wr == 0) PG8_BAR; }
    PG8_BAR;
    if constexpr (Epi::AFTER_DRAIN) { E.fused(acc, cur, wr, wc, fr, fq, lds, wid, lane); S.done(cur); }
#undef PG8_SA
#undef PG8_SB
#undef PG8_STAGE
#undef PG8_LDA
#undef PG8_LDB
#undef PG8_MMA
#undef PG8_WAIT_V
#undef PG8_WAIT_L
#undef PG8_BAR
#undef PG8_SCHED
}
}
#define GAS __attribute__((address_space(1)))
#define LAS __attribute__((address_space(3)))
typedef unsigned short bf16;
typedef unsigned v4u __attribute__((ext_vector_type(4)));
typedef float f32x4 __attribute__((ext_vector_type(4)));
typedef short bf16x8 __attribute__((ext_vector_type(8)));
typedef GAS unsigned gu32;
typedef GAS unsigned long long gu64;
#define RLX_AGENT __ATOMIC_RELAXED, __HIP_MEMORY_SCOPE_AGENT
#define LDS_WAIT() asm volatile("s_waitcnt lgkmcnt(0)" ::: "memory")
#define VM_WAIT() asm volatile("s_waitcnt vmcnt(0)" ::: "memory")
__device__ __forceinline__ unsigned long long rt() { return __builtin_amdgcn_s_memrealtime(); }
__device__ __forceinline__ unsigned f2bf(float f) { unsigned u = __builtin_bit_cast(unsigned, f); return (u + 0x7fffu + ((u >> 16) & 1u)) >> 16; }
__device__ __forceinline__ unsigned pk2(float lo, float hi) { return f2bf(lo) | (f2bf(hi) << 16); }

#define XB_TMO      128
#define XB_XCNT(j)  (256  + 64 * (j))
#define XB_XSUB(j)  (1280 + 64 * (j))
#define XB_XGEN(j)  (2304 + 64 * (j))
#define XB_TOP      3328
#define XB_TOPGEN   3392
#define XCD_BAR_WORDS 3456
#define XB_SPIN_CAP (1u << 18)

__device__ __forceinline__ unsigned xb_ld(unsigned* p)              { return __hip_atomic_load(p, __ATOMIC_RELAXED, __HIP_MEMORY_SCOPE_AGENT); }
__device__ __forceinline__ unsigned xb_add(unsigned* p, unsigned v) { return __hip_atomic_fetch_add(p, v, __ATOMIC_RELAXED, __HIP_MEMORY_SCOPE_AGENT); }
__device__ __forceinline__ unsigned xb_xcc_id() { return (unsigned)__builtin_amdgcn_s_getreg((3 << 11) | 20) & 0xFu; }
#define XB_SPIN(cond, bar) do { unsigned _sp = 0; while (cond) { __builtin_amdgcn_s_sleep(1); \
    if ((++_sp & 255u) == 0u) { if (xb_ld(&(bar)[XB_TMO])) break; if (_sp > XB_SPIN_CAP) { atomicAdd(&(bar)[XB_TMO], 1u); break; } } } } while (0)

struct XcdBarrier {
    unsigned* bar; unsigned x;
    volatile LAS unsigned* st;
};

__device__ __forceinline__ XcdBarrier xcd_barrier_post(unsigned* bar, volatile LAS unsigned* st) {
    XcdBarrier b; b.bar = bar; b.x = xb_xcc_id(); b.st = st;
    if (threadIdx.x == 0) (void)xb_add(&bar[XB_XCNT(b.x)], 1u);
    return b;
}
__device__ __forceinline__ void xcd_barrier_complete(unsigned* bar, unsigned x, unsigned& nloc, unsigned& nx) {
    const unsigned G = gridDim.x * gridDim.y * gridDim.z;
    unsigned sum, cnt, mine, sp = 0u;
    for (;;) {
        sum = 0u; cnt = 0u; mine = 0u;
#pragma unroll
        for (unsigned j = 0; j < 16; ++j) { const unsigned c = xb_ld(&bar[XB_XCNT(j)]); sum += c; cnt += (c > 0u) ? 1u : 0u; mine = (j == x) ? c : mine; }
        if (sum == G) break;
        __builtin_amdgcn_s_sleep(1);
        if ((++sp & 255u) == 0u) { if (xb_ld(&bar[XB_TMO])) break; if (sp > XB_SPIN_CAP) { atomicAdd(&bar[XB_TMO], 1u); break; } }
    }
    nloc = mine > 0u ? mine : 1u; nx = cnt > 0u ? cnt : 1u;
}

__device__ __forceinline__ void xcd_barrier(const XcdBarrier& b) {
    asm volatile("s_waitcnt vmcnt(0)" ::: "memory");
    __syncthreads();
    if (threadIdx.x == 0) {
        unsigned* bar = b.bar;
        __builtin_amdgcn_s_waitcnt(0);
        unsigned nloc = b.st[0], nx = b.st[1];
        if (nloc == 0u) { xcd_barrier_complete(bar, b.x, nloc, nx); b.st[0] = nloc; b.st[1] = nx; }
        const unsigned old = xb_add(&bar[XB_XSUB(b.x)], 1u);
        const unsigned gen = old / nloc;
        if (old + 1u == (gen + 1u) * nloc) {
            __builtin_amdgcn_fence(__ATOMIC_RELEASE, "agent");
            asm volatile("s_waitcnt vmcnt(0)" ::: "memory");
            const unsigned og = xb_add(&bar[XB_TOP], 1u);
            const unsigned tg = og / nx;
            if (og + 1u == (tg + 1u) * nx) xb_add(&bar[XB_TOPGEN], 1u);
            else XB_SPIN(xb_ld(&bar[XB_TOPGEN]) == tg, bar);
            __builtin_amdgcn_fence(__ATOMIC_ACQUIRE, "agent");
            xb_add(&bar[XB_XGEN(b.x)], 1u);
            asm volatile("s_waitcnt vmcnt(0)" ::: "memory");
        } else {
            XB_SPIN(xb_ld(&bar[XB_XGEN(b.x)]) == gen, bar);
            __builtin_amdgcn_fence(__ATOMIC_ACQUIRE, "agent");
            asm volatile("s_waitcnt vmcnt(0)" ::: "memory");
        }
    }
    __syncthreads();
}
constexpr int NWAVES = 8;
constexpr int T = 8192, NBATCH = 2, MP = NBATCH * T, MS = 32, MALL = 16640, D = 1024, NIN = 6656, FF = 4096;
constexpr int C_QA = 0, C_KVC = 512, C_KVS = 768, C_KVW = 1024, C_QB = 1280, C_FB = 2304, C_IB = 3328, C_GB = 3840, C_MG = 4352, C_GLA = 6400;
constexpr int PAST = 16384, NPAGES = 128, NCMP_S = 1023, NCMP_P = 511;
constexpr float LN_EPS = 1e-5f;
constexpr float DN_ALPHA = 1.189207115002721f;
constexpr size_t OFF0 = 0, OFF1 = OFF0 + (size_t)MP * D, OFF2 = OFF1 + (size_t)MS * D, OFF3 = OFF2 + (size_t)MP * 256, OFF4 = OFF3 + (size_t)MP * 256,
                 OFF5 = OFF4 + (size_t)NBATCH * 512 * 256, OFF6 = OFF5 + (size_t)NBATCH * 8 * 128 * 64, OFF7 = OFF6 + (size_t)MS * 256, OFF8 = OFF7 + (size_t)MS * 256,
                 OFF9 = OFF8 + (size_t)MS * 512 * 256, OUT_TOTAL = OFF9 + (size_t)MS * 8 * 128 * 64;
constexpr size_t MiB = 1u << 20;
constexpr size_t al(size_t x) { return (x + MiB - 1) / MiB * MiB; }
constexpr size_t WS_CTL = 0, CTL_ZERO_BYTES = 1 * MiB;
constexpr size_t WS_WIN = 2 * MiB;
constexpr size_t WS_WA = WS_WIN + al((size_t)NIN * D * 2);
constexpr size_t WS_WB = WS_WA + al((size_t)D * 512 * 2);
constexpr size_t WS_WO = WS_WB + al((size_t)D * 512 * 2);
constexpr size_t WS_WUP = WS_WO + al((size_t)D * D * 2);
constexpr size_t WS_WDN = WS_WUP + al((size_t)FF * D * 2);
constexpr size_t WS_WC = WS_WDN + al((size_t)FF * D * 2);
constexpr size_t WS_SMALL = WS_WC + al((size_t)2 * 64 * 2048 * 2);
constexpr size_t WS_XB = WS_SMALL + MiB;
constexpr size_t WS_HB = WS_XB + al((size_t)MALL * D * 2);
constexpr size_t WS_KCP = WS_HB + al((size_t)MALL * NIN * 2);
constexpr size_t WS_VCTP = WS_KCP + MiB;
constexpr size_t WS_KCVS = WS_VCTP + MiB;
constexpr size_t WS_VST = WS_KCVS + al((size_t)MS * 1024 * 256 * 4);
constexpr size_t WS_VWT = WS_VST + al((size_t)4 * 64 * T * 2);
constexpr size_t WS_OA = WS_VWT + al((size_t)4 * 64 * T * 2);
constexpr size_t WS_OB = WS_OA + al((size_t)MALL * 512 * 2);
constexpr size_t WS_HGL = WS_OB + al((size_t)MALL * 512 * 2);
constexpr size_t WS_HGD = WS_HGL + al((size_t)16 * 16 * 8192 * 4);
constexpr size_t WS_TB = WS_HGD + MiB;
constexpr size_t WS_MG = WS_TB + al((size_t)MALL * D * 4);
constexpr size_t WS_Z1 = WS_MG + al((size_t)MALL * D * 2);
constexpr size_t WS_X1F = WS_Z1 + al((size_t)MALL * D * 4);
constexpr size_t WS_X1B = WS_X1F + al((size_t)MALL * D * 4);
constexpr size_t WS_UB = WS_X1B + al((size_t)MALL * D * 2);
constexpr size_t WS_Z2 = WS_UB + al((size_t)MALL * FF * 2);
constexpr size_t WS_KSC = WS_Z2 + al((size_t)MALL * D * 4);
constexpr size_t WS_KWC = WS_KSC + al((size_t)4 * T * 64 * 2);
constexpr size_t WS_OTS = WS_KWC + al((size_t)4 * T * 64 * 2);
constexpr size_t WS_END = WS_OTS + al((size_t)256 * 32 * 512 * 4);
constexpr int CW_TMO = 0, CW_CODE = 1, CW_BAR = 4096;
constexpr int RING_OFF = 0, RING_BYTES = 131072;
constexpr int LDSCTL_OFF = RING_BYTES, MISC_OFF = LDSCTL_OFF + 320;
constexpr int LDS_BYTES = 147456;

namespace pg8 {
struct EpiInProj {
    static constexpr bool PERM = true, AFTER_DRAIN = false;
    bf16_t* HB; float* out;
    __device__ __forceinline__ void operator()(const f32x4 (&acc)[2][2][4][2], const Unit& u, int wr, int wc, int fr, int fq) const {
        const int row0 = u.pm * BM + wr * 64 + fr, cc0 = wc * 32 + 8 * fq, col0 = u.pn * BM + cc0;
#pragma unroll
        for (int ai = 0; ai < 2; ++ai)
#pragma unroll
            for (int m = 0; m < 4; ++m) {
                const int r = row0 + ai * HALF + m * 16;
                bf16_t* rowp = HB + (size_t)r * NIN + col0;
                float* fdst = nullptr;
                if (u.pn == 2) { if (r < MP) fdst = out + OFF2 + (size_t)r * 256; else if (r < MP + MS) fdst = out + OFF6 + (size_t)(r - MP) * 256; }
                else if (u.pn == 3) { if (r < MP) fdst = out + OFF3 + (size_t)r * 256; else if (r < MP + MS) fdst = out + OFF7 + (size_t)(r - MP) * 256; }
                else if (u.pn == 4) { if (r < MP) { const int t = r & (T - 1), b = r >> 13; if (t >= T - 512) fdst = out + OFF4 + (size_t)(b * 512 + t - (T - 512)) * 256; }
                                      else if (r < MP + MS) fdst = out + OFF8 + ((size_t)(r - MP) * 512 + 511) * 256; }
#pragma unroll
                for (int bj = 0; bj < 2; ++bj) { const f32x4 v0 = acc[ai][bj][m][0], v1 = acc[ai][bj][m][1];
                    u32x4 w; w.x = cvt_pk_bf16(v0[0], v0[1]); w.y = cvt_pk_bf16(v0[2], v0[3]); w.z = cvt_pk_bf16(v1[0], v1[1]); w.w = cvt_pk_bf16(v1[2], v1[3]);
                    *(u32x4*)(rowp + bj * HALF) = w;
                    if (fdst) { *(f32x4*)(fdst + cc0 + bj * HALF) = v0; *(f32x4*)(fdst + cc0 + bj * HALF + 4) = v1; } }
            }
    }
};
}

struct Frame {
    LAS unsigned char* lds;
    volatile LAS unsigned* MISC;
    gu32* ctl;
    int tid, lane, wave;
    int vcu, G;
    const float* in[21]; float* out; unsigned char* ws;
};
__device__ __forceinline__ float bf2f(unsigned short b) { return __uint_as_float(((unsigned)b) << 16); }
typedef float f32x2_t __attribute__((ext_vector_type(2))); typedef __bf16 bf16x2_t __attribute__((ext_vector_type(2)));
__device__ __forceinline__ unsigned cvtpk(float lo, float hi) { f32x2_t v = {lo, hi}; bf16x2_t b = __builtin_convertvector(v, bf16x2_t); return __builtin_bit_cast(unsigned, b); }
__device__ __forceinline__ float wave_sum(float v) {
#pragma unroll
    for (int o = 1; o < 64; o <<= 1) v += __shfl_xor(v, o);
    return v;
}
__device__ __forceinline__ float sigmoidf_(float x) { return 1.0f / (1.0f + __expf(-x)); }

__device__ __forceinline__ void p0_transpose_item(const float* W, int K, int Nsrc, bf16* WT, int k0, int n0, int s0, int nvalid, LAS float* scr, int lane) {
#pragma unroll 8
    for (int i = 0; i < 32; ++i) { const int kk = 2 * i + (lane >> 5), c = lane & 31; scr[kk * 33 + c] = (c < nvalid) ? W[(size_t)(k0 + kk) * Nsrc + s0 + c] : 0.f; }
    LDS_WAIT(); asm volatile("" ::: "memory");
    const int c = lane & 7;
#pragma unroll
    for (int j = 0; j < 4; ++j) { const int n = (lane >> 3) + 8 * j; const LAS float* s = scr + (8 * c) * 33 + n;
        v4u o; o.x = pk2(s[0 * 33], s[1 * 33]); o.y = pk2(s[2 * 33], s[3 * 33]); o.z = pk2(s[4 * 33], s[5 * 33]); o.w = pk2(s[6 * 33], s[7 * 33]);
        *(GAS v4u*)(WT + (size_t)(n0 + n) * K + k0 + 8 * c) = o; }
    LDS_WAIT(); asm volatile("" ::: "memory");
}
__device__ __forceinline__ void p0_prologue(Frame& F) {
    LAS float* scr = (LAS float*)(F.lds + RING_OFF + F.wave * 16384);
    const int gw = F.vcu * NWAVES + F.wave, NGW = F.G * NWAVES, lane = F.lane;
    bf16* WinT = (bf16*)(F.ws + WS_WIN); bf16* WaT = (bf16*)(F.ws + WS_WA); bf16* WbT = (bf16*)(F.ws + WS_WB); bf16* WoT = (bf16*)(F.ws + WS_WO);
    bf16* WupT = (bf16*)(F.ws + WS_WUP); bf16* WdnT = (bf16*)(F.ws + WS_WDN); bf16* WcT = (bf16*)(F.ws + WS_WC);
    float* small = (float*)(F.ws + WS_SMALL);
    constexpr int I_IN = (D / 64) * (NIN / 32), I_A = (512 / 64) * (D / 32), I_O = (D / 64) * (D / 32), I_UP = (D / 64) * (FF / 32), I_DN = (FF / 64) * (D / 32), I_C = 2 * (2048 / 64) * 2;
    constexpr int I_T = I_IN + 2 * I_A + I_O + I_UP + I_DN + I_C;
    constexpr int I_X = MALL;
    constexpr int I_CB = 64;
    constexpr int I_LB = 16;
    constexpr int I_W8 = MS * 511;
    constexpr int I_Z = 2 * (MALL - MP - MS);
    constexpr int NITEMS = I_T + I_X + I_CB + I_LB + I_W8 + I_Z;
    for (int it = gw; it < NITEMS; it += NGW) {
        int r = it;
        if (r < I_T) {
            if (r < I_IN) { const int nblk = NIN / 32, kb = r / nblk, nb = r % nblk, n0 = 32 * nb; int s0, nv;
                if (n0 < 1280) { s0 = n0; nv = 32; } else if (n0 < 6400) { s0 = n0 + 24; nv = 32; } else if (n0 == 6400) { s0 = 1280; nv = 24; } else { s0 = 0; nv = 0; }
                p0_transpose_item(F.in[7], D, 6424, WinT, 64 * kb, n0, s0, nv, scr, lane); continue; } r -= I_IN;
            if (r < I_A) { const int nblk = D / 32, kb = r / nblk, nb = r % nblk; p0_transpose_item(F.in[12], 512, D, WaT, 64 * kb, 32 * nb, 32 * nb, 32, scr, lane); continue; } r -= I_A;
            if (r < I_A) { const int nblk = D / 32, kb = r / nblk, nb = r % nblk; p0_transpose_item(F.in[13], 512, D, WbT, 64 * kb, 32 * nb, 32 * nb, 32, scr, lane); continue; } r -= I_A;
            if (r < I_O) { const int nblk = D / 32, kb = r / nblk, nb = r % nblk; p0_transpose_item(F.in[14], D, D, WoT, 64 * kb, 32 * nb, 32 * nb, 32, scr, lane); continue; } r -= I_O;
            if (r < I_UP) { const int nblk = FF / 32, kb = r / nblk, nb = r % nblk; p0_transpose_item(F.in[17], D, FF, WupT, 64 * kb, 32 * nb, 32 * nb, 32, scr, lane); continue; } r -= I_UP;
            if (r < I_DN) { const int nblk = D / 32, kb = r / nblk, nb = r % nblk; p0_transpose_item(F.in[18], FF, D, WdnT, 64 * kb, 32 * nb, 32 * nb, 32, scr, lane); continue; } r -= I_DN;
            { const int c = r / 64, q = r % 64, kb = q / 2, nb = q % 2;
              p0_transpose_item(F.in[8] + (size_t)c * 2048 * 64, 2048, 64, WcT + (size_t)c * 64 * 2048, 64 * kb, 32 * nb, 32 * nb, 32, scr, lane); continue; }
        }
        r -= I_T;
        if (r < I_X) {
            const float* src = r < MP ? F.in[0] + (size_t)r * D : (r < MP + MS ? F.in[1] + (size_t)(r - MP) * D : nullptr);
            bf16* dst = (bf16*)(F.ws + WS_XB) + (size_t)r * D;
#pragma unroll
            for (int j = 0; j < 4; ++j) { f32x4 v = src ? *((const GAS f32x4*)src + lane + 64 * j) : (f32x4){0.f, 0.f, 0.f, 0.f};
                *((GAS unsigned long long*)dst + lane + 64 * j) = (unsigned long long)pk2(v.x, v.y) | ((unsigned long long)pk2(v.z, v.w) << 32); }
            continue;
        }
        r -= I_X;
        if (r < I_CB) {
            const int c = r >> 5, l = r & 31; const float* pos = F.in[9] + ((size_t)c * 32 + l) * 64; const float* w = F.in[8] + (((size_t)c * 32 + l) * 64) * 64;
            float s = 0.f;
            for (int d = 0; d < 64; ++d) s += pos[d] * w[(size_t)d * 64 + lane];
            small[(c * 32 + l) * 64 + lane] = s; continue;
        }
        r -= I_CB;
        if (r < I_LB) { const int i = r * 64 + lane; const float l0 = F.in[10][i], l1 = F.in[10][1024 + i]; small[4096 + i] = 1.0f / (1.0f + expf(l1 - l0)); continue; }
        r -= I_LB;
        if (r < I_W8) { const int b = r / 511, i = r % 511;
            const GAS f32x4* s = (const GAS f32x4*)(F.in[4] + ((size_t)b * 512 + i + 1) * 256); GAS f32x4* d = (GAS f32x4*)(F.out + OFF8 + ((size_t)b * 512 + i) * 256);
            d[lane] = s[lane]; continue; }
        r -= I_W8;
        { const int half = I_Z / 2, which = r / half, row = MP + MS + r % half; bf16* o = (bf16*)(F.ws + (which ? WS_OB : WS_OA)) + (size_t)row * 512;
          *((GAS v4u*)o + lane) = (v4u){0u, 0u, 0u, 0u}; }
    }
}
typedef float f32x16 __attribute__((ext_vector_type(16)));
typedef short s16x4 __attribute__((ext_vector_type(4)));
typedef unsigned u32x2 __attribute__((ext_vector_type(2)));
#define MFMA32(a, b, c) __builtin_amdgcn_mfma_f32_32x32x16_bf16((a), (b), (c), 0, 0, 0)
__device__ __forceinline__ int crow(int reg, int h) { return (reg & 3) + 8 * (reg >> 2) + 4 * h; }
__device__ __forceinline__ bf16x8 pack8(f32x4 a, f32x4 b) { v4u p; p.x = cvtpk(a.x, a.y); p.y = cvtpk(a.z, a.w); p.z = cvtpk(b.x, b.y); p.w = cvtpk(b.z, b.w); return __builtin_bit_cast(bf16x8, p); }
#define PACK_STEP(x, s) pack8((f32x4){(x)[8 * (s)], (x)[8 * (s) + 1], (x)[8 * (s) + 2], (x)[8 * (s) + 3]}, (f32x4){(x)[8 * (s) + 4], (x)[8 * (s) + 5], (x)[8 * (s) + 6], (x)[8 * (s) + 7]})
__device__ __forceinline__ bf16x8 join44(s16x4 lo, s16x4 hi) { return __builtin_shufflevector(lo, hi, 0, 1, 2, 3, 4, 5, 6, 7); }

constexpr int NRT = 3, CT_GP = (NCMP_P + NRT * 16 - 1) / (NRT * 16), CT_GS = (NCMP_S + NRT * 16 - 1) / (NRT * 16);
constexpr int CT_PROMPT = NBATCH * 2 * CT_GP, CT_SAMPLE = MS * 2 * CT_GS, CT_ALL = CT_PROMPT + CT_SAMPLE;
__device__ __forceinline__ void compress_task(Frame& F, int task) {
    const int lane = F.lane, m = lane & 31, h = lane >> 5, ii = m & 15, g = m >> 4;
    const bool prompt = task < CT_PROMPT;
    int b, c, ig, nblk, tsrc;
    if (prompt) { b = task / (2 * CT_GP); c = (task / CT_GP) & 1; ig = task % CT_GP; nblk = NCMP_P; tsrc = T; }
    else { const int t2 = task - CT_PROMPT; b = t2 / (2 * CT_GS); c = (t2 / CT_GS) & 1; ig = t2 % CT_GS; nblk = NCMP_S; tsrc = PAST; }
    const int* pt = (const int*)F.in[6] + b * NPAGES;
    const bf16* WcT = (const bf16*)(F.ws + WS_WC) + (size_t)c * 64 * 2048;
    const float* small = (const float*)(F.ws + WS_SMALL);
    f32x16 acc[NRT][2];
#pragma unroll
    for (int rt = 0; rt < NRT; ++rt)
#pragma unroll
        for (int i = 0; i < 16; ++i) { acc[rt][0][i] = 0.f; acc[rt][1][i] = 0.f; }
    const char* rbase = prompt ? (const char*)(F.out + OFF2 + (size_t)b * T * 256) : (const char*)F.in[2];
    unsigned offA[NRT], offB[NRT];
#pragma unroll
    for (int rt = 0; rt < NRT; ++rt) {
        const int blk = ig * (NRT * 16) + rt * 16 + ii;
        int tA = 16 * blk, tB = 16 * blk + 16; tA = tA <= tsrc - 16 ? tA : tsrc - 16; tB = tB <= tsrc - 16 ? tB : tsrc - 16;
        const unsigned rA = prompt ? (unsigned)tA : (unsigned)pt[tA >> 7] * 128u + (unsigned)(tA & 127), rB = prompt ? (unsigned)tB : (unsigned)pt[tB >> 7] * 128u + (unsigned)(tB & 127);
        offA[rt] = (rA * 256u + (unsigned)(c * 128 + g * 64 + 8 * h)) * 4u; offB[rt] = (rB * 256u + (unsigned)(c * 128 + g * 64 + 8 * h)) * 4u;
    }
    const bf16* bp0 = WcT + (size_t)m * 2048 + 8 * h;
    f32x4 a0[2][NRT], a1[2][NRT]; bf16x8 Bv[2][2];
#define CMP_LOAD(st, l_, dc_) do { const unsigned ro_ = (unsigned)(((l_) & 15) * 256 + (dc_) * 16) * 4u; const bf16* bp_ = bp0 + (l_) * 64 + (dc_) * 16; \
        Bv[st][0] = *(const GAS bf16x8*)bp_; Bv[st][1] = *(const GAS bf16x8*)(bp_ + 32 * 2048); \
        _Pragma("unroll") for (int rt = 0; rt < NRT; ++rt) { const char* ap_ = rbase + (((l_) < 16 ? offA[rt] : offB[rt]) + ro_); a0[st][rt] = *(const GAS f32x4*)ap_; a1[st][rt] = *(const GAS f32x4*)(ap_ + 16); } } while (0)
#define CMP_MMA(st) do { _Pragma("unroll") for (int rt = 0; rt < NRT; ++rt) { const bf16x8 A_ = pack8(a0[st][rt], a1[st][rt]); acc[rt][0] = MFMA32(A_, Bv[st][0], acc[rt][0]); acc[rt][1] = MFMA32(A_, Bv[st][1], acc[rt][1]); } } while (0)
    CMP_LOAD(0, 0, 0);
#pragma unroll 1
    for (int l = 0; l < 32; ++l) {
        CMP_LOAD(1, l, 1); __builtin_amdgcn_sched_barrier(0); CMP_MMA(0); __builtin_amdgcn_sched_barrier(0);
        CMP_LOAD(0, l, 2); __builtin_amdgcn_sched_barrier(0); CMP_MMA(1); __builtin_amdgcn_sched_barrier(0);
        CMP_LOAD(1, l, 3); __builtin_amdgcn_sched_barrier(0); CMP_MMA(0); __builtin_amdgcn_sched_barrier(0);
        { const int ln = l < 31 ? l + 1 : 31; CMP_LOAD(0, ln, 0); } __builtin_amdgcn_sched_barrier(0); CMP_MMA(1); __builtin_amdgcn_sched_barrier(0);
    }
#undef CMP_LOAD
#undef CMP_MMA
    float be0 = 0.f, be1 = 0.f;
    for (int l = 0; l < 32; ++l) { be0 += small[(c * 32 + l) * 64 + m]; be1 += small[(c * 32 + l) * 64 + 32 + m]; }
#pragma unroll
    for (int rt = 0; rt < NRT; ++rt)
#pragma unroll
    for (int v = 0; v < 16; ++v) {
        const int mr = crow(v, h), oi = mr & 15, og = mr >> 4, ob = ig * (NRT * 16) + rt * 16 + oi;
        if (ob < nblk) {
            const float v0 = acc[rt][0][v] + be0, v1 = acc[rt][1][v] + be1;
            if (prompt) {
                if (c == 0) { bf16* kc = (bf16*)(F.ws + WS_KCP) + ((size_t)(b * 2 + og) * 512 + ob) * 64; kc[m] = (bf16)f2bf(v0); kc[32 + m] = (bf16)f2bf(v1); }
                else { bf16* vc = (bf16*)(F.ws + WS_VCTP) + (size_t)(b * 2 + og) * 64 * 512 + ob; vc[(size_t)m * 512] = (bf16)f2bf(v0); vc[(size_t)(32 + m) * 512] = (bf16)f2bf(v1); }
            } else {
                float* o = (float*)(F.ws + WS_KCVS) + ((size_t)b * 1024 + ob) * 256 + c * 128 + og * 64; o[m] = v0; o[32 + m] = v1;
            }
        }
    }
}
constexpr int VT_ITEMS = 2 * 2 * 2 * 128;
__device__ __forceinline__ void vt_item(Frame& F, int it) {
    const int tensor = it >> 9, b = (it >> 8) & 1, g = (it >> 7) & 1, tb = it & 127, lane = F.lane;
    const bf16* src = (const bf16*)(F.ws + WS_HB) + (size_t)(b * T + tb * 64 + lane) * NIN + (tensor ? C_KVW : C_KVS) + 128 + g * 64;
    bf16* dst = (bf16*)(F.ws + (tensor ? WS_VWT : WS_VST)) + (size_t)(b * 2 + g) * 64 * T + tb * 64 + lane;
    v4u r[8];
#pragma unroll
    for (int i = 0; i < 8; ++i) r[i] = *((const GAS v4u*)src + i);
    { const bf16* ksrc = src - 128; bf16* kdst = (bf16*)(F.ws + (tensor ? WS_KWC : WS_KSC)) + ((size_t)(b * 2 + g) * T + tb * 64 + lane) * 64;
#pragma unroll
      for (int i = 0; i < 8; ++i) *((GAS v4u*)kdst + i) = *((const GAS v4u*)ksrc + i); }
#pragma unroll
    for (int i = 0; i < 8; ++i) {
        const unsigned w[4] = {r[i].x, r[i].y, r[i].z, r[i].w};
#pragma unroll
        for (int j = 0; j < 4; ++j) { dst[(size_t)(i * 8 + 2 * j) * T] = (bf16)(w[j] & 0xffffu); dst[(size_t)(i * 8 + 2 * j + 1) * T] = (bf16)(w[j] >> 16); }
    }
}

constexpr int HG_SEG = 512, HG_NSEG = T / HG_SEG, HG_CH = 32;
constexpr int HL_QT = 0, HL_KT = 8704, HL_KD = 17408, HL_VT = 27648, HL_DEC = 32768, HL_PSUM = 33280, HL_SLAB = 35328, HL_END = HL_SLAB + 4 * 32 * 272;
static_assert(HL_END <= RING_BYTES, "hgrn lds");
template <int MODE> __device__ __forceinline__ void hgrn_segment(Frame& F, int bh, int seg) {
    int tid = F.tid; asm volatile("" : "+v"(tid));
    const int lane = tid & 63, w = F.wave, kt = w >> 1, vt = w & 1, h5 = lane >> 5, l31 = lane & 31;
    const int b = bh >> 3, hh = bh & 7;
    LAS unsigned char* L = F.lds + RING_OFF;
    const bf16* HB = (const bf16*)(F.ws + WS_HB);
    const float* small = (const float*)(F.ws + WS_SMALL);
    float* HGL = (float*)(F.ws + WS_HGL); float* HGD = (float*)(F.ws + WS_HGD);
    f32x16 S;
#pragma unroll
    for (int i = 0; i < 16; ++i) S[i] = 0.f;
    if (MODE == 1) {
        for (int i = 0; i < seg; ++i) {
            const float* Lp = HGL + ((size_t)(bh * HG_NSEG + i)) * 8192 + w * 1024 + lane; const float* Dp = HGD + (size_t)(bh * HG_NSEG + i) * 128 + 32 * kt;
#pragma unroll
            for (int v = 0; v < 16; ++v) S[v] = S[v] * Dp[crow(v, h5)] + Lp[v * 64];
        }
    }
    const int k = tid & 127, q4 = tid >> 7;
    const float lb = small[4096 + hh * 128 + k];
    float lcsum = 0.f;
    for (int ch = 0; ch < HG_SEG / HG_CH; ++ch) {
        const int row0 = b * T + seg * HG_SEG + ch * HG_CH;
        float kk[8], cs[8]; float run = 0.f;
#pragma unroll
        for (int j = 0; j < 8; ++j) {
            const float x = bf2f(HB[(size_t)(row0 + 8 * q4 + j) * NIN + C_FB + hh * 128 + k]);
            const float e = __expf(-x), sg = 1.0f / (1.0f + e), om = e / (1.0f + e);
            const float f = lb + (1.0f - lb) * sg; kk[j] = (1.0f - lb) * om; run += __logf(f); cs[j] = run;
        }
        ((LAS float*)(L + HL_PSUM))[q4 * 128 + k] = run;
        __syncthreads();
        float off = 0.f, tot = 0.f;
#pragma unroll
        for (int q = 0; q < 4; ++q) { const float p = ((LAS float*)(L + HL_PSUM))[q * 128 + k]; tot += p; if (q < q4) off += p; }
#pragma unroll
        for (int j = 0; j < 8; ++j) {
            const int s = 8 * q4 + j; const float lc = off + cs[j];
            if (MODE == 1) {
                const float qv = bf2f(HB[(size_t)(row0 + s) * NIN + C_QB + hh * 128 + k]);
                ((LAS bf16*)(L + HL_QT))[s * 136 + k] = (bf16)f2bf(qv * __expf(lc));
                ((LAS bf16*)(L + HL_KT))[s * 136 + k] = (bf16)f2bf(kk[j] * __expf(-lc));
            }
            ((LAS bf16*)(L + HL_KD))[k * 40 + s] = (bf16)f2bf(kk[j] * __expf(tot - lc));
        }
        if (q4 == 0) { ((LAS float*)(L + HL_DEC))[k] = __expf(tot); lcsum += tot; }
        { const int s = tid >> 4, vq = tid & 15;
          const u32x2 vv = *(const GAS u32x2*)(HB + (size_t)(row0 + s) * NIN + C_IB + hh * 64 + 4 * vq);
          LAS bf16* vtp = (LAS bf16*)(L + HL_VT);
          vtp[(4 * vq + 0) * 40 + s] = (bf16)(vv.x & 0xffffu); vtp[(4 * vq + 1) * 40 + s] = (bf16)(vv.x >> 16);
          vtp[(4 * vq + 2) * 40 + s] = (bf16)(vv.y & 0xffffu); vtp[(4 * vq + 3) * 40 + s] = (bf16)(vv.y >> 16); }
        __syncthreads();
        if (MODE == 1) {
            f32x16 oacc;
#pragma unroll
            for (int i = 0; i < 16; ++i) oacc[i] = 0.f;
            if (kt == 0) {
                f32x16 at;
#pragma unroll
                for (int i = 0; i < 16; ++i) at[i] = 0.f;
#pragma unroll
                for (int ks = 0; ks < 8; ++ks) {
                    const bf16x8 a = *(const LAS bf16x8*)(L + HL_KT + l31 * 272 + (16 * ks + 8 * h5) * 2);
                    const bf16x8 bq = *(const LAS bf16x8*)(L + HL_QT + l31 * 272 + (16 * ks + 8 * h5) * 2);
                    at = MFMA32(a, bq, at);
                }
#pragma unroll
                for (int i = 0; i < 16; ++i) at[i] = (crow(i, h5) <= l31) ? at[i] : 0.f;
#pragma unroll
                for (int kq = 0; kq < 2; ++kq) {
                    const s16x4 lo = *(const LAS s16x4*)(L + HL_VT + (32 * vt + l31) * 80 + (16 * kq + 4 * h5) * 2);
                    const s16x4 hi = *(const LAS s16x4*)(L + HL_VT + (32 * vt + l31) * 80 + (16 * kq + 8 + 4 * h5) * 2);
                    oacc = MFMA32(join44(lo, hi), PACK_STEP(at, kq), oacc);
                }
            }
#pragma unroll
            for (int kq = 0; kq < 2; ++kq) {
                const s16x4 lo = *(const LAS s16x4*)(L + HL_QT + l31 * 272 + (32 * kt + 16 * kq + 4 * h5) * 2);
                const s16x4 hi = *(const LAS s16x4*)(L + HL_QT + l31 * 272 + (32 * kt + 16 * kq + 8 + 4 * h5) * 2);
                oacc = MFMA32(PACK_STEP(S, kq), join44(lo, hi), oacc);
            }
#pragma unroll
            for (int a = 0; a < 4; ++a)
                *(LAS f32x4*)(L + HL_SLAB + (kt * 32 + l31) * 272 + (32 * vt + 8 * a + 4 * h5) * 4) = (f32x4){oacc[4 * a], oacc[4 * a + 1], oacc[4 * a + 2], oacc[4 * a + 3]};
        }
        {
#pragma unroll
            for (int a = 0; a < 4; ++a) { const f32x4 d = *(const LAS f32x4*)(L + HL_DEC + (32 * kt + 8 * a + 4 * h5) * 4);
                S[4 * a] *= d.x; S[4 * a + 1] *= d.y; S[4 * a + 2] *= d.z; S[4 * a + 3] *= d.w; }
#pragma unroll
            for (int kq = 0; kq < 2; ++kq) {
                const bf16x8 a = *(const LAS bf16x8*)(L + HL_KD + (32 * kt + l31) * 80 + (16 * kq + 8 * h5) * 2);
                const bf16x8 bv = *(const LAS bf16x8*)(L + HL_VT + (32 * vt + l31) * 80 + (16 * kq + 8 * h5) * 2);
                S = MFMA32(a, bv, S);
            }
        }
        __syncthreads();
        if (MODE == 1) {
            const int t = tid >> 4, vq = tid & 15;
            f32x4 o = (f32x4){0.f, 0.f, 0.f, 0.f};
#pragma unroll
            for (int q = 0; q < 4; ++q) o += *(const LAS f32x4*)(L + HL_SLAB + (q * 32 + t) * 272 + 16 * vq);
            float ss = (o.x * o.x + o.y * o.y) + (o.z * o.z + o.w * o.w);
            ss += __shfl_xor(ss, 1); ss += __shfl_xor(ss, 2); ss += __shfl_xor(ss, 4); ss += __shfl_xor(ss, 8);
            const float rs = 1.0f / sqrtf(ss * (1.0f / 64.0f) + LN_EPS);
            const f32x4 ng = *(const GAS f32x4*)(F.in[11] + 4 * vq);
            const u32x2 gv = *(const GAS u32x2*)(HB + (size_t)(row0 + t) * NIN + C_GB + hh * 64 + 4 * vq);
            const float g0 = bf2f(gv.x & 0xffffu), g1 = bf2f(gv.x >> 16), g2 = bf2f(gv.y & 0xffffu), g3 = bf2f(gv.y >> 16);
            u32x2 ow; ow.x = cvtpk(o.x * rs * ng.x * g0 * sigmoidf_(g0), o.y * rs * ng.y * g1 * sigmoidf_(g1)); ow.y = cvtpk(o.z * rs * ng.z * g2 * sigmoidf_(g2), o.w * rs * ng.w * g3 * sigmoidf_(g3));
            *(GAS u32x2*)((bf16*)(F.ws + WS_OB) + (size_t)(row0 + t) * 512 + hh * 64 + 4 * vq) = ow;
        }
    }
    if (MODE == 0) {
        float* Lp = HGL + ((size_t)(bh * HG_NSEG + seg)) * 8192 + w * 1024 + lane;
#pragma unroll
        for (int v = 0; v < 16; ++v) Lp[v * 64] = S[v];
        if (q4 == 0) HGD[(size_t)(bh * HG_NSEG + seg) * 128 + k] = __expf(lcsum);
    } else if (seg == HG_NSEG - 1) {
        float* o = F.out + OFF5 + (size_t)bh * 8192;
#pragma unroll
        for (int v = 0; v < 16; ++v) o[(32 * kt + crow(v, h5)) * 64 + 32 * vt + l31] = S[v];
    }
    __syncthreads();
}
__device__ __forceinline__ void hgrn_sample_unit(Frame& F, int unit) {
    const int b = unit >> 3, hh = unit & 7, tid = F.tid, v = tid & 63, kq = tid >> 6;
    const bf16* HB = (const bf16*)(F.ws + WS_HB) + (size_t)(MP + b) * NIN;
    const float* small = (const float*)(F.ws + WS_SMALL);
    const float* st = F.in[5] + (size_t)(b * 8 + hh) * 8192; float* so = F.out + OFF9 + (size_t)(b * 8 + hh) * 8192;
    const float vv = bf2f(HB[C_IB + hh * 64 + v]);
    float po = 0.f;
#pragma unroll 4
    for (int j = 0; j < 16; ++j) {
        const int k = kq * 16 + j; const float x = bf2f(HB[C_FB + hh * 128 + k]), lb = small[4096 + hh * 128 + k];
        const float e = __expf(-x), sg = 1.0f / (1.0f + e), om = e / (1.0f + e);
        const float f = lb + (1.0f - lb) * sg, kx = (1.0f - lb) * om;
        const float sn = f * st[k * 64 + v] + kx * vv; so[k * 64 + v] = sn;
        po += bf2f(HB[C_QB + hh * 128 + k]) * sn;
    }
    LAS float* red = (LAS float*)(F.lds + RING_OFF);
    red[kq * 64 + v] = po;
    __syncthreads();
    if (tid < 64) {
        float o = 0.f;
#pragma unroll
        for (int q = 0; q < 8; ++q) o += red[q * 64 + v];
        const float ss = wave_sum(o * o), rs = 1.0f / sqrtf(ss * (1.0f / 64.0f) + LN_EPS);
        const float g = bf2f(HB[C_GB + hh * 64 + v]);
        ((bf16*)(F.ws + WS_OB))[(size_t)(MP + b) * 512 + hh * 64 + v] = (bf16)f2bf(o * rs * F.in[11][v] * g * sigmoidf_(g));
    }
    __syncthreads();
}
__device__ __forceinline__ void p2_phase(Frame& F) {
    for (int u = blockIdx.x; u < 16 * (HG_NSEG - 1); u += F.G) hgrn_segment<0>(F, u / (HG_NSEG - 1), u % (HG_NSEG - 1));
    for (int u = blockIdx.x; u < MS * 8; u += F.G) hgrn_sample_unit(F, u);
    const int NGW = F.G * NWAVES;
    for (int it = F.wave * F.G + F.vcu; it < CT_ALL + VT_ITEMS; it += NGW) { if (it < CT_ALL) compress_task(F, it); else vt_item(F, it - CT_ALL); }
}
constexpr int AT_NB = 5, AT_D = 4;
constexpr int AL_BUF = 16384  , AL_K = 0, AL_V = 8192;
constexpr int AL_IMP = AT_NB * AL_BUF, AL_SELM = AL_IMP + 64 * 128 * 4, AL_UNI = AL_SELM + 64 * 4 * 4, AL_TL = AL_UNI + 16, AL_END = AL_TL + 160 * 4;
static_assert(AL_END <= RING_BYTES, "attn lds");
constexpr float LOG2E = 1.4426950408889634f;
#define NEG_INF (-__builtin_inff())
__device__ __forceinline__ int swz(int row, int chunk) { return (chunk ^ ((row >> 1) & 7)) * 16; }
__device__ __forceinline__ f32x16 qk_sub(const LAS unsigned char* L, int sub, const bf16x8 (&qf)[4], int l31, int h5) {
    f32x16 acc;
#pragma unroll
    for (int i = 0; i < 16; ++i) acc[i] = 0.f;
    const int row = sub * 32 + l31;
#pragma unroll
    for (int s = 0; s < 4; ++s) { const bf16x8 a = *(const LAS bf16x8*)(L + AL_K + row * 128 + swz(row, 2 * s + h5)); acc = MFMA32(a, qf[s], acc); }
    return acc;
}
__device__ __forceinline__ void pv_sub(const LAS unsigned char* L, int sub, const f32x16& p, f32x16 (&O)[2], int l31, int h5) {
#pragma unroll
    for (int kq = 0; kq < 2; ++kq) {
        const bf16x8 pb = PACK_STEP(p, kq);
#pragma unroll
        for (int dt = 0; dt < 2; ++dt) {
            const int row = dt * 32 + l31;
            const s16x4 lo = *(const LAS s16x4*)(L + AL_V + row * 128 + swz(row, 4 * sub + 2 * kq) + 8 * h5);
            const s16x4 hi = *(const LAS s16x4*)(L + AL_V + row * 128 + swz(row, 4 * sub + 2 * kq + 1) + 8 * h5);
            O[dt] = MFMA32(join44(lo, hi), pb, O[dt]);
        }
    }
}
__device__ __forceinline__ void online_update2(const LAS unsigned char* L, f32x16& s0, f32x16& s1, float& m, float& l, f32x16 (&O)[2], int l31, int h5) {
    float tmax = fmaxf(s0[0], s1[0]);
#pragma unroll
    for (int i = 1; i < 16; ++i) tmax = fmaxf(tmax, fmaxf(s0[i], s1[i]));
    tmax = fmaxf(tmax, __shfl_xor(tmax, 32));
    const float mnew = fmaxf(m, tmax), ms = (mnew == NEG_INF) ? 0.f : mnew;
    const float alpha = __builtin_amdgcn_exp2f(m - ms);
    float ps = 0.f;
#pragma unroll
    for (int i = 0; i < 16; ++i) { s0[i] = __builtin_amdgcn_exp2f(s0[i] - ms); s1[i] = __builtin_amdgcn_exp2f(s1[i] - ms); ps += s0[i] + s1[i]; }
    l = l * alpha + ps; m = mnew;
    if (__any(alpha != 1.0f)) {
#pragma unroll
        for (int i = 0; i < 16; ++i) { O[0][i] *= alpha; O[1][i] *= alpha; }
    }
    pv_sub(L, 0, s0, O, l31, h5); pv_sub(L, 1, s1, O, l31, h5);
}

__device__ __forceinline__ void bias2(f32x16& s0, f32x16& s1, float scale2, float slopec, float cb) {
    const float cb1 = cb + slopec * 32.f;
#pragma unroll
    for (int k = 0; k < 16; ++k) { const float ck = (float)((k & 3) + 8 * (k >> 2)); s0[k] = s0[k] * scale2 + (slopec * ck + cb); s1[k] = s1[k] * scale2 + (slopec * ck + cb1); }
}
struct AttnSrc { const bf16* KCP; const bf16* VCTP; const bf16* Ks; const bf16* Vs; const bf16* Kw; const bf16* Vw; };
__device__ __forceinline__ void tile_dma(const AttnSrc& A, int e, LAS unsigned char* Lb, int w, int lane) {
    const int kind = e >> 24, idx = e & 0xffffff; const unsigned row = 8u * (unsigned)w + ((unsigned)lane >> 3), ch = (((unsigned)lane & 7u) ^ ((row >> 1) & 7u)) * 16u;
    const char* kb; const char* vb; unsigned vo;
    if (kind <= 1) { kb = (const char*)(A.KCP + (size_t)idx * 64 * 64); vb = (const char*)(A.VCTP + idx * 64); vo = row * 1024u + ch; }
    else if (kind == 2) { kb = (const char*)(A.Kw + (size_t)idx * 64 * 64); vb = (const char*)(A.Vw + idx * 64); vo = row * (unsigned)(T * 2) + ch; }
    else { kb = (const char*)(A.Ks + (size_t)idx * 64 * 64); vb = (const char*)(A.Vs + idx * 64); vo = row * (unsigned)(T * 2) + ch; }
    __builtin_amdgcn_global_load_lds((const unsigned*)(kb + (row * 128u + ch)), (LAS unsigned*)(Lb + AL_K + w * 1024), 16, 0, 0);
    __builtin_amdgcn_global_load_lds((const unsigned*)(vb + vo), (LAS unsigned*)(Lb + AL_V + w * 1024), 16, 0, 0);
}
__device__ __forceinline__ void nsa_prompt_unit(Frame& F, int unit) {
    const int b = unit >> 8, g = (unit >> 7) & 1, qt = unit & 127, t0 = qt * 64;
    int tid = F.tid; asm volatile("" : "+v"(tid));
    const int lane = tid & 63, w = F.wave, l31 = lane & 31, h5 = lane >> 5, ql = l31 >> 2, r = l31 & 3;
    LAS unsigned char* L = F.lds + RING_OFF;
    const bf16* HB = (const bf16*)(F.ws + WS_HB);
    const int pos = t0 + 8 * w + ql;
    const size_t qrow = (size_t)(b * T + pos);
    const float slope2 = __builtin_amdgcn_exp2f(-(float)(g * 4 + r + 1)) * LOG2E, scale2 = 0.125f * LOG2E;
    bf16x8 qf[4];
#pragma unroll
    for (int s = 0; s < 4; ++s) qf[s] = *(const GAS bf16x8*)(HB + qrow * NIN + C_QA + (g * 4 + r) * 64 + 16 * s + 8 * h5);
#define NSA_GATE(i) sigmoidf_(bf2f(HB[qrow * NIN + C_GLA + (g * 4 + r) * 3 + (i)]))
    AttnSrc A;
    A.KCP = (const bf16*)(F.ws + WS_KCP) + (size_t)(b * 2 + g) * 512 * 64; A.VCTP = (const bf16*)(F.ws + WS_VCTP) + (size_t)(b * 2 + g) * 64 * 512;
    A.Ks = (const bf16*)(F.ws + WS_KSC) + (size_t)(b * 2 + g) * T * 64; A.Vs = (const bf16*)(F.ws + WS_VST) + (size_t)(b * 2 + g) * 64 * T;
    A.Kw = (const bf16*)(F.ws + WS_KWC) + (size_t)(b * 2 + g) * T * 64; A.Vw = (const bf16*)(F.ws + WS_VWT) + (size_t)(b * 2 + g) * 64 * T;
    LAS int* TL = (LAS int*)(L + AL_TL);
    for (int i = tid; i < (AL_TL - AL_IMP) / 4; i += NWAVES * 64) ((LAS unsigned*)(L + AL_IMP))[i] = 0u;
    const int nmax_u = (t0 + 63 - 31) >> 4, nc = (nmax_u >> 6) + 1;
    const int nmax_w = (t0 + 8 * w + 7 - 31) >> 4;
    const int kb_lo = qt >= 8 ? qt - 8 : 0, nw = qt - kb_lo + 1;
    if (tid < 2 * nc + nw) TL[tid] = tid < nc ? tid : (tid < 2 * nc ? (1 << 24) | (tid - nc) : (2 << 24) | (kb_lo + tid - 2 * nc));
    __syncthreads();
    f32x16 O[2];
#pragma unroll
    for (int i = 0; i < 16; ++i) { O[0][i] = 0.f; O[1][i] = 0.f; }
    float* ots = (float*)(F.ws + WS_OTS) + ((size_t)blockIdx.x * 512 + tid) * 32;
    float m = NEG_INF, l = 0.f, inv_l = 0.f, mfin = 0.f;
    int n = 2 * nc + nw;
#define NSA_TILE_LOOP(stream) \
    { \
_Pragma("unroll") \
    for (int j = 0; j < AT_D; ++j) tile_dma(A, TL[j < n ? j : n - 1], L + j * AL_BUF, w, lane); \
    int bi = 0; \
_Pragma("unroll 1") \
    for (int i = 0; i < n; ++i) { \
        asm volatile("s_waitcnt vmcnt(6)" ::: "memory"); __builtin_amdgcn_s_barrier(); asm volatile("" ::: "memory"); \
        { const int jn = i + AT_D < n ? i + AT_D : n - 1; const int bn = bi + AT_D >= AT_NB ? bi + AT_D - AT_NB : bi + AT_D; tile_dma(A, TL[jn], L + bn * AL_BUF, w, lane); } \
        const int e = TL[i], kind = (stream) == 1 ? 3 : (e >> 24), idx = e & 0xffffff; \
        const LAS unsigned char* Lb = L + bi * AL_BUF; bi = bi + 1 == AT_NB ? 0 : bi + 1; \
        if (stream == 0 && i == nc) { l += __shfl_xor(l, 32); inv_l = l > 0.f ? 1.0f / l : 0.f; mfin = (m == NEG_INF) ? 0.f : m; } \
        if (stream == 0 && i == 2 * nc) { \
            { const float g0_ = NSA_GATE(0); _Pragma("unroll") for (int k = 0; k < 16; ++k) { ots[k] = g0_ * O[0][k]; ots[16 + k] = g0_ * O[1][k]; O[0][k] = 0.f; O[1][k] = 0.f; } } \
            asm volatile("s_waitcnt vmcnt(0)" ::: "memory"); \
            m = NEG_INF; l = 0.f; } \
        if ((stream) == 0 && kind <= 1) { \
            const int n0 = idx * 64; \
            if (n0 <= nmax_w) { \
                f32x16 s0 = qk_sub(Lb, 0, qf, l31, h5), s1 = qk_sub(Lb, 1, qf, l31, h5); \
                const float slopec = 16.f * slope2; \
                bias2(s0, s1, scale2, slopec, slope2 * (float)(16 * n0 + 31 - pos) + slopec * (float)(4 * h5) - (kind == 1 ? mfin : 0.f)); \
                if (16 * (n0 + 63) + 31 > t0 + 8 * w) { \
_Pragma("unroll") \
                    for (int k = 0; k < 16; ++k) { const int d0 = pos - (16 * (n0 + crow(k, h5)) + 31), d1 = d0 - 512; s0[k] = d0 >= 0 ? s0[k] : NEG_INF; s1[k] = d1 >= 0 ? s1[k] : NEG_INF; } \
                } \
                if (kind == 0) { \
                    float tmax = fmaxf(s0[0], s1[0]); \
_Pragma("unroll") \
                    for (int k = 1; k < 16; ++k) tmax = fmaxf(tmax, fmaxf(s0[k], s1[k])); \
                    tmax = fmaxf(tmax, __shfl_xor(tmax, 32)); \
                    const float mnew = fmaxf(m, tmax), ms = (mnew == NEG_INF) ? 0.f : mnew; \
                    float ps = 0.f; \
_Pragma("unroll") \
                    for (int k = 0; k < 16; ++k) ps += __builtin_amdgcn_exp2f(s0[k] - ms) + __builtin_amdgcn_exp2f(s1[k] - ms); \
                    l = l * __builtin_amdgcn_exp2f(m - ms) + ps; m = mnew; \
                } else { \
_Pragma("unroll") \
                    for (int k = 0; k < 16; ++k) { s0[k] = __builtin_amdgcn_exp2f(s0[k]) * inv_l; s1[k] = __builtin_amdgcn_exp2f(s1[k]) * inv_l; } \
_Pragma("unroll") \
                    for (int a = 0; a < 4; ++a) { \
                        float sm0 = (s0[4 * a] + s0[4 * a + 1]) + (s0[4 * a + 2] + s0[4 * a + 3]), sm1 = (s1[4 * a] + s1[4 * a + 1]) + (s1[4 * a + 2] + s1[4 * a + 3]); \
                        sm0 += __shfl_xor(sm0, 1); sm0 += __shfl_xor(sm0, 2); sm1 += __shfl_xor(sm1, 1); sm1 += __shfl_xor(sm1, 2); \
                        if (r == 0) { ((LAS float*)(L + AL_IMP))[(8 * w + ql) * 128 + (n0 >> 2) + 2 * a + h5] = sm0; ((LAS float*)(L + AL_IMP))[(8 * w + ql) * 128 + (n0 >> 2) + 8 + 2 * a + h5] = sm1; } \
                    } \
                    pv_sub(Lb, 0, s0, O, l31, h5); pv_sub(Lb, 1, s1, O, l31, h5); \
                } \
            } \
        } else { \
            const int pos0 = idx * 64; \
            const bool sel = (stream) == 0 ? true : ((((LAS unsigned*)(L + AL_SELM))[(8 * w + ql) * 4 + (idx >> 5)] >> (idx & 31)) & 1u) != 0u; \
            if (__any(sel && pos >= pos0)) { \
                f32x16 s0 = qk_sub(Lb, 0, qf, l31, h5), s1 = qk_sub(Lb, 1, qf, l31, h5); \
                bias2(s0, s1, scale2, slope2, sel ? slope2 * (float)(pos0 - pos + 4 * h5) : NEG_INF); \
                if (idx == qt || ((stream) == 0 && idx == qt - 8)) { \
_Pragma("unroll") \
                    for (int k = 0; k < 16; ++k) { const int d0 = pos - (pos0 + crow(k, h5)), d1 = d0 - 32; \
                        s0[k] = (d0 >= 0 && ((stream) == 1 || d0 < 512)) ? s0[k] : NEG_INF; s1[k] = (d1 >= 0 && ((stream) == 1 || d1 < 512)) ? s1[k] : NEG_INF; } \
                } \
                online_update2(Lb, s0, s1, m, l, O, l31, h5); \
            } \
        } \
    } \
    asm volatile("s_waitcnt vmcnt(0)" ::: "memory"); __builtin_amdgcn_s_barrier(); asm volatile("" ::: "memory"); \
    l += __shfl_xor(l, 32); \
    const float sc_ = l > 0.f ? NSA_GATE(stream == 0 ? 2 : 1) / l : 0.f; \
    if (stream == 0) { \
_Pragma("unroll") \
        for (int k = 0; k < 16; ++k) { ots[k] += sc_ * O[0][k]; ots[16 + k] += sc_ * O[1][k]; } \
    } else { \
_Pragma("unroll") \
        for (int k = 0; k < 16; ++k) { O[0][k] = ots[k] + sc_ * O[0][k]; O[1][k] = ots[16 + k] + sc_ * O[1][k]; } \
    } \
    }
    NSA_TILE_LOOP(0)
    {
        const int q = tid >> 3, sub = tid & 7, cur = qt;
        float vals[16]; unsigned avail = 0u, bits = 0u;
#pragma unroll
        for (int i = 0; i < 16; ++i) { const int j = sub * 16 + i; vals[i] = ((LAS float*)(L + AL_IMP))[q * 128 + j];
            if (j <= cur) { if (cur < 16 || j == 0 || j == cur || j == cur - 1) bits |= 1u << i; else avail |= 1u << i; } }
        if (cur >= 16) {
            for (int round = 0; round < 13; ++round) {
                float bv = -1.0f; int bi = 1 << 20;
#pragma unroll
                for (int i = 0; i < 16; ++i) if (((avail >> i) & 1u) && vals[i] > bv) { bv = vals[i]; bi = sub * 16 + i; }
#pragma unroll
                for (int o = 1; o < 8; o <<= 1) { const float ov = __shfl_xor(bv, o); const int oi = __shfl_xor(bi, o); if (ov > bv || (ov == bv && oi < bi)) { bv = ov; bi = oi; } }
                if ((bi >> 4) == sub) { avail &= ~(1u << (bi & 15)); bits |= 1u << (bi & 15); }
            }
        }
        if (bits) { __hip_atomic_fetch_or((LAS unsigned*)(L + AL_SELM) + q * 4 + (sub >> 1), bits << (16 * (sub & 1)), __ATOMIC_RELAXED, __HIP_MEMORY_SCOPE_WORKGROUP); __hip_atomic_fetch_or((LAS unsigned*)(L + AL_UNI) + (sub >> 1), bits << (16 * (sub & 1)), __ATOMIC_RELAXED, __HIP_MEMORY_SCOPE_WORKGROUP); }
        __syncthreads();
        const unsigned u0 = ((LAS unsigned*)(L + AL_UNI))[0], u1 = ((LAS unsigned*)(L + AL_UNI))[1], u2 = ((LAS unsigned*)(L + AL_UNI))[2], u3 = ((LAS unsigned*)(L + AL_UNI))[3];
        n = __builtin_popcount(u0) + __builtin_popcount(u1) + __builtin_popcount(u2) + __builtin_popcount(u3);
        n = __builtin_amdgcn_readfirstlane(n);
        if (tid < 128) { const int wq = tid >> 5, bq = tid & 31; const unsigned uw = wq == 0 ? u0 : (wq == 1 ? u1 : (wq == 2 ? u2 : u3));
            if ((uw >> bq) & 1u) { const int rank = __builtin_popcount(uw & ((1u << bq) - 1u)) + (wq > 0 ? __builtin_popcount(u0) : 0) + (wq > 1 ? __builtin_popcount(u1) : 0) + (wq > 2 ? __builtin_popcount(u2) : 0);
                TL[rank] = (3 << 24) | tid; } }
        __syncthreads();
        m = NEG_INF; l = 0.f;
#pragma unroll
        for (int i = 0; i < 16; ++i) { O[0][i] = 0.f; O[1][i] = 0.f; }
    }
    NSA_TILE_LOOP(1)
#undef NSA_TILE_LOOP
#undef NSA_GATE
    bf16* oa = (bf16*)(F.ws + WS_OA) + qrow * 512 + (g * 4 + r) * 64;
#pragma unroll
    for (int dt = 0; dt < 2; ++dt)
#pragma unroll
        for (int a = 0; a < 4; ++a) { u32x2 ow; ow.x = cvtpk(O[dt][4 * a], O[dt][4 * a + 1]); ow.y = cvtpk(O[dt][4 * a + 2], O[dt][4 * a + 3]);
            *(GAS u32x2*)(oa + dt * 32 + 8 * a + 4 * h5) = ow; }
    __syncthreads();
}

constexpr int SL_SC = 0, SL_Q = 16384, SL_RED = SL_Q + 1024, SL_IMP = SL_RED + 8192, SL_SEL = SL_IMP + 2048, SL_SELB = SL_SEL + 64, SL_OUT = SL_SELB + 128, SL_END = SL_OUT + 1024;
static_assert(SL_END <= RING_BYTES, "sample lds");
struct SampleCtx { const float* kcvs; const float* csel; const float* cwin; const float* new_sel; const float* new_win; };
template <int KIND> __device__ __forceinline__ const float* sample_key(const SampleCtx& c, const LAS int* SEL, const LAS unsigned long long* SELB, int kidx, int& dist, bool& valid) {
    if (KIND == 0) { valid = kidx < NCMP_S; dist = PAST - (16 * kidx + 31); return c.kcvs + (size_t)(valid ? kidx : 0) * 256; }
    if (KIND == 1) { const int slot = kidx >> 6, i = kidx & 63, jb = SEL[slot];
        if (jb < 256) { valid = true; dist = PAST - (jb * 64 + i); return c.csel + SELB[slot] + (size_t)i * 256; }
        valid = (i == 0); dist = 0; return c.new_sel; }
    valid = (kidx >= 1 && kidx <= 512); dist = 512 - kidx;
    return kidx == 512 ? c.new_win : c.cwin + (size_t)((kidx >= 1 && kidx < 512) ? kidx : 1) * 256;
}
__device__ __forceinline__ void block_max4(LAS float* red, float (&v)[4], int wave, int lane) {
#pragma unroll
    for (int r = 0; r < 4; ++r) { float x = v[r];
#pragma unroll
        for (int o = 1; o < 64; o <<= 1) x = fmaxf(x, __shfl_xor(x, o));
        if (lane == 0) red[wave * 4 + r] = x; }
    __syncthreads();
#pragma unroll
    for (int r = 0; r < 4; ++r) { float x = red[r];
#pragma unroll
        for (int q = 1; q < 8; ++q) x = fmaxf(x, red[q * 4 + r]);
        v[r] = x; }
    __syncthreads();
}
__device__ __forceinline__ void block_sum4(LAS float* red, float (&v)[4], int wave, int lane) {
#pragma unroll
    for (int r = 0; r < 4; ++r) { const float x = wave_sum(v[r]); if (lane == 0) red[wave * 4 + r] = x; }
    __syncthreads();
#pragma unroll
    for (int r = 0; r < 4; ++r) { float x = 0.f;
#pragma unroll
        for (int q = 0; q < 8; ++q) x += red[q * 4 + r];
        v[r] = x; }
    __syncthreads();
}
template <int KIND> __device__ __forceinline__ void sample_branch(Frame& F, const SampleCtx& c, int b, int g, int tid) {
    constexpr int NK = KIND == 2 ? 544 : 1024;
    const int lane = tid & 63, wave = F.wave, sub = lane & 15, kg = lane >> 4;
    LAS unsigned char* L = F.lds + RING_OFF;
    LAS float* SC = (LAS float*)(L + SL_SC); LAS float* Q = (LAS float*)(L + SL_Q); LAS float* red = (LAS float*)(L + SL_RED);
    const LAS int* SEL = (const LAS int*)(L + SL_SEL); const LAS unsigned long long* SELB = (const LAS unsigned long long*)(L + SL_SELB);
    f32x4 q4[4];
#pragma unroll
    for (int r = 0; r < 4; ++r) q4[r] = *(const LAS f32x4*)(Q + r * 64 + 4 * sub);
    constexpr int NIT = NK / 32, NBATCH_S = (NIT % 4 == 0) ? 4 : 1;
#pragma unroll 1
    for (int it0 = 0; it0 < NIT; it0 += NBATCH_S) {
        f32x4 kv[NBATCH_S]; int dist[NBATCH_S]; bool valid[NBATCH_S];
#pragma unroll
        for (int u = 0; u < NBATCH_S; ++u) { const int kidx = (it0 + u) * 32 + wave * 4 + kg; const float* kp = sample_key<KIND>(c, SEL, SELB, kidx, dist[u], valid[u]); kv[u] = *(const GAS f32x4*)(kp + 4 * sub); }
#pragma unroll
        for (int u = 0; u < NBATCH_S; ++u) {
            const int kidx = (it0 + u) * 32 + wave * 4 + kg;
            float part[4];
#pragma unroll
            for (int r = 0; r < 4; ++r) { float p = (kv[u].x * q4[r].x + kv[u].y * q4[r].y) + (kv[u].z * q4[r].z + kv[u].w * q4[r].w);
                p += __shfl_xor(p, 1); p += __shfl_xor(p, 2); p += __shfl_xor(p, 4); p += __shfl_xor(p, 8); part[r] = p; }
            if (sub < 4) { const float pr = sub == 0 ? part[0] : (sub == 1 ? part[1] : (sub == 2 ? part[2] : part[3]));
                SC[sub * 1024 + kidx] = valid[u] ? pr * 0.125f - __builtin_amdgcn_exp2f(-(float)(g * 4 + sub + 1)) * (float)dist[u] : NEG_INF; }
        }
    }
    __syncthreads();
    float mx[4] = {NEG_INF, NEG_INF, NEG_INF, NEG_INF};
    for (int kidx = tid; kidx < NK; kidx += 512)
#pragma unroll
        for (int r = 0; r < 4; ++r) mx[r] = fmaxf(mx[r], SC[r * 1024 + kidx]);
    block_max4(red, mx, wave, lane);
    float sm[4] = {0.f, 0.f, 0.f, 0.f};
    for (int kidx = tid; kidx < NK; kidx += 512)
#pragma unroll
        for (int r = 0; r < 4; ++r) { const float s = SC[r * 1024 + kidx]; const float p = s == NEG_INF ? 0.f : __expf(s - mx[r]); SC[r * 1024 + kidx] = p; sm[r] += p; }
    block_sum4(red, sm, wave, lane);
    for (int kidx = tid; kidx < NK; kidx += 512)
#pragma unroll
        for (int r = 0; r < 4; ++r) SC[r * 1024 + kidx] *= (sm[r] > 0.f ? 1.0f / sm[r] : 0.f);
    __syncthreads();
    f32x4 acc[4];
#pragma unroll
    for (int r = 0; r < 4; ++r) acc[r] = (f32x4){0.f, 0.f, 0.f, 0.f};
#pragma unroll 1
    for (int it0 = 0; it0 < NIT; it0 += NBATCH_S) {
        f32x4 vv[NBATCH_S];
#pragma unroll
        for (int u = 0; u < NBATCH_S; ++u) { const int kidx = (it0 + u) * 32 + wave * 4 + kg; int dist; bool valid; const float* kp = sample_key<KIND>(c, SEL, SELB, kidx, dist, valid); vv[u] = *(const GAS f32x4*)(kp + 128 + 4 * sub); }
#pragma unroll
        for (int u = 0; u < NBATCH_S; ++u) { const int kidx = (it0 + u) * 32 + wave * 4 + kg;
#pragma unroll
            for (int r = 0; r < 4; ++r) acc[r] += vv[u] * SC[r * 1024 + kidx]; }
    }
#pragma unroll
    for (int r = 0; r < 4; ++r)
#pragma unroll
        for (int j = 0; j < 4; ++j) { float x = acc[r][j]; x += __shfl_xor(x, 16); x += __shfl_xor(x, 32); acc[r][j] = x; }
    if (lane < 16) {
#pragma unroll
        for (int r = 0; r < 4; ++r) *(LAS f32x4*)(red + wave * 256 + r * 64 + 4 * sub) = acc[r];
    }
    __syncthreads();
    if (tid < 256) { const int r = tid >> 6; float o = 0.f;
#pragma unroll
        for (int wv = 0; wv < 8; ++wv) o += red[wv * 256 + tid];
        const float gt = sigmoidf_(bf2f(((const bf16*)(F.ws + WS_HB))[(size_t)(MP + b) * NIN + C_GLA + (g * 4 + r) * 3 + KIND]));
        ((LAS float*)(L + SL_OUT))[tid] += gt * o; }
    __syncthreads();
}
__device__ __forceinline__ void nsa_sample_unit(Frame& F, int unit) {
    const int b = unit >> 1, g = unit & 1;
    int tid = F.tid; asm volatile("" : "+v"(tid));
    LAS unsigned char* L = F.lds + RING_OFF;
    LAS float* SC = (LAS float*)(L + SL_SC); LAS float* Q = (LAS float*)(L + SL_Q); LAS float* IMP = (LAS float*)(L + SL_IMP); LAS int* SEL = (LAS int*)(L + SL_SEL);
    LAS unsigned long long* SELB = (LAS unsigned long long*)(L + SL_SELB);
    SampleCtx c;
    c.kcvs = (const float*)(F.ws + WS_KCVS) + (size_t)b * 1024 * 256 + g * 64; c.csel = F.in[3] + g * 64; c.cwin = F.in[4] + (size_t)b * 512 * 256 + g * 64;
    c.new_sel = F.out + OFF7 + (size_t)b * 256 + g * 64; c.new_win = F.out + OFF8 + ((size_t)b * 512 + 511) * 256 + g * 64;
    __syncthreads();
    if (tid < 256) { Q[tid] = bf2f(((const bf16*)(F.ws + WS_HB))[(size_t)(MP + b) * NIN + C_QA + g * 256 + tid]); ((LAS float*)(L + SL_OUT))[tid] = 0.f; }
    __syncthreads();
    sample_branch<0>(F, c, b, g, tid);
    if (tid < 257) { float s = 0.f;
#pragma unroll
        for (int cc = 0; cc < 4; ++cc) { const int n = 4 * tid + cc; if (n < NCMP_S) s += (SC[n] + SC[1024 + n]) + (SC[2048 + n] + SC[3072 + n]); }
        IMP[tid] = (tid == 0 || tid >= 255) ? -1.0f : s; }
    __syncthreads();
    if (tid < 64) {
        if (tid == 0) { SEL[0] = 0; SEL[1] = 255; SEL[2] = 256; }
        float vals[4]; unsigned avail = 0xfu;
#pragma unroll
        for (int i = 0; i < 4; ++i) { const int j = tid * 4 + i; vals[i] = IMP[j]; if (vals[i] < 0.f) avail &= ~(1u << i); }
        for (int round = 0; round < 13; ++round) {
            float bv = -1.0f; int bi = 1 << 20;
#pragma unroll
            for (int i = 0; i < 4; ++i) if (((avail >> i) & 1u) && vals[i] > bv) { bv = vals[i]; bi = tid * 4 + i; }
#pragma unroll
            for (int o = 1; o < 64; o <<= 1) { const float ov = __shfl_xor(bv, o); const int oi = __shfl_xor(bi, o); if (ov > bv || (ov == bv && oi < bi)) { bv = ov; bi = oi; } }
            if ((bi >> 2) == tid) avail &= ~(1u << (bi & 3));
            if (tid == 0) SEL[3 + round] = bi;
        }
    }
    __syncthreads();
    if (tid < 16) { const int jb = SEL[tid]; const int* pt = (const int*)F.in[6] + b * NPAGES;
        SELB[tid] = jb < 256 ? ((unsigned long long)pt[jb >> 1] * 128ull + (unsigned long long)((jb & 1) * 64)) * 256ull : 0ull; }
    __syncthreads();
    sample_branch<1>(F, c, b, g, tid);
    sample_branch<2>(F, c, b, g, tid);
    if (tid < 256) ((bf16*)(F.ws + WS_OA))[(size_t)(MP + b) * 512 + g * 256 + tid] = (bf16)f2bf(((LAS float*)(L + SL_OUT))[tid]);
    __syncthreads();
}
__device__ __forceinline__ void p3_phase(Frame& F) {
    for (int u = blockIdx.x; u < 16 * HG_NSEG; u += F.G) hgrn_segment<1>(F, u / HG_NSEG, u % HG_NSEG);
#pragma unroll 1
    for (int u2 = 2 * blockIdx.x; u2 < 512; u2 += 2 * F.G) {
#pragma unroll 1
        for (int which = 0; which < 2; ++which) { const int p = u2 >> 1, bg = p >> 6, qq = p & 63; nsa_prompt_unit(F, bg * 128 + (which ? qq : 127 - qq)); } }
    for (int u = blockIdx.x; u < 2 * MS; u += F.G) nsa_sample_unit(F, u);
}
namespace pg8 {
typedef unsigned u32x2e __attribute__((ext_vector_type(2)));
__device__ __forceinline__ float bfl(unsigned w) { return __uint_as_float(w << 16); }
__device__ __forceinline__ float bfh(unsigned w) { return __uint_as_float(w & 0xffff0000u); }
__device__ __forceinline__ float sgm(float x) { return 1.0f / (1.0f + __expf(-x)); }
struct EpiGateA {
    static constexpr bool PERM = false, AFTER_DRAIN = false;
    const bf16_t* HBp; float* TB;
    __device__ __forceinline__ void operator()(const f32x4 (&acc)[2][2][4][2], const Unit& u, int wr, int wc, int fr, int fq) const {
        const int row0 = u.pm * BM + wr * 64 + fr, col0 = u.pn * BM + wc * 32 + 4 * fq;
#pragma unroll
        for (int ai = 0; ai < 2; ++ai)
#pragma unroll
            for (int m = 0; m < 4; ++m) { const size_t r = (size_t)(row0 + ai * HALF + m * 16);
#pragma unroll
                for (int bj = 0; bj < 2; ++bj)
#pragma unroll
                    for (int n = 0; n < 2; ++n) { const int c = col0 + bj * HALF + n * 16; const u32x2e gw = *(const u32x2e*)(HBp + r * NIN + C_MG + c); const f32x4 a = acc[ai][bj][m][n];
                        *(f32x4*)(TB + r * D + c) = (f32x4){sgm(bfl(gw.x)) * a[0], sgm(bfh(gw.x)) * a[1], sgm(bfl(gw.y)) * a[2], sgm(bfh(gw.y)) * a[3]}; } }
    }
};
struct EpiGateB {
    static constexpr bool PERM = false, AFTER_DRAIN = false;
    const bf16_t* HBp; const float* TB; bf16_t* MG;
    __device__ __forceinline__ void operator()(const f32x4 (&acc)[2][2][4][2], const Unit& u, int wr, int wc, int fr, int fq) const {
        const int row0 = u.pm * BM + wr * 64 + fr, col0 = u.pn * BM + wc * 32 + 4 * fq;
#pragma unroll
        for (int ai = 0; ai < 2; ++ai)
#pragma unroll
            for (int m = 0; m < 4; ++m) { const size_t r = (size_t)(row0 + ai * HALF + m * 16);
#pragma unroll
                for (int bj = 0; bj < 2; ++bj)
#pragma unroll
                    for (int n = 0; n < 2; ++n) { const int c = col0 + bj * HALF + n * 16; const u32x2e gw = *(const u32x2e*)(HBp + r * NIN + C_MG + D + c); const f32x4 a = acc[ai][bj][m][n]; const f32x4 t = *(const f32x4*)(TB + r * D + c);
                        u32x2e o; o.x = cvt_pk_bf16(t[0] + sgm(bfl(gw.x)) * a[0], t[1] + sgm(bfh(gw.x)) * a[1]); o.y = cvt_pk_bf16(t[2] + sgm(bfl(gw.y)) * a[2], t[3] + sgm(bfh(gw.y)) * a[3]);
                        *(u32x2e*)(MG + r * D + c) = o; } }
    }
};
struct EpiResid {
    static constexpr bool PERM = false, AFTER_DRAIN = false;
    const float* rp; const float* rs; float* Z;
    __device__ __forceinline__ void operator()(const f32x4 (&acc)[2][2][4][2], const Unit& u, int wr, int wc, int fr, int fq) const {
        const int row0 = u.pm * BM + wr * 64 + fr, col0 = u.pn * BM + wc * 32 + 4 * fq;
#pragma unroll
        for (int ai = 0; ai < 2; ++ai)
#pragma unroll
            for (int m = 0; m < 4; ++m) { const int r = row0 + ai * HALF + m * 16; const float* xr = r < MP ? rp + (size_t)r * D : (r < MP + MS ? rs + (size_t)(r - MP) * D : nullptr);
#pragma unroll
                for (int bj = 0; bj < 2; ++bj)
#pragma unroll
                    for (int n = 0; n < 2; ++n) { const int c = col0 + bj * HALF + n * 16; const f32x4 x = xr ? *(const f32x4*)(xr + c) : (f32x4){0.f, 0.f, 0.f, 0.f};
                        *(f32x4*)(Z + (size_t)r * D + c) = x * DN_ALPHA + acc[ai][bj][m][n]; } }
    }
};
struct EpiRelu2 {
    static constexpr bool PERM = true, AFTER_DRAIN = false;
    bf16_t* U;
    __device__ __forceinline__ void operator()(const f32x4 (&acc)[2][2][4][2], const Unit& u, int wr, int wc, int fr, int fq) const {
        const int row0 = u.pm * BM + wr * 64 + fr, col0 = u.pn * BM + wc * 32 + 8 * fq;
#pragma unroll
        for (int ai = 0; ai < 2; ++ai)
#pragma unroll
            for (int m = 0; m < 4; ++m) { bf16_t* rowp = U + (size_t)(row0 + ai * HALF + m * 16) * FF + col0;
#pragma unroll
                for (int bj = 0; bj < 2; ++bj) { f32x4 v0 = acc[ai][bj][m][0], v1 = acc[ai][bj][m][1];
#pragma unroll
                    for (int j = 0; j < 4; ++j) { const float a = fmaxf(v0[j], 0.f), b = fmaxf(v1[j], 0.f); v0[j] = a * a; v1[j] = b * b; }
                    u32x4 w; w.x = cvt_pk_bf16(v0[0], v0[1]); w.y = cvt_pk_bf16(v0[2], v0[3]); w.z = cvt_pk_bf16(v1[0], v1[1]); w.w = cvt_pk_bf16(v1[2], v1[3]);
                    *(u32x4*)(rowp + bj * HALF) = w; } }
    }
};
}
__device__ __forceinline__ void ln_phase(Frame& F, const float* Z, const float* gam, const float* bet, int which) {
    const int gw = F.vcu * NWAVES + F.wave, NGW = F.G * NWAVES, lane = F.lane;
    const int nrows = MP + MS;
    for (int r = gw; r < nrows; r += NGW) {
        const GAS f32x4* zr = (const GAS f32x4*)(Z + (size_t)r * D) + lane;
        f32x4 v[4]; float s = 0.f;
        if (which && r >= MP) {
            const GAS f32x4* x1r = (const GAS f32x4*)((const float*)(F.ws + WS_X1F) + (size_t)r * D) + lane;
#pragma unroll
            for (int j = 0; j < 4; ++j) { f32x4 t = x1r[64 * j] * DN_ALPHA;
#pragma unroll
                for (int kq = 0; kq < 4; ++kq) t += *((const GAS f32x4*)(Z + (size_t)(MP + 32 * kq + (r - MP)) * D) + lane + 64 * j);
                v[j] = t; s += (t.x + t.y) + (t.z + t.w); }
        } else {
#pragma unroll
        for (int j = 0; j < 4; ++j) { v[j] = zr[64 * j]; s += (v[j].x + v[j].y) + (v[j].z + v[j].w); }
        }
        const float mean = wave_sum(s) * (1.f / D); float s2 = 0.f;
#pragma unroll
        for (int j = 0; j < 4; ++j) { v[j] = v[j] - mean; s2 += (v[j].x * v[j].x + v[j].y * v[j].y) + (v[j].z * v[j].z + v[j].w * v[j].w); }
        const float rstd = 1.f / sqrtf(wave_sum(s2) * (1.f / D) + LN_EPS);
        float* of = which ? (r < MP ? F.out + OFF0 + (size_t)r * D : F.out + OFF1 + (size_t)(r - MP) * D) : (float*)(F.ws + WS_X1F) + (size_t)r * D;
#pragma unroll
        for (int j = 0; j < 4; ++j) { const f32x4 gg = *((const GAS f32x4*)gam + lane + 64 * j), bb = *((const GAS f32x4*)bet + lane + 64 * j);
            v[j] = v[j] * rstd * gg + bb; *((GAS f32x4*)of + lane + 64 * j) = v[j]; }
        if (!which) { GAS unsigned long long* o8 = (GAS unsigned long long*)((bf16*)(F.ws + WS_X1B) + (size_t)r * D) + lane;
#pragma unroll
            for (int j = 0; j < 4; ++j) o8[64 * j] = (unsigned long long)pk2(v[j].x, v[j].y) | ((unsigned long long)pk2(v[j].z, v[j].w) << 32); }
    }
}
__device__ __forceinline__ f32x16 small_gemm(const bf16* A, int lda, const bf16* Bt, int K, int n0, int k0, int k1, int l31, int h5, f32x16 acc) {
    const bf16* ap = A + (size_t)l31 * lda + 8 * h5; const bf16* bp = Bt + (size_t)(n0 + l31) * K + 8 * h5;
#pragma unroll 1
    for (int k = k0; k < k1; k += 128) {
        bf16x8 av[8], bv[8];
#pragma unroll
        for (int j = 0; j < 8; ++j) { av[j] = *(const GAS bf16x8*)(ap + k + 16 * j); bv[j] = *(const GAS bf16x8*)(bp + k + 16 * j); }
#pragma unroll
        for (int j = 0; j < 8; ++j) acc = MFMA32(av[j], bv[j], acc);
    }
    return acc;
}
#define SMALL_TASK_LOOP(NT) for (int it = F.vcu + F.G * F.wave; it < (NT); it += F.G * NWAVES)
__device__ __forceinline__ f32x16 zero16() { f32x16 z;
#pragma unroll
    for (int i = 0; i < 16; ++i) z[i] = 0.f;
    return z; }
__device__ __forceinline__ void sample_merge_tasks(Frame& F) {
    const int l31 = F.lane & 31, h5 = F.lane >> 5; const bf16* HB = (const bf16*)(F.ws + WS_HB);
    SMALL_TASK_LOOP(32) { const int n0 = it * 32, n = n0 + l31;
        const f32x16 aa = small_gemm((const bf16*)(F.ws + WS_OA) + (size_t)MP * 512, 512, (const bf16*)(F.ws + WS_WA), 512, n0, 0, 512, l31, h5, zero16());
        const f32x16 ab = small_gemm((const bf16*)(F.ws + WS_OB) + (size_t)MP * 512, 512, (const bf16*)(F.ws + WS_WB), 512, n0, 0, 512, l31, h5, zero16());
#pragma unroll
        for (int v = 0; v < 16; ++v) { const size_t row = (size_t)(MP + crow(v, h5));
            const float g1 = sigmoidf_(bf2f(HB[row * NIN + C_MG + n])), g2 = sigmoidf_(bf2f(HB[row * NIN + C_MG + D + n]));
            ((bf16*)(F.ws + WS_MG))[row * D + n] = (bf16)f2bf(g1 * aa[v] + g2 * ab[v]); } }
}
__device__ __forceinline__ void sample_wout_tasks(Frame& F) {
    const int l31 = F.lane & 31, h5 = F.lane >> 5;
    SMALL_TASK_LOOP(32) { const int n0 = it * 32, n = n0 + l31;
        const f32x16 a = small_gemm((const bf16*)(F.ws + WS_MG) + (size_t)MP * D, D, (const bf16*)(F.ws + WS_WO), D, n0, 0, D, l31, h5, zero16());
#pragma unroll
        for (int v = 0; v < 16; ++v) { const int row = crow(v, h5); ((float*)(F.ws + WS_Z1))[(size_t)(MP + row) * D + n] = DN_ALPHA * F.in[1][(size_t)row * D + n] + a[v]; } }
}
__device__ __forceinline__ void sample_up_tasks(Frame& F) {
    const int l31 = F.lane & 31, h5 = F.lane >> 5;
    SMALL_TASK_LOOP(128) { const int n0 = it * 32, n = n0 + l31;
        const f32x16 a = small_gemm((const bf16*)(F.ws + WS_X1B) + (size_t)MP * D, D, (const bf16*)(F.ws + WS_WUP), D, n0, 0, D, l31, h5, zero16());
#pragma unroll
        for (int v = 0; v < 16; ++v) { const float x = fmaxf(a[v], 0.f); ((bf16*)(F.ws + WS_UB))[(size_t)(MP + crow(v, h5)) * FF + n] = (bf16)f2bf(x * x); } }
}
__device__ __forceinline__ void sample_down_tasks(Frame& F) {
    const int l31 = F.lane & 31, h5 = F.lane >> 5;
    SMALL_TASK_LOOP(128) { const int n0 = (it & 31) * 32, kq = it >> 5, n = n0 + l31;
        const f32x16 a = small_gemm((const bf16*)(F.ws + WS_UB) + (size_t)MP * FF, FF, (const bf16*)(F.ws + WS_WDN), FF, n0, kq * 1024, kq * 1024 + 1024, l31, h5, zero16());
#pragma unroll
        for (int v = 0; v < 16; ++v) ((float*)(F.ws + WS_Z2))[(size_t)(MP + 32 * kq + crow(v, h5)) * D + n] = a[v]; }
}

#ifdef PROBE_LAST
#ifndef PROBE_BASE
#define PROBE_BASE WS_KCP
#endif
#ifndef PROBE_BYTES
#define PROBE_BYTES (WS_TB - WS_KCP)
#endif
__device__ __forceinline__ void probe_digest(Frame& F, const XcdBarrier& bar) {
    const size_t i0 = (size_t)blockIdx.x * 512 + F.tid, st = (size_t)F.G * 512;
    for (size_t i = i0; i < OUT_TOTAL; i += st) F.out[i] = 0.f;
    xcd_barrier(bar);
    const unsigned* w = (const unsigned*)(F.ws + PROBE_BASE); const size_t nw = (size_t)(PROBE_BYTES) / 4;
    unsigned h = 0u;
    for (size_t i = i0; i < nw; i += st) h += (w[i] ^ (unsigned)i) * 2654435761u;
#pragma unroll
    for (int o = 1; o < 64; o <<= 1) h += __shfl_xor(h, o);
    if (F.lane == 0) F.out[(size_t)blockIdx.x * 8 + F.wave] = (float)(h & 0xFFFFFu);
}
#endif
struct Args { const float* in[21]; float* out; unsigned char* ws; int ph_lo, ph_hi; };
__global__ void __launch_bounds__(NWAVES * 64, 2) nsa_fwd(Args args) {
    extern __shared__ __attribute__((aligned(16))) unsigned char lds[];
    Frame F;
    F.lds = (LAS unsigned char*)lds;
    F.MISC = (volatile LAS unsigned*)(F.lds + MISC_OFF);
    F.tid = threadIdx.x; F.lane = F.tid & 63; F.wave = __builtin_amdgcn_readfirstlane(F.tid >> 6);
    F.G = gridDim.x; { const int bx = blockIdx.x; F.vcu = (F.G % 8 == 0) ? (bx % 8) * (F.G / 8) + bx / 8 : bx; }
    F.ws = args.ws; F.out = args.out;
#pragma unroll
    for (int i = 0; i < 21; ++i) F.in[i] = args.in[i];
    F.ctl = (gu32*)(F.ws + WS_CTL);
    for (int u = F.tid; u < (LDS_BYTES - LDSCTL_OFF) / 4; u += NWAVES * 64) ((LAS unsigned*)(F.lds + LDSCTL_OFF))[u] = 0u;
    __syncthreads();
    XcdBarrier bar = xcd_barrier_post((unsigned*)(F.ctl + CW_BAR), F.MISC + 8);
    const int lo = args.ph_lo, hi = args.ph_hi;
#ifdef PROBE_TIMING
    unsigned long long ts[11];
#define STAMP(k) ts[k] = rt();
#else
#define STAMP(k)
#endif
    STAMP(0)
#define IN(k) (lo <= (k) && (k) < hi)
#define BOTH(k) (IN(k) && IN((k) + 1))
#define GRID_BAR() xcd_barrier(bar)


#ifdef PROBE_LAST
#define PROBE_AFTER(k) if ((k) == PROBE_LAST) { probe_digest(F, bar); return; }
#else
#define PROBE_AFTER(k)
#endif
    if (IN(0)) { p0_prologue(F); if (BOTH(0)) GRID_BAR(); }
    PROBE_AFTER(0)
    STAMP(1)
    if (IN(1)) {
        pg8::Gemm g{(const pg8::bf16_t*)(F.ws + WS_XB), (const pg8::bf16_t*)(F.ws + WS_WIN), MALL, NIN, D}; pg8::StaticOrder S; S.init(MALL, NIN, F.G, (int)blockIdx.x);
        pg8::EpiInProj E{(pg8::bf16_t*)(F.ws + WS_HB), F.out};
        pg8::gemm_phase<pg8::EpiInProj, pg8::StaticOrder, true, true>(F.lds + RING_OFF, g, S, E);
        if (BOTH(1)) GRID_BAR();
    }
    PROBE_AFTER(1)
    STAMP(2)

    if (IN(2)) { p2_phase(F); if (BOTH(2)) GRID_BAR(); }
    PROBE_AFTER(2)
    STAMP(3)
    if (IN(3)) { p3_phase(F); if (BOTH(3)) GRID_BAR(); }
    PROBE_AFTER(3)
    STAMP(4)
    if (IN(4)) {
        { pg8::Gemm g{(const pg8::bf16_t*)(F.ws + WS_OA), (const pg8::bf16_t*)(F.ws + WS_WA), MP, D, 512}; pg8::StaticOrder S; S.init(MP, D, F.G, (int)blockIdx.x);
          pg8::EpiGateA E{(const pg8::bf16_t*)(F.ws + WS_HB), (float*)(F.ws + WS_TB)};
          pg8::gemm_phase<pg8::EpiGateA, pg8::StaticOrder, true, true>(F.lds + RING_OFF, g, S, E); }
        { pg8::Gemm g{(const pg8::bf16_t*)(F.ws + WS_OB), (const pg8::bf16_t*)(F.ws + WS_WB), MP, D, 512}; pg8::StaticOrder S; S.init(MP, D, F.G, (int)blockIdx.x);
          pg8::EpiGateB E{(const pg8::bf16_t*)(F.ws + WS_HB), (const float*)(F.ws + WS_TB), (pg8::bf16_t*)(F.ws + WS_MG)};
          pg8::gemm_phase<pg8::EpiGateB, pg8::StaticOrder, true, true>(F.lds + RING_OFF, g, S, E); }
        sample_merge_tasks(F);
        if (BOTH(4)) GRID_BAR();
    }
    PROBE_AFTER(4)
    STAMP(5)
    if (IN(5)) {
        pg8::Gemm g{(const pg8::bf16_t*)(F.ws + WS_MG), (const pg8::bf16_t*)(F.ws + WS_WO), MP, D, D}; pg8::StaticOrder S; S.init(MP, D, F.G, (int)blockIdx.x);
        pg8::EpiResid E{F.in[0], F.in[1], (float*)(F.ws + WS_Z1)};
        pg8::gemm_phase<pg8::EpiResid, pg8::StaticOrder, true, true>(F.lds + RING_OFF, g, S, E);
        sample_wout_tasks(F);
        if (BOTH(5)) GRID_BAR();
    }
    PROBE_AFTER(5)
    STAMP(6)
    if (IN(6)) { ln_phase(F, (const float*)(F.ws + WS_Z1), F.in[15], F.in[16], 0); if (BOTH(6)) GRID_BAR(); }
    PROBE_AFTER(6)
    STAMP(7)
    if (IN(7)) {
        pg8::Gemm g{(const pg8::bf16_t*)(F.ws + WS_X1B), (const pg8::bf16_t*)(F.ws + WS_WUP), MP, FF, D}; pg8::StaticOrder S; S.init(MP, FF, F.G, (int)blockIdx.x);
        pg8::EpiRelu2 E{(pg8::bf16_t*)(F.ws + WS_UB)};
        pg8::gemm_phase<pg8::EpiRelu2, pg8::StaticOrder, true, true>(F.lds + RING_OFF, g, S, E);
        sample_up_tasks(F);
        if (BOTH(7)) GRID_BAR();
    }
    PROBE_AFTER(7)
    STAMP(8)
    if (IN(8)) {
        pg8::Gemm g{(const pg8::bf16_t*)(F.ws + WS_UB), (const pg8::bf16_t*)(F.ws + WS_WDN), MP, D, FF}; pg8::StaticOrder S; S.init(MP, D, F.G, (int)blockIdx.x);
        pg8::EpiResid E{(const float*)(F.ws + WS_X1F), (const float*)(F.ws + WS_X1F) + (size_t)MP * D, (float*)(F.ws + WS_Z2)};
        pg8::gemm_phase<pg8::EpiResid, pg8::StaticOrder, true, true>(F.lds + RING_OFF, g, S, E);
        sample_down_tasks(F);
        if (BOTH(8)) GRID_BAR();
    }
    PROBE_AFTER(8)
    STAMP(9)
    if (IN(9)) { ln_phase(F, (const float*)(F.ws + WS_Z2), F.in[19], F.in[20], 1); }
#ifdef PROBE_TIMING
    GRID_BAR();
    STAMP(10)
    { const size_t i0 = (size_t)blockIdx.x * 512 + F.tid, st = (size_t)F.G * 512; for (size_t i = i0; i < OUT_TOTAL; i += st) ((unsigned*)F.out)[i] = 0xAAAAAAABu; }
    GRID_BAR();
    if (blockIdx.x == 0) {
        const size_t offs[10] = {OFF0, OFF1, OFF2, OFF3, OFF4, OFF5, OFF6, OFF7, OFF8, OFF9};
#pragma unroll
        for (int k = 0; k < 10; ++k) { const unsigned n = (unsigned)((ts[k + 1] - ts[k]) / 10ull); for (unsigned i = F.tid; i < n; i += 512) ((unsigned*)F.out)[offs[k] + i] = 0xAAAAAAAAu; }
    }
#endif
#ifdef PROBE_SANITIZE
    GRID_BAR();
    { const size_t i0 = (size_t)blockIdx.x * 512 + F.tid, st = (size_t)F.G * 512;
      for (size_t i = i0; i < OUT_TOTAL; i += st) { const float v = F.out[i]; if (!(v - v == 0.f)) F.out[i] = 0.f; } }
#endif
#undef IN
#undef BOTH
}

extern "C" void kernel_launch(void* const* d_in, const int* in_sizes, int n_in, void* d_out, int out_size, void* d_ws, size_t ws_size, hipStream_t stream) {
    static int grid = 0;
    if (grid == 0) {
        if (n_in != 21 || (size_t)out_size != OUT_TOTAL || ws_size < WS_END) { fprintf(stderr, "kernel_launch: unexpected shapes: n_in %d out %d ws %zu (need %zu)\n", n_in, out_size, ws_size, (size_t)WS_END); grid = -1; return; }
        int dev = 0, cus = 0, per_cu = 0;
        if (hipGetDevice(&dev) != hipSuccess || hipDeviceGetAttribute(&cus, hipDeviceAttributeMultiprocessorCount, dev) != hipSuccess) { grid = -1; return; }
        if (hipFuncSetAttribute((const void*)nsa_fwd, hipFuncAttributeMaxDynamicSharedMemorySize, LDS_BYTES) != hipSuccess) { fprintf(stderr, "kernel_launch: hipFuncSetAttribute failed\n"); grid = -1; return; }
        if (hipOccupancyMaxActiveBlocksPerMultiprocessor(&per_cu, (const void*)nsa_fwd, NWAVES * 64, LDS_BYTES) != hipSuccess || per_cu < 1) { fprintf(stderr, "kernel_launch: occupancy query says %d\n", per_cu); }
        (void)hipGetLastError();
        grid = cus;
    }
    if (grid < 0) return;
    if (hipMemsetAsync((char*)d_ws + WS_CTL, 0, CTL_ZERO_BYTES, stream) != hipSuccess) return;
    Args a{};
    for (int i = 0; i < 21; ++i) a.in[i] = (const float*)d_in[i];
    a.out = (float*)d_out; a.ws = (unsigned char*)d_ws; a.ph_lo = 0; a.ph_hi = 100;
    hipLaunchKernelGGL(nsa_fwd, dim3(grid), dim3(NWAVES * 64), LDS_BYTES, stream, a);
}
```

```cpp
#include <hip/hip_runtime.h>
#include <cstdio>
#include <cstdint>
namespace pg8 {
#define PG8_LAS __attribute__((address_space(3)))
typedef unsigned short bf16_t;
typedef short bf16x8 __attribute__((ext_vector_type(8)));
typedef float f32x4 __attribute__((ext_vector_type(4)));
typedef unsigned u32x4 __attribute__((ext_vector_type(4)));
constexpr int BM = 256, BK = 64, HALF = 128, HTB = HALF * BK * 2  , STAGE_BYTES = 8 * HTB, NXCD = 8, WGM = 8;

__host__ __device__ __forceinline__ int lds_byte(int r, int c) { const int st = (r >> 4) * 2 + (c >> 5), rr = r & 15, cc = c & 31, ob = rr * 64 + cc * 2; return st * 1024 + (ob ^ (((ob >> 9) & 1) << 5)); }
__host__ __device__ __forceinline__ void stage_rc(int b, int& R, int& C) { const int st = b / 1024, sb = b % 1024, swz = sb ^ (((sb >> 9) & 1) << 5); R = (st >> 1) * 16 + swz / 64; C = (st & 1) * 32 + (swz % 64) / 2; }
__host__ __device__ __forceinline__ int perm32(int rho) { const int n = rho >> 4, i = rho & 15; return 8 * (i >> 2) + 4 * n + (i & 3); }

struct Unit { int pm, pn; };
struct Gemm { const bf16_t* A; const bf16_t* Bt; int M, N, K; };

struct StaticOrder {
    int nM, nN, nwg, G, c;
    __host__ __device__ void init(int M, int N, int G_, int c_) { nM = M / BM; nN = N / BM; nwg = nM * nN; G = G_; c = c_; }
    __host__ __device__ bool next(int i, Unit& u) const {
        const long L = (long)i * G + c; if (L >= nwg) return false;
        int wgid = (int)L; { const int q = nwg / NXCD, r = nwg % NXCD, xcd = wgid % NXCD, off = wgid / NXCD; wgid = (xcd < r ? xcd * (q + 1) : r * (q + 1) + (xcd - r) * q) + off; }
        const int nig = WGM * nN, gid = wgid / nig, fm = gid * WGM, gsz = (nM - fm) < WGM ? (nM - fm) : WGM;
        u.pm = fm + ((wgid % nig) % gsz); u.pn = (wgid % nig) / gsz; return true;
    }
    __device__ __forceinline__ void a_ready(const Unit&) const {}
    __device__ __forceinline__ void done(const Unit&) const {}
};

__device__ __forceinline__ unsigned cvt_pk_bf16(float lo, float hi) { unsigned r; asm volatile("v_cvt_pk_bf16_f32 %0, %1, %2" : "=v"(r) : "v"(lo), "v"(hi)); return r; }
typedef float f32x2 __attribute__((ext_vector_type(2)));
__device__ __forceinline__ f32x2 gelu_pk(f32x2 v) {
    const f32x2 av = __builtin_elementwise_abs(v), d = av * 0.2316418882f + 1.0f;
    f32x2 t; t.x = __builtin_amdgcn_rcpf(d.x); t.y = __builtin_amdgcn_rcpf(d.y);
    f32x2 q = t * 0.5307027145f + (-0.7265760135f); q = q * t + 0.7107068705f; q = q * t + (-0.142248368f); q = q * t + 0.127414796f; q = q * t;
    const f32x2 s = (v * v) * (-0.72134752044f);
    f32x2 e; e.x = __builtin_amdgcn_exp2f(s.x); e.y = __builtin_amdgcn_exp2f(s.y);
    const f32x2 m = v * (q * e), r = v - m;
    f32x2 o; o.x = v.x < 0.f ? m.x : r.x; o.y = v.y < 0.f ? m.y : r.y; return o;
}

template <int ACT  > struct EpiBf16 {
    static constexpr bool PERM = true, AFTER_DRAIN = false; static_assert(ACT == 0 || ACT == 1, "EpiBf16: ACT is 0 (none) or 1 (gelu_pk)");
    bf16_t* O; int ldc; const float* bias; int split_cols; size_t split_stride; float scale0;
    __device__ __forceinline__ void operator()(const f32x4 (&acc)[2][2][4][2], const Unit& u, int wr, int wc, int fr, int fq) const {
        const int row0 = u.pm * BM + wr * 64 + fr; int colt = u.pn * BM; bf16_t* base = O;
        float sc = 1.f; if (split_cols) { const int t = colt / split_cols; base += (size_t)t * split_stride; colt -= t * split_cols; if (t == 0) sc = scale0; }
        const int col0 = colt + wc * 32 + 8 * fq, bcol0 = u.pn * BM + wc * 32 + 8 * fq;
        f32x4 bv[2][2];
#pragma unroll
        for (int bj = 0; bj < 2; ++bj)
#pragma unroll
            for (int n = 0; n < 2; ++n) bv[bj][n] = bias ? *(const f32x4*)(bias + bcol0 + bj * HALF + 4 * n) : (f32x4){0.f, 0.f, 0.f, 0.f};
#pragma unroll
        for (int ai = 0; ai < 2; ++ai)
#pragma unroll
            for (int m = 0; m < 4; ++m) { bf16_t* rowp = base + (size_t)(row0 + ai * HALF + m * 16) * ldc + col0;
#pragma unroll
                for (int bj = 0; bj < 2; ++bj) { f32x4 v0 = acc[ai][bj][m][0] + bv[bj][0], v1 = acc[ai][bj][m][1] + bv[bj][1];
                    if (ACT == 1) { f32x2 a = gelu_pk((f32x2){v0[0], v0[1]}), b = gelu_pk((f32x2){v0[2], v0[3]}), c = gelu_pk((f32x2){v1[0], v1[1]}), d = gelu_pk((f32x2){v1[2], v1[3]});
                        v0 = (f32x4){a.x, a.y, b.x, b.y}; v1 = (f32x4){c.x, c.y, d.x, d.y}; }
                    v0 = v0 * sc; v1 = v1 * sc; u32x4 w; w.x = cvt_pk_bf16(v0[0], v0[1]); w.y = cvt_pk_bf16(v0[2], v0[3]); w.z = cvt_pk_bf16(v1[0], v1[1]); w.w = cvt_pk_bf16(v1[2], v1[3]);
                    *(u32x4*)(rowp + bj * HALF) = w; } }
    }
};

struct PanelStats {
    unsigned* xbuf;
    unsigned* cnt;
    unsigned* tmo;
    int ntn; float eps;
    unsigned code;
    __device__ __forceinline__ bool run(const f32x4 (&v)[2][2][4][2], const Unit& u, int wr, int wc, int fr, int fq, PG8_LAS unsigned char* lds, int wid, int lane) const {
        typedef float f32x2v __attribute__((ext_vector_type(2)));
        PG8_LAS f32x2v* P = (PG8_LAS f32x2v*)lds;
        PG8_LAS f32x2v* S = (PG8_LAS f32x2v*)(lds + 8192);
        PG8_LAS unsigned* flag = (PG8_LAS unsigned*)(lds + 8192 + 2048);
#pragma unroll
        for (int ai = 0; ai < 2; ++ai)
#pragma unroll
            for (int m = 0; m < 4; ++m) {
                float s = 0.f;
#pragma unroll
                for (int bj = 0; bj < 2; ++bj)
#pragma unroll
                    for (int n = 0; n < 2; ++n) { const f32x4 x = v[ai][bj][m][n]; s += (x[0] + x[1]) + (x[2] + x[3]); }
                s += __shfl_xor(s, 16); s += __shfl_xor(s, 32);
                const float mw = s * (1.0f / 64.0f); float q = 0.f;
#pragma unroll
                for (int bj = 0; bj < 2; ++bj)
#pragma unroll
                    for (int n = 0; n < 2; ++n) { const f32x4 d = v[ai][bj][m][n] - mw; q += (d[0] * d[0] + d[1] * d[1]) + (d[2] * d[2] + d[3] * d[3]); }
                q += __shfl_xor(q, 16); q += __shfl_xor(q, 32);
                if (fq == 0) P[(ai * HALF + wr * 64 + m * 16 + fr) * 4 + wc] = (f32x2v){mw, q};
            }
        asm volatile("s_waitcnt lgkmcnt(0)" ::: "memory"); __builtin_amdgcn_s_barrier(); asm volatile("" ::: "memory");
#if defined(BROKEN_EXCHANGE_NO_WAIT)
#warning BROKEN CONTROL BUILD: the row-statistics exchange does not wait; results are wrong by design
        if (blockIdx.x >= 64) { const long long t0_ = clock64(); while (clock64() - t0_ < 60000) __builtin_amdgcn_s_sleep(8); }
#endif
        const int row = wid * 32 + (lane & 31);
        if (lane < 32) {
            const f32x2v a = P[row * 4 + 0], b = P[row * 4 + 1], c = P[row * 4 + 2], d = P[row * 4 + 3];
            const float mt = (a.x + b.x + c.x + d.x) * 0.25f;
            const float da = a.x - mt, db = b.x - mt, dc = c.x - mt, dd = d.x - mt;
            const float m2 = (a.y + b.y) + (c.y + d.y) + 64.0f * ((da * da + db * db) + (dc * dc + dd * dd));
            unsigned long long* slot = (unsigned long long*)xbuf + ((size_t)(u.pm * BM + row) * 4 + u.pn);
            __hip_atomic_store(slot, ((unsigned long long)__float_as_uint(m2) << 32) | __float_as_uint(mt), __ATOMIC_RELAXED, __HIP_MEMORY_SCOPE_AGENT);
        }
        asm volatile("s_waitcnt vmcnt(0)" ::: "memory");
        if (lane == 0) __hip_atomic_fetch_add(cnt + 64 * u.pm, 1u, __ATOMIC_RELAXED, __HIP_MEMORY_SCOPE_AGENT);
        if (wid == 0) {
            bool dead = false; const unsigned long long t0 = __builtin_amdgcn_s_memrealtime(); const unsigned want = 8u * (unsigned)ntn;
            for (;;) {
#if defined(BROKEN_EXCHANGE_NO_WAIT)
                break;
#endif
                if ((unsigned)__builtin_amdgcn_readfirstlane(__hip_atomic_load(cnt + 64 * u.pm, __ATOMIC_RELAXED, __HIP_MEMORY_SCOPE_AGENT)) >= want) break;
                if (__builtin_amdgcn_s_memrealtime() - t0 > 2000000ull) {
                    if (lane == 0) { unsigned expect = 0u; __hip_atomic_compare_exchange_strong(tmo + 1, &expect, code | (unsigned)(u.pm & 0xff), __ATOMIC_RELAXED, __ATOMIC_RELAXED, __HIP_MEMORY_SCOPE_AGENT);
                                     __hip_atomic_store(tmo, 1u, __ATOMIC_RELAXED, __HIP_MEMORY_SCOPE_AGENT); }
                    dead = true; break; }
                __builtin_amdgcn_s_sleep(2);
            }
            __builtin_amdgcn_fence(__ATOMIC_ACQUIRE, "agent");
            if (lane == 0) flag[0] = dead ? 1u : 0u;
        }
        asm volatile("s_waitcnt vmcnt(0) lgkmcnt(0)" ::: "memory"); __builtin_amdgcn_s_barrier(); asm volatile("" ::: "memory");
        const bool bad = flag[0] != 0u;
        if (lane < 32) {
            const unsigned long long* slot = (const unsigned long long*)xbuf + (size_t)(u.pm * BM + row) * 4; float mt[4], m2[4]; float ms = 0.f;
#pragma unroll
            for (int t = 0; t < 4; ++t) { if (t < ntn) { const unsigned long long w = __hip_atomic_load(slot + t, __ATOMIC_RELAXED, __HIP_MEMORY_SCOPE_AGENT); mt[t] = __uint_as_float((unsigned)w); m2[t] = __uint_as_float((unsigned)(w >> 32)); } else { mt[t] = 0.f; m2[t] = 0.f; } ms += mt[t]; }
            const float mean = ms / (float)ntn; float q = 0.f;
#pragma unroll
            for (int t = 0; t < 4; ++t) if (t < ntn) { const float dm = mt[t] - mean; q += m2[t] + 256.0f * dm * dm; }
            S[row] = (f32x2v){mean, 1.0f / sqrtf(q / (256.0f * (float)ntn) + eps)};
        }
        asm volatile("s_waitcnt lgkmcnt(0)" ::: "memory"); __builtin_amdgcn_s_barrier(); asm volatile("" ::: "memory");
        return bad;
    }
};
struct EpiLnRes {
    static constexpr bool PERM = false, AFTER_DRAIN = true;
    const float* base; float* out; int ldc; const float* bias; PanelStats st; unsigned poison;
    __device__ __forceinline__ void fused(f32x4 (&acc)[2][2][4][2], const Unit& u, int wr, int wc, int fr, int fq, PG8_LAS unsigned char* lds, int wid, int lane) const {
        typedef float f32x2v __attribute__((ext_vector_type(2)));
        const PG8_LAS f32x2v* S = (const PG8_LAS f32x2v*)(lds + 8192);
        const int col0 = u.pn * BM + wc * 32 + 4 * fq;
#pragma unroll
        for (int bj = 0; bj < 2; ++bj)
#pragma unroll
            for (int n = 0; n < 2; ++n) { const f32x4 bv = bias ? *(const f32x4*)(bias + col0 + bj * HALF + n * 16) : (f32x4){0.f, 0.f, 0.f, 0.f};
#pragma unroll
                for (int ai = 0; ai < 2; ++ai)
#pragma unroll
                    for (int m = 0; m < 4; ++m) acc[ai][bj][m][n] += bv; }
        f32x4 pre[4][2][2];
#pragma unroll
        for (int m = 0; m < 4; ++m) { const size_t off = (size_t)(u.pm * BM + wr * 64 + m * 16 + fr) * ldc + col0;
#pragma unroll
            for (int bj = 0; bj < 2; ++bj)
#pragma unroll
                for (int n = 0; n < 2; ++n) pre[m][bj][n] = *(const f32x4*)(base + off + bj * HALF + n * 16); }
        const bool bad = st.run(acc, u, wr, wc, fr, fq, lds, wid, lane) || poison != 0u;
        const float qnan = __builtin_nanf("");
#pragma unroll
        for (int ai = 0; ai < 2; ++ai)
#pragma unroll
            for (int m = 0; m < 4; ++m) { const int r = ai * HALF + wr * 64 + m * 16 + fr; const f32x2v sr = S[r]; const size_t off = (size_t)(u.pm * BM + r) * ldc + col0;
#pragma unroll
                for (int bj = 0; bj < 2; ++bj)
#pragma unroll
                    for (int n = 0; n < 2; ++n) { const f32x4 bs = ai == 0 ? pre[m][bj][n] : *(const f32x4*)(base + off + bj * HALF + n * 16); f32x4 o = bs + (acc[ai][bj][m][n] - sr.x) * sr.y;
                        if (bad) o = (f32x4){qnan, qnan, qnan, qnan}; *(f32x4*)(out + off + bj * HALF + n * 16) = o; }
                if (m & 1) asm volatile("" ::: "memory"); }
    }
};
struct EpiLnResLn {
    static constexpr bool PERM = false, AFTER_DRAIN = true;
    const float* base; float* out; bf16_t* xn; int ldc; const float* bias; PanelStats st1, st2; unsigned poison;
    __device__ __forceinline__ void fused(f32x4 (&acc)[2][2][4][2], const Unit& u, int wr, int wc, int fr, int fq, PG8_LAS unsigned char* lds, int wid, int lane) const {
        typedef float f32x2v __attribute__((ext_vector_type(2))); typedef unsigned u32x2v __attribute__((ext_vector_type(2)));
        const PG8_LAS f32x2v* S = (const PG8_LAS f32x2v*)(lds + 8192);
        const int col0 = u.pn * BM + wc * 32 + 4 * fq;
#pragma unroll
        for (int bj = 0; bj < 2; ++bj)
#pragma unroll
            for (int n = 0; n < 2; ++n) { const f32x4 bv = bias ? *(const f32x4*)(bias + col0 + bj * HALF + n * 16) : (f32x4){0.f, 0.f, 0.f, 0.f};
#pragma unroll
                for (int ai = 0; ai < 2; ++ai)
#pragma unroll
                    for (int m = 0; m < 4; ++m) acc[ai][bj][m][n] += bv; }
        bool bad = st1.run(acc, u, wr, wc, fr, fq, lds, wid, lane) || poison != 0u;
        const float qnan = __builtin_nanf("");
#pragma unroll
        for (int ai = 0; ai < 2; ++ai)
#pragma unroll
            for (int m = 0; m < 4; ++m) { const int r = ai * HALF + wr * 64 + m * 16 + fr; const f32x2v sr = S[r]; const size_t off = (size_t)(u.pm * BM + r) * ldc + col0;
#pragma unroll
                for (int bj = 0; bj < 2; ++bj)
#pragma unroll
                    for (int n = 0; n < 2; ++n) { const f32x4 bs = *(const f32x4*)(base + off + bj * HALF + n * 16); acc[ai][bj][m][n] = bs + (acc[ai][bj][m][n] - sr.x) * sr.y; }
                asm volatile("" : "+v"(acc[ai][0][m][0]), "+v"(acc[ai][0][m][1]), "+v"(acc[ai][1][m][0]), "+v"(acc[ai][1][m][1]));
                if (m & 1) asm volatile("" ::: "memory"); }
        const bool bad1 = bad;
        bad = st2.run(acc, u, wr, wc, fr, fq, lds, wid, lane) || bad;
#pragma unroll
        for (int ai = 0; ai < 2; ++ai)
#pragma unroll
            for (int m = 0; m < 4; ++m) { const int r = ai * HALF + wr * 64 + m * 16 + fr; const f32x2v sr = S[r]; const size_t off = (size_t)(u.pm * BM + r) * ldc + col0;
#pragma unroll
                for (int bj = 0; bj < 2; ++bj)
#pragma unroll
                    for (int n = 0; n < 2; ++n) { const f32x4 x1 = acc[ai][bj][m][n]; *(f32x4*)(out + off + bj * HALF + n * 16) = bad1 ? (f32x4){qnan, qnan, qnan, qnan} : x1;
                        const f32x4 o = (x1 - sr.x) * sr.y; u32x2v w; w.x = cvt_pk_bf16(o[0], o[1]); w.y = cvt_pk_bf16(o[2], o[3]);
                        if (bad) { w.x = 0x7fc07fc0u; w.y = 0x7fc07fc0u; } *(u32x2v*)(xn + off + bj * HALF + n * 16) = w; }
                asm volatile("" ::: "memory"); }
    }
};

template <class Epi, class Sched, bool ALIGN_EPI = false, bool SP2 = false>
__device__ __forceinline__ void gemm_phase(PG8_LAS unsigned char* lds, const Gemm g, const Sched& S, const Epi& E) {
    const int tid = threadIdx.x, wid = __builtin_amdgcn_readfirstlane(tid >> 6), lane = tid & 63, wr = wid >> 2, wc = wid & 3, fr = lane & 15, fq = lane >> 4;
    const int K = g.K, nt = K / BK;
    unsigned voffA[2], voffB[2];
#pragma unroll
    for (int i = 0; i < 2; ++i) { int R, C; stage_rc(tid * 16 + i * 8192, R, C); const int Rb = Epi::PERM ? ((R & ~31) + perm32(R & 31)) : R;
        voffA[i] = (unsigned)(R * K + C) * 2u; voffB[i] = (unsigned)(Rb * K + C) * 2u; }
    const size_t kstep = (size_t)(BK * 2);
    const size_t hstep = (size_t)HALF * K * 2;
    const size_t tstep = 2 * hstep;
    const unsigned ldsw = (unsigned)wid * 1024u;
    const int aoff = lds_byte(wr * 64 + fr, fq * 8), boff = lds_byte(wc * 32 + fr, fq * 8);
#define PG8_SA(b, h) (((b) * 2 + (h)) * HTB)
#define PG8_SB(b, h) ((4 + (b) * 2 + (h)) * HTB)
#define PG8_STAGE(bufoff, gbase, voff) do { _Pragma("unroll") for (int _i = 0; _i < 2; ++_i) \
        __builtin_amdgcn_global_load_lds((const unsigned*)((const char*)(gbase) + (voff)[_i]), (PG8_LAS unsigned*)(lds + (bufoff) + ldsw + _i * 8192), 16, 0, 0); } while (0)
#define PG8_LDA(dst, b, h) do { _Pragma("unroll") for (int m = 0; m < 4; ++m) _Pragma("unroll") for (int k = 0; k < 2; ++k) dst[m][k] = *(const PG8_LAS bf16x8*)(lds + PG8_SA(b, h) + aoff + m * 2048 + k * 1024); } while (0)
#define PG8_LDB(dst, b, h) do { _Pragma("unroll") for (int n = 0; n < 2; ++n) _Pragma("unroll") for (int k = 0; k < 2; ++k) dst[n][k] = *(const PG8_LAS bf16x8*)(lds + PG8_SB(b, h) + boff + n * 2048 + k * 1024); } while (0)
#define PG8_MMA(ai, bj, At, Bt) do { __builtin_amdgcn_s_setprio(1); _Pragma("unroll") for (int m = 0; m < 4; ++m) _Pragma("unroll") for (int n = 0; n < 2; ++n) _Pragma("unroll") for (int k = 0; k < 2; ++k) \
        acc[ai][bj][m][n] = __builtin_amdgcn_mfma_f32_16x16x32_bf16(Bt[n][k], At[m][k], acc[ai][bj][m][n], 0, 0, 0); __builtin_amdgcn_s_setprio(0); } while (0)
#define PG8_WAIT_V(n) asm volatile("s_waitcnt vmcnt(" #n ")" ::: "memory")
#define PG8_WAIT_L(n) asm volatile("s_waitcnt lgkmcnt(" #n ")" ::: "memory")
#define PG8_BAR __builtin_amdgcn_s_barrier()
#define PG8_SCHED __builtin_amdgcn_sched_barrier(0)
    Unit cur, nxt; int ui = 0;
    if (!S.next(0, cur)) return;
    f32x4 acc[2][2][4][2];
#pragma unroll
    for (int a = 0; a < 2; ++a)
#pragma unroll
        for (int b = 0; b < 2; ++b)
#pragma unroll
            for (int m = 0; m < 4; ++m)
#pragma unroll
                for (int n = 0; n < 2; ++n) acc[a][b][m][n] = (f32x4){0.f, 0.f, 0.f, 0.f};
    bf16x8 At[4][2], B0[2][2], B1[2][2];
    const char* cA = (const char*)g.A + (size_t)cur.pm * tstep; const char* cB = (const char*)g.Bt + (size_t)cur.pn * tstep;
    S.a_ready(cur);
    if constexpr (SP2) {
        PG8_STAGE(PG8_SB(0, 0), cB, voffB); PG8_STAGE(PG8_SB(0, 1), cB + hstep, voffB); PG8_STAGE(PG8_SA(0, 0), cA, voffA); PG8_STAGE(PG8_SA(0, 1), cA + hstep, voffA);
        if (wr == 1) PG8_BAR;
        PG8_WAIT_V(2); PG8_BAR;
        PG8_STAGE(PG8_SB(1, 0), cB + kstep, voffB); PG8_STAGE(PG8_SA(1, 0), cA + kstep, voffA); PG8_STAGE(PG8_SB(1, 1), cB + hstep + kstep, voffB);
        PG8_WAIT_V(6); PG8_BAR;
    } else {
        PG8_STAGE(PG8_SB(0, 0), cB, voffB); PG8_STAGE(PG8_SA(0, 0), cA, voffA); PG8_STAGE(PG8_SB(0, 1), cB + hstep, voffB); PG8_STAGE(PG8_SA(0, 1), cA + hstep, voffA);
        if (wr == 1) PG8_BAR;
        PG8_WAIT_V(4); PG8_BAR;
        PG8_STAGE(PG8_SB(1, 0), cB + kstep, voffB); PG8_STAGE(PG8_SA(1, 0), cA + kstep, voffA); PG8_STAGE(PG8_SB(1, 1), cB + hstep + kstep, voffB);
        PG8_WAIT_V(6); PG8_BAR;
    }
    for (;;) {
        const bool has_next = S.next(ui + 1, nxt);
        const char* nA = has_next ? (const char*)g.A + (size_t)nxt.pm * tstep : cA; const char* nB = has_next ? (const char*)g.Bt + (size_t)nxt.pn * tstep : cB;
        for (int t = 0; t < nt; t += 2) {
            const bool last = (t == nt - 2);
            const char* a1 = cA + (size_t)(t + 1) * kstep;
            const char* a2 = last ? nA : cA + (size_t)(t + 2) * kstep; const char* b2 = last ? nB : cB + (size_t)(t + 2) * kstep;
            const char* a3 = a2 + kstep; const char* b3 = b2 + kstep;
            if (last && has_next) S.a_ready(nxt);
            if constexpr (SP2) {
            PG8_LDB(B0, 0, 0); PG8_LDB(B1, 0, 1); PG8_SCHED; PG8_LDA(At, 0, 0); PG8_STAGE(PG8_SA(1, 1), a1 + hstep, voffA);
            PG8_WAIT_V(8); PG8_WAIT_L(0); PG8_BAR; PG8_MMA(0, 0, At, B0); PG8_MMA(0, 1, At, B1); PG8_BAR; PG8_SCHED;
            PG8_LDA(At, 0, 1); PG8_STAGE(PG8_SB(0, 0), b2, voffB); PG8_STAGE(PG8_SB(0, 1), b2 + hstep, voffB); PG8_STAGE(PG8_SA(0, 0), a2, voffA);
            PG8_WAIT_V(8); PG8_WAIT_L(0); PG8_BAR; PG8_MMA(1, 0, At, B0); PG8_MMA(1, 1, At, B1); PG8_BAR; PG8_SCHED;
            PG8_LDB(B0, 1, 0); PG8_LDB(B1, 1, 1); PG8_SCHED; PG8_LDA(At, 1, 0); PG8_STAGE(PG8_SA(0, 1), a2 + hstep, voffA);
            PG8_WAIT_V(8); PG8_WAIT_L(0); PG8_BAR; PG8_MMA(0, 0, At, B0); PG8_MMA(0, 1, At, B1); PG8_BAR; PG8_SCHED;
            PG8_LDA(At, 1, 1); PG8_STAGE(PG8_SB(1, 0), b3, voffB); PG8_STAGE(PG8_SB(1, 1), b3 + hstep, voffB); PG8_STAGE(PG8_SA(1, 0), a3, voffA);
            PG8_WAIT_V(8); PG8_WAIT_L(0); PG8_BAR; PG8_MMA(1, 0, At, B0); PG8_MMA(1, 1, At, B1); PG8_BAR; PG8_SCHED;
            } else {
            PG8_LDB(B0, 0, 0); PG8_SCHED; PG8_LDA(At, 0, 0); PG8_STAGE(PG8_SA(1, 1), a1 + hstep, voffA);
            PG8_WAIT_L(8); PG8_BAR; PG8_WAIT_L(0); PG8_MMA(0, 0, At, B0); PG8_BAR; PG8_SCHED;
            PG8_LDB(B1, 0, 1); PG8_STAGE(PG8_SB(0, 0), b2, voffB);
            PG8_BAR; PG8_WAIT_L(0); PG8_MMA(0, 1, At, B1); PG8_BAR;
            PG8_LDA(At, 0, 1); PG8_STAGE(PG8_SA(0, 0), a2, voffA);
            PG8_BAR; PG8_WAIT_L(0); PG8_MMA(1, 0, At, B0); PG8_BAR; PG8_SCHED;
            PG8_STAGE(PG8_SB(0, 1), b2 + hstep, voffB);
            PG8_WAIT_V(6); PG8_BAR; PG8_MMA(1, 1, At, B1); PG8_BAR;
            PG8_LDB(B0, 1, 0); PG8_SCHED; PG8_LDA(At, 1, 0); PG8_STAGE(PG8_SA(0, 1), a2 + hstep, voffA);
            PG8_WAIT_L(8); PG8_BAR; PG8_WAIT_L(0); PG8_MMA(0, 0, At, B0); PG8_BAR; PG8_SCHED;
            PG8_LDB(B1, 1, 1); PG8_STAGE(PG8_SB(1, 0), b3, voffB);
            PG8_BAR; PG8_WAIT_L(0); PG8_MMA(0, 1, At, B1); PG8_BAR;
            PG8_LDA(At, 1, 1); PG8_STAGE(PG8_SA(1, 0), a3, voffA);
            PG8_BAR; PG8_WAIT_L(0); PG8_MMA(1, 0, At, B0); PG8_BAR; PG8_SCHED;
            PG8_STAGE(PG8_SB(1, 1), b3 + hstep, voffB);
            PG8_WAIT_V(6); PG8_BAR; PG8_MMA(1, 1, At, B1); PG8_BAR;
            }
        }
        if constexpr (ALIGN_EPI) { if (wr == 0) PG8_BAR; }
        if constexpr (!Epi::AFTER_DRAIN) { E(acc, cur, wr, wc, fr, fq); S.done(cur); }
        if (!has_next) break;
#pragma unroll
        for (int a = 0; a < 2; ++a)
#pragma unroll
            for (int b = 0; b < 2; ++b)
#pragma unroll
                for (int m = 0; m < 4; ++m)
#pragma unroll
                    for (int n = 0; n < 2; ++n) acc[a][b][m][n] = (f32x4){0.f, 0.f, 0.f, 0.f};
        cur = nxt; cA = nA; cB = nB; ++ui;
        if constexpr (ALIGN_EPI) { if (wr == 1) PG8_BAR; }
    }
    PG8_WAIT_V(0);
    if constexpr (!ALIGN_EPI) { if (wr == 0) PG8_BAR; }
    PG8_BAR;
    if constexpr (Epi::AFTER_DRAIN) { E.fused(acc, cur, wr, wc, fr, fq, lds, wid, lane); S.done(cur); }
#undef PG8_SA
#undef PG8_SB
#undef PG8_STAGE
#undef PG8_LDA
#undef PG8_LDB
#undef PG8_MMA
#undef PG8_WAIT_V
#undef PG8_WAIT_L
#undef PG8_BAR
#undef PG8_SCHED
}
}
#define GAS __attribute__((address_space(1)))
#define LAS __attribute__((address_space(3)))
typedef unsigned short bf16;
typedef unsigned v4u __attribute__((ext_vector_type(4)));
typedef float f32x4 __attribute__((ext_vector_type(4)));
typedef short bf16x8 __attribute__((ext_vector_type(8)));
typedef GAS unsigned gu32;
typedef GAS unsigned long long gu64;
#define RLX_AGENT __ATOMIC_RELAXED, __HIP_MEMORY_SCOPE_AGENT
#define LDS_WAIT() asm volatile("s_waitcnt lgkmcnt(0)" ::: "memory")
#define VM_WAIT() asm volatile("s_waitcnt vmcnt(0)" ::: "memory")
__device__ __forceinline__ unsigned long long rt() { return __builtin_amdgcn_s_memrealtime(); }
__device__ __forceinline__ unsigned f2bf(float f) { unsigned u = __builtin_bit_cast(unsigned, f); return (u + 0x7fffu + ((u >> 16) & 1u)) >> 16; }
__device__ __forceinline__ unsigned pk2(float lo, float hi) { return f2bf(lo) | (f2bf(hi) << 16); }

#define XB_TMO      128
#define XB_XCNT(j)  (256  + 64 * (j))
#define XB_XSUB(j)  (1280 + 64 * (j))
#define XB_XGEN(j)  (2304 + 64 * (j))
#define XB_TOP      3328
#define XB_TOPGEN   3392
#define XCD_BAR_WORDS 3456
#define XB_SPIN_CAP (1u << 18)

__device__ __forceinline__ unsigned xb_ld(unsigned* p)              { return __hip_atomic_load(p, __ATOMIC_RELAXED, __HIP_MEMORY_SCOPE_AGENT); }
__device__ __forceinline__ unsigned xb_add(unsigned* p, unsigned v) { return __hip_atomic_fetch_add(p, v, __ATOMIC_RELAXED, __HIP_MEMORY_SCOPE_AGENT); }
__device__ __forceinline__ unsigned xb_xcc_id() { return (unsigned)__builtin_amdgcn_s_getreg((3 << 11) | 20) & 0xFu; }
#define XB_SPIN(cond, bar) do { unsigned _sp = 0; while (cond) { __builtin_amdgcn_s_sleep(1); \
    if ((++_sp & 255u) == 0u) { if (xb_ld(&(bar)[XB_TMO])) break; if (_sp > XB_SPIN_CAP) { atomicAdd(&(bar)[XB_TMO], 1u); break; } } } } while (0)

struct XcdBarrier {
    unsigned* bar; unsigned x;
    volatile LAS unsigned* st;
};

__device__ __forceinline__ XcdBarrier xcd_barrier_post(unsigned* bar, volatile LAS unsigned* st) {
    XcdBarrier b; b.bar = bar; b.x = xb_xcc_id(); b.st = st;
    if (threadIdx.x == 0) (void)xb_add(&bar[XB_XCNT(b.x)], 1u);
    return b;
}
__device__ __forceinline__ void xcd_barrier_complete(unsigned* bar, unsigned x, unsigned& nloc, unsigned& nx) {
    const unsigned G = gridDim.x * gridDim.y * gridDim.z;
    unsigned sum, cnt, mine, sp = 0u;
    for (;;) {
        sum = 0u; cnt = 0u; mine = 0u;
#pragma unroll
        for (unsigned j = 0; j < 16; ++j) { const unsigned c = xb_ld(&bar[XB_XCNT(j)]); sum += c; cnt += (c > 0u) ? 1u : 0u; mine = (j == x) ? c : mine; }
        if (sum == G) break;
        __builtin_amdgcn_s_sleep(1);
        if ((++sp & 255u) == 0u) { if (xb_ld(&bar[XB_TMO])) break; if (sp > XB_SPIN_CAP) { atomicAdd(&bar[XB_TMO], 1u); break; } }
    }
    nloc = mine > 0u ? mine : 1u; nx = cnt > 0u ? cnt : 1u;
}

__device__ __forceinline__ void xcd_barrier(const XcdBarrier& b) {
    asm volatile("s_waitcnt vmcnt(0)" ::: "memory");
    __syncthreads();
    if (threadIdx.x == 0) {
        unsigned* bar = b.bar;
        __builtin_amdgcn_s_waitcnt(0);
        unsigned nloc = b.st[0], nx = b.st[1];
        if (nloc == 0u) { xcd_barrier_complete(bar, b.x, nloc, nx); b.st[0] = nloc; b.st[1] = nx; }
        const unsigned old = xb_add(&bar[XB_XSUB(b.x)], 1u);
        const unsigned gen = old / nloc;
        if (old + 1u == (gen + 1u) * nloc) {
            __builtin_amdgcn_fence(__ATOMIC_RELEASE, "agent");
            asm volatile("s_waitcnt vmcnt(0)" ::: "memory");
            const unsigned og = xb_add(&bar[XB_TOP], 1u);
            const unsigned tg = og / nx;
            if (og + 1u == (tg + 1u) * nx) xb_add(&bar[XB_TOPGEN], 1u);
            else XB_SPIN(xb_ld(&bar[XB_TOPGEN]) == tg, bar);
            __builtin_amdgcn_fence(__ATOMIC_ACQUIRE, "agent");
            xb_add(&bar[XB_XGEN(b.x)], 1u);
            asm volatile("s_waitcnt vmcnt(0)" ::: "memory");
        } else {
            XB_SPIN(xb_ld(&bar[XB_XGEN(b.x)]) == gen, bar);
            __builtin_amdgcn_fence(__ATOMIC_ACQUIRE, "agent");
            asm volatile("s_waitcnt vmcnt(0)" ::: "memory");
        }
    }
    __syncthreads();
}
constexpr int NWAVES = 8;
constexpr int T = 8192, NBATCH = 2, MP = NBATCH * T, MS = 32, MALL = 16640, D = 1024, NIN = 6656, FF = 4096;
constexpr int C_QA = 0, C_KVC = 512, C_KVS = 768, C_KVW = 1024, C_QB = 1280, C_FB = 2304, C_IB = 3328, C_GB = 3840, C_MG = 4352, C_GLA = 6400;
constexpr int PAST = 16384, NPAGES = 128, NCMP_S = 1023, NCMP_P = 511;
constexpr float LN_EPS = 1e-5f;
constexpr float DN_ALPHA = 1.189207115002721f;
constexpr size_t OFF0 = 0, OFF1 = OFF0 + (size_t)MP * D, OFF2 = OFF1 + (size_t)MS * D, OFF3 = OFF2 + (size_t)MP * 256, OFF4 = OFF3 + (size_t)MP * 256,
                 OFF5 = OFF4 + (size_t)NBATCH * 512 * 256, OFF6 = OFF5 + (size_t)NBATCH * 8 * 128 * 64, OFF7 = OFF6 + (size_t)MS * 256, OFF8 = OFF7 + (size_t)MS * 256,
                 OFF9 = OFF8 + (size_t)MS * 512 * 256, OUT_TOTAL = OFF9 + (size_t)MS * 8 * 128 * 64;
constexpr size_t MiB = 1u << 20;
constexpr size_t al(size_t x) { return (x + MiB - 1) / MiB * MiB; }
constexpr size_t WS_CTL = 0, CTL_ZERO_BYTES = 1 * MiB;
constexpr size_t WS_WIN = 2 * MiB;
constexpr size_t WS_WA = WS_WIN + al((size_t)NIN * D * 2);
constexpr size_t WS_WB = WS_WA + al((size_t)D * 512 * 2);
constexpr size_t WS_WO = WS_WB + al((size_t)D * 512 * 2);
constexpr size_t WS_WUP = WS_WO + al((size_t)D * D * 2);
constexpr size_t WS_WDN = WS_WUP + al((size_t)FF * D * 2);
constexpr size_t WS_WC = WS_WDN + al((size_t)FF * D * 2);
constexpr size_t WS_SMALL = WS_WC + al((size_t)2 * 64 * 2048 * 2);
constexpr size_t WS_XB = WS_SMALL + MiB;
constexpr size_t WS_HB = WS_XB + al((size_t)MALL * D * 2);
constexpr size_t WS_KCP = WS_HB + al((size_t)MALL * NIN * 2);
constexpr size_t WS_VCTP = WS_KCP + MiB;
constexpr size_t WS_KCVS = WS_VCTP + MiB;
constexpr size_t WS_VST = WS_KCVS + al((size_t)MS * 1024 * 256 * 4);
constexpr size_t WS_VWT = WS_VST + al((size_t)4 * 64 * T * 2);
constexpr size_t WS_OA = WS_VWT + al((size_t)4 * 64 * T * 2);
constexpr size_t WS_OB = WS_OA + al((size_t)MALL * 512 * 2);
constexpr size_t WS_HGL = WS_OB + al((size_t)MALL * 512 * 2);
constexpr size_t WS_HGD = WS_HGL + al((size_t)16 * 16 * 8192 * 4);
constexpr size_t WS_TB = WS_HGD + MiB;
constexpr size_t WS_MG = WS_TB + al((size_t)MALL * D * 4);
constexpr size_t WS_Z1 = WS_MG + al((size_t)MALL * D * 2);
constexpr size_t WS_X1F = WS_Z1 + al((size_t)MALL * D * 4);
constexpr size_t WS_X1B = WS_X1F + al((size_t)MALL * D * 4);
constexpr size_t WS_UB = WS_X1B + al((size_t)MALL * D * 2);
constexpr size_t WS_Z2 = WS_UB + al((size_t)MALL * FF * 2);
constexpr size_t WS_KSC = WS_Z2 + al((size_t)MALL * D * 4);
constexpr size_t WS_KWC = WS_KSC + al((size_t)4 * T * 64 * 2);
constexpr size_t WS_OTS = WS_KWC + al((size_t)4 * T * 64 * 2);
constexpr size_t WS_END = WS_OTS + al((size_t)256 * 32 * 512 * 4);
constexpr int CW_TMO = 0, CW_CODE = 1, CW_BAR = 4096;
constexpr int RING_OFF = 0, RING_BYTES = 131072;
constexpr int LDSCTL_OFF = RING_BYTES, MISC_OFF = LDSCTL_OFF + 320;
constexpr int LDS_BYTES = 147456;

namespace pg8 {
struct EpiInProj {
    static constexpr bool PERM = true, AFTER_DRAIN = false;
    bf16_t* HB; float* out;
    __device__ __forceinline__ void operator()(const f32x4 (&acc)[2][2][4][2], const Unit& u, int wr, int wc, int fr, int fq) const {
        const int row0 = u.pm * BM + wr * 64 + fr, cc0 = wc * 32 + 8 * fq, col0 = u.pn * BM + cc0;
#pragma unroll
        for (int ai = 0; ai < 2; ++ai)
#pragma unroll
            for (int m = 0; m < 4; ++m) {
                const int r = row0 + ai * HALF + m * 16;
                bf16_t* rowp = HB + (size_t)r * NIN + col0;
                float* fdst = nullptr;
                if (u.pn == 2) { if (r < MP) fdst = out + OFF2 + (size_t)r * 256; else if (r < MP + MS) fdst = out + OFF6 + (size_t)(r - MP) * 256; }
                else if (u.pn == 3) { if (r < MP) fdst = out + OFF3 + (size_t)r * 256; else if (r < MP + MS) fdst = out + OFF7 + (size_t)(r - MP) * 256; }
                else if (u.pn == 4) { if (r < MP) { const int t = r & (T - 1), b = r >> 13; if (t >= T - 512) fdst = out + OFF4 + (size_t)(b * 512 + t - (T - 512)) * 256; }
                                      else if (r < MP + MS) fdst = out + OFF8 + ((size_t)(r - MP) * 512 + 511) * 256; }
#pragma unroll
                for (int bj = 0; bj < 2; ++bj) { const f32x4 v0 = acc[ai][bj][m][0], v1 = acc[ai][bj][m][1];
                    u32x4 w; w.x = cvt_pk_bf16(v0[0], v0[1]); w.y = cvt_pk_bf16(v0[2], v0[3]); w.z = cvt_pk_bf16(v1[0], v1[1]); w.w = cvt_pk_bf16(v1[2], v1[3]);
                    *(u32x4*)(rowp + bj * HALF) = w;
                    if (fdst) { *(f32x4*)(fdst + cc0 + bj * HALF) = v0; *(f32x4*)(fdst + cc0 + bj * HALF + 4) = v1; } }
            }
    }
};
}

struct Frame {
    LAS unsigned char* lds;
    volatile LAS unsigned* MISC;
    gu32* ctl;
    int tid, lane, wave;
    int vcu, G;
    const float* in[21]; float* out; unsigned char* ws;
};
__device__ __forceinline__ float bf2f(unsigned short b) { return __uint_as_float(((unsigned)b) << 16); }
typedef float f32x2_t __attribute__((ext_vector_type(2))); typedef __bf16 bf16x2_t __attribute__((ext_vector_type(2)));
__device__ __forceinline__ unsigned cvtpk(float lo, float hi) { f32x2_t v = {lo, hi}; bf16x2_t b = __builtin_convertvector(v, bf16x2_t); return __builtin_bit_cast(unsigned, b); }
__device__ __forceinline__ float wave_sum(float v) {
#pragma unroll
    for (int o = 1; o < 64; o <<= 1) v += __shfl_xor(v, o);
    return v;
}
__device__ __forceinline__ float sigmoidf_(float x) { return 1.0f / (1.0f + __expf(-x)); }

__device__ __forceinline__ void p0_transpose_item(const float* W, int K, int Nsrc, bf16* WT, int k0, int n0, int s0, int nvalid, LAS float* scr, int lane) {
#pragma unroll 8
    for (int i = 0; i < 32; ++i) { const int kk = 2 * i + (lane >> 5), c = lane & 31; scr[kk * 33 + c] = (c < nvalid) ? W[(size_t)(k0 + kk) * Nsrc + s0 + c] : 0.f; }
    LDS_WAIT(); asm volatile("" ::: "memory");
    const int c = lane & 7;
#pragma unroll
    for (int j = 0; j < 4; ++j) { const int n = (lane >> 3) + 8 * j; const LAS float* s = scr + (8 * c) * 33 + n;
        v4u o; o.x = pk2(s[0 * 33], s[1 * 33]); o.y = pk2(s[2 * 33], s[3 * 33]); o.z = pk2(s[4 * 33], s[5 * 33]); o.w = pk2(s[6 * 33], s[7 * 33]);
        *(GAS v4u*)(WT + (size_t)(n0 + n) * K + k0 + 8 * c) = o; }
    LDS_WAIT(); asm volatile("" ::: "memory");
}
__device__ __forceinline__ void p0_prologue(Frame& F) {
    LAS float* scr = (LAS float*)(F.lds + RING_OFF + F.wave * 16384);
    const int gw = F.vcu * NWAVES + F.wave, NGW = F.G * NWAVES, lane = F.lane;
    bf16* WinT = (bf16*)(F.ws + WS_WIN); bf16* WaT = (bf16*)(F.ws + WS_WA); bf16* WbT = (bf16*)(F.ws + WS_WB); bf16* WoT = (bf16*)(F.ws + WS_WO);
    bf16* WupT = (bf16*)(F.ws + WS_WUP); bf16* WdnT = (bf16*)(F.ws + WS_WDN); bf16* WcT = (bf16*)(F.ws + WS_WC);
    float* small = (float*)(F.ws + WS_SMALL);
    constexpr int I_IN = (D / 64) * (NIN / 32), I_A = (512 / 64) * (D / 32), I_O = (D / 64) * (D / 32), I_UP = (D / 64) * (FF / 32), I_DN = (FF / 64) * (D / 32), I_C = 2 * (2048 / 64) * 2;
    constexpr int I_T = I_IN + 2 * I_A + I_O + I_UP + I_DN + I_C;
    constexpr int I_X = MALL;
    constexpr int I_CB = 64;
    constexpr int I_LB = 16;
    constexpr int I_W8 = MS * 511;
    constexpr int I_Z = 2 * (MALL - MP - MS);
    constexpr int NITEMS = I_T + I_X + I_CB + I_LB + I_W8 + I_Z;
    for (int it = gw; it < NITEMS; it += NGW) {
        int r = it;
        if (r < I_T) {
            if (r < I_IN) { const int nblk = NIN / 32, kb = r / nblk, nb = r % nblk, n0 = 32 * nb; int s0, nv;
                if (n0 < 1280) { s0 = n0; nv = 32; } else if (n0 < 6400) { s0 = n0 + 24; nv = 32; } else if (n0 == 6400) { s0 = 1280; nv = 24; } else { s0 = 0; nv = 0; }
                p0_transpose_item(F.in[7], D, 6424, WinT, 64 * kb, n0, s0, nv, scr, lane); continue; } r -= I_IN;
            if (r < I_A) { const int nblk = D / 32, kb = r / nblk, nb = r % nblk; p0_transpose_item(F.in[12], 512, D, WaT, 64 * kb, 32 * nb, 32 * nb, 32, scr, lane); continue; } r -= I_A;
            if (r < I_A) { const int nblk = D / 32, kb = r / nblk, nb = r % nblk; p0_transpose_item(F.in[13], 512, D, WbT, 64 * kb, 32 * nb, 32 * nb, 32, scr, lane); continue; } r -= I_A;
            if (r < I_O) { const int nblk = D / 32, kb = r / nblk, nb = r % nblk; p0_transpose_item(F.in[14], D, D, WoT, 64 * kb, 32 * nb, 32 * nb, 32, scr, lane); continue; } r -= I_O;
            if (r < I_UP) { const int nblk = FF / 32, kb = r / nblk, nb = r % nblk; p0_transpose_item(F.in[17], D, FF, WupT, 64 * kb, 32 * nb, 32 * nb, 32, scr, lane); continue; } r -= I_UP;
            if (r < I_DN) { const int nblk = D / 32, kb = r / nblk, nb = r % nblk; p0_transpose_item(F.in[18], FF, D, WdnT, 64 * kb, 32 * nb, 32 * nb, 32, scr, lane); continue; } r -= I_DN;
            { const int c = r / 64, q = r % 64, kb = q / 2, nb = q % 2;
              p0_transpose_item(F.in[8] + (size_t)c * 2048 * 64, 2048, 64, WcT + (size_t)c * 64 * 2048, 64 * kb, 32 * nb, 32 * nb, 32, scr, lane); continue; }
        }
        r -= I_T;
        if (r < I_X) {
            const float* src = r < MP ? F.in[0] + (size_t)r * D : (r < MP + MS ? F.in[1] + (size_t)(r - MP) * D : nullptr);
            bf16* dst = (bf16*)(F.ws + WS_XB) + (size_t)r * D;
#pragma unroll
            for (int j = 0; j < 4; ++j) { f32x4 v = src ? *((const GAS f32x4*)src + lane + 64 * j) : (f32x4){0.f, 0.f, 0.f, 0.f};
                *((GAS unsigned long long*)dst + lane + 64 * j) = (unsigned long long)pk2(v.x, v.y) | ((unsigned long long)pk2(v.z, v.w) << 32); }
            continue;
        }
        r -= I_X;
        if (r < I_CB) {
            const int c = r >> 5, l = r & 31; const float* pos = F.in[9] + ((size_t)c * 32 + l) * 64; const float* w = F.in[8] + (((size_t)c * 32 + l) * 64) * 64;
            float s = 0.f;
            for (int d = 0; d < 64; ++d) s += pos[d] * w[(size_t)d * 64 + lane];
            small[(c * 32 + l) * 64 + lane] = s; continue;
        }
        r -= I_CB;
        if (r < I_LB) { const int i = r * 64 + lane; const float l0 = F.in[10][i], l1 = F.in[10][1024 + i]; small[4096 + i] = 1.0f / (1.0f + expf(l1 - l0)); continue; }
        r -= I_LB;
        if (r < I_W8) { const int b = r / 511, i = r % 511;
            const GAS f32x4* s = (const GAS f32x4*)(F.in[4] + ((size_t)b * 512 + i + 1) * 256); GAS f32x4* d = (GAS f32x4*)(F.out + OFF8 + ((size_t)b * 512 + i) * 256);
            d[lane] = s[lane]; continue; }
        r -= I_W8;
        { const int half = I_Z / 2, which = r / half, row = MP + MS + r % half; bf16* o = (bf16*)(F.ws + (which ? WS_OB : WS_OA)) + (size_t)row * 512;
          *((GAS v4u*)o + lane) = (v4u){0u, 0u, 0u, 0u}; }
    }
}
typedef float f32x16 __attribute__((ext_vector_type(16)));
typedef short s16x4 __attribute__((ext_vector_type(4)));
typedef unsigned u32x2 __attribute__((ext_vector_type(2)));
#define MFMA32(a, b, c) __builtin_amdgcn_mfma_f32_32x32x16_bf16((a), (b), (c), 0, 0, 0)
__device__ __forceinline__ int crow(int reg, int h) { return (reg & 3) + 8 * (reg >> 2) + 4 * h; }
__device__ __forceinline__ bf16x8 pack8(f32x4 a, f32x4 b) { v4u p; p.x = cvtpk(a.x, a.y); p.y = cvtpk(a.z, a.w); p.z = cvtpk(b.x, b.y); p.w = cvtpk(b.z, b.w); return __builtin_bit_cast(bf16x8, p); }
#define PACK_STEP(x, s) pack8((f32x4){(x)[8 * (s)], (x)[8 * (s) + 1], (x)[8 * (s) + 2], (x)[8 * (s) + 3]}, (f32x4){(x)[8 * (s) + 4], (x)[8 * (s) + 5], (x)[8 * (s) + 6], (x)[8 * (s) + 7]})
__device__ __forceinline__ bf16x8 join44(s16x4 lo, s16x4 hi) { return __builtin_shufflevector(lo, hi, 0, 1, 2, 3, 4, 5, 6, 7); }

constexpr int NRT = 3, CT_GP = (NCMP_P + NRT * 16 - 1) / (NRT * 16), CT_GS = (NCMP_S + NRT * 16 - 1) / (NRT * 16);
constexpr int CT_PROMPT = NBATCH * 2 * CT_GP, CT_SAMPLE = MS * 2 * CT_GS, CT_ALL = CT_PROMPT + CT_SAMPLE;
__device__ __forceinline__ void compress_task(Frame& F, int task) {
    const int lane = F.lane, m = lane & 31, h = lane >> 5, ii = m & 15, g = m >> 4;
    const bool prompt = task < CT_PROMPT;
    int b, c, ig, nblk, tsrc;
    if (prompt) { b = task / (2 * CT_GP); c = (task / CT_GP) & 1; ig = task % CT_GP; nblk = NCMP_P; tsrc = T; }
    else { const int t2 = task - CT_PROMPT; b = t2 / (2 * CT_GS); c = (t2 / CT_GS) & 1; ig = t2 % CT_GS; nblk = NCMP_S; tsrc = PAST; }
    const int* pt = (const int*)F.in[6] + b * NPAGES;
    const bf16* WcT = (const bf16*)(F.ws + WS_WC) + (size_t)c * 64 * 2048;
    const float* small = (const float*)(F.ws + WS_SMALL);
    f32x16 acc[NRT][2];
#pragma unroll
    for (int rt = 0; rt < NRT; ++rt)
#pragma unroll
        for (int i = 0; i < 16; ++i) { acc[rt][0][i] = 0.f; acc[rt][1][i] = 0.f; }
    const char* rbase = prompt ? (const char*)(F.out + OFF2 + (size_t)b * T * 256) : (const char*)F.in[2];
    unsigned offA[NRT], offB[NRT];
#pragma unroll
    for (int rt = 0; rt < NRT; ++rt) {
        const int blk = ig * (NRT * 16) + rt * 16 + ii;
        int tA = 16 * blk, tB = 16 * blk + 16; tA = tA <= tsrc - 16 ? tA : tsrc - 16; tB = tB <= tsrc - 16 ? tB : tsrc - 16;
        const unsigned rA = prompt ? (unsigned)tA : (unsigned)pt[tA >> 7] * 128u + (unsigned)(tA & 127), rB = prompt ? (unsigned)tB : (unsigned)pt[tB >> 7] * 128u + (unsigned)(tB & 127);
        offA[rt] = (rA * 256u + (unsigned)(c * 128 + g * 64 + 8 * h)) * 4u; offB[rt] = (rB * 256u + (unsigned)(c * 128 + g * 64 + 8 * h)) * 4u;
    }
    const bf16* bp0 = WcT + (size_t)m * 2048 + 8 * h;
    f32x4 a0[2][NRT], a1[2][NRT]; bf16x8 Bv[2][2];
#define CMP_LOAD(st, l_, dc_) do { const unsigned ro_ = (unsigned)(((l_) & 15) * 256 + (dc_) * 16) * 4u; const bf16* bp_ = bp0 + (l_) * 64 + (dc_) * 16; \
        Bv[st][0] = *(const GAS bf16x8*)bp_; Bv[st][1] = *(const GAS bf16x8*)(bp_ + 32 * 2048); \
        _Pragma("unroll") for (int rt = 0; rt < NRT; ++rt) { const char* ap_ = rbase + (((l_) < 16 ? offA[rt] : offB[rt]) + ro_); a0[st][rt] = *(const GAS f32x4*)ap_; a1[st][rt] = *(const GAS f32x4*)(ap_ + 16); } } while (0)
#define CMP_MMA(st) do { _Pragma("unroll") for (int rt = 0; rt < NRT; ++rt) { const bf16x8 A_ = pack8(a0[st][rt], a1[st][rt]); acc[rt][0] = MFMA32(A_, Bv[st][0], acc[rt][0]); acc[rt][1] = MFMA32(A_, Bv[st][1], acc[rt][1]); } } while (0)
    CMP_LOAD(0, 0, 0);
#pragma unroll 1
    for (int l = 0; l < 32; ++l) {
        CMP_LOAD(1, l, 1); __builtin_amdgcn_sched_barrier(0); CMP_MMA(0); __builtin_amdgcn_sched_barrier(0);
        CMP_LOAD(0, l, 2); __builtin_amdgcn_sched_barrier(0); CMP_MMA(1); __builtin_amdgcn_sched_barrier(0);
        CMP_LOAD(1, l, 3); __builtin_amdgcn_sched_barrier(0); CMP_MMA(0); __builtin_amdgcn_sched_barrier(0);
        { const int ln = l < 31 ? l + 1 : 31; CMP_LOAD(0, ln, 0); } __builtin_amdgcn_sched_barrier(0); CMP_MMA(1); __builtin_amdgcn_sched_barrier(0);
    }
#undef CMP_LOAD
#undef CMP_MMA
    float be0 = 0.f, be1 = 0.f;
    for (int l = 0; l < 32; ++l) { be0 += small[(c * 32 + l) * 64 + m]; be1 += small[(c * 32 + l) * 64 + 32 + m]; }
#pragma unroll
    for (int rt = 0; rt < NRT; ++rt)
#pragma unroll
    for (int v = 0; v < 16; ++v) {
        const int mr = crow(v, h), oi = mr & 15, og = mr >> 4, ob = ig * (NRT * 16) + rt * 16 + oi;
        if (ob < nblk) {
            const float v0 = acc[rt][0][v] + be0, v1 = acc[rt][1][v] + be1;
            if (prompt) {
                if (c == 0) { bf16* kc = (bf16*)(F.ws + WS_KCP) + ((size_t)(b * 2 + og) * 512 + ob) * 64; kc[m] = (bf16)f2bf(v0); kc[32 + m] = (bf16)f2bf(v1); }
                else { bf16* vc = (bf16*)(F.ws + WS_VCTP) + (size_t)(b * 2 + og) * 64 * 512 + ob; vc[(size_t)m * 512] = (bf16)f2bf(v0); vc[(size_t)(32 + m) * 512] = (bf16)f2bf(v1); }
            } else {
                float* o = (float*)(F.ws + WS_KCVS) + ((size_t)b * 1024 + ob) * 256 + c * 128 + og * 64; o[m] = v0; o[32 + m] = v1;
            }
        }
    }
}
constexpr int VT_ITEMS = 2 * 2 * 2 * 128;
__device__ __forceinline__ void vt_item(Frame& F, int it) {
    const int tensor = it >> 9, b = (it >> 8) & 1, g = (it >> 7) & 1, tb = it & 127, lane = F.lane;
    const bf16* src = (const bf16*)(F.ws + WS_HB) + (size_t)(b * T + tb * 64 + lane) * NIN + (tensor ? C_KVW : C_KVS) + 128 + g * 64;
    bf16* dst = (bf16*)(F.ws + (tensor ? WS_VWT : WS_VST)) + (size_t)(b * 2 + g) * 64 * T + tb * 64 + lane;
    v4u r[8];
#pragma unroll
    for (int i = 0; i < 8; ++i) r[i] = *((const GAS v4u*)src + i);
    { const bf16* ksrc = src - 128; bf16* kdst = (bf16*)(F.ws + (tensor ? WS_KWC : WS_KSC)) + ((size_t)(b * 2 + g) * T + tb * 64 + lane) * 64;
#pragma unroll
      for (int i = 0; i < 8; ++i) *((GAS v4u*)kdst + i) = *((const GAS v4u*)ksrc + i); }
#pragma unroll
    for (int i = 0; i < 8; ++i) {
        const unsigned w[4] = {r[i].x, r[i].y, r[i].z, r[i].w};
#pragma unroll
        for (int j = 0; j < 4; ++j) { dst[(size_t)(i * 8 + 2 * j) * T] = (bf16)(w[j] & 0xffffu); dst[(size_t)(i * 8 + 2 * j + 1) * T] = (bf16)(w[j] >> 16); }
    }
}

constexpr int HG_SEG = 512, HG_NSEG = T / HG_SEG, HG_CH = 32;
constexpr int HL_QT = 0, HL_KT = 8704, HL_KD = 17408, HL_VT = 27648, HL_DEC = 32768, HL_PSUM = 33280, HL_SLAB = 35328, HL_END = HL_SLAB + 4 * 32 * 272;
static_assert(HL_END <= RING_BYTES, "hgrn lds");
template <int MODE> __device__ __forceinline__ void hgrn_segment(Frame& F, int bh, int seg) {
    int tid = F.tid; asm volatile("" : "+v"(tid));
    const int lane = tid & 63, w = F.wave, kt = w >> 1, vt = w & 1, h5 = lane >> 5, l31 = lane & 31;
    const int b = bh >> 3, hh = bh & 7;
    LAS unsigned char* L = F.lds + RING_OFF;
    const bf16* HB = (const bf16*)(F.ws + WS_HB);
    const float* small = (const float*)(F.ws + WS_SMALL);
    float* HGL = (float*)(F.ws + WS_HGL); float* HGD = (float*)(F.ws + WS_HGD);
    f32x16 S;
#pragma unroll
    for (int i = 0; i < 16; ++i) S[i] = 0.f;
    if (MODE == 1) {
        for (int i = 0; i < seg; ++i) {
            const float* Lp = HGL + ((size_t)(bh * HG_NSEG + i)) * 8192 + w * 1024 + lane; const float* Dp = HGD + (size_t)(bh * HG_NSEG + i) * 128 + 32 * kt;
#pragma unroll
            for (int v = 0; v < 16; ++v) S[v] = S[v] * Dp[crow(v, h5)] + Lp[v * 64];
        }
    }
    const int k = tid & 127, q4 = tid >> 7;
    const float lb = small[4096 + hh * 128 + k];
    float lcsum = 0.f;
    unsigned short pf[8], pq[8]; u32x2 pv_, pg_;
#define HG_FETCH(ch_) do { const int r0_ = b * T + seg * HG_SEG + (ch_) * HG_CH; \
        _Pragma("unroll") for (int j = 0; j < 8; ++j) { pf[j] = HB[(size_t)(r0_ + 8 * q4 + j) * NIN + C_FB + hh * 128 + k]; if (MODE == 1) pq[j] = HB[(size_t)(r0_ + 8 * q4 + j) * NIN + C_QB + hh * 128 + k]; } \
        pv_ = *(const GAS u32x2*)(HB + (size_t)(r0_ + (tid >> 4)) * NIN + C_IB + hh * 64 + 4 * (tid & 15)); \
        if (MODE == 1) pg_ = *(const GAS u32x2*)(HB + (size_t)(r0_ + (tid >> 4)) * NIN + C_GB + hh * 64 + 4 * (tid & 15)); } while (0)
    HG_FETCH(0);
    for (int ch = 0; ch < HG_SEG / HG_CH; ++ch) {
        const int row0 = b * T + seg * HG_SEG + ch * HG_CH;
        unsigned short cf[8], cq[8]; const u32x2 vv = pv_, gv = pg_;
#pragma unroll
        for (int j = 0; j < 8; ++j) { cf[j] = pf[j]; cq[j] = pq[j]; }
        { const int chn = ch + 1 < HG_SEG / HG_CH ? ch + 1 : ch; HG_FETCH(chn); }
        float kk[8], cs[8]; float run = 0.f;
#pragma unroll
        for (int j = 0; j < 8; ++j) {
            const float x = bf2f(cf[j]);
            const float e = __expf(-x), sg = 1.0f / (1.0f + e), om = e / (1.0f + e);
            const float f = lb + (1.0f - lb) * sg; kk[j] = (1.0f - lb) * om; run += __logf(f); cs[j] = run;
        }
        ((LAS float*)(L + HL_PSUM))[q4 * 128 + k] = run;
        __syncthreads();
        float off = 0.f, tot = 0.f;
#pragma unroll
        for (int q = 0; q < 4; ++q) { const float p = ((LAS float*)(L + HL_PSUM))[q * 128 + k]; tot += p; if (q < q4) off += p; }
#pragma unroll
        for (int j = 0; j < 8; ++j) {
            const int s = 8 * q4 + j; const float lc = off + cs[j];
            if (MODE == 1) {
                const float qv = bf2f(cq[j]);
                ((LAS bf16*)(L + HL_QT))[s * 136 + k] = (bf16)f2bf(qv * __expf(lc));
                ((LAS bf16*)(L + HL_KT))[s * 136 + k] = (bf16)f2bf(kk[j] * __expf(-lc));
            }
            ((LAS bf16*)(L + HL_KD))[k * 40 + s] = (bf16)f2bf(kk[j] * __expf(tot - lc));
        }
        if (q4 == 0) { ((LAS float*)(L + HL_DEC))[k] = __expf(tot); lcsum += tot; }
        { const int s = tid >> 4, vq = tid & 15;
          LAS bf16* vtp = (LAS bf16*)(L + HL_VT);
          vtp[(4 * vq + 0) * 40 + s] = (bf16)(vv.x & 0xffffu); vtp[(4 * vq + 1) * 40 + s] = (bf16)(vv.x >> 16);
          vtp[(4 * vq + 2) * 40 + s] = (bf16)(vv.y & 0xffffu); vtp[(4 * vq + 3) * 40 + s] = (bf16)(vv.y >> 16); }
        __syncthreads();
        if (MODE == 1) {
            f32x16 oacc;
#pragma unroll
            for (int i = 0; i < 16; ++i) oacc[i] = 0.f;
            if (kt == 0) {
                f32x16 at;
#pragma unroll
                for (int i = 0; i < 16; ++i) at[i] = 0.f;
#pragma unroll
                for (int ks = 0; ks < 8; ++ks) {
                    const bf16x8 a = *(const LAS bf16x8*)(L + HL_KT + l31 * 272 + (16 * ks + 8 * h5) * 2);
                    const bf16x8 bq = *(const LAS bf16x8*)(L + HL_QT + l31 * 272 + (16 * ks + 8 * h5) * 2);
                    at = MFMA32(a, bq, at);
                }
#pragma unroll
                for (int i = 0; i < 16; ++i) at[i] = (crow(i, h5) <= l31) ? at[i] : 0.f;
#pragma unroll
                for (int kq = 0; kq < 2; ++kq) {
                    const s16x4 lo = *(const LAS s16x4*)(L + HL_VT + (32 * vt + l31) * 80 + (16 * kq + 4 * h5) * 2);
                    const s16x4 hi = *(const LAS s16x4*)(L + HL_VT + (32 * vt + l31) * 80 + (16 * kq + 8 + 4 * h5) * 2);
                    oacc = MFMA32(join44(lo, hi), PACK_STEP(at, kq), oacc);
                }
            }
#pragma unroll
            for (int kq = 0; kq < 2; ++kq) {
                const s16x4 lo = *(const LAS s16x4*)(L + HL_QT + l31 * 272 + (32 * kt + 16 * kq + 4 * h5) * 2);
                const s16x4 hi = *(const LAS s16x4*)(L + HL_QT + l31 * 272 + (32 * kt + 16 * kq + 8 + 4 * h5) * 2);
                oacc = MFMA32(PACK_STEP(S, kq), join44(lo, hi), oacc);
            }
#pragma unroll
            for (int a = 0; a < 4; ++a)
                *(LAS f32x4*)(L + HL_SLAB + (kt * 32 + l31) * 272 + (32 * vt + 8 * a + 4 * h5) * 4) = (f32x4){oacc[4 * a], oacc[4 * a + 1], oacc[4 * a + 2], oacc[4 * a + 3]};
        }
        {
#pragma unroll
            for (int a = 0; a < 4; ++a) { const f32x4 d = *(const LAS f32x4*)(L + HL_DEC + (32 * kt + 8 * a + 4 * h5) * 4);
                S[4 * a] *= d.x; S[4 * a + 1] *= d.y; S[4 * a + 2] *= d.z; S[4 * a + 3] *= d.w; }
#pragma unroll
            for (int kq = 0; kq < 2; ++kq) {
                const bf16x8 a = *(const LAS bf16x8*)(L + HL_KD + (32 * kt + l31) * 80 + (16 * kq + 8 * h5) * 2);
                const bf16x8 bv = *(const LAS bf16x8*)(L + HL_VT + (32 * vt + l31) * 80 + (16 * kq + 8 * h5) * 2);
                S = MFMA32(a, bv, S);
            }
        }
        __syncthreads();
        if (MODE == 1) {
            const int t = tid >> 4, vq = tid & 15;
            f32x4 o = (f32x4){0.f, 0.f, 0.f, 0.f};
#pragma unroll
            for (int q = 0; q < 4; ++q) o += *(const LAS f32x4*)(L + HL_SLAB + (q * 32 + t) * 272 + 16 * vq);
            float ss = (o.x * o.x + o.y * o.y) + (o.z * o.z + o.w * o.w);
            ss += __shfl_xor(ss, 1); ss += __shfl_xor(ss, 2); ss += __shfl_xor(ss, 4); ss += __shfl_xor(ss, 8);
            const float rs = 1.0f / sqrtf(ss * (1.0f / 64.0f) + LN_EPS);
            const f32x4 ng = *(const GAS f32x4*)(F.in[11] + 4 * vq);
            const float g0 = bf2f(gv.x & 0xffffu), g1 = bf2f(gv.x >> 16), g2 = bf2f(gv.y & 0xffffu), g3 = bf2f(gv.y >> 16);
            u32x2 ow; ow.x = cvtpk(o.x * rs * ng.x * g0 * sigmoidf_(g0), o.y * rs * ng.y * g1 * sigmoidf_(g1)); ow.y = cvtpk(o.z * rs * ng.z * g2 * sigmoidf_(g2), o.w * rs * ng.w * g3 * sigmoidf_(g3));
            *(GAS u32x2*)((bf16*)(F.ws + WS_OB) + (size_t)(row0 + t) * 512 + hh * 64 + 4 * vq) = ow;
        }
    }
    if (MODE == 0) {
        float* Lp = HGL + ((size_t)(bh * HG_NSEG + seg)) * 8192 + w * 1024 + lane;
#pragma unroll
        for (int v = 0; v < 16; ++v) Lp[v * 64] = S[v];
        if (q4 == 0) HGD[(size_t)(bh * HG_NSEG + seg) * 128 + k] = __expf(lcsum);
    } else if (seg == HG_NSEG - 1) {
        float* o = F.out + OFF5 + (size_t)bh * 8192;
#pragma unroll
        for (int v = 0; v < 16; ++v) o[(32 * kt + crow(v, h5)) * 64 + 32 * vt + l31] = S[v];
    }
#undef HG_FETCH
    __syncthreads();
}
__device__ __forceinline__ void hgrn_sample_unit(Frame& F, int unit) {
    const int b = unit >> 3, hh = unit & 7, tid = F.tid, v = tid & 63, kq = tid >> 6;
    const bf16* HB = (const bf16*)(F.ws + WS_HB) + (size_t)(MP + b) * NIN;
    const float* small = (const float*)(F.ws + WS_SMALL);
    const float* st = F.in[5] + (size_t)(b * 8 + hh) * 8192; float* so = F.out + OFF9 + (size_t)(b * 8 + hh) * 8192;
    const float vv = bf2f(HB[C_IB + hh * 64 + v]);
    float po = 0.f;
#pragma unroll 4
    for (int j = 0; j < 16; ++j) {
        const int k = kq * 16 + j; const float x = bf2f(HB[C_FB + hh * 128 + k]), lb = small[4096 + hh * 128 + k];
        const float e = __expf(-x), sg = 1.0f / (1.0f + e), om = e / (1.0f + e);
        const float f = lb + (1.0f - lb) * sg, kx = (1.0f - lb) * om;
        const float sn = f * st[k * 64 + v] + kx * vv; so[k * 64 + v] = sn;
        po += bf2f(HB[C_QB + hh * 128 + k]) * sn;
    }
    LAS float* red = (LAS float*)(F.lds + RING_OFF);
    red[kq * 64 + v] = po;
    __syncthreads();
    if (tid < 64) {
        float o = 0.f;
#pragma unroll
        for (int q = 0; q < 8; ++q) o += red[q * 64 + v];
        const float ss = wave_sum(o * o), rs = 1.0f / sqrtf(ss * (1.0f / 64.0f) + LN_EPS);
        const float g = bf2f(HB[C_GB + hh * 64 + v]);
        ((bf16*)(F.ws + WS_OB))[(size_t)(MP + b) * 512 + hh * 64 + v] = (bf16)f2bf(o * rs * F.in[11][v] * g * sigmoidf_(g));
    }
    __syncthreads();
}
__device__ __forceinline__ void p2_phase(Frame& F) {
    for (int u = blockIdx.x; u < 16 * (HG_NSEG - 1); u += F.G) hgrn_segment<0>(F, u / (HG_NSEG - 1), u % (HG_NSEG - 1));
    for (int u = blockIdx.x; u < MS * 8; u += F.G) hgrn_sample_unit(F, u);
    const int NGW = F.G * NWAVES;
    for (int it = F.wave * F.G + F.vcu; it < CT_ALL + VT_ITEMS; it += NGW) { if (it < CT_ALL) compress_task(F, it); else vt_item(F, it - CT_ALL); }
}
constexpr int AT_NB = 5, AT_D = 4;
constexpr int AL_BUF = 16384  , AL_K = 0, AL_V = 8192;
constexpr int AL_IMP = AT_NB * AL_BUF, AL_SELM = AL_IMP + 64 * 128 * 4, AL_UNI = AL_SELM + 64 * 4 * 4, AL_TL = AL_UNI + 16, AL_END = AL_TL + 160 * 4;
static_assert(AL_END <= RING_BYTES, "attn lds");
constexpr float LOG2E = 1.4426950408889634f;
#define NEG_INF (-__builtin_inff())
__device__ __forceinline__ int swz(int row, int chunk) { return (chunk ^ ((row >> 1) & 7)) * 16; }
__device__ __forceinline__ f32x16 qk_sub(const LAS unsigned char* L, int sub, const bf16x8 (&qf)[4], int l31, int h5) {
    f32x16 acc;
#pragma unroll
    for (int i = 0; i < 16; ++i) acc[i] = 0.f;
    const int row = sub * 32 + l31;
#pragma unroll
    for (int s = 0; s < 4; ++s) { const bf16x8 a = *(const LAS bf16x8*)(L + AL_K + row * 128 + swz(row, 2 * s + h5)); acc = MFMA32(a, qf[s], acc); }
    return acc;
}
__device__ __forceinline__ void pv_sub(const LAS unsigned char* L, int sub, const f32x16& p, f32x16 (&O)[2], int l31, int h5) {
#pragma unroll
    for (int kq = 0; kq < 2; ++kq) {
        const bf16x8 pb = PACK_STEP(p, kq);
#pragma unroll
        for (int dt = 0; dt < 2; ++dt) {
            const int row = dt * 32 + l31;
            const s16x4 lo = *(const LAS s16x4*)(L + AL_V + row * 128 + swz(row, 4 * sub + 2 * kq) + 8 * h5);
            const s16x4 hi = *(const LAS s16x4*)(L + AL_V + row * 128 + swz(row, 4 * sub + 2 * kq + 1) + 8 * h5);
            O[dt] = MFMA32(join44(lo, hi), pb, O[dt]);
        }
    }
}
__device__ __forceinline__ void online_update2(const LAS unsigned char* L, f32x16& s0, f32x16& s1, float& m, float& l, f32x16 (&O)[2], int l31, int h5) {
    float tmax = fmaxf(s0[0], s1[0]);
#pragma unroll
    for (int i = 1; i < 16; ++i) tmax = fmaxf(tmax, fmaxf(s0[i], s1[i]));
    tmax = fmaxf(tmax, __shfl_xor(tmax, 32));
    const float mnew = fmaxf(m, tmax), ms = (mnew == NEG_INF) ? 0.f : mnew;
    const float alpha = __builtin_amdgcn_exp2f(m - ms);
    float ps = 0.f;
#pragma unroll
    for (int i = 0; i < 16; ++i) { s0[i] = __builtin_amdgcn_exp2f(s0[i] - ms); s1[i] = __builtin_amdgcn_exp2f(s1[i] - ms); ps += s0[i] + s1[i]; }
    l = l * alpha + ps; m = mnew;
    if (__any(alpha != 1.0f)) {
#pragma unroll
        for (int i = 0; i < 16; ++i) { O[0][i] *= alpha; O[1][i] *= alpha; }
    }
    pv_sub(L, 0, s0, O, l31, h5); pv_sub(L, 1, s1, O, l31, h5);
}

__device__ __forceinline__ void bias2(f32x16& s0, f32x16& s1, float scale2, float slopec, float cb) {
    const float cb1 = cb + slopec * 32.f;
#pragma unroll
    for (int k = 0; k < 16; ++k) { const float ck = (float)((k & 3) + 8 * (k >> 2)); s0[k] = s0[k] * scale2 + (slopec * ck + cb); s1[k] = s1[k] * scale2 + (slopec * ck + cb1); }
}
struct AttnSrc { const bf16* KCP; const bf16* VCTP; const bf16* Ks; const bf16* Vs; const bf16* Kw; const bf16* Vw; };
__device__ __forceinline__ void tile_dma(const AttnSrc& A, int e, LAS unsigned char* Lb, int w, int lane) {
    const int kind = e >> 24, idx = e & 0xffffff; const unsigned row = 8u * (unsigned)w + ((unsigned)lane >> 3), ch = (((unsigned)lane & 7u) ^ ((row >> 1) & 7u)) * 16u;
    const char* kb; const char* vb; unsigned vo;
    if (kind <= 1) { kb = (const char*)(A.KCP + (size_t)idx * 64 * 64); vb = (const char*)(A.VCTP + idx * 64); vo = row * 1024u + ch; }
    else if (kind == 2) { kb = (const char*)(A.Kw + (size_t)idx * 64 * 64); vb = (const char*)(A.Vw + idx * 64); vo = row * (unsigned)(T * 2) + ch; }
    else { kb = (const char*)(A.Ks + (size_t)idx * 64 * 64); vb = (const char*)(A.Vs + idx * 64); vo = row * (unsigned)(T * 2) + ch; }
    __builtin_amdgcn_global_load_lds((const unsigned*)(kb + (row * 128u + ch)), (LAS unsigned*)(Lb + AL_K + w * 1024), 16, 0, 0);
    __builtin_amdgcn_global_load_lds((const unsigned*)(vb + vo), (LAS unsigned*)(Lb + AL_V + w * 1024), 16, 0, 0);
}
__device__ __forceinline__ void nsa_prompt_unit(Frame& F, int unit) {
    const int b = unit >> 8, g = (unit >> 7) & 1, qt = unit & 127, t0 = qt * 64;
    int tid = F.tid; asm volatile("" : "+v"(tid));
    const int lane = tid & 63, w = F.wave, l31 = lane & 31, h5 = lane >> 5, ql = l31 >> 2, r = l31 & 3;
    LAS unsigned char* L = F.lds + RING_OFF;
    const bf16* HB = (const bf16*)(F.ws + WS_HB);
    const int pos = t0 + 8 * w + ql;
    const size_t qrow = (size_t)(b * T + pos);
    const float slope2 = __builtin_amdgcn_exp2f(-(float)(g * 4 + r + 1)) * LOG2E, scale2 = 0.125f * LOG2E;
    bf16x8 qf[4];
#pragma unroll
    for (int s = 0; s < 4; ++s) qf[s] = *(const GAS bf16x8*)(HB + qrow * NIN + C_QA + (g * 4 + r) * 64 + 16 * s + 8 * h5);
#define NSA_GATE(i) sigmoidf_(bf2f(HB[qrow * NIN + C_GLA + (g * 4 + r) * 3 + (i)]))
    AttnSrc A;
    A.KCP = (const bf16*)(F.ws + WS_KCP) + (size_t)(b * 2 + g) * 512 * 64; A.VCTP = (const bf16*)(F.ws + WS_VCTP) + (size_t)(b * 2 + g) * 64 * 512;
    A.Ks = (const bf16*)(F.ws + WS_KSC) + (size_t)(b * 2 + g) * T * 64; A.Vs = (const bf16*)(F.ws + WS_VST) + (size_t)(b * 2 + g) * 64 * T;
    A.Kw = (const bf16*)(F.ws + WS_KWC) + (size_t)(b * 2 + g) * T * 64; A.Vw = (const bf16*)(F.ws + WS_VWT) + (size_t)(b * 2 + g) * 64 * T;
    LAS int* TL = (LAS int*)(L + AL_TL);
    for (int i = tid; i < (AL_TL - AL_IMP) / 4; i += NWAVES * 64) ((LAS unsigned*)(L + AL_IMP))[i] = 0u;
    const int nmax_u = (t0 + 63 - 31) >> 4, nc = (nmax_u >> 6) + 1;
    const int nmax_w = (t0 + 8 * w + 7 - 31) >> 4;
    const int kb_lo = qt >= 8 ? qt - 8 : 0, nw = qt - kb_lo + 1;
    if (tid < 2 * nc + nw) TL[tid] = tid < nc ? tid : (tid < 2 * nc ? (1 << 24) | (tid - nc) : (2 << 24) | (kb_lo + tid - 2 * nc));
    __syncthreads();
    f32x16 O[2];
#pragma unroll
    for (int i = 0; i < 16; ++i) { O[0][i] = 0.f; O[1][i] = 0.f; }
    float* ots = (float*)(F.ws + WS_OTS) + ((size_t)blockIdx.x * 512 + tid) * 32;
    float m = NEG_INF, l = 0.f, inv_l = 0.f, mfin = 0.f;
    int n = 2 * nc + nw;
#define NSA_TILE_LOOP(stream) \
    { \
_Pragma("unroll") \
    for (int j = 0; j < AT_D; ++j) tile_dma(A, TL[j < n ? j : n - 1], L + j * AL_BUF, w, lane); \
    int bi = 0; \
_Pragma("unroll 1") \
    for (int i = 0; i < n; ++i) { \
        asm volatile("s_waitcnt vmcnt(6)" ::: "memory"); __builtin_amdgcn_s_barrier(); asm volatile("" ::: "memory"); \
        { const int jn = i + AT_D < n ? i + AT_D : n - 1; const int bn = bi + AT_D >= AT_NB ? bi + AT_D - AT_NB : bi + AT_D; tile_dma(A, TL[jn], L + bn * AL_BUF, w, lane); } \
        const int e = TL[i], kind = (stream) == 1 ? 3 : (e >> 24), idx = e & 0xffffff; \
        const LAS unsigned char* Lb = L + bi * AL_BUF; bi = bi + 1 == AT_NB ? 0 : bi + 1; \
        if (stream == 0 && i == nc) { l += __shfl_xor(l, 32); inv_l = l > 0.f ? 1.0f / l : 0.f; mfin = (m == NEG_INF) ? 0.f : m; } \
        if (stream == 0 && i == 2 * nc) { \
            { const float g0_ = NSA_GATE(0); _Pragma("unroll") for (int k = 0; k < 16; ++k) { ots[k] = g0_ * O[0][k]; ots[16 + k] = g0_ * O[1][k]; O[0][k] = 0.f; O[1][k] = 0.f; } } \
            asm volatile("s_waitcnt vmcnt(0)" ::: "memory"); \
            m = NEG_INF; l = 0.f; } \
        if ((stream) == 0 && kind <= 1) { \
            const int n0 = idx * 64; \
            if (n0 <= nmax_w) { \
                f32x16 s0 = qk_sub(Lb, 0, qf, l31, h5), s1 = qk_sub(Lb, 1, qf, l31, h5); \
                const float slopec = 16.f * slope2; \
                bias2(s0, s1, scale2, slopec, slope2 * (float)(16 * n0 + 31 - pos) + slopec * (float)(4 * h5) - (kind == 1 ? mfin : 0.f)); \
                if (16 * (n0 + 63) + 31 > t0 + 8 * w) { \
_Pragma("unroll") \
                    for (int k = 0; k < 16; ++k) { const int d0 = pos - (16 * (n0 + crow(k, h5)) + 31), d1 = d0 - 512; s0[k] = d0 >= 0 ? s0[k] : NEG_INF; s1[k] = d1 >= 0 ? s1[k] : NEG_INF; } \
                } \
                if (kind == 0) { \
                    float tmax = fmaxf(s0[0], s1[0]); \
_Pragma("unroll") \
                    for (int k = 1; k < 16; ++k) tmax = fmaxf(tmax, fmaxf(s0[k], s1[k])); \
                    tmax = fmaxf(tmax, __shfl_xor(tmax, 32)); \
                    const float mnew = fmaxf(m, tmax), ms = (mnew == NEG_INF) ? 0.f : mnew; \
                    float ps = 0.f; \
_Pragma("unroll") \
                    for (int k = 0; k < 16; ++k) ps += __builtin_amdgcn_exp2f(s0[k] - ms) + __builtin_amdgcn_exp2f(s1[k] - ms); \
                    l = l * __builtin_amdgcn_exp2f(m - ms) + ps; m = mnew; \
                } else { \
_Pragma("unroll") \
                    for (int k = 0; k < 16; ++k) { s0[k] = __builtin_amdgcn_exp2f(s0[k]) * inv_l; s1[k] = __builtin_amdgcn_exp2f(s1[k]) * inv_l; } \
_Pragma("unroll") \
                    for (int a = 0; a < 4; ++a) { \
                        float sm0 = (s0[4 * a] + s0[4 * a + 1]) + (s0[4 * a + 2] + s0[4 * a + 3]), sm1 = (s1[4 * a] + s1[4 * a + 1]) + (s1[4 * a + 2] + s1[4 * a + 3]); \
                        sm0 += __shfl_xor(sm0, 1); sm0 += __shfl_xor(sm0, 2); sm1 += __shfl_xor(sm1, 1); sm1 += __shfl_xor(sm1, 2); \
                        if (r == 0) { ((LAS float*)(L + AL_IMP))[(8 * w + ql) * 128 + (n0 >> 2) + 2 * a + h5] = sm0; ((LAS float*)(L + AL_IMP))[(8 * w + ql) * 128 + (n0 >> 2) + 8 + 2 * a + h5] = sm1; } \
                    } \
                    pv_sub(Lb, 0, s0, O, l31, h5); pv_sub(Lb, 1, s1, O, l31, h5); \
                } \
            } \
        } else { \
            const int pos0 = idx * 64; \
            const bool sel = (stream) == 0 ? true : ((((LAS unsigned*)(L + AL_SELM))[(8 * w + ql) * 4 + (idx >> 5)] >> (idx & 31)) & 1u) != 0u; \
            if (__any(sel && pos >= pos0)) { \
                f32x16 s0 = qk_sub(Lb, 0, qf, l31, h5), s1 = qk_sub(Lb, 1, qf, l31, h5); \
                bias2(s0, s1, scale2, slope2, sel ? slope2 * (float)(pos0 - pos + 4 * h5) : NEG_INF); \
                if (idx == qt || ((stream) == 0 && idx == qt - 8)) { \
_Pragma("unroll") \
                    for (int k = 0; k < 16; ++k) { const int d0 = pos - (pos0 + crow(k, h5)), d1 = d0 - 32; \
                        s0[k] = (d0 >= 0 && ((stream) == 1 || d0 < 512)) ? s0[k] : NEG_INF; s1[k] = (d1 >= 0 && ((stream) == 1 || d1 < 512)) ? s1[k] : NEG_INF; } \
                } \
                online_update2(Lb, s0, s1, m, l, O, l31, h5); \
            } \
        } \
    } \
    asm volatile("s_waitcnt vmcnt(0)" ::: "memory"); __builtin_amdgcn_s_barrier(); asm volatile("" ::: "memory"); \
    l += __shfl_xor(l, 32); \
    const float sc_ = l > 0.f ? NSA_GATE(stream == 0 ? 2 : 1) / l : 0.f; \
    if (stream == 0) { \
_Pragma("unroll") \
        for (int k = 0; k < 16; ++k) { ots[k] += sc_ * O[0][k]; ots[16 + k] += sc_ * O[1][k]; } \
    } else { \
_Pragma("unroll") \
        for (int k = 0; k < 16; ++k) { O[0][k] = ots[k] + sc_ * O[0][k]; O[1][k] = ots[16 + k] + sc_ * O[1][k]; } \
    } \
    }
    NSA_TILE_LOOP(0)
    {
        const int q = tid >> 3, sub = tid & 7, cur = qt;
        float vals[16]; unsigned avail = 0u, bits = 0u;
#pragma unroll
        for (int i = 0; i < 16; ++i) { const int j = sub * 16 + i; vals[i] = ((LAS float*)(L + AL_IMP))[q * 128 + j];
            if (j <= cur) { if (cur < 16 || j == 0 || j == cur || j == cur - 1) bits |= 1u << i; else avail |= 1u << i; } }
        if (cur >= 16) {
            for (int round = 0; round < 13; ++round) {
                float bv = -1.0f; int bi = 1 << 20;
#pragma unroll
                for (int i = 0; i < 16; ++i) if (((avail >> i) & 1u) && vals[i] > bv) { bv = vals[i]; bi = sub * 16 + i; }
#pragma unroll
                for (int o = 1; o < 8; o <<= 1) { const float ov = __shfl_xor(bv, o); const int oi = __shfl_xor(bi, o); if (ov > bv || (ov == bv && oi < bi)) { bv = ov; bi = oi; } }
                if ((bi >> 4) == sub) { avail &= ~(1u << (bi & 15)); bits |= 1u << (bi & 15); }
            }
        }
        if (bits) { __hip_atomic_fetch_or((LAS unsigned*)(L + AL_SELM) + q * 4 + (sub >> 1), bits << (16 * (sub & 1)), __ATOMIC_RELAXED, __HIP_MEMORY_SCOPE_WORKGROUP); __hip_atomic_fetch_or((LAS unsigned*)(L + AL_UNI) + (sub >> 1), bits << (16 * (sub & 1)), __ATOMIC_RELAXED, __HIP_MEMORY_SCOPE_WORKGROUP); }
        __syncthreads();
        const unsigned u0 = ((LAS unsigned*)(L + AL_UNI))[0], u1 = ((LAS unsigned*)(L + AL_UNI))[1], u2 = ((LAS unsigned*)(L + AL_UNI))[2], u3 = ((LAS unsigned*)(L + AL_UNI))[3];
        n = __builtin_popcount(u0) + __builtin_popcount(u1) + __builtin_popcount(u2) + __builtin_popcount(u3);
        n = __builtin_amdgcn_readfirstlane(n);
        if (tid < 128) { const int wq = tid >> 5, bq = tid & 31; const unsigned uw = wq == 0 ? u0 : (wq == 1 ? u1 : (wq == 2 ? u2 : u3));
            if ((uw >> bq) & 1u) { const int rank = __builtin_popcount(uw & ((1u << bq) - 1u)) + (wq > 0 ? __builtin_popcount(u0) : 0) + (wq > 1 ? __builtin_popcount(u1) : 0) + (wq > 2 ? __builtin_popcount(u2) : 0);
                TL[rank] = (3 << 24) | tid; } }
        __syncthreads();
        m = NEG_INF; l = 0.f;
#pragma unroll
        for (int i = 0; i < 16; ++i) { O[0][i] = 0.f; O[1][i] = 0.f; }
    }
    NSA_TILE_LOOP(1)
#undef NSA_TILE_LOOP
#undef NSA_GATE
    bf16* oa = (bf16*)(F.ws + WS_OA) + qrow * 512 + (g * 4 + r) * 64;
#pragma unroll
    for (int dt = 0; dt < 2; ++dt)
#pragma unroll
        for (int a = 0; a < 4; ++a) { u32x2 ow; ow.x = cvtpk(O[dt][4 * a], O[dt][4 * a + 1]); ow.y = cvtpk(O[dt][4 * a + 2], O[dt][4 * a + 3]);
            *(GAS u32x2*)(oa + dt * 32 + 8 * a + 4 * h5) = ow; }
    __syncthreads();
}

constexpr int SL_SC = 0, SL_Q = 16384, SL_RED = SL_Q + 1024, SL_IMP = SL_RED + 8192, SL_SEL = SL_IMP + 2048, SL_SELB = SL_SEL + 64, SL_OUT = SL_SELB + 128, SL_END = SL_OUT + 1024;
static_assert(SL_END <= RING_BYTES, "sample lds");
struct SampleCtx { const float* kcvs; const float* csel; const float* cwin; const float* new_sel; const float* new_win; };
template <int KIND> __device__ __forceinline__ const float* sample_key(const SampleCtx& c, const LAS int* SEL, const LAS unsigned long long* SELB, int kidx, int& dist, bool& valid) {
    if (KIND == 0) { valid = kidx < NCMP_S; dist = PAST - (16 * kidx + 31); return c.kcvs + (size_t)(valid ? kidx : 0) * 256; }
    if (KIND == 1) { const int slot = kidx >> 6, i = kidx & 63, jb = SEL[slot];
        if (jb < 256) { valid = true; dist = PAST - (jb * 64 + i); return c.csel + SELB[slot] + (size_t)i * 256; }
        valid = (i == 0); dist = 0; return c.new_sel; }
    valid = true; dist = 511 - kidx;
    return kidx == 511 ? c.new_win : c.cwin + (size_t)(kidx + 1) * 256;
}
__device__ __forceinline__ void block_max4(LAS float* red, float (&v)[4], int wave, int lane) {
#pragma unroll
    for (int r = 0; r < 4; ++r) { float x = v[r];
#pragma unroll
        for (int o = 1; o < 64; o <<= 1) x = fmaxf(x, __shfl_xor(x, o));
        if (lane == 0) red[wave * 4 + r] = x; }
    __syncthreads();
#pragma unroll
    for (int r = 0; r < 4; ++r) { float x = red[r];
#pragma unroll
        for (int q = 1; q < 8; ++q) x = fmaxf(x, red[q * 4 + r]);
        v[r] = x; }
    __syncthreads();
}
__device__ __forceinline__ void block_sum4(LAS float* red, float (&v)[4], int wave, int lane) {
#pragma unroll
    for (int r = 0; r < 4; ++r) { const float x = wave_sum(v[r]); if (lane == 0) red[wave * 4 + r] = x; }
    __syncthreads();
#pragma unroll
    for (int r = 0; r < 4; ++r) { float x = 0.f;
#pragma unroll
        for (int q = 0; q < 8; ++q) x += red[q * 4 + r];
        v[r] = x; }
    __syncthreads();
}
template <int KIND> __device__ __forceinline__ void sample_branch(Frame& F, const SampleCtx& c, int b, int g, int tid) {
    constexpr int NK = KIND == 2 ? 512 : 1024;
    const int lane = tid & 63, wave = F.wave, sub = lane & 15, kg = lane >> 4;
    LAS unsigned char* L = F.lds + RING_OFF;
    LAS float* SC = (LAS float*)(L + SL_SC); LAS float* Q = (LAS float*)(L + SL_Q); LAS float* red = (LAS float*)(L + SL_RED);
    const LAS int* SEL = (const LAS int*)(L + SL_SEL); const LAS unsigned long long* SELB = (const LAS unsigned long long*)(L + SL_SELB);
    f32x4 q4[4];
#pragma unroll
    for (int r = 0; r < 4; ++r) q4[r] = *(const LAS f32x4*)(Q + r * 64 + 4 * sub);
    constexpr int NIT = NK / 32, NBATCH_S = (NIT % 8 == 0) ? 8 : 1;
#pragma unroll 1
    for (int it0 = 0; it0 < NIT; it0 += NBATCH_S) {
        f32x4 kv[NBATCH_S]; int dist[NBATCH_S]; bool valid[NBATCH_S];
#pragma unroll
        for (int u = 0; u < NBATCH_S; ++u) { const int kidx = (it0 + u) * 32 + wave * 4 + kg; const float* kp = sample_key<KIND>(c, SEL, SELB, kidx, dist[u], valid[u]); kv[u] = *(const GAS f32x4*)(kp + 4 * sub); }
#pragma unroll
        for (int u = 0; u < NBATCH_S; ++u) {
            const int kidx = (it0 + u) * 32 + wave * 4 + kg;
            float part[4];
#pragma unroll
            for (int r = 0; r < 4; ++r) { float p = (kv[u].x * q4[r].x + kv[u].y * q4[r].y) + (kv[u].z * q4[r].z + kv[u].w * q4[r].w);
                p += __shfl_xor(p, 1); p += __shfl_xor(p, 2); p += __shfl_xor(p, 4); p += __shfl_xor(p, 8); part[r] = p; }
            if (sub < 4) { const float pr = sub == 0 ? part[0] : (sub == 1 ? part[1] : (sub == 2 ? part[2] : part[3]));
                SC[sub * 1024 + kidx] = valid[u] ? pr * 0.125f - __builtin_amdgcn_exp2f(-(float)(g * 4 + sub + 1)) * (float)dist[u] : NEG_INF; }
        }
    }
    __syncthreads();
    float mx[4] = {NEG_INF, NEG_INF, NEG_INF, NEG_INF};
    for (int kidx = tid; kidx < NK; kidx += 512)
#pragma unroll
        for (int r = 0; r < 4; ++r) mx[r] = fmaxf(mx[r], SC[r * 1024 + kidx]);
    block_max4(red, mx, wave, lane);
    float sm[4] = {0.f, 0.f, 0.f, 0.f};
    for (int kidx = tid; kidx < NK; kidx += 512)
#pragma unroll
        for (int r = 0; r < 4; ++r) { const float s = SC[r * 1024 + kidx]; const float p = s == NEG_INF ? 0.f : __expf(s - mx[r]); SC[r * 1024 + kidx] = p; sm[r] += p; }
    block_sum4(red, sm, wave, lane);
    for (int kidx = tid; kidx < NK; kidx += 512)
#pragma unroll
        for (int r = 0; r < 4; ++r) SC[r * 1024 + kidx] *= (sm[r] > 0.f ? 1.0f / sm[r] : 0.f);
    __syncthreads();
    f32x4 acc[4];
#pragma unroll
    for (int r = 0; r < 4; ++r) acc[r] = (f32x4){0.f, 0.f, 0.f, 0.f};
#pragma unroll 1
    for (int it0 = 0; it0 < NIT; it0 += NBATCH_S) {
        f32x4 vv[NBATCH_S];
#pragma unroll
        for (int u = 0; u < NBATCH_S; ++u) { const int kidx = (it0 + u) * 32 + wave * 4 + kg; int dist; bool valid; const float* kp = sample_key<KIND>(c, SEL, SELB, kidx, dist, valid); vv[u] = *(const GAS f32x4*)(kp + 128 + 4 * sub); }
#pragma unroll
        for (int u = 0; u < NBATCH_S; ++u) { const int kidx = (it0 + u) * 32 + wave * 4 + kg;
#pragma unroll
            for (int r = 0; r < 4; ++r) acc[r] += vv[u] * SC[r * 1024 + kidx]; }
    }
#pragma unroll
    for (int r = 0; r < 4; ++r)
#pragma unroll
        for (int j = 0; j < 4; ++j) { float x = acc[r][j]; x += __shfl_xor(x, 16); x += __shfl_xor(x, 32); acc[r][j] = x; }
    if (lane < 16) {
#pragma unroll
        for (int r = 0; r < 4; ++r) *(LAS f32x4*)(red + wave * 256 + r * 64 + 4 * sub) = acc[r];
    }
    __syncthreads();
    if (tid < 256) { const int r = tid >> 6; float o = 0.f;
#pragma unroll
        for (int wv = 0; wv < 8; ++wv) o += red[wv * 256 + tid];
        const float gt = sigmoidf_(bf2f(((const bf16*)(F.ws + WS_HB))[(size_t)(MP + b) * NIN + C_GLA + (g * 4 + r) * 3 + KIND]));
        ((LAS float*)(L + SL_OUT))[tid] += gt * o; }
    __syncthreads();
}
__device__ __forceinline__ void nsa_sample_unit(Frame& F, int unit) {
    const int b = unit >> 1, g = unit & 1;
    int tid = F.tid; asm volatile("" : "+v"(tid));
    LAS unsigned char* L = F.lds + RING_OFF;
    LAS float* SC = (LAS float*)(L + SL_SC); LAS float* Q = (LAS float*)(L + SL_Q); LAS float* IMP = (LAS float*)(L + SL_IMP); LAS int* SEL = (LAS int*)(L + SL_SEL);
    LAS unsigned long long* SELB = (LAS unsigned long long*)(L + SL_SELB);
    SampleCtx c;
    c.kcvs = (const float*)(F.ws + WS_KCVS) + (size_t)b * 1024 * 256 + g * 64; c.csel = F.in[3] + g * 64; c.cwin = F.in[4] + (size_t)b * 512 * 256 + g * 64;
    c.new_sel = F.out + OFF7 + (size_t)b * 256 + g * 64; c.new_win = F.out + OFF8 + ((size_t)b * 512 + 511) * 256 + g * 64;
    __syncthreads();
    if (tid < 256) { Q[tid] = bf2f(((const bf16*)(F.ws + WS_HB))[(size_t)(MP + b) * NIN + C_QA + g * 256 + tid]); ((LAS float*)(L + SL_OUT))[tid] = 0.f; }
    __syncthreads();
    sample_branch<0>(F, c, b, g, tid);
    if (tid < 257) { float s = 0.f;
#pragma unroll
        for (int cc = 0; cc < 4; ++cc) { const int n = 4 * tid + cc; if (n < NCMP_S) s += (SC[n] + SC[1024 + n]) + (SC[2048 + n] + SC[3072 + n]); }
        IMP[tid] = (tid == 0 || tid >= 255) ? -1.0f : s; }
    __syncthreads();
    if (tid < 64) {
        if (tid == 0) { SEL[0] = 0; SEL[1] = 255; SEL[2] = 256; }
        float vals[4]; unsigned avail = 0xfu;
#pragma unroll
        for (int i = 0; i < 4; ++i) { const int j = tid * 4 + i; vals[i] = IMP[j]; if (vals[i] < 0.f) avail &= ~(1u << i); }
        for (int round = 0; round < 13; ++round) {
            float bv = -1.0f; int bi = 1 << 20;
#pragma unroll
            for (int i = 0; i < 4; ++i) if (((avail >> i) & 1u) && vals[i] > bv) { bv = vals[i]; bi = tid * 4 + i; }
#pragma unroll
            for (int o = 1; o < 64; o <<= 1) { const float ov = __shfl_xor(bv, o); const int oi = __shfl_xor(bi, o); if (ov > bv || (ov == bv && oi < bi)) { bv = ov; bi = oi; } }
            if ((bi >> 2) == tid) avail &= ~(1u << (bi & 3));
            if (tid == 0) SEL[3 + round] = bi;
        }
    }
    __syncthreads();
    if (tid < 16) { const int jb = SEL[tid]; const int* pt = (const int*)F.in[6] + b * NPAGES;
        SELB[tid] = jb < 256 ? ((unsigned long long)pt[jb >> 1] * 128ull + (unsigned long long)((jb & 1) * 64)) * 256ull : 0ull; }
    __syncthreads();
    sample_branch<1>(F, c, b, g, tid);
    sample_branch<2>(F, c, b, g, tid);
    if (tid < 256) ((bf16*)(F.ws + WS_OA))[(size_t)(MP + b) * 512 + g * 256 + tid] = (bf16)f2bf(((LAS float*)(L + SL_OUT))[tid]);
    __syncthreads();
}
__device__ __forceinline__ void p3_phase(Frame& F) {
    for (int u = blockIdx.x; u < 16 * HG_NSEG; u += F.G) hgrn_segment<1>(F, u / HG_NSEG, u % HG_NSEG);
#pragma unroll 1
    for (int u2 = 2 * blockIdx.x; u2 < 512; u2 += 2 * F.G) {
#pragma unroll 1
        for (int which = 0; which < 2; ++which) { const int p = u2 >> 1, bg = p >> 6, qq = p & 63; nsa_prompt_unit(F, bg * 128 + (which ? qq : 127 - qq)); } }
    for (int u = blockIdx.x; u < 2 * MS; u += F.G) nsa_sample_unit(F, u);
}
namespace pg8 {
typedef unsigned u32x2e __attribute__((ext_vector_type(2)));
__device__ __forceinline__ float bfl(unsigned w) { return __uint_as_float(w << 16); }
__device__ __forceinline__ float bfh(unsigned w) { return __uint_as_float(w & 0xffff0000u); }
__device__ __forceinline__ float sgm(float x) { return 1.0f / (1.0f + __expf(-x)); }
struct EpiGateA {
    static constexpr bool PERM = false, AFTER_DRAIN = false;
    const bf16_t* HBp; float* TB;
    __device__ __forceinline__ void operator()(const f32x4 (&acc)[2][2][4][2], const Unit& u, int wr, int wc, int fr, int fq) const {
        const int row0 = u.pm * BM + wr * 64 + fr, col0 = u.pn * BM + wc * 32 + 4 * fq;
#pragma unroll
        for (int ai = 0; ai < 2; ++ai)
#pragma unroll
            for (int m = 0; m < 4; ++m) { const size_t r = (size_t)(row0 + ai * HALF + m * 16);
#pragma unroll
                for (int bj = 0; bj < 2; ++bj)
#pragma unroll
                    for (int n = 0; n < 2; ++n) { const int c = col0 + bj * HALF + n * 16; const u32x2e gw = *(const u32x2e*)(HBp + r * NIN + C_MG + c); const f32x4 a = acc[ai][bj][m][n];
                        *(f32x4*)(TB + r * D + c) = (f32x4){sgm(bfl(gw.x)) * a[0], sgm(bfh(gw.x)) * a[1], sgm(bfl(gw.y)) * a[2], sgm(bfh(gw.y)) * a[3]}; } }
    }
};
struct EpiGateB {
    static constexpr bool PERM = false, AFTER_DRAIN = false;
    const bf16_t* HBp; const float* TB; bf16_t* MG;
    __device__ __forceinline__ void operator()(const f32x4 (&acc)[2][2][4][2], const Unit& u, int wr, int wc, int fr, int fq) const {
        const int row0 = u.pm * BM + wr * 64 + fr, col0 = u.pn * BM + wc * 32 + 4 * fq;
#pragma unroll
        for (int ai = 0; ai < 2; ++ai)
#pragma unroll
            for (int m = 0; m < 4; ++m) { const size_t r = (size_t)(row0 + ai * HALF + m * 16);
#pragma unroll
                for (int bj = 0; bj < 2; ++bj)
#pragma unroll
                    for (int n = 0; n < 2; ++n) { const int c = col0 + bj * HALF + n * 16; const u32x2e gw = *(const u32x2e*)(HBp + r * NIN + C_MG + D + c); const f32x4 a = acc[ai][bj][m][n]; const f32x4 t = *(const f32x4*)(TB + r * D + c);
                        u32x2e o; o.x = cvt_pk_bf16(t[0] + sgm(bfl(gw.x)) * a[0], t[1] + sgm(bfh(gw.x)) * a[1]); o.y = cvt_pk_bf16(t[2] + sgm(bfl(gw.y)) * a[2], t[3] + sgm(bfh(gw.y)) * a[3]);
                        *(u32x2e*)(MG + r * D + c) = o; } }
    }
};
struct EpiResid {
    static constexpr bool PERM = false, AFTER_DRAIN = false;
    const float* rp; const float* rs; float* Z;
    __device__ __forceinline__ void operator()(const f32x4 (&acc)[2][2][4][2], const Unit& u, int wr, int wc, int fr, int fq) const {
        const int row0 = u.pm * BM + wr * 64 + fr, col0 = u.pn * BM + wc * 32 + 4 * fq;
#pragma unroll
        for (int ai = 0; ai < 2; ++ai)
#pragma unroll
            for (int m = 0; m < 4; ++m) { const int r = row0 + ai * HALF + m * 16; const float* xr = r < MP ? rp + (size_t)r * D : (r < MP + MS ? rs + (size_t)(r - MP) * D : nullptr);
#pragma unroll
                for (int bj = 0; bj < 2; ++bj)
#pragma unroll
                    for (int n = 0; n < 2; ++n) { const int c = col0 + bj * HALF + n * 16; const f32x4 x = xr ? *(const f32x4*)(xr + c) : (f32x4){0.f, 0.f, 0.f, 0.f};
                        *(f32x4*)(Z + (size_t)r * D + c) = x * DN_ALPHA + acc[ai][bj][m][n]; } }
    }
};
struct EpiRelu2 {
    static constexpr bool PERM = true, AFTER_DRAIN = false;
    bf16_t* U;
    __device__ __forceinline__ void operator()(const f32x4 (&acc)[2][2][4][2], const Unit& u, int wr, int wc, int fr, int fq) const {
        const int row0 = u.pm * BM + wr * 64 + fr, col0 = u.pn * BM + wc * 32 + 8 * fq;
#pragma unroll
        for (int ai = 0; ai < 2; ++ai)
#pragma unroll
            for (int m = 0; m < 4; ++m) { bf16_t* rowp = U + (size_t)(row0 + ai * HALF + m * 16) * FF + col0;
#pragma unroll
                for (int bj = 0; bj < 2; ++bj) { f32x4 v0 = acc[ai][bj][m][0], v1 = acc[ai][bj][m][1];
#pragma unroll
                    for (int j = 0; j < 4; ++j) { const float a = fmaxf(v0[j], 0.f), b = fmaxf(v1[j], 0.f); v0[j] = a * a; v1[j] = b * b; }
                    u32x4 w; w.x = cvt_pk_bf16(v0[0], v0[1]); w.y = cvt_pk_bf16(v0[2], v0[3]); w.z = cvt_pk_bf16(v1[0], v1[1]); w.w = cvt_pk_bf16(v1[2], v1[3]);
                    *(u32x4*)(rowp + bj * HALF) = w; } }
    }
};
}
__device__ __forceinline__ void ln_phase(Frame& F, const float* Z, const float* gam, const float* bet, int which) {
    const int gw = F.vcu * NWAVES + F.wave, NGW = F.G * NWAVES, lane = F.lane;
    const int nrows = MP + MS;
    for (int r = gw; r < nrows; r += NGW) {
        const GAS f32x4* zr = (const GAS f32x4*)(Z + (size_t)r * D) + lane;
        f32x4 v[4]; float s = 0.f;
        if (which && r >= MP) {
            const GAS f32x4* x1r = (const GAS f32x4*)((const float*)(F.ws + WS_X1F) + (size_t)r * D) + lane;
#pragma unroll
            for (int j = 0; j < 4; ++j) { f32x4 t = x1r[64 * j] * DN_ALPHA;
#pragma unroll
                for (int kq = 0; kq < 4; ++kq) t += *((const GAS f32x4*)(Z + (size_t)(MP + 32 * kq + (r - MP)) * D) + lane + 64 * j);
                v[j] = t; s += (t.x + t.y) + (t.z + t.w); }
        } else {
#pragma unroll
        for (int j = 0; j < 4; ++j) { v[j] = zr[64 * j]; s += (v[j].x + v[j].y) + (v[j].z + v[j].w); }
        }
        const float mean = wave_sum(s) * (1.f / D); float s2 = 0.f;
#pragma unroll
        for (int j = 0; j < 4; ++j) { v[j] = v[j] - mean; s2 += (v[j].x * v[j].x + v[j].y * v[j].y) + (v[j].z * v[j].z + v[j].w * v[j].w); }
        const float rstd = 1.f / sqrtf(wave_sum(s2) * (1.f / D) + LN_EPS);
        float* of = which ? (r < MP ? F.out + OFF0 + (size_t)r * D : F.out + OFF1 + (size_t)(r - MP) * D) : (float*)(F.ws + WS_X1F) + (size_t)r * D;
#pragma unroll
        for (int j = 0; j < 4; ++j) { const f32x4 gg = *((const GAS f32x4*)gam + lane + 64 * j), bb = *((const GAS f32x4*)bet + lane + 64 * j);
            v[j] = v[j] * rstd * gg + bb; *((GAS f32x4*)of + lane + 64 * j) = v[j]; }
        if (!which) { GAS unsigned long long* o8 = (GAS unsigned long long*)((bf16*)(F.ws + WS_X1B) + (size_t)r * D) + lane;
#pragma unroll
            for (int j = 0; j < 4; ++j) o8[64 * j] = (unsigned long long)pk2(v[j].x, v[j].y) | ((unsigned long long)pk2(v[j].z, v[j].w) << 32); }
    }
}
__device__ __forceinline__ f32x16 small_gemm(const bf16* A, int lda, const bf16* Bt, int K, int n0, int k0, int k1, int l31, int h5, f32x16 acc) {
    const bf16* ap = A + (size_t)l31 * lda + 8 * h5; const bf16* bp = Bt + (size_t)(n0 + l31) * K + 8 * h5;
#pragma unroll 1
    for (int k = k0; k < k1; k += 128) {
        bf16x8 av[8], bv[8];
#pragma unroll
        for (int j = 0; j < 8; ++j) { av[j] = *(const GAS bf16x8*)(ap + k + 16 * j); bv[j] = *(const GAS bf16x8*)(bp + k + 16 * j); }
#pragma unroll
        for (int j = 0; j < 8; ++j) acc = MFMA32(av[j], bv[j], acc);
    }
    return acc;
}
#define SMALL_TASK_LOOP(NT) for (int it = F.vcu + F.G * F.wave; it < (NT); it += F.G * NWAVES)
__device__ __forceinline__ f32x16 zero16() { f32x16 z;
#pragma unroll
    for (int i = 0; i < 16; ++i) z[i] = 0.f;
    return z; }
__device__ __forceinline__ void sample_merge_tasks(Frame& F) {
    const int l31 = F.lane & 31, h5 = F.lane >> 5; const bf16* HB = (const bf16*)(F.ws + WS_HB);
    SMALL_TASK_LOOP(32) { const int n0 = it * 32, n = n0 + l31;
        const f32x16 aa = small_gemm((const bf16*)(F.ws + WS_OA) + (size_t)MP * 512, 512, (const bf16*)(F.ws + WS_WA), 512, n0, 0, 512, l31, h5, zero16());
        const f32x16 ab = small_gemm((const bf16*)(F.ws + WS_OB) + (size_t)MP * 512, 512, (const bf16*)(F.ws + WS_WB), 512, n0, 0, 512, l31, h5, zero16());
#pragma unroll
        for (int v = 0; v < 16; ++v) { const size_t row = (size_t)(MP + crow(v, h5));
            const float g1 = sigmoidf_(bf2f(HB[row * NIN + C_MG + n])), g2 = sigmoidf_(bf2f(HB[row * NIN + C_MG + D + n]));
            ((bf16*)(F.ws + WS_MG))[row * D + n] = (bf16)f2bf(g1 * aa[v] + g2 * ab[v]); } }
}
__device__ __forceinline__ void sample_wout_tasks(Frame& F) {
    const int l31 = F.lane & 31, h5 = F.lane >> 5;
    SMALL_TASK_LOOP(32) { const int n0 = it * 32, n = n0 + l31;
        const f32x16 a = small_gemm((const bf16*)(F.ws + WS_MG) + (size_t)MP * D, D, (const bf16*)(F.ws + WS_WO), D, n0, 0, D, l31, h5, zero16());
#pragma unroll
        for (int v = 0; v < 16; ++v) { const int row = crow(v, h5); ((float*)(F.ws + WS_Z1))[(size_t)(MP + row) * D + n] = DN_ALPHA * F.in[1][(size_t)row * D + n] + a[v]; } }
}
__device__ __forceinline__ void sample_up_tasks(Frame& F) {
    const int l31 = F.lane & 31, h5 = F.lane >> 5;
    SMALL_TASK_LOOP(128) { const int n0 = it * 32, n = n0 + l31;
        const f32x16 a = small_gemm((const bf16*)(F.ws + WS_X1B) + (size_t)MP * D, D, (const bf16*)(F.ws + WS_WUP), D, n0, 0, D, l31, h5, zero16());
#pragma unroll
        for (int v = 0; v < 16; ++v) { const float x = fmaxf(a[v], 0.f); ((bf16*)(F.ws + WS_UB))[(size_t)(MP + crow(v, h5)) * FF + n] = (bf16)f2bf(x * x); } }
}
__device__ __forceinline__ void sample_down_tasks(Frame& F) {
    const int l31 = F.lane & 31, h5 = F.lane >> 5;
    SMALL_TASK_LOOP(128) { const int n0 = (it & 31) * 32, kq = it >> 5, n = n0 + l31;
        const f32x16 a = small_gemm((const bf16*)(F.ws + WS_UB) + (size_t)MP * FF, FF, (const bf16*)(F.ws + WS_WDN), FF, n0, kq * 1024, kq * 1024 + 1024, l31, h5, zero16());
#pragma unroll
        for (int v = 0; v < 16; ++v) ((float*)(F.ws + WS_Z2))[(size_t)(MP + 32 * kq + crow(v, h5)) * D + n] = a[v]; }
}

#ifdef PROBE_LAST
#ifndef PROBE_BASE
#define PROBE_BASE WS_KCP
#endif
#ifndef PROBE_BYTES
#define PROBE_BYTES (WS_TB - WS_KCP)
#endif
__device__ __forceinline__ void probe_digest(Frame& F, const XcdBarrier& bar) {
    const size_t i0 = (size_t)blockIdx.x * 512 + F.tid, st = (size_t)F.G * 512;
    for (size_t i = i0; i < OUT_TOTAL; i += st) F.out[i] = 0.f;
    xcd_barrier(bar);
    const unsigned* w = (const unsigned*)(F.ws + PROBE_BASE); const size_t nw = (size_t)(PROBE_BYTES) / 4;
    unsigned h = 0u;
    for (size_t i = i0; i < nw; i += st) h += (w[i] ^ (unsigned)i) * 2654435761u;
#pragma unroll
    for (int o = 1; o < 64; o <<= 1) h += __shfl_xor(h, o);
    if (F.lane == 0) F.out[(size_t)blockIdx.x * 8 + F.wave] = (float)(h & 0xFFFFFu);
}
#endif
struct Args { const float* in[21]; float* out; unsigned char* ws; int ph_lo, ph_hi; };
__global__ void __launch_bounds__(NWAVES * 64, 2) nsa_fwd(Args args) {
    extern __shared__ __attribute__((aligned(16))) unsigned char lds[];
    Frame F;
    F.lds = (LAS unsigned char*)lds;
    F.MISC = (volatile LAS unsigned*)(F.lds + MISC_OFF);
    F.tid = threadIdx.x; F.lane = F.tid & 63; F.wave = __builtin_amdgcn_readfirstlane(F.tid >> 6);
    F.G = gridDim.x; { const int bx = blockIdx.x; F.vcu = (F.G % 8 == 0) ? (bx % 8) * (F.G / 8) + bx / 8 : bx; }
    F.ws = args.ws; F.out = args.out;
#pragma unroll
    for (int i = 0; i < 21; ++i) F.in[i] = args.in[i];
    F.ctl = (gu32*)(F.ws + WS_CTL);
    for (int u = F.tid; u < (LDS_BYTES - LDSCTL_OFF) / 4; u += NWAVES * 64) ((LAS unsigned*)(F.lds + LDSCTL_OFF))[u] = 0u;
    __syncthreads();
    XcdBarrier bar = xcd_barrier_post((unsigned*)(F.ctl + CW_BAR), F.MISC + 8);
    const int lo = args.ph_lo, hi = args.ph_hi;
#ifdef PROBE_TIMING
    unsigned long long ts[11];
#define STAMP(k) ts[k] = rt();
#else
#define STAMP(k)
#endif
    STAMP(0)
#define IN(k) (lo <= (k) && (k) < hi)
#define BOTH(k) (IN(k) && IN((k) + 1))
#define GRID_BAR() xcd_barrier(bar)


#ifdef PROBE_LAST
#define PROBE_AFTER(k) if ((k) == PROBE_LAST) { probe_digest(F, bar); return; }
#else
#define PROBE_AFTER(k)
#endif
    if (IN(0)) { p0_prologue(F); if (BOTH(0)) GRID_BAR(); }
    PROBE_AFTER(0)
    STAMP(1)
    if (IN(1)) {
        pg8::Gemm g{(const pg8::bf16_t*)(F.ws + WS_XB), (const pg8::bf16_t*)(F.ws + WS_WIN), MALL, NIN, D}; pg8::StaticOrder S; S.init(MALL, NIN, F.G, (int)blockIdx.x);
        pg8::EpiInProj E{(pg8::bf16_t*)(F.ws + WS_HB), F.out};
        pg8::gemm_phase<pg8::EpiInProj, pg8::StaticOrder, true, true>(F.lds + RING_OFF, g, S, E);
        if (BOTH(1)) GRID_BAR();
    }
    PROBE_AFTER(1)
    STAMP(2)

    if (IN(2)) { p2_phase(F); if (BOTH(2)) GRID_BAR(); }
    PROBE_AFTER(2)
    STAMP(3)
    if (IN(3)) { p3_phase(F); if (BOTH(3)) GRID_BAR(); }
    PROBE_AFTER(3)
    STAMP(4)
    if (IN(4)) {
        { pg8::Gemm g{(const pg8::bf16_t*)(F.ws + WS_OA), (const pg8::bf16_t*)(F.ws + WS_WA), MP, D, 512}; pg8::StaticOrder S; S.init(MP, D, F.G, (int)blockIdx.x);
          pg8::EpiGateA E{(const pg8::bf16_t*)(F.ws + WS_HB), (float*)(F.ws + WS_TB)};
          pg8::gemm_phase<pg8::EpiGateA, pg8::StaticOrder, true, true>(F.lds + RING_OFF, g, S, E); }
        { pg8::Gemm g{(const pg8::bf16_t*)(F.ws + WS_OB), (const pg8::bf16_t*)(F.ws + WS_WB), MP, D, 512}; pg8::StaticOrder S; S.init(MP, D, F.G, (int)blockIdx.x);
          pg8::EpiGateB E{(const pg8::bf16_t*)(F.ws + WS_HB), (const float*)(F.ws + WS_TB), (pg8::bf16_t*)(F.ws + WS_MG)};
          pg8::gemm_phase<pg8::EpiGateB, pg8::StaticOrder, true, true>(F.lds + RING_OFF, g, S, E); }
        sample_merge_tasks(F);
        if (BOTH(4)) GRID_BAR();
    }
    PROBE_AFTER(4)
    STAMP(5)
    if (IN(5)) {
        pg8::Gemm g{(const pg8::bf16_t*)(F.ws + WS_MG), (const pg8::bf16_t*)(F.ws + WS_WO), MP, D, D}; pg8::StaticOrder S; S.init(MP, D, F.G, (int)blockIdx.x);
        pg8::EpiResid E{F.in[0], F.in[1], (float*)(F.ws + WS_Z1)};
        pg8::gemm_phase<pg8::EpiResid, pg8::StaticOrder, true, true>(F.lds + RING_OFF, g, S, E);
        sample_wout_tasks(F);
        if (BOTH(5)) GRID_BAR();
    }
    PROBE_AFTER(5)
    STAMP(6)
    if (IN(6)) { ln_phase(F, (const float*)(F.ws + WS_Z1), F.in[15], F.in[16], 0); if (BOTH(6)) GRID_BAR(); }
    PROBE_AFTER(6)
    STAMP(7)
    if (IN(7)) {
        pg8::Gemm g{(const pg8::bf16_t*)(F.ws + WS_X1B), (const pg8::bf16_t*)(F.ws + WS_WUP), MP, FF, D}; pg8::StaticOrder S; S.init(MP, FF, F.G, (int)blockIdx.x);
        pg8::EpiRelu2 E{(pg8::bf16_t*)(F.ws + WS_UB)};
        pg8::gemm_phase<pg8::EpiRelu2, pg8::StaticOrder, true, true>(F.lds + RING_OFF, g, S, E);
        sample_up_tasks(F);
        if (BOTH(7)) GRID_BAR();
    }
    PROBE_AFTER(7)
    STAMP(8)
    if (IN(8)) {
        pg8::Gemm g{(const pg8::bf16_t*)(F.ws + WS_UB), (const pg8::bf16_t*)(F.ws + WS_WDN), MP, D, FF}; pg8::StaticOrder S; S.init(MP, D, F.G, (int)blockIdx.x);
        pg8::EpiResid E{(const float*)(F.ws + WS_X1F), (const float*)(F.ws + WS_X1F) + (size_t)MP * D, (float*)(F.ws + WS_Z2)};
        pg8::gemm_phase<pg8::EpiResid, pg8::StaticOrder, true, true>(F.lds + RING_OFF, g, S, E);
        sample_down_tasks(F);
        if (BOTH(8)) GRID_BAR();
    }
    PROBE_AFTER(8)
    STAMP(9)
    if (IN(9)) { ln_phase(F, (const float*)(F.ws + WS_Z2), F.in[19], F.in[20], 1); }
#ifdef PROBE_TIMING
    GRID_BAR();
    STAMP(10)
    { const size_t i0 = (size_t)blockIdx.x * 512 + F.tid, st = (size_t)F.G * 512; for (size_t i = i0; i < OUT_TOTAL; i += st) ((unsigned*)F.out)[i] = 0xAAAAAAABu; }
    GRID_BAR();
    if (blockIdx.x == 0) {
        const size_t offs[10] = {OFF0, OFF1, OFF2, OFF3, OFF4, OFF5, OFF6, OFF7, OFF8, OFF9};
#pragma unroll
        for (int k = 0; k < 10; ++k) { const unsigned n = (unsigned)((ts[k + 1] - ts[k]) / 10ull); for (unsigned i = F.tid; i < n; i += 512) ((unsigned*)F.out)[offs[k] + i] = 0xAAAAAAAAu; }
    }
#endif
#ifdef PROBE_SANITIZE
    GRID_BAR();
    { const size_t i0 = (size_t)blockIdx.x * 512 + F.tid, st = (size_t)F.G * 512;
      for (size_t i = i0; i < OUT_TOTAL; i += st) { const float v = F.out[i]; if (!(v - v == 0.f)) F.out[i] = 0.f; } }
#endif
#undef IN
#undef BOTH
}

extern "C" void kernel_launch(void* const* d_in, const int* in_sizes, int n_in, void* d_out, int out_size, void* d_ws, size_t ws_size, hipStream_t stream) {
    static int grid = 0;
    if (grid == 0) {
        if (n_in != 21 || (size_t)out_size != OUT_TOTAL || ws_size < WS_END) { fprintf(stderr, "kernel_launch: unexpected shapes: n_in %d out %d ws %zu (need %zu)\n", n_in, out_size, ws_size, (size_t)WS_END); grid = -1; return; }
        int dev = 0, cus = 0, per_cu = 0;
        if (hipGetDevice(&dev) != hipSuccess || hipDeviceGetAttribute(&cus, hipDeviceAttributeMultiprocessorCount, dev) != hipSuccess) { grid = -1; return; }
        if (hipFuncSetAttribute((const void*)nsa_fwd, hipFuncAttributeMaxDynamicSharedMemorySize, LDS_BYTES) != hipSuccess) { fprintf(stderr, "kernel_launch: hipFuncSetAttribute failed\n"); grid = -1; return; }
        if (hipOccupancyMaxActiveBlocksPerMultiprocessor(&per_cu, (const void*)nsa_fwd, NWAVES * 64, LDS_BYTES) != hipSuccess || per_cu < 1) { fprintf(stderr, "kernel_launch: occupancy query says %d\n", per_cu); }
        (void)hipGetLastError();
        grid = cus;
    }
    if (grid < 0) return;
    if (hipMemsetAsync((char*)d_ws + WS_CTL, 0, CTL_ZERO_BYTES, stream) != hipSuccess) return;
    Args a{};
    for (int i = 0; i < 21; ++i) a.in[i] = (const float*)d_in[i];
    a.out = (float*)d_out; a.ws = (unsigned char*)d_ws; a.ph_lo = 0; a.ph_hi = 100;
    hipLaunchKernelGGL(nsa_fwd, dim3(grid), dim3(NWAVES * 64), LDS_BYTES, stream, a);
}
```

```cpp
#include <hip/hip_runtime.h>
#include <cstdio>
#include <cstdint>
namespace pg8 {
#define PG8_LAS __attribute__((address_space(3)))
typedef unsigned short bf16_t;
typedef short bf16x8 __attribute__((ext_vector_type(8)));
typedef float f32x4 __attribute__((ext_vector_type(4)));
typedef unsigned u32x4 __attribute__((ext_vector_type(4)));
constexpr int BM = 256, BK = 64, HALF = 128, HTB = HALF * BK * 2  , STAGE_BYTES = 8 * HTB, NXCD = 8, WGM = 8;

__host__ __device__ __forceinline__ int lds_byte(int r, int c) { const int st = (r >> 4) * 2 + (c >> 5), rr = r & 15, cc = c & 31, ob = rr * 64 + cc * 2; return st * 1024 + (ob ^ (((ob >> 9) & 1) << 5)); }
__host__ __device__ __forceinline__ void stage_rc(int b, int& R, int& C) { const int st = b / 1024, sb = b % 1024, swz = sb ^ (((sb >> 9) & 1) << 5); R = (st >> 1) * 16 + swz / 64; C = (st & 1) * 32 + (swz % 64) / 2; }
__host__ __device__ __forceinline__ int perm32(int rho) { const int n = rho >> 4, i = rho & 15; return 8 * (i >> 2) + 4 * n + (i & 3); }

struct Unit { int pm, pn; };
struct Gemm { const bf16_t* A; const bf16_t* Bt; int M, N, K; };

struct StaticOrder {
    int nM, nN, nwg, G, c;
    __host__ __device__ void init(int M, int N, int G_, int c_) { nM = M / BM; nN = N / BM; nwg = nM * nN; G = G_; c = c_; }
    __host__ __device__ bool next(int i, Unit& u) const {
        const long L = (long)i * G + c; if (L >= nwg) return false;
        int wgid = (int)L; { const int q = nwg / NXCD, r = nwg % NXCD, xcd = wgid % NXCD, off = wgid / NXCD; wgid = (xcd < r ? xcd * (q + 1) : r * (q + 1) + (xcd - r) * q) + off; }
        const int nig = WGM * nN, gid = wgid / nig, fm = gid * WGM, gsz = (nM - fm) < WGM ? (nM - fm) : WGM;
        u.pm = fm + ((wgid % nig) % gsz); u.pn = (wgid % nig) / gsz; return true;
    }
    __device__ __forceinline__ void a_ready(const Unit&) const {}
    __device__ __forceinline__ void done(const Unit&) const {}
};

__device__ __forceinline__ unsigned cvt_pk_bf16(float lo, float hi) { unsigned r; asm volatile("v_cvt_pk_bf16_f32 %0, %1, %2" : "=v"(r) : "v"(lo), "v"(hi)); return r; }
typedef float f32x2 __attribute__((ext_vector_type(2)));
__device__ __forceinline__ f32x2 gelu_pk(f32x2 v) {
    const f32x2 av = __builtin_elementwise_abs(v), d = av * 0.2316418882f + 1.0f;
    f32x2 t; t.x = __builtin_amdgcn_rcpf(d.x); t.y = __builtin_amdgcn_rcpf(d.y);
    f32x2 q = t * 0.5307027145f + (-0.7265760135f); q = q * t + 0.7107068705f; q = q * t + (-0.142248368f); q = q * t + 0.127414796f; q = q * t;
    const f32x2 s = (v * v) * (-0.72134752044f);
    f32x2 e; e.x = __builtin_amdgcn_exp2f(s.x); e.y = __builtin_amdgcn_exp2f(s.y);
    const f32x2 m = v * (q * e), r = v - m;
    f32x2 o; o.x = v.x < 0.f ? m.x : r.x; o.y = v.y < 0.f ? m.y : r.y; return o;
}

template <int ACT  > struct EpiBf16 {
    static constexpr bool PERM = true, AFTER_DRAIN = false; static_assert(ACT == 0 || ACT == 1, "EpiBf16: ACT is 0 (none) or 1 (gelu_pk)");
    bf16_t* O; int ldc; const float* bias; int split_cols; size_t split_stride; float scale0;
    __device__ __forceinline__ void operator()(const f32x4 (&acc)[2][2][4][2], const Unit& u, int wr, int wc, int fr, int fq) const {
        const int row0 = u.pm * BM + wr * 64 + fr; int colt = u.pn * BM; bf16_t* base = O;
        float sc = 1.f; if (split_cols) { const int t = colt / split_cols; base += (size_t)t * split_stride; colt -= t * split_cols; if (t == 0) sc = scale0; }
        const int col0 = colt + wc * 32 + 8 * fq, bcol0 = u.pn * BM + wc * 32 + 8 * fq;
        f32x4 bv[2][2];
#pragma unroll
        for (int bj = 0; bj < 2; ++bj)
#pragma unroll
            for (int n = 0; n < 2; ++n) bv[bj][n] = bias ? *(const f32x4*)(bias + bcol0 + bj * HALF + 4 * n) : (f32x4){0.f, 0.f, 0.f, 0.f};
#pragma unroll
        for (int ai = 0; ai < 2; ++ai)
#pragma unroll
            for (int m = 0; m < 4; ++m) { bf16_t* rowp = base + (size_t)(row0 + ai * HALF + m * 16) * ldc + col0;
#pragma unroll
                for (int bj = 0; bj < 2; ++bj) { f32x4 v0 = acc[ai][bj][m][0] + bv[bj][0], v1 = acc[ai][bj][m][1] + bv[bj][1];
                    if (ACT == 1) { f32x2 a = gelu_pk((f32x2){v0[0], v0[1]}), b = gelu_pk((f32x2){v0[2], v0[3]}), c = gelu_pk((f32x2){v1[0], v1[1]}), d = gelu_pk((f32x2){v1[2], v1[3]});
                        v0 = (f32x4){a.x, a.y, b.x, b.y}; v1 = (f32x4){c.x, c.y, d.x, d.y}; }
                    v0 = v0 * sc; v1 = v1 * sc; u32x4 w; w.x = cvt_pk_bf16(v0[0], v0[1]); w.y = cvt_pk_bf16(v0[2], v0[3]); w.z = cvt_pk_bf16(v1[0], v1[1]); w.w = cvt_pk_bf16(v1[2], v1[3]);
                    *(u32x4*)(rowp + bj * HALF) = w; } }
    }
};

struct PanelStats {
    unsigned* xbuf;
    unsigned* cnt;
    unsigned* tmo;
    int ntn; float eps;
    unsigned code;
    __device__ __forceinline__ bool run(const f32x4 (&v)[2][2][4][2], const Unit& u, int wr, int wc, int fr, int fq, PG8_LAS unsigned char* lds, int wid, int lane) const {
        typedef float f32x2v __attribute__((ext_vector_type(2)));
        PG8_LAS f32x2v* P = (PG8_LAS f32x2v*)lds;
        PG8_LAS f32x2v* S = (PG8_LAS f32x2v*)(lds + 8192);
        PG8_LAS unsigned* flag = (PG8_LAS unsigned*)(lds + 8192 + 2048);
#pragma unroll
        for (int ai = 0; ai < 2; ++ai)
#pragma unroll
            for (int m = 0; m < 4; ++m) {
                float s = 0.f;
#pragma unroll
                for (int bj = 0; bj < 2; ++bj)
#pragma unroll
                    for (int n = 0; n < 2; ++n) { const f32x4 x = v[ai][bj][m][n]; s += (x[0] + x[1]) + (x[2] + x[3]); }
                s += __shfl_xor(s, 16); s += __shfl_xor(s, 32);
                const float mw = s * (1.0f / 64.0f); float q = 0.f;
#pragma unroll
                for (int bj = 0; bj < 2; ++bj)
#pragma unroll
                    for (int n = 0; n < 2; ++n) { const f32x4 d = v[ai][bj][m][n] - mw; q += (d[0] * d[0] + d[1] * d[1]) + (d[2] * d[2] + d[3] * d[3]); }
                q += __shfl_xor(q, 16); q += __shfl_xor(q, 32);
                if (fq == 0) P[(ai * HALF + wr * 64 + m * 16 + fr) * 4 + wc] = (f32x2v){mw, q};
            }
        asm volatile("s_waitcnt lgkmcnt(0)" ::: "memory"); __builtin_amdgcn_s_barrier(); asm volatile("" ::: "memory");
#if defined(BROKEN_EXCHANGE_NO_WAIT)
#warning BROKEN CONTROL BUILD: the row-statistics exchange does not wait; results are wrong by design
        if (blockIdx.x >= 64) { const long long t0_ = clock64(); while (clock64() - t0_ < 60000) __builtin_amdgcn_s_sleep(8); }
#endif
        const int row = wid * 32 + (lane & 31);
        if (lane < 32) {
            const f32x2v a = P[row * 4 + 0], b = P[row * 4 + 1], c = P[row * 4 + 2], d = P[row * 4 + 3];
            const float mt = (a.x + b.x + c.x + d.x) * 0.25f;
            const float da = a.x - mt, db = b.x - mt, dc = c.x - mt, dd = d.x - mt;
            const float m2 = (a.y + b.y) + (c.y + d.y) + 64.0f * ((da * da + db * db) + (dc * dc + dd * dd));
            unsigned long long* slot = (unsigned long long*)xbuf + ((size_t)(u.pm * BM + row) * 4 + u.pn);
            __hip_atomic_store(slot, ((unsigned long long)__float_as_uint(m2) << 32) | __float_as_uint(mt), __ATOMIC_RELAXED, __HIP_MEMORY_SCOPE_AGENT);
        }
        asm volatile("s_waitcnt vmcnt(0)" ::: "memory");
        if (lane == 0) __hip_atomic_fetch_add(cnt + 64 * u.pm, 1u, __ATOMIC_RELAXED, __HIP_MEMORY_SCOPE_AGENT);
        if (wid == 0) {
            bool dead = false; const unsigned long long t0 = __builtin_amdgcn_s_memrealtime(); const unsigned want = 8u * (unsigned)ntn;
            for (;;) {
#if defined(BROKEN_EXCHANGE_NO_WAIT)
                break;
#endif
                if ((unsigned)__builtin_amdgcn_readfirstlane(__hip_atomic_load(cnt + 64 * u.pm, __ATOMIC_RELAXED, __HIP_MEMORY_SCOPE_AGENT)) >= want) break;
                if (__builtin_amdgcn_s_memrealtime() - t0 > 2000000ull) {
                    if (lane == 0) { unsigned expect = 0u; __hip_atomic_compare_exchange_strong(tmo + 1, &expect, code | (unsigned)(u.pm & 0xff), __ATOMIC_RELAXED, __ATOMIC_RELAXED, __HIP_MEMORY_SCOPE_AGENT);
                                     __hip_atomic_store(tmo, 1u, __ATOMIC_RELAXED, __HIP_MEMORY_SCOPE_AGENT); }
                    dead = true; break; }
                __builtin_amdgcn_s_sleep(2);
            }
            __builtin_amdgcn_fence(__ATOMIC_ACQUIRE, "agent");
            if (lane == 0) flag[0] = dead ? 1u : 0u;
        }
        asm volatile("s_waitcnt vmcnt(0) lgkmcnt(0)" ::: "memory"); __builtin_amdgcn_s_barrier(); asm volatile("" ::: "memory");
        const bool bad = flag[0] != 0u;
        if (lane < 32) {
            const unsigned long long* slot = (const unsigned long long*)xbuf + (size_t)(u.pm * BM + row) * 4; float mt[4], m2[4]; float ms = 0.f;
#pragma unroll
            for (int t = 0; t < 4; ++t) { if (t < ntn) { const unsigned long long w = __hip_atomic_load(slot + t, __ATOMIC_RELAXED, __HIP_MEMORY_SCOPE_AGENT); mt[t] = __uint_as_float((unsigned)w); m2[t] = __uint_as_float((unsigned)(w >> 32)); } else { mt[t] = 0.f; m2[t] = 0.f; } ms += mt[t]; }
            const float mean = ms / (float)ntn; float q = 0.f;
#pragma unroll
            for (int t = 0; t < 4; ++t) if (t < ntn) { const float dm = mt[t] - mean; q += m2[t] + 256.0f * dm * dm; }
            S[row] = (f32x2v){mean, 1.0f / sqrtf(q / (256.0f * (float)ntn) + eps)};
        }
        asm volatile("s_waitcnt lgkmcnt(0)" ::: "memory"); __builtin_amdgcn_s_barrier(); asm volatile("" ::: "memory");
        return bad;
    }
};
struct EpiLnRes {
    static constexpr bool PERM = false, AFTER_DRAIN = true;
    const float* base; float* out; int ldc; const float* bias; PanelStats st; unsigned poison;
    __device__ __forceinline__ void fused(f32x4 (&acc)[2][2][4][2], const Unit& u, int wr, int wc, int fr, int fq, PG8_LAS unsigned char* lds, int wid, int lane) const {
        typedef float f32x2v __attribute__((ext_vector_type(2)));
        const PG8_LAS f32x2v* S = (const PG8_LAS f32x2v*)(lds + 8192);
        const int col0 = u.pn * BM + wc * 32 + 4 * fq;
#pragma unroll
        for (int bj = 0; bj < 2; ++bj)
#pragma unroll
            for (int n = 0; n < 2; ++n) { const f32x4 bv = bias ? *(const f32x4*)(bias + col0 + bj * HALF + n * 16) : (f32x4){0.f, 0.f, 0.f, 0.f};
#pragma unroll
                for (int ai = 0; ai < 2; ++ai)
#pragma unroll
                    for (int m = 0; m < 4; ++m) acc[ai][bj][m][n] += bv; }
        f32x4 pre[4][2][2];
#pragma unroll
        for (int m = 0; m < 4; ++m) { const size_t off = (size_t)(u.pm * BM + wr * 64 + m * 16 + fr) * ldc + col0;
#pragma unroll
            for (int bj = 0; bj < 2; ++bj)
#pragma unroll
                for (int n = 0; n < 2; ++n) pre[m][bj][n] = *(const f32x4*)(base + off + bj * HALF + n * 16); }
        const bool bad = st.run(acc, u, wr, wc, fr, fq, lds, wid, lane) || poison != 0u;
        const float qnan = __builtin_nanf("");
#pragma unroll
        for (int ai = 0; ai < 2; ++ai)
#pragma unroll
            for (int m = 0; m < 4; ++m) { const int r = ai * HALF + wr * 64 + m * 16 + fr; const f32x2v sr = S[r]; const size_t off = (size_t)(u.pm * BM + r) * ldc + col0;
#pragma unroll
                for (int bj = 0; bj < 2; ++bj)
#pragma unroll
                    for (int n = 0; n < 2; ++n) { const f32x4 bs = ai == 0 ? pre[m][bj][n] : *(const f32x4*)(base + off + bj * HALF + n * 16); f32x4 o = bs + (acc[ai][bj][m][n] - sr.x) * sr.y;
                        if (bad) o = (f32x4){qnan, qnan, qnan, qnan}; *(f32x4*)(out + off + bj * HALF + n * 16) = o; }
                if (m & 1) asm volatile("" ::: "memory"); }
    }
};
struct EpiLnResLn {
    static constexpr bool PERM = false, AFTER_DRAIN = true;
    const float* base; float* out; bf16_t* xn; int ldc; const float* bias; PanelStats st1, st2; unsigned poison;
    __device__ __forceinline__ void fused(f32x4 (&acc)[2][2][4][2], const Unit& u, int wr, int wc, int fr, int fq, PG8_LAS unsigned char* lds, int wid, int lane) const {
        typedef float f32x2v __attribute__((ext_vector_type(2))); typedef unsigned u32x2v __attribute__((ext_vector_type(2)));
        const PG8_LAS f32x2v* S = (const PG8_LAS f32x2v*)(lds + 8192);
        const int col0 = u.pn * BM + wc * 32 + 4 * fq;
#pragma unroll
        for (int bj = 0; bj < 2; ++bj)
#pragma unroll
            for (int n = 0; n < 2; ++n) { const f32x4 bv = bias ? *(const f32x4*)(bias + col0 + bj * HALF + n * 16) : (f32x4){0.f, 0.f, 0.f, 0.f};
#pragma unroll
                for (int ai = 0; ai < 2; ++ai)
#pragma unroll
                    for (int m = 0; m < 4; ++m) acc[ai][bj][m][n] += bv; }
        bool bad = st1.run(acc, u, wr, wc, fr, fq, lds, wid, lane) || poison != 0u;
        const float qnan = __builtin_nanf("");
#pragma unroll
        for (int ai = 0; ai < 2; ++ai)
#pragma unroll
            for (int m = 0; m < 4; ++m) { const int r = ai * HALF + wr * 64 + m * 16 + fr; const f32x2v sr = S[r]; const size_t off = (size_t)(u.pm * BM + r) * ldc + col0;
#pragma unroll
                for (int bj = 0; bj < 2; ++bj)
#pragma unroll
                    for (int n = 0; n < 2; ++n) { const f32x4 bs = *(const f32x4*)(base + off + bj * HALF + n * 16); acc[ai][bj][m][n] = bs + (acc[ai][bj][m][n] - sr.x) * sr.y; }
                asm volatile("" : "+v"(acc[ai][0][m][0]), "+v"(acc[ai][0][m][1]), "+v"(acc[ai][1][m][0]), "+v"(acc[ai][1][m][1]));
                if (m & 1) asm volatile("" ::: "memory"); }
        const bool bad1 = bad;
        bad = st2.run(acc, u, wr, wc, fr, fq, lds, wid, lane) || bad;
#pragma unroll
        for (int ai = 0; ai < 2; ++ai)
#pragma unroll
            for (int m = 0; m < 4; ++m) { const int r = ai * HALF + wr * 64 + m * 16 + fr; const f32x2v sr = S[r]; const size_t off = (size_t)(u.pm * BM + r) * ldc + col0;
#pragma unroll
                for (int bj = 0; bj < 2; ++bj)
#pragma unroll
                    for (int n = 0; n < 2; ++n) { const f32x4 x1 = acc[ai][bj][m][n]; *(f32x4*)(out + off + bj * HALF + n * 16) = bad1 ? (f32x4){qnan, qnan, qnan, qnan} : x1;
                        const f32x4 o = (x1 - sr.x) * sr.y; u32x2v w; w.x = cvt_pk_bf16(o[0], o[1]); w.y = cvt_pk_bf16(o[2], o[3]);
                        if (bad) { w.x = 0x7fc07fc0u; w.y = 0x7fc07fc0u; } *(u32x2v*)(xn + off + bj * HALF + n * 16) = w; }
                asm volatile("" ::: "memory"); }
    }
};

template <class Epi, class Sched, bool ALIGN_EPI = false, bool SP2 = false>
__device__ __forceinline__ void gemm_phase(PG8_LAS unsigned char* lds, const Gemm g, const Sched& S, const Epi& E) {
    const int tid = threadIdx.x, wid = __builtin_amdgcn_readfirstlane(tid >> 6), lane = tid & 63, wr = wid >> 2, wc = wid & 3, fr = lane & 15, fq = lane >> 4;
    const int K = g.K, nt = K / BK;
    unsigned voffA[2], voffB[2];
#pragma unroll
    for (int i = 0; i < 2; ++i) { int R, C; stage_rc(tid * 16 + i * 8192, R, C); const int Rb = Epi::PERM ? ((R & ~31) + perm32(R & 31)) : R;
        voffA[i] = (unsigned)(R * K + C) * 2u; voffB[i] = (unsigned)(Rb * K + C) * 2u; }
    const size_t kstep = (size_t)(BK * 2);
    const size_t hstep = (size_t)HALF * K * 2;
    const size_t tstep = 2 * hstep;
    const unsigned ldsw = (unsigned)wid * 1024u;
    const int aoff = lds_byte(wr * 64 + fr, fq * 8), boff = lds_byte(wc * 32 + fr, fq * 8);
#define PG8_SA(b, h) (((b) * 2 + (h)) * HTB)
#define PG8_SB(b, h) ((4 + (b) * 2 + (h)) * HTB)
#define PG8_STAGE(bufoff, gbase, voff) do { _Pragma("unroll") for (int _i = 0; _i < 2; ++_i) \
        __builtin_amdgcn_global_load_lds((const unsigned*)((const char*)(gbase) + (voff)[_i]), (PG8_LAS unsigned*)(lds + (bufoff) + ldsw + _i * 8192), 16, 0, 0); } while (0)
#define PG8_LDA(dst, b, h) do { _Pragma("unroll") for (int m = 0; m < 4; ++m) _Pragma("unroll") for (int k = 0; k < 2; ++k) dst[m][k] = *(const PG8_LAS bf16x8*)(lds + PG8_SA(b, h) + aoff + m * 2048 + k * 1024); } while (0)
#define PG8_LDB(dst, b, h) do { _Pragma("unroll") for (int n = 0; n < 2; ++n) _Pragma("unroll") for (int k = 0; k < 2; ++k) dst[n][k] = *(const PG8_LAS bf16x8*)(lds + PG8_SB(b, h) + boff + n * 2048 + k * 1024); } while (0)
#define PG8_MMA(ai, bj, At, Bt) do { __builtin_amdgcn_s_setprio(1); _Pragma("unroll") for (int m = 0; m < 4; ++m) _Pragma("unroll") for (int n = 0; n < 2; ++n) _Pragma("unroll") for (int k = 0; k < 2; ++k) \
        acc[ai][bj][m][n] = __builtin_amdgcn_mfma_f32_16x16x32_bf16(Bt[n][k], At[m][k], acc[ai][bj][m][n], 0, 0, 0); __builtin_amdgcn_s_setprio(0); } while (0)
#define PG8_WAIT_V(n) asm volatile("s_waitcnt vmcnt(" #n ")" ::: "memory")
#define PG8_WAIT_L(n) asm volatile("s_waitcnt lgkmcnt(" #n ")" ::: "memory")
#define PG8_BAR __builtin_amdgcn_s_barrier()
#define PG8_SCHED __builtin_amdgcn_sched_barrier(0)
    Unit cur, nxt; int ui = 0;
    if (!S.next(0, cur)) return;
    f32x4 acc[2][2][4][2];
#pragma unroll
    for (int a = 0; a < 2; ++a)
#pragma unroll
        for (int b = 0; b < 2; ++b)
#pragma unroll
            for (int m = 0; m < 4; ++m)
#pragma unroll
                for (int n = 0; n < 2; ++n) acc[a][b][m][n] = (f32x4){0.f, 0.f, 0.f, 0.f};
    bf16x8 At[4][2], B0[2][2], B1[2][2];
    const char* cA = (const char*)g.A + (size_t)cur.pm * tstep; const char* cB = (const char*)g.Bt + (size_t)cur.pn * tstep;
    S.a_ready(cur);
    if constexpr (SP2) {
        PG8_STAGE(PG8_SB(0, 0), cB, voffB); PG8_STAGE(PG8_SB(0, 1), cB + hstep, voffB); PG8_STAGE(PG8_SA(0, 0), cA, voffA); PG8_STAGE(PG8_SA(0, 1), cA + hstep, voffA);
        if (wr == 1) PG8_BAR;
        PG8_WAIT_V(2); PG8_BAR;
        PG8_STAGE(PG8_SB(1, 0), cB + kstep, voffB); PG8_STAGE(PG8_SA(1, 0), cA + kstep, voffA); PG8_STAGE(PG8_SB(1, 1), cB + hstep + kstep, voffB);
        PG8_WAIT_V(6); PG8_BAR;
    } else {
        PG8_STAGE(PG8_SB(0, 0), cB, voffB); PG8_STAGE(PG8_SA(0, 0), cA, voffA); PG8_STAGE(PG8_SB(0, 1), cB + hstep, voffB); PG8_STAGE(PG8_SA(0, 1), cA + hstep, voffA);
        if (wr == 1) PG8_BAR;
        PG8_WAIT_V(4); PG8_BAR;
        PG8_STAGE(PG8_SB(1, 0), cB + kstep, voffB); PG8_STAGE(PG8_SA(1, 0), cA + kstep, voffA); PG8_STAGE(PG8_SB(1, 1), cB + hstep + kstep, voffB);
        PG8_WAIT_V(6); PG8_BAR;
    }
    for (;;) {
        const bool has_next = S.next(ui + 1, nxt);
        const char* nA = has_next ? (const char*)g.A + (size_t)nxt.pm * tstep : cA; const char* nB = has_next ? (const char*)g.Bt + (size_t)nxt.pn * tstep : cB;
        for (int t = 0; t < nt; t += 2) {
            const bool last = (t == nt - 2);
            const char* a1 = cA + (size_t)(t + 1) * kstep;
            const char* a2 = last ? nA : cA + (size_t)(t + 2) * kstep; const char* b2 = last ? nB : cB + (size_t)(t + 2) * kstep;
            const char* a3 = a2 + kstep; const char* b3 = b2 + kstep;
            if (last && has_next) S.a_ready(nxt);
            if constexpr (SP2) {
            PG8_LDB(B0, 0, 0); PG8_LDB(B1, 0, 1); PG8_SCHED; PG8_LDA(At, 0, 0); PG8_STAGE(PG8_SA(1, 1), a1 + hstep, voffA);
            PG8_WAIT_V(8); PG8_WAIT_L(0); PG8_BAR; PG8_MMA(0, 0, At, B0); PG8_MMA(0, 1, At, B1); PG8_BAR; PG8_SCHED;
            PG8_LDA(At, 0, 1); PG8_STAGE(PG8_SB(0, 0), b2, voffB); PG8_STAGE(PG8_SB(0, 1), b2 + hstep, voffB); PG8_STAGE(PG8_SA(0, 0), a2, voffA);
            PG8_WAIT_V(8); PG8_WAIT_L(0); PG8_BAR; PG8_MMA(1, 0, At, B0); PG8_MMA(1, 1, At, B1); PG8_BAR; PG8_SCHED;
            PG8_LDB(B0, 1, 0); PG8_LDB(B1, 1, 1); PG8_SCHED; PG8_LDA(At, 1, 0); PG8_STAGE(PG8_SA(0, 1), a2 + hstep, voffA);
            PG8_WAIT_V(8); PG8_WAIT_L(0); PG8_BAR; PG8_MMA(0, 0, At, B0); PG8_MMA(0, 1, At, B1); PG8_BAR; PG8_SCHED;
            PG8_LDA(At, 1, 1); PG8_STAGE(PG8_SB(1, 0), b3, voffB); PG8_STAGE(PG8_SB(1, 1), b3 + hstep, voffB); PG8_STAGE(PG8_SA(1, 0), a3, voffA);
            PG8_WAIT_V(8); PG8_WAIT_L(0); PG8_BAR; PG8_MMA(1, 0, At, B0); PG8_MMA(1, 1, At, B1); PG8_BAR; PG8_SCHED;
            } else {
            PG8_LDB(B0, 0, 0); PG8_SCHED; PG8_LDA(At, 0, 0); PG8_STAGE(PG8_SA(1, 1), a1 + hstep, voffA);
            PG8_WAIT_L(8); PG8_BAR; PG8_WAIT_L(0); PG8_MMA(0, 0, At, B0); PG8_BAR; PG8_SCHED;
            PG8_LDB(B1, 0, 1); PG8_STAGE(PG8_SB(0, 0), b2, voffB);
            PG8_BAR; PG8_WAIT_L(0); PG8_MMA(0, 1, At, B1); PG8_BAR;
            PG8_LDA(At, 0, 1); PG8_STAGE(PG8_SA(0, 0), a2, voffA);
            PG8_BAR; PG8_WAIT_L(0); PG8_MMA(1, 0, At, B0); PG8_BAR; PG8_SCHED;
            PG8_STAGE(PG8_SB(0, 1), b2 + hstep, voffB);
            PG8_WAIT_V(6); PG8_BAR; PG8_MMA(1, 1, At, B1); PG8_BAR;
            PG8_LDB(B0, 1, 0); PG8_SCHED; PG8_LDA(At, 1, 0); PG8_STAGE(PG8_SA(0, 1), a2 + hstep, voffA);
            PG8_WAIT_L(8); PG8_BAR; PG8_WAIT_L(0); PG8_MMA(0, 0, At, B0); PG8_BAR; PG8_SCHED;
            PG8_LDB(B1, 1, 1); PG8_STAGE(PG8_SB(1, 0), b3, voffB);
            PG8_BAR; PG8_WAIT_L(0); PG8_MMA(0, 1, At, B1); PG8_BAR;
            PG8_LDA(At, 1, 1); PG8_STAGE(PG8_SA(1, 0), a3, voffA);
            PG8_BAR; PG8_WAIT_L(0); PG8_MMA(1, 0, At, B0); PG8_BAR; PG8_SCHED;
            PG8_STAGE(PG8_SB(1, 1), b3 + hstep, voffB);
            PG8_WAIT_V(6); PG8_BAR; PG8_MMA(1, 1, At, B1); PG8_BAR;
            }
        }
        if constexpr (ALIGN_EPI) { if (wr == 0) PG8_BAR; }
        if constexpr (!Epi::AFTER_DRAIN) { E(acc, cur, wr, wc, fr, fq); S.done(cur); }
        if (!has_next) break;
#pragma unroll
        for (int a = 0; a < 2; ++a)
#pragma unroll
            for (int b = 0; b < 2; ++b)
#pragma unroll
                for (int m = 0; m < 4; ++m)
#pragma unroll
                    for (int n = 0; n < 2; ++n) acc[a][b][m][n] = (f32x4){0.f, 0.f, 0.f, 0.f};
        cur = nxt; cA = nA; cB = nB; ++ui;
        if constexpr (ALIGN_EPI) { if (wr == 1) PG8_BAR; }
    }
    PG8_WAIT_V(0);
    if constexpr (!ALIGN_EPI) { if (wr == 0) PG8_BAR; }
    PG8_BAR;
    if constexpr (Epi::AFTER_DRAIN) { E.fused(acc, cur, wr, wc, fr, fq, lds, wid, lane); S.done(cur); }
#undef PG8_SA
#undef PG8_SB
#undef PG8_STAGE
#undef PG8_LDA
#undef PG8_LDB
#undef PG8_MMA
#undef PG8_WAIT_V
#undef PG8_WAIT_L
#undef PG8_BAR
#undef PG8_SCHED
}
}
#define GAS __attribute__((address_space(1)))
#define LAS __attribute__((address_space(3)))
typedef unsigned short bf16;
typedef unsigned v4u __attribute__((ext_vector_type(4)));
typedef float f32x4 __attribute__((ext_vector_type(4)));
typedef short bf16x8 __attribute__((ext_vector_type(8)));
typedef GAS unsigned gu32;
typedef GAS unsigned long long gu64;
#define RLX_AGENT __ATOMIC_RELAXED, __HIP_MEMORY_SCOPE_AGENT
#define LDS_WAIT() asm volatile("s_waitcnt lgkmcnt(0)" ::: "memory")
#define VM_WAIT() asm volatile("s_waitcnt vmcnt(0)" ::: "memory")
__device__ __forceinline__ unsigned long long rt() { return __builtin_amdgcn_s_memrealtime(); }
__device__ __forceinline__ unsigned f2bf(float f) { unsigned u = __builtin_bit_cast(unsigned, f); return (u + 0x7fffu + ((u >> 16) & 1u)) >> 16; }
__device__ __forceinline__ unsigned pk2(float lo, float hi) { return f2bf(lo) | (f2bf(hi) << 16); }

#define XB_TMO      128
#define XB_XCNT(j)  (256  + 64 * (j))
#define XB_XSUB(j)  (1280 + 64 * (j))
#define XB_XGEN(j)  (2304 + 64 * (j))
#define XB_TOP      3328
#define XB_TOPGEN   3392
#define XCD_BAR_WORDS 3456
#define XB_SPIN_CAP (1u << 18)

__device__ __forceinline__ unsigned xb_ld(unsigned* p)              { return __hip_atomic_load(p, __ATOMIC_RELAXED, __HIP_MEMORY_SCOPE_AGENT); }
__device__ __forceinline__ unsigned xb_add(unsigned* p, unsigned v) { return __hip_atomic_fetch_add(p, v, __ATOMIC_RELAXED, __HIP_MEMORY_SCOPE_AGENT); }
__device__ __forceinline__ unsigned xb_xcc_id() { return (unsigned)__builtin_amdgcn_s_getreg((3 << 11) | 20) & 0xFu; }
#define XB_SPIN(cond, bar) do { unsigned _sp = 0; while (cond) { __builtin_amdgcn_s_sleep(1); \
    if ((++_sp & 255u) == 0u) { if (xb_ld(&(bar)[XB_TMO])) break; if (_sp > XB_SPIN_CAP) { atomicAdd(&(bar)[XB_TMO], 1u); break; } } } } while (0)

struct XcdBarrier {
    unsigned* bar; unsigned x;
    volatile LAS unsigned* st;
};

__device__ __forceinline__ XcdBarrier xcd_barrier_post(unsigned* bar, volatile LAS unsigned* st) {
    XcdBarrier b; b.bar = bar; b.x = xb_xcc_id(); b.st = st;
    if (threadIdx.x == 0) (void)xb_add(&bar[XB_XCNT(b.x)], 1u);
    return b;
}
__device__ __forceinline__ void xcd_barrier_complete(unsigned* bar, unsigned x, unsigned& nloc, unsigned& nx) {
    const unsigned G = gridDim.x * gridDim.y * gridDim.z;
    unsigned sum, cnt, mine, sp = 0u;
    for (;;) {
        sum = 0u; cnt = 0u; mine = 0u;
#pragma unroll
        for (unsigned j = 0; j < 16; ++j) { const unsigned c = xb_ld(&bar[XB_XCNT(j)]); sum += c; cnt += (c > 0u) ? 1u : 0u; mine = (j == x) ? c : mine; }
        if (sum == G) break;
        __builtin_amdgcn_s_sleep(1);
        if ((++sp & 255u) == 0u) { if (xb_ld(&bar[XB_TMO])) break; if (sp > XB_SPIN_CAP) { atomicAdd(&bar[XB_TMO], 1u); break; } }
    }
    nloc = mine > 0u ? mine : 1u; nx = cnt > 0u ? cnt : 1u;
}

__device__ __forceinline__ void xcd_barrier(const XcdBarrier& b) {
    asm volatile("s_waitcnt vmcnt(0)" ::: "memory");
    __syncthreads();
    if (threadIdx.x == 0) {
        unsigned* bar = b.bar;
        __builtin_amdgcn_s_waitcnt(0);
        unsigned nloc = b.st[0], nx = b.st[1];
        if (nloc == 0u) { xcd_barrier_complete(bar, b.x, nloc, nx); b.st[0] = nloc; b.st[1] = nx; }
        const unsigned old = xb_add(&bar[XB_XSUB(b.x)], 1u);
        const unsigned gen = old / nloc;
        if (old + 1u == (gen + 1u) * nloc) {
            __builtin_amdgcn_fence(__ATOMIC_RELEASE, "agent");
            asm volatile("s_waitcnt vmcnt(0)" ::: "memory");
            const unsigned og = xb_add(&bar[XB_TOP], 1u);
            const unsigned tg = og / nx;
            if (og + 1u == (tg + 1u) * nx) xb_add(&bar[XB_TOPGEN], 1u);
            else XB_SPIN(xb_ld(&bar[XB_TOPGEN]) == tg, bar);
            __builtin_amdgcn_fence(__ATOMIC_ACQUIRE, "agent");
            xb_add(&bar[XB_XGEN(b.x)], 1u);
            asm volatile("s_waitcnt vmcnt(0)" ::: "memory");
        } else {
            XB_SPIN(xb_ld(&bar[XB_XGEN(b.x)]) == gen, bar);
            __builtin_amdgcn_fence(__ATOMIC_ACQUIRE, "agent");
            asm volatile("s_waitcnt vmcnt(0)" ::: "memory");
        }
    }
    __syncthreads();
}
constexpr int NWAVES = 8;
constexpr int T = 8192, NBATCH = 2, MP = NBATCH * T, MS = 32, MALL = 16640, D = 1024, NIN = 6656, FF = 4096;
constexpr int C_QA = 0, C_KVC = 512, C_KVS = 768, C_KVW = 1024, C_QB = 1280, C_FB = 2304, C_IB = 3328, C_GB = 3840, C_MG = 4352, C_GLA = 6400;
constexpr int PAST = 16384, NPAGES = 128, NCMP_S = 1023, NCMP_P = 511;
constexpr float LN_EPS = 1e-5f;
constexpr float DN_ALPHA = 1.189207115002721f;
constexpr size_t OFF0 = 0, OFF1 = OFF0 + (size_t)MP * D, OFF2 = OFF1 + (size_t)MS * D, OFF3 = OFF2 + (size_t)MP * 256, OFF4 = OFF3 + (size_t)MP * 256,
                 OFF5 = OFF4 + (size_t)NBATCH * 512 * 256, OFF6 = OFF5 + (size_t)NBATCH * 8 * 128 * 64, OFF7 = OFF6 + (size_t)MS * 256, OFF8 = OFF7 + (size_t)MS * 256,
                 OFF9 = OFF8 + (size_t)MS * 512 * 256, OUT_TOTAL = OFF9 + (size_t)MS * 8 * 128 * 64;
constexpr size_t MiB = 1u << 20;
constexpr size_t al(size_t x) { return (x + MiB - 1) / MiB * MiB; }
constexpr size_t WS_CTL = 0, CTL_ZERO_BYTES = 1 * MiB;
constexpr size_t WS_WIN = 2 * MiB;
constexpr size_t WS_WA = WS_WIN + al((size_t)NIN * D * 2);
constexpr size_t WS_WB = WS_WA + al((size_t)D * 512 * 2);
constexpr size_t WS_WO = WS_WB + al((size_t)D * 512 * 2);
constexpr size_t WS_WUP = WS_WO + al((size_t)D * D * 2);
constexpr size_t WS_WDN = WS_WUP + al((size_t)FF * D * 2);
constexpr size_t WS_WC = WS_WDN + al((size_t)FF * D * 2);
constexpr size_t WS_SMALL = WS_WC + al((size_t)2 * 64 * 2048 * 2);
constexpr size_t WS_XB = WS_SMALL + MiB;
constexpr size_t WS_HB = WS_XB + al((size_t)MALL * D * 2);
constexpr size_t WS_KCP = WS_HB + al((size_t)MALL * NIN * 2);
constexpr size_t WS_VCTP = WS_KCP + MiB;
constexpr size_t WS_KCVS = WS_VCTP + MiB;
constexpr size_t WS_VST = WS_KCVS + al((size_t)MS * 1024 * 256 * 4);
constexpr size_t WS_VWT = WS_VST + al((size_t)4 * 64 * T * 2);
constexpr size_t WS_OA = WS_VWT + al((size_t)4 * 64 * T * 2);
constexpr size_t WS_OB = WS_OA + al((size_t)MALL * 512 * 2);
constexpr size_t WS_HGL = WS_OB + al((size_t)MALL * 512 * 2);
constexpr size_t WS_HGD = WS_HGL + al((size_t)16 * 16 * 8192 * 4);
constexpr size_t WS_TB = WS_HGD + MiB;
constexpr size_t WS_MG = WS_TB + al((size_t)MALL * D * 4);
constexpr size_t WS_Z1 = WS_MG + al((size_t)MALL * D * 2);
constexpr size_t WS_X1F = WS_Z1 + al((size_t)MALL * D * 4);
constexpr size_t WS_X1B = WS_X1F + al((size_t)MALL * D * 4);
constexpr size_t WS_UB = WS_X1B + al((size_t)MALL * D * 2);
constexpr size_t WS_Z2 = WS_UB + al((size_t)MALL * FF * 2);
constexpr size_t WS_KSC = WS_Z2 + al((size_t)MALL * D * 4);
constexpr size_t WS_KWC = WS_KSC + al((size_t)4 * T * 64 * 2);
constexpr size_t WS_OTS = WS_KWC + al((size_t)4 * T * 64 * 2);
constexpr size_t WS_END = WS_OTS + al((size_t)256 * 32 * 512 * 4);
constexpr int CW_TMO = 0, CW_CODE = 1, CW_BAR = 4096;
constexpr int RING_OFF = 0, RING_BYTES = 131072;
constexpr int LDSCTL_OFF = RING_BYTES, MISC_OFF = LDSCTL_OFF + 320;
constexpr int LDS_BYTES = 147456;

namespace pg8 {
struct EpiInProj {
    static constexpr bool PERM = true, AFTER_DRAIN = false;
    bf16_t* HB; float* out;
    __device__ __forceinline__ void operator()(const f32x4 (&acc)[2][2][4][2], const Unit& u, int wr, int wc, int fr, int fq) const {
        const int row0 = u.pm * BM + wr * 64 + fr, cc0 = wc * 32 + 8 * fq, col0 = u.pn * BM + cc0;
#pragma unroll
        for (int ai = 0; ai < 2; ++ai)
#pragma unroll
            for (int m = 0; m < 4; ++m) {
                const int r = row0 + ai * HALF + m * 16;
                bf16_t* rowp = HB + (size_t)r * NIN + col0;
                float* fdst = nullptr;
                if (u.pn == 2) { if (r < MP) fdst = out + OFF2 + (size_t)r * 256; else if (r < MP + MS) fdst = out + OFF6 + (size_t)(r - MP) * 256; }
                else if (u.pn == 3) { if (r < MP) fdst = out + OFF3 + (size_t)r * 256; else if (r < MP + MS) fdst = out + OFF7 + (size_t)(r - MP) * 256; }
                else if (u.pn == 4) { if (r < MP) { const int t = r & (T - 1), b = r >> 13; if (t >= T - 512) fdst = out + OFF4 + (size_t)(b * 512 + t - (T - 512)) * 256; }
                                      else if (r < MP + MS) fdst = out + OFF8 + ((size_t)(r - MP) * 512 + 511) * 256; }
#pragma unroll
                for (int bj = 0; bj < 2; ++bj) { const f32x4 v0 = acc[ai][bj][m][0], v1 = acc[ai][bj][m][1];
                    u32x4 w; w.x = cvt_pk_bf16(v0[0], v0[1]); w.y = cvt_pk_bf16(v0[2], v0[3]); w.z = cvt_pk_bf16(v1[0], v1[1]); w.w = cvt_pk_bf16(v1[2], v1[3]);
                    *(u32x4*)(rowp + bj * HALF) = w;
                    if (fdst) { *(f32x4*)(fdst + cc0 + bj * HALF) = v0; *(f32x4*)(fdst + cc0 + bj * HALF + 4) = v1; } }
            }
    }
};
}

struct Frame {
    LAS unsigned char* lds;
    volatile LAS unsigned* MISC;
    gu32* ctl;
    int tid, lane, wave;
    int vcu, G;
    const float* in[21]; float* out; unsigned char* ws;
};
__device__ __forceinline__ float bf2f(unsigned short b) { return __uint_as_float(((unsigned)b) << 16); }
typedef float f32x2_t __attribute__((ext_vector_type(2))); typedef __bf16 bf16x2_t __attribute__((ext_vector_type(2)));
__device__ __forceinline__ unsigned cvtpk(float lo, float hi) { f32x2_t v = {lo, hi}; bf16x2_t b = __builtin_convertvector(v, bf16x2_t); return __builtin_bit_cast(unsigned, b); }
__device__ __forceinline__ float wave_sum(float v) {
#pragma unroll
    for (int o = 1; o < 64; o <<= 1) v += __shfl_xor(v, o);
    return v;
}
__device__ __forceinline__ float sigmoidf_(float x) { return 1.0f / (1.0f + __expf(-x)); }

__device__ __forceinline__ void p0_transpose_item(const float* W, int K, int Nsrc, bf16* WT, int k0, int n0, int s0, int nvalid, LAS float* scr, int lane) {
#pragma unroll 8
    for (int i = 0; i < 32; ++i) { const int kk = 2 * i + (lane >> 5), c = lane & 31; scr[kk * 33 + c] = (c < nvalid) ? W[(size_t)(k0 + kk) * Nsrc + s0 + c] : 0.f; }
    LDS_WAIT(); asm volatile("" ::: "memory");
    const int c = lane & 7;
#pragma unroll
    for (int j = 0; j < 4; ++j) { const int n = (lane >> 3) + 8 * j; const LAS float* s = scr + (8 * c) * 33 + n;
        v4u o; o.x = pk2(s[0 * 33], s[1 * 33]); o.y = pk2(s[2 * 33], s[3 * 33]); o.z = pk2(s[4 * 33], s[5 * 33]); o.w = pk2(s[6 * 33], s[7 * 33]);
        *(GAS v4u*)(WT + (size_t)(n0 + n) * K + k0 + 8 * c) = o; }
    LDS_WAIT(); asm volatile("" ::: "memory");
}
__device__ __forceinline__ void p0_prologue(Frame& F) {
    LAS float* scr = (LAS float*)(F.lds + RING_OFF + F.wave * 16384);
    const int gw = F.vcu * NWAVES + F.wave, NGW = F.G * NWAVES, lane = F.lane;
    bf16* WinT = (bf16*)(F.ws + WS_WIN); bf16* WaT = (bf16*)(F.ws + WS_WA); bf16* WbT = (bf16*)(F.ws + WS_WB); bf16* WoT = (bf16*)(F.ws + WS_WO);
    bf16* WupT = (bf16*)(F.ws + WS_WUP); bf16* WdnT = (bf16*)(F.ws + WS_WDN); bf16* WcT = (bf16*)(F.ws + WS_WC);
    float* small = (float*)(F.ws + WS_SMALL);
    constexpr int I_IN = (D / 64) * (NIN / 32), I_A = (512 / 64) * (D / 32), I_O = (D / 64) * (D / 32), I_UP = (D / 64) * (FF / 32), I_DN = (FF / 64) * (D / 32), I_C = 2 * (2048 / 64) * 2;
    constexpr int I_T = I_IN + 2 * I_A + I_O + I_UP + I_DN + I_C;
    constexpr int I_X = MALL;
    constexpr int I_CB = 64;
    constexpr int I_LB = 16;
    constexpr int I_W8 = MS * 511;
    constexpr int I_Z = 2 * (MALL - MP - MS);
    constexpr int NITEMS = I_T + I_X + I_CB + I_LB + I_W8 + I_Z;
    for (int it = gw; it < NITEMS; it += NGW) {
        int r = it;
        if (r < I_T) {
            if (r < I_IN) { const int nblk = NIN / 32, kb = r / nblk, nb = r % nblk, n0 = 32 * nb; int s0, nv;
                if (n0 < 1280) { s0 = n0; nv = 32; } else if (n0 < 6400) { s0 = n0 + 24; nv = 32; } else if (n0 == 6400) { s0 = 1280; nv = 24; } else { s0 = 0; nv = 0; }
                p0_transpose_item(F.in[7], D, 6424, WinT, 64 * kb, n0, s0, nv, scr, lane); continue; } r -= I_IN;
            if (r < I_A) { const int nblk = D / 32, kb = r / nblk, nb = r % nblk; p0_transpose_item(F.in[12], 512, D, WaT, 64 * kb, 32 * nb, 32 * nb, 32, scr, lane); continue; } r -= I_A;
            if (r < I_A) { const int nblk = D / 32, kb = r / nblk, nb = r % nblk; p0_transpose_item(F.in[13], 512, D, WbT, 64 * kb, 32 * nb, 32 * nb, 32, scr, lane); continue; } r -= I_A;
            if (r < I_O) { const int nblk = D / 32, kb = r / nblk, nb = r % nblk; p0_transpose_item(F.in[14], D, D, WoT, 64 * kb, 32 * nb, 32 * nb, 32, scr, lane); continue; } r -= I_O;
            if (r < I_UP) { const int nblk = FF / 32, kb = r / nblk, nb = r % nblk; p0_transpose_item(F.in[17], D, FF, WupT, 64 * kb, 32 * nb, 32 * nb, 32, scr, lane); continue; } r -= I_UP;
            if (r < I_DN) { const int nblk = D / 32, kb = r / nblk, nb = r % nblk; p0_transpose_item(F.in[18], FF, D, WdnT, 64 * kb, 32 * nb, 32 * nb, 32, scr, lane); continue; } r -= I_DN;
            { const int c = r / 64, q = r % 64, kb = q / 2, nb = q % 2;
              p0_transpose_item(F.in[8] + (size_t)c * 2048 * 64, 2048, 64, WcT + (size_t)c * 64 * 2048, 64 * kb, 32 * nb, 32 * nb, 32, scr, lane); continue; }
        }
        r -= I_T;
        if (r < I_X) {
            const float* src = r < MP ? F.in[0] + (size_t)r * D : (r < MP + MS ? F.in[1] + (size_t)(r - MP) * D : nullptr);
            bf16* dst = (bf16*)(F.ws + WS_XB) + (size_t)r * D;
#pragma unroll
            for (int j = 0; j < 4; ++j) { f32x4 v = src ? *((const GAS f32x4*)src + lane + 64 * j) : (f32x4){0.f, 0.f, 0.f, 0.f};
                *((GAS unsigned long long*)dst + lane + 64 * j) = (unsigned long long)pk2(v.x, v.y) | ((unsigned long long)pk2(v.z, v.w) << 32); }
            continue;
        }
        r -= I_X;
        if (r < I_CB) {
            const int c = r >> 5, l = r & 31; const float* pos = F.in[9] + ((size_t)c * 32 + l) * 64; const float* w = F.in[8] + (((size_t)c * 32 + l) * 64) * 64;
            float s = 0.f;
            for (int d = 0; d < 64; ++d) s += pos[d] * w[(size_t)d * 64 + lane];
            small[(c * 32 + l) * 64 + lane] = s; continue;
        }
        r -= I_CB;
        if (r < I_LB) { const int i = r * 64 + lane; const float l0 = F.in[10][i], l1 = F.in[10][1024 + i]; small[4096 + i] = 1.0f / (1.0f + expf(l1 - l0)); continue; }
        r -= I_LB;
        if (r < I_W8) { const int b = r / 511, i = r % 511;
            const GAS f32x4* s = (const GAS f32x4*)(F.in[4] + ((size_t)b * 512 + i + 1) * 256); GAS f32x4* d = (GAS f32x4*)(F.out + OFF8 + ((size_t)b * 512 + i) * 256);
            d[lane] = s[lane]; continue; }
        r -= I_W8;
        { const int half = I_Z / 2, which = r / half, row = MP + MS + r % half; bf16* o = (bf16*)(F.ws + (which ? WS_OB : WS_OA)) + (size_t)row * 512;
          *((GAS v4u*)o + lane) = (v4u){0u, 0u, 0u, 0u}; }
    }
}
typedef float f32x16 __attribute__((ext_vector_type(16)));
typedef short s16x4 __attribute__((ext_vector_type(4)));
typedef unsigned u32x2 __attribute__((ext_vector_type(2)));
#define MFMA32(a, b, c) __builtin_amdgcn_mfma_f32_32x32x16_bf16((a), (b), (c), 0, 0, 0)
__device__ __forceinline__ int crow(int reg, int h) { return (reg & 3) + 8 * (reg >> 2) + 4 * h; }
__device__ __forceinline__ bf16x8 pack8(f32x4 a, f32x4 b) { v4u p; p.x = cvtpk(a.x, a.y); p.y = cvtpk(a.z, a.w); p.z = cvtpk(b.x, b.y); p.w = cvtpk(b.z, b.w); return __builtin_bit_cast(bf16x8, p); }
#define PACK_STEP(x, s) pack8((f32x4){(x)[8 * (s)], (x)[8 * (s) + 1], (x)[8 * (s) + 2], (x)[8 * (s) + 3]}, (f32x4){(x)[8 * (s) + 4], (x)[8 * (s) + 5], (x)[8 * (s) + 6], (x)[8 * (s) + 7]})
__device__ __forceinline__ bf16x8 join44(s16x4 lo, s16x4 hi) { return __builtin_shufflevector(lo, hi, 0, 1, 2, 3, 4, 5, 6, 7); }

constexpr int NRT = 3, CT_GP = (NCMP_P + NRT * 16 - 1) / (NRT * 16), CT_GS = (NCMP_S + NRT * 16 - 1) / (NRT * 16);
constexpr int CT_PROMPT = NBATCH * 2 * CT_GP, CT_SAMPLE = MS * 2 * CT_GS, CT_ALL = CT_PROMPT + CT_SAMPLE;
__device__ __forceinline__ void compress_task(Frame& F, int task) {
    const int lane = F.lane, m = lane & 31, h = lane >> 5, ii = m & 15, g = m >> 4;
    const bool prompt = task < CT_PROMPT;
    int b, c, ig, nblk, tsrc;
    if (prompt) { b = task / (2 * CT_GP); c = (task / CT_GP) & 1; ig = task % CT_GP; nblk = NCMP_P; tsrc = T; }
    else { const int t2 = task - CT_PROMPT; b = t2 / (2 * CT_GS); c = (t2 / CT_GS) & 1; ig = t2 % CT_GS; nblk = NCMP_S; tsrc = PAST; }
    const int* pt = (const int*)F.in[6] + b * NPAGES;
    const bf16* WcT = (const bf16*)(F.ws + WS_WC) + (size_t)c * 64 * 2048;
    const float* small = (const float*)(F.ws + WS_SMALL);
    f32x16 acc[NRT][2];
#pragma unroll
    for (int rt = 0; rt < NRT; ++rt)
#pragma unroll
        for (int i = 0; i < 16; ++i) { acc[rt][0][i] = 0.f; acc[rt][1][i] = 0.f; }
    const char* rbase = prompt ? (const char*)(F.out + OFF2 + (size_t)b * T * 256) : (const char*)F.in[2];
    unsigned offA[NRT];
    LAS unsigned* offB = (LAS unsigned*)(F.lds + RING_OFF + 98304) + F.tid * 4;
#pragma unroll
    for (int rt = 0; rt < NRT; ++rt) {
        const int blk = ig * (NRT * 16) + rt * 16 + ii;
        int tA = 16 * blk, tB = 16 * blk + 16; tA = tA <= tsrc - 16 ? tA : tsrc - 16; tB = tB <= tsrc - 16 ? tB : tsrc - 16;
        const unsigned rA = prompt ? (unsigned)tA : (unsigned)pt[tA >> 7] * 128u + (unsigned)(tA & 127), rB = prompt ? (unsigned)tB : (unsigned)pt[tB >> 7] * 128u + (unsigned)(tB & 127);
        offA[rt] = (rA * 256u + (unsigned)(c * 128 + g * 64 + 8 * h)) * 4u; offB[rt] = (rB * 256u + (unsigned)(c * 128 + g * 64 + 8 * h)) * 4u;
    }
    const unsigned bo0 = ((unsigned)m * 2048u + 8u * (unsigned)h) * 2u;
    static_assert(NRT == 3, "the schedule below is written for 3 row tiles");
    f32x4 av[2][8]; bf16x8 Bv[4][2];
#define CMP_LOAD_A(st, l_, rt_) do { const char* ap_ = rbase + (((l_) < 16 ? offA[rt_] : offB[rt_]) + (unsigned)(((l_) & 15) * 1024)); \
        _Pragma("unroll") for (int dc = 0; dc < 4; ++dc) { av[st][2 * dc] = *(const GAS f32x4*)(ap_ + dc * 64); av[st][2 * dc + 1] = *(const GAS f32x4*)(ap_ + dc * 64 + 16); } } while (0)
#define CMP_LOAD_B(l_) do { const char* bp_ = (const char*)WcT + (bo0 + (unsigned)((l_) * 128)); _Pragma("unroll") for (int dc = 0; dc < 4; ++dc) { Bv[dc][0] = *(const GAS bf16x8*)(bp_ + dc * 32); Bv[dc][1] = *(const GAS bf16x8*)(bp_ + 32 * 2048 * 2 + dc * 32); } } while (0)
#define CMP_MMA(st, rt_) do { _Pragma("unroll") for (int dc = 0; dc < 4; ++dc) { const bf16x8 A_ = pack8(av[st][2 * dc], av[st][2 * dc + 1]); acc[rt_][0] = MFMA32(A_, Bv[dc][0], acc[rt_][0]); acc[rt_][1] = MFMA32(A_, Bv[dc][1], acc[rt_][1]); } } while (0)
#define SB __builtin_amdgcn_sched_barrier(0)
#define LM(j) (((j) >> 1) + 16 * ((j) & 1))
    CMP_LOAD_B(LM(0)); CMP_LOAD_A(0, LM(0), 0);
#pragma unroll 1
    for (int j = 0; j < 32; j += 2) {
        const int la = LM(j), lb = LM(j + 1), lc = LM(j + 2 < 32 ? j + 2 : 31);
        CMP_LOAD_A(1, la, 1); SB; CMP_MMA(0, 0); SB;
        CMP_LOAD_A(0, la, 2); SB; CMP_MMA(1, 1); SB;
        CMP_LOAD_A(1, lb, 0); SB; CMP_MMA(0, 2); SB;
        CMP_LOAD_B(lb); SB;
        CMP_LOAD_A(0, lb, 1); SB; CMP_MMA(1, 0); SB;
        CMP_LOAD_A(1, lb, 2); SB; CMP_MMA(0, 1); SB;
        CMP_LOAD_A(0, lc, 0); SB; CMP_MMA(1, 2); SB;
        CMP_LOAD_B(lc); SB;
    }
#undef LM
#undef CMP_LOAD_A
#undef CMP_LOAD_B
#undef CMP_MMA
#undef SB
    float be0 = 0.f, be1 = 0.f;
    for (int l = 0; l < 32; ++l) { be0 += small[(c * 32 + l) * 64 + m]; be1 += small[(c * 32 + l) * 64 + 32 + m]; }
#pragma unroll
    for (int rt = 0; rt < NRT; ++rt)
#pragma unroll
    for (int v = 0; v < 16; ++v) {
        const int mr = crow(v, h), oi = mr & 15, og = mr >> 4, ob = ig * (NRT * 16) + rt * 16 + oi;
        if (ob < nblk) {
            const float v0 = acc[rt][0][v] + be0, v1 = acc[rt][1][v] + be1;
            if (prompt) {
                if (c == 0) { bf16* kc = (bf16*)(F.ws + WS_KCP) + ((size_t)(b * 2 + og) * 512 + ob) * 64; kc[m] = (bf16)f2bf(v0); kc[32 + m] = (bf16)f2bf(v1); }
                else { bf16* vc = (bf16*)(F.ws + WS_VCTP) + (size_t)(b * 2 + og) * 64 * 512 + ob; vc[(size_t)m * 512] = (bf16)f2bf(v0); vc[(size_t)(32 + m) * 512] = (bf16)f2bf(v1); }
            } else {
                float* o = (float*)(F.ws + WS_KCVS) + ((size_t)b * 1024 + ob) * 256 + c * 128 + og * 64; o[m] = v0; o[32 + m] = v1;
            }
        }
    }
}
constexpr int VT_ITEMS = 2 * 2 * 2 * 128;
__device__ __forceinline__ void vt_item(Frame& F, int it) {
    const int tensor = it >> 9, b = (it >> 8) & 1, g = (it >> 7) & 1, tb = it & 127, lane = F.lane;
    const bf16* src = (const bf16*)(F.ws + WS_HB) + (size_t)(b * T + tb * 64 + lane) * NIN + (tensor ? C_KVW : C_KVS) + 128 + g * 64;
    bf16* dst = (bf16*)(F.ws + (tensor ? WS_VWT : WS_VST)) + (size_t)(b * 2 + g) * 64 * T + tb * 64 + lane;
    v4u r[8];
#pragma unroll
    for (int i = 0; i < 8; ++i) r[i] = *((const GAS v4u*)src + i);
    { const bf16* ksrc = src - 128; bf16* kdst = (bf16*)(F.ws + (tensor ? WS_KWC : WS_KSC)) + ((size_t)(b * 2 + g) * T + tb * 64 + lane) * 64;
#pragma unroll
      for (int i = 0; i < 8; ++i) *((GAS v4u*)kdst + i) = *((const GAS v4u*)ksrc + i); }
#pragma unroll
    for (int i = 0; i < 8; ++i) {
        const unsigned w[4] = {r[i].x, r[i].y, r[i].z, r[i].w};
#pragma unroll
        for (int j = 0; j < 4; ++j) { dst[(size_t)(i * 8 + 2 * j) * T] = (bf16)(w[j] & 0xffffu); dst[(size_t)(i * 8 + 2 * j + 1) * T] = (bf16)(w[j] >> 16); }
    }
}

constexpr int HG_SEG = 512, HG_NSEG = T / HG_SEG, HG_CH = 32;
constexpr int HL_QT = 0, HL_KT = 8704, HL_KD = 17408, HL_VT = 27648, HL_DEC = 32768, HL_PSUM = 33280, HL_SLAB = 35328, HL_END = HL_SLAB + 4 * 32 * 272;
static_assert(HL_END <= RING_BYTES, "hgrn lds");
template <int MODE> __device__ __forceinline__ void hgrn_segment(Frame& F, int bh, int seg) {
    int tid = F.tid; asm volatile("" : "+v"(tid));
    const int lane = tid & 63, w = F.wave, kt = w >> 1, vt = w & 1, h5 = lane >> 5, l31 = lane & 31;
    const int b = bh >> 3, hh = bh & 7;
    LAS unsigned char* L = F.lds + RING_OFF;
    const bf16* HB = (const bf16*)(F.ws + WS_HB);
    const float* small = (const float*)(F.ws + WS_SMALL);
    float* HGL = (float*)(F.ws + WS_HGL); float* HGD = (float*)(F.ws + WS_HGD);
    f32x16 S;
#pragma unroll
    for (int i = 0; i < 16; ++i) S[i] = 0.f;
    if (MODE == 1) {
        for (int i = 0; i < seg; ++i) {
            const float* Lp = HGL + ((size_t)(bh * HG_NSEG + i)) * 8192 + w * 1024 + lane; const float* Dp = HGD + (size_t)(bh * HG_NSEG + i) * 128 + 32 * kt;
#pragma unroll
            for (int v = 0; v < 16; ++v) S[v] = S[v] * Dp[crow(v, h5)] + Lp[v * 64];
        }
    }
    const int k = tid & 127, q4 = tid >> 7;
    const float lb = small[4096 + hh * 128 + k];
    float lcsum = 0.f;
    unsigned short pf[8], pq[8]; u32x2 pv_, pg_;
#define HG_FETCH(ch_) do { const int r0_ = b * T + seg * HG_SEG + (ch_) * HG_CH; \
        _Pragma("unroll") for (int j = 0; j < 8; ++j) { pf[j] = HB[(size_t)(r0_ + 8 * q4 + j) * NIN + C_FB + hh * 128 + k]; if (MODE == 1) pq[j] = HB[(size_t)(r0_ + 8 * q4 + j) * NIN + C_QB + hh * 128 + k]; } \
        pv_ = *(const GAS u32x2*)(HB + (size_t)(r0_ + (tid >> 4)) * NIN + C_IB + hh * 64 + 4 * (tid & 15)); \
        if (MODE == 1) pg_ = *(const GAS u32x2*)(HB + (size_t)(r0_ + (tid >> 4)) * NIN + C_GB + hh * 64 + 4 * (tid & 15)); } while (0)
    HG_FETCH(0);
    for (int ch = 0; ch < HG_SEG / HG_CH; ++ch) {
        const int row0 = b * T + seg * HG_SEG + ch * HG_CH;
        unsigned short cf[8], cq[8]; const u32x2 vv = pv_, gv = pg_;
#pragma unroll
        for (int j = 0; j < 8; ++j) { cf[j] = pf[j]; cq[j] = pq[j]; }
        { const int chn = ch + 1 < HG_SEG / HG_CH ? ch + 1 : ch; HG_FETCH(chn); }
        float kk[8], cs[8]; float run = 0.f;
#pragma unroll
        for (int j = 0; j < 8; ++j) {
            const float x = bf2f(cf[j]);
            const float e = __expf(-x), sg = 1.0f / (1.0f + e), om = e / (1.0f + e);
            const float f = lb + (1.0f - lb) * sg; kk[j] = (1.0f - lb) * om; run += __logf(f); cs[j] = run;
        }
        ((LAS float*)(L + HL_PSUM))[q4 * 128 + k] = run;
        __syncthreads();
        float off = 0.f, tot = 0.f;
#pragma unroll
        for (int q = 0; q < 4; ++q) { const float p = ((LAS float*)(L + HL_PSUM))[q * 128 + k]; tot += p; if (q < q4) off += p; }
#pragma unroll
        for (int j = 0; j < 8; ++j) {
            const int s = 8 * q4 + j; const float lc = off + cs[j];
            if (MODE == 1) {
                const float qv = bf2f(cq[j]);
                ((LAS bf16*)(L + HL_QT))[s * 136 + k] = (bf16)f2bf(qv * __expf(lc));
                ((LAS bf16*)(L + HL_KT))[s * 136 + k] = (bf16)f2bf(kk[j] * __expf(-lc));
            }
            ((LAS bf16*)(L + HL_KD))[k * 40 + s] = (bf16)f2bf(kk[j] * __expf(tot - lc));
        }
        if (q4 == 0) { ((LAS float*)(L + HL_DEC))[k] = __expf(tot); lcsum += tot; }
        { const int s = tid >> 4, vq = tid & 15;
          LAS bf16* vtp = (LAS bf16*)(L + HL_VT);
          vtp[(4 * vq + 0) * 40 + s] = (bf16)(vv.x & 0xffffu); vtp[(4 * vq + 1) * 40 + s] = (bf16)(vv.x >> 16);
          vtp[(4 * vq + 2) * 40 + s] = (bf16)(vv.y & 0xffffu); vtp[(4 * vq + 3) * 40 + s] = (bf16)(vv.y >> 16); }
        __syncthreads();
        if (MODE == 1) {
            f32x16 oacc;
#pragma unroll
            for (int i = 0; i < 16; ++i) oacc[i] = 0.f;
            if (kt == 0) {
                f32x16 at;
#pragma unroll
                for (int i = 0; i < 16; ++i) at[i] = 0.f;
#pragma unroll
                for (int ks = 0; ks < 8; ++ks) {
                    const bf16x8 a = *(const LAS bf16x8*)(L + HL_KT + l31 * 272 + (16 * ks + 8 * h5) * 2);
                    const bf16x8 bq = *(const LAS bf16x8*)(L + HL_QT + l31 * 272 + (16 * ks + 8 * h5) * 2);
                    at = MFMA32(a, bq, at);
                }
#pragma unroll
                for (int i = 0; i < 16; ++i) at[i] = (crow(i, h5) <= l31) ? at[i] : 0.f;
#pragma unroll
                for (int kq = 0; kq < 2; ++kq) {
                    const s16x4 lo = *(const LAS s16x4*)(L + HL_VT + (32 * vt + l31) * 80 + (16 * kq + 4 * h5) * 2);
                    const s16x4 hi = *(const LAS s16x4*)(L + HL_VT + (32 * vt + l31) * 80 + (16 * kq + 8 + 4 * h5) * 2);
                    oacc = MFMA32(join44(lo, hi), PACK_STEP(at, kq), oacc);
                }
            }
#pragma unroll
            for (int kq = 0; kq < 2; ++kq) {
                const s16x4 lo = *(const LAS s16x4*)(L + HL_QT + l31 * 272 + (32 * kt + 16 * kq + 4 * h5) * 2);
                const s16x4 hi = *(const LAS s16x4*)(L + HL_QT + l31 * 272 + (32 * kt + 16 * kq + 8 + 4 * h5) * 2);
                oacc = MFMA32(PACK_STEP(S, kq), join44(lo, hi), oacc);
            }
#pragma unroll
            for (int a = 0; a < 4; ++a)
                *(LAS f32x4*)(L + HL_SLAB + (kt * 32 + l31) * 272 + (32 * vt + 8 * a + 4 * h5) * 4) = (f32x4){oacc[4 * a], oacc[4 * a + 1], oacc[4 * a + 2], oacc[4 * a + 3]};
        }
        {
#pragma unroll
            for (int a = 0; a < 4; ++a) { const f32x4 d = *(const LAS f32x4*)(L + HL_DEC + (32 * kt + 8 * a + 4 * h5) * 4);
                S[4 * a] *= d.x; S[4 * a + 1] *= d.y; S[4 * a + 2] *= d.z; S[4 * a + 3] *= d.w; }
#pragma unroll
            for (int kq = 0; kq < 2; ++kq) {
                const bf16x8 a = *(const LAS bf16x8*)(L + HL_KD + (32 * kt + l31) * 80 + (16 * kq + 8 * h5) * 2);
                const bf16x8 bv = *(const LAS bf16x8*)(L + HL_VT + (32 * vt + l31) * 80 + (16 * kq + 8 * h5) * 2);
                S = MFMA32(a, bv, S);
            }
        }
        __syncthreads();
        if (MODE == 1) {
            const int t = tid >> 4, vq = tid & 15;
            f32x4 o = (f32x4){0.f, 0.f, 0.f, 0.f};
#pragma unroll
            for (int q = 0; q < 4; ++q) o += *(const LAS f32x4*)(L + HL_SLAB + (q * 32 + t) * 272 + 16 * vq);
            float ss = (o.x * o.x + o.y * o.y) + (o.z * o.z + o.w * o.w);
            ss += __shfl_xor(ss, 1); ss += __shfl_xor(ss, 2); ss += __shfl_xor(ss, 4); ss += __shfl_xor(ss, 8);
            const float rs = 1.0f / sqrtf(ss * (1.0f / 64.0f) + LN_EPS);
            const f32x4 ng = *(const GAS f32x4*)(F.in[11] + 4 * vq);
            const float g0 = bf2f(gv.x & 0xffffu), g1 = bf2f(gv.x >> 16), g2 = bf2f(gv.y & 0xffffu), g3 = bf2f(gv.y >> 16);
            u32x2 ow; ow.x = cvtpk(o.x * rs * ng.x * g0 * sigmoidf_(g0), o.y * rs * ng.y * g1 * sigmoidf_(g1)); ow.y = cvtpk(o.z * rs * ng.z * g2 * sigmoidf_(g2), o.w * rs * ng.w * g3 * sigmoidf_(g3));
            *(GAS u32x2*)((bf16*)(F.ws + WS_OB) + (size_t)(row0 + t) * 512 + hh * 64 + 4 * vq) = ow;
        }
    }
    if (MODE == 0) {
        float* Lp = HGL + ((size_t)(bh * HG_NSEG + seg)) * 8192 + w * 1024 + lane;
#pragma unroll
        for (int v = 0; v < 16; ++v) Lp[v * 64] = S[v];
        if (q4 == 0) HGD[(size_t)(bh * HG_NSEG + seg) * 128 + k] = __expf(lcsum);
    } else if (seg == HG_NSEG - 1) {
        float* o = F.out + OFF5 + (size_t)bh * 8192;
#pragma unroll
        for (int v = 0; v < 16; ++v) o[(32 * kt + crow(v, h5)) * 64 + 32 * vt + l31] = S[v];
    }
#undef HG_FETCH
    __syncthreads();
}
__device__ __forceinline__ void hgrn_sample_unit(Frame& F, int unit) {
    const int b = unit >> 3, hh = unit & 7, tid = F.tid, v = tid & 63, kq = tid >> 6;
    const bf16* HB = (const bf16*)(F.ws + WS_HB) + (size_t)(MP + b) * NIN;
    const float* small = (const float*)(F.ws + WS_SMALL);
    const float* st = F.in[5] + (size_t)(b * 8 + hh) * 8192; float* so = F.out + OFF9 + (size_t)(b * 8 + hh) * 8192;
    const float vv = bf2f(HB[C_IB + hh * 64 + v]);
    float po = 0.f;
#pragma unroll 4
    for (int j = 0; j < 16; ++j) {
        const int k = kq * 16 + j; const float x = bf2f(HB[C_FB + hh * 128 + k]), lb = small[4096 + hh * 128 + k];
        const float e = __expf(-x), sg = 1.0f / (1.0f + e), om = e / (1.0f + e);
        const float f = lb + (1.0f - lb) * sg, kx = (1.0f - lb) * om;
        const float sn = f * st[k * 64 + v] + kx * vv; so[k * 64 + v] = sn;
        po += bf2f(HB[C_QB + hh * 128 + k]) * sn;
    }
    LAS float* red = (LAS float*)(F.lds + RING_OFF);
    red[kq * 64 + v] = po;
    __syncthreads();
    if (tid < 64) {
        float o = 0.f;
#pragma unroll
        for (int q = 0; q < 8; ++q) o += red[q * 64 + v];
        const float ss = wave_sum(o * o), rs = 1.0f / sqrtf(ss * (1.0f / 64.0f) + LN_EPS);
        const float g = bf2f(HB[C_GB + hh * 64 + v]);
        ((bf16*)(F.ws + WS_OB))[(size_t)(MP + b) * 512 + hh * 64 + v] = (bf16)f2bf(o * rs * F.in[11][v] * g * sigmoidf_(g));
    }
    __syncthreads();
}
__device__ __forceinline__ void p2_phase(Frame& F) {
    for (int u = blockIdx.x; u < 16 * (HG_NSEG - 1); u += F.G) hgrn_segment<0>(F, u / (HG_NSEG - 1), u % (HG_NSEG - 1));
    for (int u = blockIdx.x; u < MS * 8; u += F.G) hgrn_sample_unit(F, u);
    const int NGW = F.G * NWAVES;
    for (int it = F.wave * F.G + F.vcu; it < CT_ALL + VT_ITEMS; it += NGW) { if (it < CT_ALL) compress_task(F, it); else vt_item(F, it - CT_ALL); }
}
constexpr int AT_NB = 5, AT_D = 4;
constexpr int AL_BUF = 16384  , AL_K = 0, AL_V = 8192;
constexpr int AL_IMP = AT_NB * AL_BUF, AL_SELM = AL_IMP + 64 * 128 * 4, AL_UNI = AL_SELM + 64 * 4 * 4, AL_TL = AL_UNI + 16, AL_END = AL_TL + 160 * 4;
static_assert(AL_END <= RING_BYTES, "attn lds");
constexpr float LOG2E = 1.4426950408889634f;
#define NEG_INF (-__builtin_inff())
__device__ __forceinline__ int swz(int row, int chunk) { return (chunk ^ ((row >> 1) & 7)) * 16; }
__device__ __forceinline__ f32x16 qk_sub(const LAS unsigned char* L, int sub, const bf16x8 (&qf)[4], int l31, int h5) {
    f32x16 acc;
#pragma unroll
    for (int i = 0; i < 16; ++i) acc[i] = 0.f;
    const int row = sub * 32 + l31;
#pragma unroll
    for (int s = 0; s < 4; ++s) { const bf16x8 a = *(const LAS bf16x8*)(L + AL_K + row * 128 + swz(row, 2 * s + h5)); acc = MFMA32(a, qf[s], acc); }
    return acc;
}
__device__ __forceinline__ void pv_sub(const LAS unsigned char* L, int sub, const f32x16& p, f32x16 (&O)[2], int l31, int h5) {
#pragma unroll
    for (int kq = 0; kq < 2; ++kq) {
        const bf16x8 pb = PACK_STEP(p, kq);
#pragma unroll
        for (int dt = 0; dt < 2; ++dt) {
            const int row = dt * 32 + l31;
            const s16x4 lo = *(const LAS s16x4*)(L + AL_V + row * 128 + swz(row, 4 * sub + 2 * kq) + 8 * h5);
            const s16x4 hi = *(const LAS s16x4*)(L + AL_V + row * 128 + swz(row, 4 * sub + 2 * kq + 1) + 8 * h5);
            O[dt] = MFMA32(join44(lo, hi), pb, O[dt]);
        }
    }
}
__device__ __forceinline__ void online_update2(const LAS unsigned char* L, f32x16& s0, f32x16& s1, float& m, float& l, f32x16 (&O)[2], int l31, int h5) {
    float tmax = fmaxf(s0[0], s1[0]);
#pragma unroll
    for (int i = 1; i < 16; ++i) tmax = fmaxf(tmax, fmaxf(s0[i], s1[i]));
    tmax = fmaxf(tmax, __shfl_xor(tmax, 32));
    const float mnew = fmaxf(m, tmax), ms = (mnew == NEG_INF) ? 0.f : mnew;
    const float alpha = __builtin_amdgcn_exp2f(m - ms);
    float ps = 0.f;
#pragma unroll
    for (int i = 0; i < 16; ++i) { s0[i] = __builtin_amdgcn_exp2f(s0[i] - ms); s1[i] = __builtin_amdgcn_exp2f(s1[i] - ms); ps += s0[i] + s1[i]; }
    l = l * alpha + ps; m = mnew;
    if (__any(alpha != 1.0f)) {
#pragma unroll
        for (int i = 0; i < 16; ++i) { O[0][i] *= alpha; O[1][i] *= alpha; }
    }
    pv_sub(L, 0, s0, O, l31, h5); pv_sub(L, 1, s1, O, l31, h5);
}

__device__ __forceinline__ void bias2(f32x16& s0, f32x16& s1, float scale2, float slopec, float cb) {
    const float cb1 = cb + slopec * 32.f;
#pragma unroll
    for (int k = 0; k < 16; ++k) { const float ck = (float)((k & 3) + 8 * (k >> 2)); s0[k] = s0[k] * scale2 + (slopec * ck + cb); s1[k] = s1[k] * scale2 + (slopec * ck + cb1); }
}
struct AttnSrc { const bf16* KCP; const bf16* VCTP; const bf16* Ks; const bf16* Vs; const bf16* Kw; const bf16* Vw; };
__device__ __forceinline__ void tile_dma(const AttnSrc& A, int e, LAS unsigned char* Lb, int w, int lane) {
    const int kind = e >> 24, idx = e & 0xffffff; const unsigned row = 8u * (unsigned)w + ((unsigned)lane >> 3), ch = (((unsigned)lane & 7u) ^ ((row >> 1) & 7u)) * 16u;
    const char* kb; const char* vb; unsigned vo;
    if (kind <= 1) { kb = (const char*)(A.KCP + (size_t)idx * 64 * 64); vb = (const char*)(A.VCTP + idx * 64); vo = row * 1024u + ch; }
    else if (kind == 2) { kb = (const char*)(A.Kw + (size_t)idx * 64 * 64); vb = (const char*)(A.Vw + idx * 64); vo = row * (unsigned)(T * 2) + ch; }
    else { kb = (const char*)(A.Ks + (size_t)idx * 64 * 64); vb = (const char*)(A.Vs + idx * 64); vo = row * (unsigned)(T * 2) + ch; }
    __builtin_amdgcn_global_load_lds((const unsigned*)(kb + (row * 128u + ch)), (LAS unsigned*)(Lb + AL_K + w * 1024), 16, 0, 0);
    __builtin_amdgcn_global_load_lds((const unsigned*)(vb + vo), (LAS unsigned*)(Lb + AL_V + w * 1024), 16, 0, 0);
}
__device__ __forceinline__ void nsa_prompt_unit(Frame& F, int unit) {
    const int b = unit >> 8, g = (unit >> 7) & 1, qt = unit & 127, t0 = qt * 64;
    int tid = F.tid; asm volatile("" : "+v"(tid));
    const int lane = tid & 63, w = F.wave, l31 = lane & 31, h5 = lane >> 5, ql = l31 >> 2, r = l31 & 3;
    LAS unsigned char* L = F.lds + RING_OFF;
    const bf16* HB = (const bf16*)(F.ws + WS_HB);
    const int pos = t0 + 8 * w + ql;
    const size_t qrow = (size_t)(b * T + pos);
    const float slope2 = __builtin_amdgcn_exp2f(-(float)(g * 4 + r + 1)) * LOG2E, scale2 = 0.125f * LOG2E;
    bf16x8 qf[4];
#pragma unroll
    for (int s = 0; s < 4; ++s) qf[s] = *(const GAS bf16x8*)(HB + qrow * NIN + C_QA + (g * 4 + r) * 64 + 16 * s + 8 * h5);
#define NSA_GATE(i) sigmoidf_(bf2f(HB[qrow * NIN + C_GLA + (g * 4 + r) * 3 + (i)]))
    AttnSrc A;
    A.KCP = (const bf16*)(F.ws + WS_KCP) + (size_t)(b * 2 + g) * 512 * 64; A.VCTP = (const bf16*)(F.ws + WS_VCTP) + (size_t)(b * 2 + g) * 64 * 512;
    A.Ks = (const bf16*)(F.ws + WS_KSC) + (size_t)(b * 2 + g) * T * 64; A.Vs = (const bf16*)(F.ws + WS_VST) + (size_t)(b * 2 + g) * 64 * T;
    A.Kw = (const bf16*)(F.ws + WS_KWC) + (size_t)(b * 2 + g) * T * 64; A.Vw = (const bf16*)(F.ws + WS_VWT) + (size_t)(b * 2 + g) * 64 * T;
    LAS int* TL = (LAS int*)(L + AL_TL);
    for (int i = tid; i < (AL_TL - AL_IMP) / 4; i += NWAVES * 64) ((LAS unsigned*)(L + AL_IMP))[i] = 0u;
    const int nmax_u = (t0 + 63 - 31) >> 4, nc = (nmax_u >> 6) + 1;
    const int nmax_w = (t0 + 8 * w + 7 - 31) >> 4;
    const int kb_lo = qt >= 8 ? qt - 8 : 0, nw = qt - kb_lo + 1;
    if (tid < 2 * nc + nw) TL[tid] = tid < nc ? tid : (tid < 2 * nc ? (1 << 24) | (tid - nc) : (2 << 24) | (kb_lo + tid - 2 * nc));
    __syncthreads();
    f32x16 O[2];
#pragma unroll
    for (int i = 0; i < 16; ++i) { O[0][i] = 0.f; O[1][i] = 0.f; }
    float* ots = (float*)(F.ws + WS_OTS) + ((size_t)blockIdx.x * 512 + tid) * 32;
    float m = NEG_INF, l = 0.f, inv_l = 0.f, mfin = 0.f;
    int n = 2 * nc + nw;
#define NSA_TILE_LOOP(stream) \
    { \
_Pragma("unroll") \
    for (int j = 0; j < AT_D; ++j) tile_dma(A, TL[j < n ? j : n - 1], L + j * AL_BUF, w, lane); \
    int bi = 0; \
_Pragma("unroll 1") \
    for (int i = 0; i < n; ++i) { \
        asm volatile("s_waitcnt vmcnt(6)" ::: "memory"); __builtin_amdgcn_s_barrier(); asm volatile("" ::: "memory"); \
        { const int jn = i + AT_D < n ? i + AT_D : n - 1; const int bn = bi + AT_D >= AT_NB ? bi + AT_D - AT_NB : bi + AT_D; tile_dma(A, TL[jn], L + bn * AL_BUF, w, lane); } \
        const int e = TL[i], kind = (stream) == 1 ? 3 : (e >> 24), idx = e & 0xffffff; \
        const LAS unsigned char* Lb = L + bi * AL_BUF; bi = bi + 1 == AT_NB ? 0 : bi + 1; \
        if (stream == 0 && i == nc) { l += __shfl_xor(l, 32); inv_l = l > 0.f ? 1.0f / l : 0.f; mfin = (m == NEG_INF) ? 0.f : m; } \
        if (stream == 0 && i == 2 * nc) { \
            { const float g0_ = NSA_GATE(0); _Pragma("unroll") for (int k = 0; k < 16; ++k) { ots[k] = g0_ * O[0][k]; ots[16 + k] = g0_ * O[1][k]; O[0][k] = 0.f; O[1][k] = 0.f; } } \
            asm volatile("s_waitcnt vmcnt(0)" ::: "memory"); \
            m = NEG_INF; l = 0.f; } \
        if ((stream) == 0 && kind <= 1) { \
            const int n0 = idx * 64; \
            if (n0 <= nmax_w) { \
                f32x16 s0 = qk_sub(Lb, 0, qf, l31, h5), s1 = qk_sub(Lb, 1, qf, l31, h5); \
                const float slopec = 16.f * slope2; \
                bias2(s0, s1, scale2, slopec, slope2 * (float)(16 * n0 + 31 - pos) + slopec * (float)(4 * h5) - (kind == 1 ? mfin : 0.f)); \
                if (16 * (n0 + 63) + 31 > t0 + 8 * w) { \
_Pragma("unroll") \
                    for (int k = 0; k < 16; ++k) { const int d0 = pos - (16 * (n0 + crow(k, h5)) + 31), d1 = d0 - 512; s0[k] = d0 >= 0 ? s0[k] : NEG_INF; s1[k] = d1 >= 0 ? s1[k] : NEG_INF; } \
                } \
                if (kind == 0) { \
                    float tmax = fmaxf(s0[0], s1[0]); \
_Pragma("unroll") \
                    for (int k = 1; k < 16; ++k) tmax = fmaxf(tmax, fmaxf(s0[k], s1[k])); \
                    tmax = fmaxf(tmax, __shfl_xor(tmax, 32)); \
                    const float mnew = fmaxf(m, tmax), ms = (mnew == NEG_INF) ? 0.f : mnew; \
                    float ps = 0.f; \
_Pragma("unroll") \
                    for (int k = 0; k < 16; ++k) ps += __builtin_amdgcn_exp2f(s0[k] - ms) + __builtin_amdgcn_exp2f(s1[k] - ms); \
                    l = l * __builtin_amdgcn_exp2f(m - ms) + ps; m = mnew; \
                } else { \
_Pragma("unroll") \
                    for (int k = 0; k < 16; ++k) { s0[k] = __builtin_amdgcn_exp2f(s0[k]) * inv_l; s1[k] = __builtin_amdgcn_exp2f(s1[k]) * inv_l; } \
_Pragma("unroll") \
                    for (int a = 0; a < 4; ++a) { \
                        float sm0 = (s0[4 * a] + s0[4 * a + 1]) + (s0[4 * a + 2] + s0[4 * a + 3]), sm1 = (s1[4 * a] + s1[4 * a + 1]) + (s1[4 * a + 2] + s1[4 * a + 3]); \
                        sm0 += __shfl_xor(sm0, 1); sm0 += __shfl_xor(sm0, 2); sm1 += __shfl_xor(sm1, 1); sm1 += __shfl_xor(sm1, 2); \
                        if (r == 0) { ((LAS float*)(L + AL_IMP))[(8 * w + ql) * 128 + (n0 >> 2) + 2 * a + h5] = sm0; ((LAS float*)(L + AL_IMP))[(8 * w + ql) * 128 + (n0 >> 2) + 8 + 2 * a + h5] = sm1; } \
                    } \
                    pv_sub(Lb, 0, s0, O, l31, h5); pv_sub(Lb, 1, s1, O, l31, h5); \
                } \
            } \
        } else { \
            const int pos0 = idx * 64; \
            const bool sel = (stream) == 0 ? true : ((((LAS unsigned*)(L + AL_SELM))[(8 * w + ql) * 4 + (idx >> 5)] >> (idx & 31)) & 1u) != 0u; \
            if (__any(sel && pos >= pos0)) { \
                f32x16 s0 = qk_sub(Lb, 0, qf, l31, h5), s1 = qk_sub(Lb, 1, qf, l31, h5); \
                bias2(s0, s1, scale2, slope2, sel ? slope2 * (float)(pos0 - pos + 4 * h5) : NEG_INF); \
                if (idx == qt || ((stream) == 0 && idx == qt - 8)) { \
_Pragma("unroll") \
                    for (int k = 0; k < 16; ++k) { const int d0 = pos - (pos0 + crow(k, h5)), d1 = d0 - 32; \
                        s0[k] = (d0 >= 0 && ((stream) == 1 || d0 < 512)) ? s0[k] : NEG_INF; s1[k] = (d1 >= 0 && ((stream) == 1 || d1 < 512)) ? s1[k] : NEG_INF; } \
                } \
                online_update2(Lb, s0, s1, m, l, O, l31, h5); \
            } \
        } \
    } \
    asm volatile("s_waitcnt vmcnt(0)" ::: "memory"); __builtin_amdgcn_s_barrier(); asm volatile("" ::: "memory"); \
    l += __shfl_xor(l, 32); \
    const float sc_ = l > 0.f ? NSA_GATE(stream == 0 ? 2 : 1) / l : 0.f; \
    if (stream == 0) { \
_Pragma("unroll") \
        for (int k = 0; k < 16; ++k) { ots[k] += sc_ * O[0][k]; ots[16 + k] += sc_ * O[1][k]; } \
    } else { \
_Pragma("unroll") \
        for (int k = 0; k < 16; ++k) { O[0][k] = ots[k] + sc_ * O[0][k]; O[1][k] = ots[16 + k] + sc_ * O[1][k]; } \
    } \
    }
    NSA_TILE_LOOP(0)
    {
        const int q = tid >> 3, sub = tid & 7, cur = qt;
        float vals[16]; unsigned avail = 0u, bits = 0u;
#pragma unroll
        for (int i = 0; i < 16; ++i) { const int j = sub * 16 + i; vals[i] = ((LAS float*)(L + AL_IMP))[q * 128 + j];
            if (j <= cur) { if (cur < 16 || j == 0 || j == cur || j == cur - 1) bits |= 1u << i; else avail |= 1u << i; } }
        if (cur >= 16) {
            for (int round = 0; round < 13; ++round) {
                float bv = -1.0f; int bi = 1 << 20;
#pragma unroll
                for (int i = 0; i < 16; ++i) if (((avail >> i) & 1u) && vals[i] > bv) { bv = vals[i]; bi = sub * 16 + i; }
#pragma unroll
                for (int o = 1; o < 8; o <<= 1) { const float ov = __shfl_xor(bv, o); const int oi = __shfl_xor(bi, o); if (ov > bv || (ov == bv && oi < bi)) { bv = ov; bi = oi; } }
                if ((bi >> 4) == sub) { avail &= ~(1u << (bi & 15)); bits |= 1u << (bi & 15); }
            }
        }
        if (bits) { __hip_atomic_fetch_or((LAS unsigned*)(L + AL_SELM) + q * 4 + (sub >> 1), bits << (16 * (sub & 1)), __ATOMIC_RELAXED, __HIP_MEMORY_SCOPE_WORKGROUP); __hip_atomic_fetch_or((LAS unsigned*)(L + AL_UNI) + (sub >> 1), bits << (16 * (sub & 1)), __ATOMIC_RELAXED, __HIP_MEMORY_SCOPE_WORKGROUP); }
        __syncthreads();
        const unsigned u0 = ((LAS unsigned*)(L + AL_UNI))[0], u1 = ((LAS unsigned*)(L + AL_UNI))[1], u2 = ((LAS unsigned*)(L + AL_UNI))[2], u3 = ((LAS unsigned*)(L + AL_UNI))[3];
        n = __builtin_popcount(u0) + __builtin_popcount(u1) + __builtin_popcount(u2) + __builtin_popcount(u3);
        n = __builtin_amdgcn_readfirstlane(n);
        if (tid < 128) { const int wq = tid >> 5, bq = tid & 31; const unsigned uw = wq == 0 ? u0 : (wq == 1 ? u1 : (wq == 2 ? u2 : u3));
            if ((uw >> bq) & 1u) { const int rank = __builtin_popcount(uw & ((1u << bq) - 1u)) + (wq > 0 ? __builtin_popcount(u0) : 0) + (wq > 1 ? __builtin_popcount(u1) : 0) + (wq > 2 ? __builtin_popcount(u2) : 0);
                TL[rank] = (3 << 24) | tid; } }
        __syncthreads();
        m = NEG_INF; l = 0.f;
#pragma unroll
        for (int i = 0; i < 16; ++i) { O[0][i] = 0.f; O[1][i] = 0.f; }
    }
    NSA_TILE_LOOP(1)
#undef NSA_TILE_LOOP
#undef NSA_GATE
    bf16* oa = (bf16*)(F.ws + WS_OA) + qrow * 512 + (g * 4 + r) * 64;
#pragma unroll
    for (int dt = 0; dt < 2; ++dt)
#pragma unroll
        for (int a = 0; a < 4; ++a) { u32x2 ow; ow.x = cvtpk(O[dt][4 * a], O[dt][4 * a + 1]); ow.y = cvtpk(O[dt][4 * a + 2], O[dt][4 * a + 3]);
            *(GAS u32x2*)(oa + dt * 32 + 8 * a + 4 * h5) = ow; }
    __syncthreads();
}

constexpr int SL_SC = 0, SL_Q = 16384, SL_RED = SL_Q + 1024, SL_IMP = SL_RED + 8192, SL_SEL = SL_IMP + 2048, SL_SELB = SL_SEL + 64, SL_OUT = SL_SELB + 128, SL_END = SL_OUT + 1024;
static_assert(SL_END <= RING_BYTES, "sample lds");
struct SampleCtx { const float* kcvs; const float* csel; const float* cwin; const float* new_sel; const float* new_win; };
template <int KIND> __device__ __forceinline__ const float* sample_key(const SampleCtx& c, const LAS int* SEL, const LAS unsigned long long* SELB, int kidx, int& dist, bool& valid) {
    if (KIND == 0) { valid = kidx < NCMP_S; dist = PAST - (16 * kidx + 31); return c.kcvs + (size_t)(valid ? kidx : 0) * 256; }
    if (KIND == 1) { const int slot = kidx >> 6, i = kidx & 63, jb = SEL[slot];
        if (jb < 256) { valid = true; dist = PAST - (jb * 64 + i); return c.csel + SELB[slot] + (size_t)i * 256; }
        valid = (i == 0); dist = 0; return c.new_sel; }
    valid = true; dist = 511 - kidx;
    return kidx == 511 ? c.new_win : c.cwin + (size_t)(kidx + 1) * 256;
}
__device__ __forceinline__ void block_max4(LAS float* red, float (&v)[4], int wave, int lane) {
#pragma unroll
    for (int r = 0; r < 4; ++r) { float x = v[r];
#pragma unroll
        for (int o = 1; o < 64; o <<= 1) x = fmaxf(x, __shfl_xor(x, o));
        if (lane == 0) red[wave * 4 + r] = x; }
    __syncthreads();
#pragma unroll
    for (int r = 0; r < 4; ++r) { float x = red[r];
#pragma unroll
        for (int q = 1; q < 8; ++q) x = fmaxf(x, red[q * 4 + r]);
        v[r] = x; }
    __syncthreads();
}
__device__ __forceinline__ void block_sum4(LAS float* red, float (&v)[4], int wave, int lane) {
#pragma unroll
    for (int r = 0; r < 4; ++r) { const float x = wave_sum(v[r]); if (lane == 0) red[wave * 4 + r] = x; }
    __syncthreads();
#pragma unroll
    for (int r = 0; r < 4; ++r) { float x = 0.f;
#pragma unroll
        for (int q = 0; q < 8; ++q) x += red[q * 4 + r];
        v[r] = x; }
    __syncthreads();
}
template <int KIND> __device__ __forceinline__ void sample_branch(Frame& F, const SampleCtx& c, int b, int g, int tid) {
    constexpr int NK = KIND == 2 ? 512 : 1024;
    const int lane = tid & 63, wave = F.wave, sub = lane & 15, kg = lane >> 4;
    LAS unsigned char* L = F.lds + RING_OFF;
    LAS float* SC = (LAS float*)(L + SL_SC); LAS float* Q = (LAS float*)(L + SL_Q); LAS float* red = (LAS float*)(L + SL_RED);
    const LAS int* SEL = (const LAS int*)(L + SL_SEL); const LAS unsigned long long* SELB = (const LAS unsigned long long*)(L + SL_SELB);
    f32x4 q4[4];
#pragma unroll
    for (int r = 0; r < 4; ++r) q4[r] = *(const LAS f32x4*)(Q + r * 64 + 4 * sub);
    constexpr int NIT = NK / 32, NBATCH_S = (NIT % 8 == 0) ? 8 : 1;
#pragma unroll 1
    for (int it0 = 0; it0 < NIT; it0 += NBATCH_S) {
        f32x4 kv[NBATCH_S]; int dist[NBATCH_S]; bool valid[NBATCH_S];
#pragma unroll
        for (int u = 0; u < NBATCH_S; ++u) { const int kidx = (it0 + u) * 32 + wave * 4 + kg; const float* kp = sample_key<KIND>(c, SEL, SELB, kidx, dist[u], valid[u]); kv[u] = *(const GAS f32x4*)(kp + 4 * sub); }
#pragma unroll
        for (int u = 0; u < NBATCH_S; ++u) {
            const int kidx = (it0 + u) * 32 + wave * 4 + kg;
            float part[4];
#pragma unroll
            for (int r = 0; r < 4; ++r) { float p = (kv[u].x * q4[r].x + kv[u].y * q4[r].y) + (kv[u].z * q4[r].z + kv[u].w * q4[r].w);
                p += __shfl_xor(p, 1); p += __shfl_xor(p, 2); p += __shfl_xor(p, 4); p += __shfl_xor(p, 8); part[r] = p; }
            if (sub < 4) { const float pr = sub == 0 ? part[0] : (sub == 1 ? part[1] : (sub == 2 ? part[2] : part[3]));
                SC[sub * 1024 + kidx] = valid[u] ? pr * 0.125f - __builtin_amdgcn_exp2f(-(float)(g * 4 + sub + 1)) * (float)dist[u] : NEG_INF; }
        }
    }
    __syncthreads();
    float mx[4] = {NEG_INF, NEG_INF, NEG_INF, NEG_INF};
    for (int kidx = tid; kidx < NK; kidx += 512)
#pragma unroll
        for (int r = 0; r < 4; ++r) mx[r] = fmaxf(mx[r], SC[r * 1024 + kidx]);
    block_max4(red, mx, wave, lane);
    float sm[4] = {0.f, 0.f, 0.f, 0.f};
    for (int kidx = tid; kidx < NK; kidx += 512)
#pragma unroll
        for (int r = 0; r < 4; ++r) { const float s = SC[r * 1024 + kidx]; const float p = s == NEG_INF ? 0.f : __expf(s - mx[r]); SC[r * 1024 + kidx] = p; sm[r] += p; }
    block_sum4(red, sm, wave, lane);
    for (int kidx = tid; kidx < NK; kidx += 512)
#pragma unroll
        for (int r = 0; r < 4; ++r) SC[r * 1024 + kidx] *= (sm[r] > 0.f ? 1.0f / sm[r] : 0.f);
    __syncthreads();
    f32x4 acc[4];
#pragma unroll
    for (int r = 0; r < 4; ++r) acc[r] = (f32x4){0.f, 0.f, 0.f, 0.f};
#pragma unroll 1
    for (int it0 = 0; it0 < NIT; it0 += NBATCH_S) {
        f32x4 vv[NBATCH_S];
#pragma unroll
        for (int u = 0; u < NBATCH_S; ++u) { const int kidx = (it0 + u) * 32 + wave * 4 + kg; int dist; bool valid; const float* kp = sample_key<KIND>(c, SEL, SELB, kidx, dist, valid); vv[u] = *(const GAS f32x4*)(kp + 128 + 4 * sub); }
#pragma unroll
        for (int u = 0; u < NBATCH_S; ++u) { const int kidx = (it0 + u) * 32 + wave * 4 + kg;
#pragma unroll
            for (int r = 0; r < 4; ++r) acc[r] += vv[u] * SC[r * 1024 + kidx]; }
    }
#pragma unroll
    for (int r = 0; r < 4; ++r)
#pragma unroll
        for (int j = 0; j < 4; ++j) { float x = acc[r][j]; x += __shfl_xor(x, 16); x += __shfl_xor(x, 32); acc[r][j] = x; }
    if (lane < 16) {
#pragma unroll
        for (int r = 0; r < 4; ++r) *(LAS f32x4*)(red + wave * 256 + r * 64 + 4 * sub) = acc[r];
    }
    __syncthreads();
    if (tid < 256) { const int r = tid >> 6; float o = 0.f;
#pragma unroll
        for (int wv = 0; wv < 8; ++wv) o += red[wv * 256 + tid];
        const float gt = sigmoidf_(bf2f(((const bf16*)(F.ws + WS_HB))[(size_t)(MP + b) * NIN + C_GLA + (g * 4 + r) * 3 + KIND]));
        ((LAS float*)(L + SL_OUT))[tid] += gt * o; }
    __syncthreads();
}
__device__ __forceinline__ void nsa_sample_unit(Frame& F, int unit) {
    const int b = unit >> 1, g = unit & 1;
    int tid = F.tid; asm volatile("" : "+v"(tid));
    LAS unsigned char* L = F.lds + RING_OFF;
    LAS float* SC = (LAS float*)(L + SL_SC); LAS float* Q = (LAS float*)(L + SL_Q); LAS float* IMP = (LAS float*)(L + SL_IMP); LAS int* SEL = (LAS int*)(L + SL_SEL);
    LAS unsigned long long* SELB = (LAS unsigned long long*)(L + SL_SELB);
    SampleCtx c;
    c.kcvs = (const float*)(F.ws + WS_KCVS) + (size_t)b * 1024 * 256 + g * 64; c.csel = F.in[3] + g * 64; c.cwin = F.in[4] + (size_t)b * 512 * 256 + g * 64;
    c.new_sel = F.out + OFF7 + (size_t)b * 256 + g * 64; c.new_win = F.out + OFF8 + ((size_t)b * 512 + 511) * 256 + g * 64;
    __syncthreads();
    if (tid < 256) { Q[tid] = bf2f(((const bf16*)(F.ws + WS_HB))[(size_t)(MP + b) * NIN + C_QA + g * 256 + tid]); ((LAS float*)(L + SL_OUT))[tid] = 0.f; }
    __syncthreads();
    sample_branch<0>(F, c, b, g, tid);
    if (tid < 257) { float s = 0.f;
#pragma unroll
        for (int cc = 0; cc < 4; ++cc) { const int n = 4 * tid + cc; if (n < NCMP_S) s += (SC[n] + SC[1024 + n]) + (SC[2048 + n] + SC[3072 + n]); }
        IMP[tid] = (tid == 0 || tid >= 255) ? -1.0f : s; }
    __syncthreads();
    if (tid < 64) {
        if (tid == 0) { SEL[0] = 0; SEL[1] = 255; SEL[2] = 256; }
        float vals[4]; unsigned avail = 0xfu;
#pragma unroll
        for (int i = 0; i < 4; ++i) { const int j = tid * 4 + i; vals[i] = IMP[j]; if (vals[i] < 0.f) avail &= ~(1u << i); }
        for (int round = 0; round < 13; ++round) {
            float bv = -1.0f; int bi = 1 << 20;
#pragma unroll
            for (int i = 0; i < 4; ++i) if (((avail >> i) & 1u) && vals[i] > bv) { bv = vals[i]; bi = tid * 4 + i; }
#pragma unroll
            for (int o = 1; o < 64; o <<= 1) { const float ov = __shfl_xor(bv, o); const int oi = __shfl_xor(bi, o); if (ov > bv || (ov == bv && oi < bi)) { bv = ov; bi = oi; } }
            if ((bi >> 2) == tid) avail &= ~(1u << (bi & 3));
            if (tid == 0) SEL[3 + round] = bi;
        }
    }
    __syncthreads();
    if (tid < 16) { const int jb = SEL[tid]; const int* pt = (const int*)F.in[6] + b * NPAGES;
        SELB[tid] = jb < 256 ? ((unsigned long long)pt[jb >> 1] * 128ull + (unsigned long long)((jb & 1) * 64)) * 256ull : 0ull; }
    __syncthreads();
    sample_branch<1>(F, c, b, g, tid);
    sample_branch<2>(F, c, b, g, tid);
    if (tid < 256) ((bf16*)(F.ws + WS_OA))[(size_t)(MP + b) * 512 + g * 256 + tid] = (bf16)f2bf(((LAS float*)(L + SL_OUT))[tid]);
    __syncthreads();
}
__device__ __forceinline__ void p3_phase(Frame& F) {
    for (int u = blockIdx.x; u < 16 * HG_NSEG; u += F.G) hgrn_segment<1>(F, u / HG_NSEG, u % HG_NSEG);
#pragma unroll 1
    for (int u2 = 2 * blockIdx.x; u2 < 512; u2 += 2 * F.G) {
#pragma unroll 1
        for (int which = 0; which < 2; ++which) { const int p = u2 >> 1, bg = p >> 6, qq = p & 63; nsa_prompt_unit(F, bg * 128 + (which ? qq : 127 - qq)); } }
    for (int u = blockIdx.x; u < 2 * MS; u += F.G) nsa_sample_unit(F, u);
}
namespace pg8 {
typedef unsigned u32x2e __attribute__((ext_vector_type(2)));
__device__ __forceinline__ float bfl(unsigned w) { return __uint_as_float(w << 16); }
__device__ __forceinline__ float bfh(unsigned w) { return __uint_as_float(w & 0xffff0000u); }
__device__ __forceinline__ float sgm(float x) { return 1.0f / (1.0f + __expf(-x)); }
struct EpiGateA {
    static constexpr bool PERM = false, AFTER_DRAIN = false;
    const bf16_t* HBp; float* TB;
    __device__ __forceinline__ void operator()(const f32x4 (&acc)[2][2][4][2], const Unit& u, int wr, int wc, int fr, int fq) const {
        const int row0 = u.pm * BM + wr * 64 + fr, col0 = u.pn * BM + wc * 32 + 4 * fq;
#pragma unroll
        for (int ai = 0; ai < 2; ++ai)
#pragma unroll
            for (int m = 0; m < 4; ++m) { const size_t r = (size_t)(row0 + ai * HALF + m * 16);
#pragma unroll
                for (int bj = 0; bj < 2; ++bj)
#pragma unroll
                    for (int n = 0; n < 2; ++n) { const int c = col0 + bj * HALF + n * 16; const u32x2e gw = *(const u32x2e*)(HBp + r * NIN + C_MG + c); const f32x4 a = acc[ai][bj][m][n];
                        *(f32x4*)(TB + r * D + c) = (f32x4){sgm(bfl(gw.x)) * a[0], sgm(bfh(gw.x)) * a[1], sgm(bfl(gw.y)) * a[2], sgm(bfh(gw.y)) * a[3]}; } }
    }
};
struct EpiGateB {
    static constexpr bool PERM = false, AFTER_DRAIN = false;
    const bf16_t* HBp; const float* TB; bf16_t* MG;
    __device__ __forceinline__ void operator()(const f32x4 (&acc)[2][2][4][2], const Unit& u, int wr, int wc, int fr, int fq) const {
        const int row0 = u.pm * BM + wr * 64 + fr, col0 = u.pn * BM + wc * 32 + 4 * fq;
#pragma unroll
        for (int ai = 0; ai < 2; ++ai)
#pragma unroll
            for (int m = 0; m < 4; ++m) { const size_t r = (size_t)(row0 + ai * HALF + m * 16);
#pragma unroll
                for (int bj = 0; bj < 2; ++bj)
#pragma unroll
                    for (int n = 0; n < 2; ++n) { const int c = col0 + bj * HALF + n * 16; const u32x2e gw = *(const u32x2e*)(HBp + r * NIN + C_MG + D + c); const f32x4 a = acc[ai][bj][m][n]; const f32x4 t = *(const f32x4*)(TB + r * D + c);
                        u32x2e o; o.x = cvt_pk_bf16(t[0] + sgm(bfl(gw.x)) * a[0], t[1] + sgm(bfh(gw.x)) * a[1]); o.y = cvt_pk_bf16(t[2] + sgm(bfl(gw.y)) * a[2], t[3] + sgm(bfh(gw.y)) * a[3]);
                        *(u32x2e*)(MG + r * D + c) = o; } }
    }
};
struct EpiResid {
    static constexpr bool PERM = false, AFTER_DRAIN = false;
    const float* rp; const float* rs; float* Z;
    __device__ __forceinline__ void operator()(const f32x4 (&acc)[2][2][4][2], const Unit& u, int wr, int wc, int fr, int fq) const {
        const int row0 = u.pm * BM + wr * 64 + fr, col0 = u.pn * BM + wc * 32 + 4 * fq;
#pragma unroll
        for (int ai = 0; ai < 2; ++ai)
#pragma unroll
            for (int m = 0; m < 4; ++m) { const int r = row0 + ai * HALF + m * 16; const float* xr = r < MP ? rp + (size_t)r * D : (r < MP + MS ? rs + (size_t)(r - MP) * D : nullptr);
#pragma unroll
                for (int bj = 0; bj < 2; ++bj)
#pragma unroll
                    for (int n = 0; n < 2; ++n) { const int c = col0 + bj * HALF + n * 16; const f32x4 x = xr ? *(const f32x4*)(xr + c) : (f32x4){0.f, 0.f, 0.f, 0.f};
                        *(f32x4*)(Z + (size_t)r * D + c) = x * DN_ALPHA + acc[ai][bj][m][n]; } }
    }
};
struct EpiRelu2 {
    static constexpr bool PERM = true, AFTER_DRAIN = false;
    bf16_t* U;
    __device__ __forceinline__ void operator()(const f32x4 (&acc)[2][2][4][2], const Unit& u, int wr, int wc, int fr, int fq) const {
        const int row0 = u.pm * BM + wr * 64 + fr, col0 = u.pn * BM + wc * 32 + 8 * fq;
#pragma unroll
        for (int ai = 0; ai < 2; ++ai)
#pragma unroll
            for (int m = 0; m < 4; ++m) { bf16_t* rowp = U + (size_t)(row0 + ai * HALF + m * 16) * FF + col0;
#pragma unroll
                for (int bj = 0; bj < 2; ++bj) { f32x4 v0 = acc[ai][bj][m][0], v1 = acc[ai][bj][m][1];
#pragma unroll
                    for (int j = 0; j < 4; ++j) { const float a = fmaxf(v0[j], 0.f), b = fmaxf(v1[j], 0.f); v0[j] = a * a; v1[j] = b * b; }
                    u32x4 w; w.x = cvt_pk_bf16(v0[0], v0[1]); w.y = cvt_pk_bf16(v0[2], v0[3]); w.z = cvt_pk_bf16(v1[0], v1[1]); w.w = cvt_pk_bf16(v1[2], v1[3]);
                    *(u32x4*)(rowp + bj * HALF) = w; } }
    }
};
}
__device__ __forceinline__ void ln_phase(Frame& F, const float* Z, const float* gam, const float* bet, int which) {
    const int gw = F.vcu * NWAVES + F.wave, NGW = F.G * NWAVES, lane = F.lane;
    const int nrows = MP + MS;
    for (int r = gw; r < nrows; r += NGW) {
        const GAS f32x4* zr = (const GAS f32x4*)(Z + (size_t)r * D) + lane;
        f32x4 v[4]; float s = 0.f;
        if (which && r >= MP) {
            const GAS f32x4* x1r = (const GAS f32x4*)((const float*)(F.ws + WS_X1F) + (size_t)r * D) + lane;
#pragma unroll
            for (int j = 0; j < 4; ++j) { f32x4 t = x1r[64 * j] * DN_ALPHA;
#pragma unroll
                for (int kq = 0; kq < 4; ++kq) t += *((const GAS f32x4*)(Z + (size_t)(MP + 32 * kq + (r - MP)) * D) + lane + 64 * j);
                v[j] = t; s += (t.x + t.y) + (t.z + t.w); }
        } else {
#pragma unroll
        for (int j = 0; j < 4; ++j) { v[j] = zr[64 * j]; s += (v[j].x + v[j].y) + (v[j].z + v[j].w); }
        }
        const float mean = wave_sum(s) * (1.f / D); float s2 = 0.f;
#pragma unroll
        for (int j = 0; j < 4; ++j) { v[j] = v[j] - mean; s2 += (v[j].x * v[j].x + v[j].y * v[j].y) + (v[j].z * v[j].z + v[j].w * v[j].w); }
        const float rstd = 1.f / sqrtf(wave_sum(s2) * (1.f / D) + LN_EPS);
        float* of = which ? (r < MP ? F.out + OFF0 + (size_t)r * D : F.out + OFF1 + (size_t)(r - MP) * D) : (float*)(F.ws + WS_X1F) + (size_t)r * D;
#pragma unroll
        for (int j = 0; j < 4; ++j) { const f32x4 gg = *((const GAS f32x4*)gam + lane + 64 * j), bb = *((const GAS f32x4*)bet + lane + 64 * j);
            v[j] = v[j] * rstd * gg + bb; *((GAS f32x4*)of + lane + 64 * j) = v[j]; }
        if (!which) { GAS unsigned long long* o8 = (GAS unsigned long long*)((bf16*)(F.ws + WS_X1B) + (size_t)r * D) + lane;
#pragma unroll
            for (int j = 0; j < 4; ++j) o8[64 * j] = (unsigned long long)pk2(v[j].x, v[j].y) | ((unsigned long long)pk2(v[j].z, v[j].w) << 32); }
    }
}
__device__ __forceinline__ f32x16 small_gemm(const bf16* A, int lda, const bf16* Bt, int K, int n0, int k0, int k1, int l31, int h5, f32x16 acc) {
    const bf16* ap = A + (size_t)l31 * lda + 8 * h5; const bf16* bp = Bt + (size_t)(n0 + l31) * K + 8 * h5;
#pragma unroll 1
    for (int k = k0; k < k1; k += 128) {
        bf16x8 av[8], bv[8];
#pragma unroll
        for (int j = 0; j < 8; ++j) { av[j] = *(const GAS bf16x8*)(ap + k + 16 * j); bv[j] = *(const GAS bf16x8*)(bp + k + 16 * j); }
#pragma unroll
        for (int j = 0; j < 8; ++j) acc = MFMA32(av[j], bv[j], acc);
    }
    return acc;
}
#define SMALL_TASK_LOOP(NT) for (int it = F.vcu + F.G * F.wave; it < (NT); it += F.G * NWAVES)
__device__ __forceinline__ f32x16 zero16() { f32x16 z;
#pragma unroll
    for (int i = 0; i < 16; ++i) z[i] = 0.f;
    return z; }
__device__ __forceinline__ void sample_merge_tasks(Frame& F) {
    const int l31 = F.lane & 31, h5 = F.lane >> 5; const bf16* HB = (const bf16*)(F.ws + WS_HB);
    SMALL_TASK_LOOP(32) { const int n0 = it * 32, n = n0 + l31;
        const f32x16 aa = small_gemm((const bf16*)(F.ws + WS_OA) + (size_t)MP * 512, 512, (const bf16*)(F.ws + WS_WA), 512, n0, 0, 512, l31, h5, zero16());
        const f32x16 ab = small_gemm((const bf16*)(F.ws + WS_OB) + (size_t)MP * 512, 512, (const bf16*)(F.ws + WS_WB), 512, n0, 0, 512, l31, h5, zero16());
#pragma unroll
        for (int v = 0; v < 16; ++v) { const size_t row = (size_t)(MP + crow(v, h5));
            const float g1 = sigmoidf_(bf2f(HB[row * NIN + C_MG + n])), g2 = sigmoidf_(bf2f(HB[row * NIN + C_MG + D + n]));
            ((bf16*)(F.ws + WS_MG))[row * D + n] = (bf16)f2bf(g1 * aa[v] + g2 * ab[v]); } }
}
__device__ __forceinline__ void sample_wout_tasks(Frame& F) {
    const int l31 = F.lane & 31, h5 = F.lane >> 5;
    SMALL_TASK_LOOP(32) { const int n0 = it * 32, n = n0 + l31;
        const f32x16 a = small_gemm((const bf16*)(F.ws + WS_MG) + (size_t)MP * D, D, (const bf16*)(F.ws + WS_WO), D, n0, 0, D, l31, h5, zero16());
#pragma unroll
        for (int v = 0; v < 16; ++v) { const int row = crow(v, h5); ((float*)(F.ws + WS_Z1))[(size_t)(MP + row) * D + n] = DN_ALPHA * F.in[1][(size_t)row * D + n] + a[v]; } }
}
__device__ __forceinline__ void sample_up_tasks(Frame& F) {
    const int l31 = F.lane & 31, h5 = F.lane >> 5;
    SMALL_TASK_LOOP(128) { const int n0 = it * 32, n = n0 + l31;
        const f32x16 a = small_gemm((const bf16*)(F.ws + WS_X1B) + (size_t)MP * D, D, (const bf16*)(F.ws + WS_WUP), D, n0, 0, D, l31, h5, zero16());
#pragma unroll
        for (int v = 0; v < 16; ++v) { const float x = fmaxf(a[v], 0.f); ((bf16*)(F.ws + WS_UB))[(size_t)(MP + crow(v, h5)) * FF + n] = (bf16)f2bf(x * x); } }
}
__device__ __forceinline__ void sample_down_tasks(Frame& F) {
    const int l31 = F.lane & 31, h5 = F.lane >> 5;
    SMALL_TASK_LOOP(128) { const int n0 = (it & 31) * 32, kq = it >> 5, n = n0 + l31;
        const f32x16 a = small_gemm((const bf16*)(F.ws + WS_UB) + (size_t)MP * FF, FF, (const bf16*)(F.ws + WS_WDN), FF, n0, kq * 1024, kq * 1024 + 1024, l31, h5, zero16());
#pragma unroll
        for (int v = 0; v < 16; ++v) ((float*)(F.ws + WS_Z2))[(size_t)(MP + 32 * kq + crow(v, h5)) * D + n] = a[v]; }
}

#ifdef PROBE_LAST
#ifndef PROBE_BASE
#define PROBE_BASE WS_KCP
#endif
#ifndef PROBE_BYTES
#define PROBE_BYTES (WS_TB - WS_KCP)
#endif
__device__ __forceinline__ void probe_digest(Frame& F, const XcdBarrier& bar) {
    const size_t i0 = (size_t)blockIdx.x * 512 + F.tid, st = (size_t)F.G * 512;
    for (size_t i = i0; i < OUT_TOTAL; i += st) F.out[i] = 0.f;
    xcd_barrier(bar);
    const unsigned* w = (const unsigned*)(F.ws + PROBE_BASE); const size_t nw = (size_t)(PROBE_BYTES) / 4;
    unsigned h = 0u;
    for (size_t i = i0; i < nw; i += st) h += (w[i] ^ (unsigned)i) * 2654435761u;
#pragma unroll
    for (int o = 1; o < 64; o <<= 1) h += __shfl_xor(h, o);
    if (F.lane == 0) F.out[(size_t)blockIdx.x * 8 + F.wave] = (float)(h & 0xFFFFFu);
}
#endif
struct Args { const float* in[21]; float* out; unsigned char* ws; int ph_lo, ph_hi; };
__global__ void __launch_bounds__(NWAVES * 64, 2) nsa_fwd(Args args) {
    extern __shared__ __attribute__((aligned(16))) unsigned char lds[];
    Frame F;
    F.lds = (LAS unsigned char*)lds;
    F.MISC = (volatile LAS unsigned*)(F.lds + MISC_OFF);
    F.tid = threadIdx.x; F.lane = F.tid & 63; F.wave = __builtin_amdgcn_readfirstlane(F.tid >> 6);
    F.G = gridDim.x; { const int bx = blockIdx.x; F.vcu = (F.G % 8 == 0) ? (bx % 8) * (F.G / 8) + bx / 8 : bx; }
    F.ws = args.ws; F.out = args.out;
#pragma unroll
    for (int i = 0; i < 21; ++i) F.in[i] = args.in[i];
    F.ctl = (gu32*)(F.ws + WS_CTL);
    for (int u = F.tid; u < (LDS_BYTES - LDSCTL_OFF) / 4; u += NWAVES * 64) ((LAS unsigned*)(F.lds + LDSCTL_OFF))[u] = 0u;
    __syncthreads();
    XcdBarrier bar = xcd_barrier_post((unsigned*)(F.ctl + CW_BAR), F.MISC + 8);
    const int lo = args.ph_lo, hi = args.ph_hi;
#ifdef PROBE_TIMING
    unsigned long long ts[11];
#define STAMP(k) ts[k] = rt();
#else
#define STAMP(k)
#endif
    STAMP(0)
#define IN(k) (lo <= (k) && (k) < hi)
#define BOTH(k) (IN(k) && IN((k) + 1))
#define GRID_BAR() xcd_barrier(bar)


#ifdef PROBE_LAST
#define PROBE_AFTER(k) if ((k) == PROBE_LAST) { probe_digest(F, bar); return; }
#else
#define PROBE_AFTER(k)
#endif
    if (IN(0)) { p0_prologue(F); if (BOTH(0)) GRID_BAR(); }
    PROBE_AFTER(0)
    STAMP(1)
    if (IN(1)) {
        pg8::Gemm g{(const pg8::bf16_t*)(F.ws + WS_XB), (const pg8::bf16_t*)(F.ws + WS_WIN), MALL, NIN, D}; pg8::StaticOrder S; S.init(MALL, NIN, F.G, (int)blockIdx.x);
        pg8::EpiInProj E{(pg8::bf16_t*)(F.ws + WS_HB), F.out};
        pg8::gemm_phase<pg8::EpiInProj, pg8::StaticOrder, true, true>(F.lds + RING_OFF, g, S, E);
        if (BOTH(1)) GRID_BAR();
    }
    PROBE_AFTER(1)
    STAMP(2)

    if (IN(2)) { p2_phase(F); if (BOTH(2)) GRID_BAR(); }
    PROBE_AFTER(2)
    STAMP(3)
    if (IN(3)) { p3_phase(F); if (BOTH(3)) GRID_BAR(); }
    PROBE_AFTER(3)
    STAMP(4)
    if (IN(4)) {
        { pg8::Gemm g{(const pg8::bf16_t*)(F.ws + WS_OA), (const pg8::bf16_t*)(F.ws + WS_WA), MP, D, 512}; pg8::StaticOrder S; S.init(MP, D, F.G, (int)blockIdx.x);
          pg8::EpiGateA E{(const pg8::bf16_t*)(F.ws + WS_HB), (float*)(F.ws + WS_TB)};
          pg8::gemm_phase<pg8::EpiGateA, pg8::StaticOrder, true, true>(F.lds + RING_OFF, g, S, E); }
        { pg8::Gemm g{(const pg8::bf16_t*)(F.ws + WS_OB), (const pg8::bf16_t*)(F.ws + WS_WB), MP, D, 512}; pg8::StaticOrder S; S.init(MP, D, F.G, (int)blockIdx.x);
          pg8::EpiGateB E{(const pg8::bf16_t*)(F.ws + WS_HB), (const float*)(F.ws + WS_TB), (pg8::bf16_t*)(F.ws + WS_MG)};
          pg8::gemm_phase<pg8::EpiGateB, pg8::StaticOrder, true, true>(F.lds + RING_OFF, g, S, E); }
        sample_merge_tasks(F);
        if (BOTH(4)) GRID_BAR();
    }
    PROBE_AFTER(4)
    STAMP(5)
    if (IN(5)) {
        pg8::Gemm g{(const pg8::bf16_t*)(F.ws + WS_MG), (const pg8::bf16_t*)(F.ws + WS_WO), MP, D, D}; pg8::StaticOrder S; S.init(MP, D, F.G, (int)blockIdx.x);
        pg8::EpiResid E{F.in[0], F.in[1], (float*)(F.ws + WS_Z1)};
        pg8::gemm_phase<pg8::EpiResid, pg8::StaticOrder, true, true>(F.lds + RING_OFF, g, S, E);
        sample_wout_tasks(F);
        if (BOTH(5)) GRID_BAR();
    }
    PROBE_AFTER(5)
    STAMP(6)
    if (IN(6)) { ln_phase(F, (const float*)(F.ws + WS_Z1), F.in[15], F.in[16], 0); if (BOTH(6)) GRID_BAR(); }
    PROBE_AFTER(6)
    STAMP(7)
    if (IN(7)) {
        pg8::Gemm g{(const pg8::bf16_t*)(F.ws + WS_X1B), (const pg8::bf16_t*)(F.ws + WS_WUP), MP, FF, D}; pg8::StaticOrder S; S.init(MP, FF, F.G, (int)blockIdx.x);
        pg8::EpiRelu2 E{(pg8::bf16_t*)(F.ws + WS_UB)};
        pg8::gemm_phase<pg8::EpiRelu2, pg8::StaticOrder, true, true>(F.lds + RING_OFF, g, S, E);
        sample_up_tasks(F);
        if (BOTH(7)) GRID_BAR();
    }
    PROBE_AFTER(7)
    STAMP(8)
    if (IN(8)) {
        pg8::Gemm g{(const pg8::bf16_t*)(F.ws + WS_UB), (const pg8::bf16_t*)(F.ws + WS_WDN), MP, D, FF}; pg8::StaticOrder S; S.init(MP, D, F.G, (int)blockIdx.x);
        pg8::EpiResid E{(const float*)(F.ws + WS_X1F), (const float*)(F.ws + WS_X1F) + (size_t)MP * D, (float*)(F.ws + WS_Z2)};
        pg8::gemm_phase<pg8::EpiResid, pg8::StaticOrder, true, true>(F.lds + RING_OFF, g, S, E);
        sample_down_tasks(F);
        if (BOTH(8)) GRID_BAR();
    }
    PROBE_AFTER(8)
    STAMP(9)
    if (IN(9)) { ln_phase(F, (const float*)(F.ws + WS_Z2), F.in[19], F.in[20], 1); }
#ifdef PROBE_TIMING
    GRID_BAR();
    STAMP(10)
    { const size_t i0 = (size_t)blockIdx.x * 512 + F.tid, st = (size_t)F.G * 512; for (size_t i = i0; i < OUT_TOTAL; i += st) ((unsigned*)F.out)[i] = 0xAAAAAAABu; }
    GRID_BAR();
    if (blockIdx.x == 0) {
        const size_t offs[10] = {OFF0, OFF1, OFF2, OFF3, OFF4, OFF5, OFF6, OFF7, OFF8, OFF9};
#pragma unroll
        for (int k = 0; k < 10; ++k) { const unsigned n = (unsigned)((ts[k + 1] - ts[k]) / 10ull); for (unsigned i = F.tid; i < n; i += 512) ((unsigned*)F.out)[offs[k] + i] = 0xAAAAAAAAu; }
    }
#endif
#ifdef PROBE_SANITIZE
    GRID_BAR();
    { const size_t i0 = (size_t)blockIdx.x * 512 + F.tid, st = (size_t)F.G * 512;
      for (size_t i = i0; i < OUT_TOTAL; i += st) { const float v = F.out[i]; if (!(v - v == 0.f)) F.out[i] = 0.f; } }
#endif
#undef IN
#undef BOTH
}

extern "C" void kernel_launch(void* const* d_in, const int* in_sizes, int n_in, void* d_out, int out_size, void* d_ws, size_t ws_size, hipStream_t stream) {
    static int grid = 0;
    if (grid == 0) {
        if (n_in != 21 || (size_t)out_size != OUT_TOTAL || ws_size < WS_END) { fprintf(stderr, "kernel_launch: unexpected shapes: n_in %d out %d ws %zu (need %zu)\n", n_in, out_size, ws_size, (size_t)WS_END); grid = -1; return; }
        int dev = 0, cus = 0, per_cu = 0;
        if (hipGetDevice(&dev) != hipSuccess || hipDeviceGetAttribute(&cus, hipDeviceAttributeMultiprocessorCount, dev) != hipSuccess) { grid = -1; return; }
        if (hipFuncSetAttribute((const void*)nsa_fwd, hipFuncAttributeMaxDynamicSharedMemorySize, LDS_BYTES) != hipSuccess) { fprintf(stderr, "kernel_launch: hipFuncSetAttribute failed\n"); grid = -1; return; }
        if (hipOccupancyMaxActiveBlocksPerMultiprocessor(&per_cu, (const void*)nsa_fwd, NWAVES * 64, LDS_BYTES) != hipSuccess || per_cu < 1) { fprintf(stderr, "kernel_launch: occupancy query says %d\n", per_cu); }
        (void)hipGetLastError();
        grid = cus;
    }
    if (grid < 0) return;
    if (hipMemsetAsync((char*)d_ws + WS_CTL, 0, CTL_ZERO_BYTES, stream) != hipSuccess) return;
    Args a{};
    for (int i = 0; i < 21; ++i) a.in[i] = (const float*)d_in[i];
    a.out = (float*)d_out; a.ws = (unsigned char*)d_ws; a.ph_lo = 0; a.ph_hi = 100;
    hipLaunchKernelGGL(nsa_fwd, dim3(grid), dim3(NWAVES * 64), LDS_BYTES, stream, a);
}
```

```cpp
#include <hip/hip_runtime.h>
#include <cstdio>
#include <cstdint>
namespace pg8 {
#define PG8_LAS __attribute__((address_space(3)))
typedef unsigned short bf16_t;
typedef short bf16x8 __attribute__((ext_vector_type(8)));
typedef float f32x4 __attribute__((ext_vector_type(4)));
typedef unsigned u32x4 __attribute__((ext_vector_type(4)));
constexpr int BM = 256, BK = 64, HALF = 128, HTB = HALF * BK * 2  , STAGE_BYTES = 8 * HTB, NXCD = 8, WGM = 8;

__host__ __device__ __forceinline__ int lds_byte(int r, int c) { const int st = (r >> 4) * 2 + (c >> 5), rr = r & 15, cc = c & 31, ob = rr * 64 + cc * 2; return st * 1024 + (ob ^ (((ob >> 9) & 1) << 5)); }
__host__ __device__ __forceinline__ void stage_rc(int b, int& R, int& C) { const int st = b / 1024, sb = b % 1024, swz = sb ^ (((sb >> 9) & 1) << 5); R = (st >> 1) * 16 + swz / 64; C = (st & 1) * 32 + (swz % 64) / 2; }
__host__ __device__ __forceinline__ int perm32(int rho) { const int n = rho >> 4, i = rho & 15; return 8 * (i >> 2) + 4 * n + (i & 3); }

struct Unit { int pm, pn; };
struct Gemm { const bf16_t* A; const bf16_t* Bt; int M, N, K; };

struct StaticOrder {
    int nM, nN, nwg, G, c;
    __host__ __device__ void init(int M, int N, int G_, int c_) { nM = M / BM; nN = N / BM; nwg = nM * nN; G = G_; c = c_; }
    __host__ __device__ bool next(int i, Unit& u) const {
        const long L = (long)i * G + c; if (L >= nwg) return false;
        int wgid = (int)L; { const int q = nwg / NXCD, r = nwg % NXCD, xcd = wgid % NXCD, off = wgid / NXCD; wgid = (xcd < r ? xcd * (q + 1) : r * (q + 1) + (xcd - r) * q) + off; }
        const int nig = WGM * nN, gid = wgid / nig, fm = gid * WGM, gsz = (nM - fm) < WGM ? (nM - fm) : WGM;
        u.pm = fm + ((wgid % nig) % gsz); u.pn = (wgid % nig) / gsz; return true;
    }
    __device__ __forceinline__ void a_ready(const Unit&) const {}
    __device__ __forceinline__ void done(const Unit&) const {}
};

__device__ __forceinline__ unsigned cvt_pk_bf16(float lo, float hi) { unsigned r; asm volatile("v_cvt_pk_bf16_f32 %0, %1, %2" : "=v"(r) : "v"(lo), "v"(hi)); return r; }
typedef float f32x2 __attribute__((ext_vector_type(2)));
__device__ __forceinline__ f32x2 gelu_pk(f32x2 v) {
    const f32x2 av = __builtin_elementwise_abs(v), d = av * 0.2316418882f + 1.0f;
    f32x2 t; t.x = __builtin_amdgcn_rcpf(d.x); t.y = __builtin_amdgcn_rcpf(d.y);
    f32x2 q = t * 0.5307027145f + (-0.7265760135f); q = q * t + 0.7107068705f; q = q * t + (-0.142248368f); q = q * t + 0.127414796f; q = q * t;
    const f32x2 s = (v * v) * (-0.72134752044f);
    f32x2 e; e.x = __builtin_amdgcn_exp2f(s.x); e.y = __builtin_amdgcn_exp2f(s.y);
    const f32x2 m = v * (q * e), r = v - m;
    f32x2 o; o.x = v.x < 0.f ? m.x : r.x; o.y = v.y < 0.f ? m.y : r.y; return o;
}

template <int ACT  > struct EpiBf16 {
    static constexpr bool PERM = true, AFTER_DRAIN = false; static_assert(ACT == 0 || ACT == 1, "EpiBf16: ACT is 0 (none) or 1 (gelu_pk)");
    bf16_t* O; int ldc; const float* bias; int split_cols; size_t split_stride; float scale0;
    __device__ __forceinline__ void operator()(const f32x4 (&acc)[2][2][4][2], const Unit& u, int wr, int wc, int fr, int fq) const {
        const int row0 = u.pm * BM + wr * 64 + fr; int colt = u.pn * BM; bf16_t* base = O;
        float sc = 1.f; if (split_cols) { const int t = colt / split_cols; base += (size_t)t * split_stride; colt -= t * split_cols; if (t == 0) sc = scale0; }
        const int col0 = colt + wc * 32 + 8 * fq, bcol0 = u.pn * BM + wc * 32 + 8 * fq;
        f32x4 bv[2][2];
#pragma unroll
        for (int bj = 0; bj < 2; ++bj)
#pragma unroll
            for (int n = 0; n < 2; ++n) bv[bj][n] = bias ? *(const f32x4*)(bias + bcol0 + bj * HALF + 4 * n) : (f32x4){0.f, 0.f, 0.f, 0.f};
#pragma unroll
        for (int ai = 0; ai < 2; ++ai)
#pragma unroll
            for (int m = 0; m < 4; ++m) { bf16_t* rowp = base + (size_t)(row0 + ai * HALF + m * 16) * ldc + col0;
#pragma unroll
                for (int bj = 0; bj < 2; ++bj) { f32x4 v0 = acc[ai][bj][m][0] + bv[bj][0], v1 = acc[ai][bj][m][1] + bv[bj][1];
                    if (ACT == 1) { f32x2 a = gelu_pk((f32x2){v0[0], v0[1]}), b = gelu_pk((f32x2){v0[2], v0[3]}), c = gelu_pk((f32x2){v1[0], v1[1]}), d = gelu_pk((f32x2){v1[2], v1[3]});
                        v0 = (f32x4){a.x, a.y, b.x, b.y}; v1 = (f32x4){c.x, c.y, d.x, d.y}; }
                    v0 = v0 * sc; v1 = v1 * sc; u32x4 w; w.x = cvt_pk_bf16(v0[0], v0[1]); w.y = cvt_pk_bf16(v0[2], v0[3]); w.z = cvt_pk_bf16(v1[0], v1[1]); w.w = cvt_pk_bf16(v1[2], v1[3]);
                    *(u32x4*)(rowp + bj * HALF) = w; } }
    }
};

struct PanelStats {
    unsigned* xbuf;
    unsigned* cnt;
    unsigned* tmo;
    int ntn; float eps;
    unsigned code;
    __device__ __forceinline__ bool run(const f32x4 (&v)[2][2][4][2], const Unit& u, int wr, int wc, int fr, int fq, PG8_LAS unsigned char* lds, int wid, int lane) const {
        typedef float f32x2v __attribute__((ext_vector_type(2)));
        PG8_LAS f32x2v* P = (PG8_LAS f32x2v*)lds;
        PG8_LAS f32x2v* S = (PG8_LAS f32x2v*)(lds + 8192);
        PG8_LAS unsigned* flag = (PG8_LAS unsigned*)(lds + 8192 + 2048);
#pragma unroll
        for (int ai = 0; ai < 2; ++ai)
#pragma unroll
            for (int m = 0; m < 4; ++m) {
                float s = 0.f;
#pragma unroll
                for (int bj = 0; bj < 2; ++bj)
#pragma unroll
                    for (int n = 0; n < 2; ++n) { const f32x4 x = v[ai][bj][m][n]; s += (x[0] + x[1]) + (x[2] + x[3]); }
                s += __shfl_xor(s, 16); s += __shfl_xor(s, 32);
                const float mw = s * (1.0f / 64.0f); float q = 0.f;
#pragma unroll
                for (int bj = 0; bj < 2; ++bj)
#pragma unroll
                    for (int n = 0; n < 2; ++n) { const f32x4 d = v[ai][bj][m][n] - mw; q += (d[0] * d[0] + d[1] * d[1]) + (d[2] * d[2] + d[3] * d[3]); }
                q += __shfl_xor(q, 16); q += __shfl_xor(q, 32);
                if (fq == 0) P[(ai * HALF + wr * 64 + m * 16 + fr) * 4 + wc] = (f32x2v){mw, q};
            }
        asm volatile("s_waitcnt lgkmcnt(0)" ::: "memory"); __builtin_amdgcn_s_barrier(); asm volatile("" ::: "memory");
#if defined(BROKEN_EXCHANGE_NO_WAIT)
#warning BROKEN CONTROL BUILD: the row-statistics exchange does not wait; results are wrong by design
        if (blockIdx.x >= 64) { const long long t0_ = clock64(); while (clock64() - t0_ < 60000) __builtin_amdgcn_s_sleep(8); }
#endif
        const int row = wid * 32 + (lane & 31);
        if (lane < 32) {
            const f32x2v a = P[row * 4 + 0], b = P[row * 4 + 1], c = P[row * 4 + 2], d = P[row * 4 + 3];
            const float mt = (a.x + b.x + c.x + d.x) * 0.25f;
            const float da = a.x - mt, db = b.x - mt, dc = c.x - mt, dd = d.x - mt;
            const float m2 = (a.y + b.y) + (c.y + d.y) + 64.0f * ((da * da + db * db) + (dc * dc + dd * dd));
            unsigned long long* slot = (unsigned long long*)xbuf + ((size_t)(u.pm * BM + row) * 4 + u.pn);
            __hip_atomic_store(slot, ((unsigned long long)__float_as_uint(m2) << 32) | __float_as_uint(mt), __ATOMIC_RELAXED, __HIP_MEMORY_SCOPE_AGENT);
        }
        asm volatile("s_waitcnt vmcnt(0)" ::: "memory");
        if (lane == 0) __hip_atomic_fetch_add(cnt + 64 * u.pm, 1u, __ATOMIC_RELAXED, __HIP_MEMORY_SCOPE_AGENT);
        if (wid == 0) {
            bool dead = false; const unsigned long long t0 = __builtin_amdgcn_s_memrealtime(); const unsigned want = 8u * (unsigned)ntn;
            for (;;) {
#if defined(BROKEN_EXCHANGE_NO_WAIT)
                break;
#endif
                if ((unsigned)__builtin_amdgcn_readfirstlane(__hip_atomic_load(cnt + 64 * u.pm, __ATOMIC_RELAXED, __HIP_MEMORY_SCOPE_AGENT)) >= want) break;
                if (__builtin_amdgcn_s_memrealtime() - t0 > 2000000ull) {
                    if (lane == 0) { unsigned expect = 0u; __hip_atomic_compare_exchange_strong(tmo + 1, &expect, code | (unsigned)(u.pm & 0xff), __ATOMIC_RELAXED, __ATOMIC_RELAXED, __HIP_MEMORY_SCOPE_AGENT);
                                     __hip_atomic_store(tmo, 1u, __ATOMIC_RELAXED, __HIP_MEMORY_SCOPE_AGENT); }
                    dead = true; break; }
                __builtin_amdgcn_s_sleep(2);
            }
            __builtin_amdgcn_fence(__ATOMIC_ACQUIRE, "agent");
            if (lane == 0) flag[0] = dead ? 1u : 0u;
        }
        asm volatile("s_waitcnt vmcnt(0) lgkmcnt(0)" ::: "memory"); __builtin_amdgcn_s_barrier(); asm volatile("" ::: "memory");
        const bool bad = flag[0] != 0u;
        if (lane < 32) {
            const unsigned long long* slot = (const unsigned long long*)xbuf + (size_t)(u.pm * BM + row) * 4; float mt[4], m2[4]; float ms = 0.f;
#pragma unroll
            for (int t = 0; t < 4; ++t) { if (t < ntn) { const unsigned long long w = __hip_atomic_load(slot + t, __ATOMIC_RELAXED, __HIP_MEMORY_SCOPE_AGENT); mt[t] = __uint_as_float((unsigned)w); m2[t] = __uint_as_float((unsigned)(w >> 32)); } else { mt[t] = 0.f; m2[t] = 0.f; } ms += mt[t]; }
            const float mean = ms / (float)ntn; float q = 0.f;
#pragma unroll
            for (int t = 0; t < 4; ++t) if (t < ntn) { const float dm = mt[t] - mean; q += m2[t] + 256.0f * dm * dm; }
            S[row] = (f32x2v){mean, 1.0f / sqrtf(q / (256.0f * (float)ntn) + eps)};
        }
        asm volatile("s_waitcnt lgkmcnt(0)" ::: "memory"); __builtin_amdgcn_s_barrier(); asm volatile("" ::: "memory");
        return bad;
    }
};
struct EpiLnRes {
    static constexpr bool PERM = false, AFTER_DRAIN = true;
    const float* base; float* out; int ldc; const float* bias; PanelStats st; unsigned poison;
    __device__ __forceinline__ void fused(f32x4 (&acc)[2][2][4][2], const Unit& u, int wr, int wc, int fr, int fq, PG8_LAS unsigned char* lds, int wid, int lane) const {
        typedef float f32x2v __attribute__((ext_vector_type(2)));
        const PG8_LAS f32x2v* S = (const PG8_LAS f32x2v*)(lds + 8192);
        const int col0 = u.pn * BM + wc * 32 + 4 * fq;
#pragma unroll
        for (int bj = 0; bj < 2; ++bj)
#pragma unroll
            for (int n = 0; n < 2; ++n) { const f32x4 bv = bias ? *(const f32x4*)(bias + col0 + bj * HALF + n * 16) : (f32x4){0.f, 0.f, 0.f, 0.f};
#pragma unroll
                for (int ai = 0; ai < 2; ++ai)
#pragma unroll
                    for (int m = 0; m < 4; ++m) acc[ai][bj][m][n] += bv; }
        f32x4 pre[4][2][2];
#pragma unroll
        for (int m = 0; m < 4; ++m) { const size_t off = (size_t)(u.pm * BM + wr * 64 + m * 16 + fr) * ldc + col0;
#pragma unroll
            for (int bj = 0; bj < 2; ++bj)
#pragma unroll
                for (int n = 0; n < 2; ++n) pre[m][bj][n] = *(const f32x4*)(base + off + bj * HALF + n * 16); }
        const bool bad = st.run(acc, u, wr, wc, fr, fq, lds, wid, lane) || poison != 0u;
        const float qnan = __builtin_nanf("");
#pragma unroll
        for (int ai = 0; ai < 2; ++ai)
#pragma unroll
            for (int m = 0; m < 4; ++m) { const int r = ai * HALF + wr * 64 + m * 16 + fr; const f32x2v sr = S[r]; const size_t off = (size_t)(u.pm * BM + r) * ldc + col0;
#pragma unroll
                for (int bj = 0; bj < 2; ++bj)
#pragma unroll
                    for (int n = 0; n < 2; ++n) { const f32x4 bs = ai == 0 ? pre[m][bj][n] : *(const f32x4*)(base + off + bj * HALF + n * 16); f32x4 o = bs + (acc[ai][bj][m][n] - sr.x) * sr.y;
                        if (bad) o = (f32x4){qnan, qnan, qnan, qnan}; *(f32x4*)(out + off + bj * HALF + n * 16) = o; }
                if (m & 1) asm volatile("" ::: "memory"); }
    }
};
struct EpiLnResLn {
    static constexpr bool PERM = false, AFTER_DRAIN = true;
    const float* base; float* out; bf16_t* xn; int ldc; const float* bias; PanelStats st1, st2; unsigned poison;
    __device__ __forceinline__ void fused(f32x4 (&acc)[2][2][4][2], const Unit& u, int wr, int wc, int fr, int fq, PG8_LAS unsigned char* lds, int wid, int lane) const {
        typedef float f32x2v __attribute__((ext_vector_type(2))); typedef unsigned u32x2v __attribute__((ext_vector_type(2)));
        const PG8_LAS f32x2v* S = (const PG8_LAS f32x2v*)(lds + 8192);
        const int col0 = u.pn * BM + wc * 32 + 4 * fq;
#pragma unroll
        for (int bj = 0; bj < 2; ++bj)
#pragma unroll
            for (int n = 0; n < 2; ++n) { const f32x4 bv = bias ? *(const f32x4*)(bias + col0 + bj * HALF + n * 16) : (f32x4){0.f, 0.f, 0.f, 0.f};
#pragma unroll
                for (int ai = 0; ai < 2; ++ai)
#pragma unroll
                    for (int m = 0; m < 4; ++m) acc[ai][bj][m][n] += bv; }
        bool bad = st1.run(acc, u, wr, wc, fr, fq, lds, wid, lane) || poison != 0u;
        const float qnan = __builtin_nanf("");
#pragma unroll
        for (int ai = 0; ai < 2; ++ai)
#pragma unroll
            for (int m = 0; m < 4; ++m) { const int r = ai * HALF + wr * 64 + m * 16 + fr; const f32x2v sr = S[r]; const size_t off = (size_t)(u.pm * BM + r) * ldc + col0;
#pragma unroll
                for (int bj = 0; bj < 2; ++bj)
#pragma unroll
                    for (int n = 0; n < 2; ++n) { const f32x4 bs = *(const f32x4*)(base + off + bj * HALF + n * 16); acc[ai][bj][m][n] = bs + (acc[ai][bj][m][n] - sr.x) * sr.y; }
                asm volatile("" : "+v"(acc[ai][0][m][0]), "+v"(acc[ai][0][m][1]), "+v"(acc[ai][1][m][0]), "+v"(acc[ai][1][m][1]));
                if (m & 1) asm volatile("" ::: "memory"); }
        const bool bad1 = bad;
        bad = st2.run(acc, u, wr, wc, fr, fq, lds, wid, lane) || bad;
#pragma unroll
        for (int ai = 0; ai < 2; ++ai)
#pragma unroll
            for (int m = 0; m < 4; ++m) { const int r = ai * HALF + wr * 64 + m * 16 + fr; const f32x2v sr = S[r]; const size_t off = (size_t)(u.pm * BM + r) * ldc + col0;
#pragma unroll
                for (int bj = 0; bj < 2; ++bj)
#pragma unroll
                    for (int n = 0; n < 2; ++n) { const f32x4 x1 = acc[ai][bj][m][n]; *(f32x4*)(out + off + bj * HALF + n * 16) = bad1 ? (f32x4){qnan, qnan, qnan, qnan} : x1;
                        const f32x4 o = (x1 - sr.x) * sr.y; u32x2v w; w.x = cvt_pk_bf16(o[0], o[1]); w.y = cvt_pk_bf16(o[2], o[3]);
                        if (bad) { w.x = 0x7fc07fc0u; w.y = 0x7fc07fc0u; } *(u32x2v*)(xn + off + bj * HALF + n * 16) = w; }
                asm volatile("" ::: "memory"); }
    }
};

template <class Epi, class Sched, bool ALIGN_EPI = false, bool SP2 = false>
__device__ __forceinline__ void gemm_phase(PG8_LAS unsigned char* lds, const Gemm g, const Sched& S, const Epi& E) {
    const int tid = threadIdx.x, wid = __builtin_amdgcn_readfirstlane(tid >> 6), lane = tid & 63, wr = wid >> 2, wc = wid & 3, fr = lane & 15, fq = lane >> 4;
    const int K = g.K, nt = K / BK;
    unsigned voffA[2], voffB[2];
#pragma unroll
    for (int i = 0; i < 2; ++i) { int R, C; stage_rc(tid * 16 + i * 8192, R, C); const int Rb = Epi::PERM ? ((R & ~31) + perm32(R & 31)) : R;
        voffA[i] = (unsigned)(R * K + C) * 2u; voffB[i] = (unsigned)(Rb * K + C) * 2u; }
    const size_t kstep = (size_t)(BK * 2);
    const size_t hstep = (size_t)HALF * K * 2;
    const size_t tstep = 2 * hstep;
    const unsigned ldsw = (unsigned)wid * 1024u;
    const int aoff = lds_byte(wr * 64 + fr, fq * 8), boff = lds_byte(wc * 32 + fr, fq * 8);
#define PG8_SA(b, h) (((b) * 2 + (h)) * HTB)
#define PG8_SB(b, h) ((4 + (b) * 2 + (h)) * HTB)
#define PG8_STAGE(bufoff, gbase, voff) do { _Pragma("unroll") for (int _i = 0; _i < 2; ++_i) \
        __builtin_amdgcn_global_load_lds((const unsigned*)((const char*)(gbase) + (voff)[_i]), (PG8_LAS unsigned*)(lds + (bufoff) + ldsw + _i * 8192), 16, 0, 0); } while (0)
#define PG8_LDA(dst, b, h) do { _Pragma("unroll") for (int m = 0; m < 4; ++m) _Pragma("unroll") for (int k = 0; k < 2; ++k) dst[m][k] = *(const PG8_LAS bf16x8*)(lds + PG8_SA(b, h) + aoff + m * 2048 + k * 1024); } while (0)
#define PG8_LDB(dst, b, h) do { _Pragma("unroll") for (int n = 0; n < 2; ++n) _Pragma("unroll") for (int k = 0; k < 2; ++k) dst[n][k] = *(const PG8_LAS bf16x8*)(lds + PG8_SB(b, h) + boff + n * 2048 + k * 1024); } while (0)
#define PG8_MMA(ai, bj, At, Bt) do { __builtin_amdgcn_s_setprio(1); _Pragma("unroll") for (int m = 0; m < 4; ++m) _Pragma("unroll") for (int n = 0; n < 2; ++n) _Pragma("unroll") for (int k = 0; k < 2; ++k) \
        acc[ai][bj][m][n] = __builtin_amdgcn_mfma_f32_16x16x32_bf16(Bt[n][k], At[m][k], acc[ai][bj][m][n], 0, 0, 0); __builtin_amdgcn_s_setprio(0); } while (0)
#define PG8_WAIT_V(n) asm volatile("s_waitcnt vmcnt(" #n ")" ::: "memory")
#define PG8_WAIT_L(n) asm volatile("s_waitcnt lgkmcnt(" #n ")" ::: "memory")
#define PG8_BAR __builtin_amdgcn_s_barrier()
#define PG8_SCHED __builtin_amdgcn_sched_barrier(0)
    Unit cur, nxt; int ui = 0;
    if (!S.next(0, cur)) return;
    f32x4 acc[2][2][4][2];
#pragma unroll
    for (int a = 0; a < 2; ++a)
#pragma unroll
        for (int b = 0; b < 2; ++b)
#pragma unroll
            for (int m = 0; m < 4; ++m)
#pragma unroll
                for (int n = 0; n < 2; ++n) acc[a][b][m][n] = (f32x4){0.f, 0.f, 0.f, 0.f};
    bf16x8 At[4][2], B0[2][2], B1[2][2];
    const char* cA = (const char*)g.A + (size_t)cur.pm * tstep; const char* cB = (const char*)g.Bt + (size_t)cur.pn * tstep;
    S.a_ready(cur);
    if constexpr (SP2) {
        PG8_STAGE(PG8_SB(0, 0), cB, voffB); PG8_STAGE(PG8_SB(0, 1), cB + hstep, voffB); PG8_STAGE(PG8_SA(0, 0), cA, voffA); PG8_STAGE(PG8_SA(0, 1), cA + hstep, voffA);
        if (wr == 1) PG8_BAR;
        PG8_WAIT_V(2); PG8_BAR;
        PG8_STAGE(PG8_SB(1, 0), cB + kstep, voffB); PG8_STAGE(PG8_SA(1, 0), cA + kstep, voffA); PG8_STAGE(PG8_SB(1, 1), cB + hstep + kstep, voffB);
        PG8_WAIT_V(6); PG8_BAR;
    } else {
        PG8_STAGE(PG8_SB(0, 0), cB, voffB); PG8_STAGE(PG8_SA(0, 0), cA, voffA); PG8_STAGE(PG8_SB(0, 1), cB + hstep, voffB); PG8_STAGE(PG8_SA(0, 1), cA + hstep, voffA);
        if (wr == 1) PG8_BAR;
        PG8_WAIT_V(4); PG8_BAR;
        PG8_STAGE(PG8_SB(1, 0), cB + kstep, voffB); PG8_STAGE(PG8_SA(1, 0), cA + kstep, voffA); PG8_STAGE(PG8_SB(1, 1), cB + hstep + kstep, voffB);
        PG8_WAIT_V(6); PG8_BAR;
    }
    for (;;) {
        const bool has_next = S.next(ui + 1, nxt);
        const char* nA = has_next ? (const char*)g.A + (size_t)nxt.pm * tstep : cA; const char* nB = has_next ? (const char*)g.Bt + (size_t)nxt.pn * tstep : cB;
        for (int t = 0; t < nt; t += 2) {
            const bool last = (t == nt - 2);
            const char* a1 = cA + (size_t)(t + 1) * kstep;
            const char* a2 = last ? nA : cA + (size_t)(t + 2) * kstep; const char* b2 = last ? nB : cB + (size_t)(t + 2) * kstep;
            const char* a3 = a2 + kstep; const char* b3 = b2 + kstep;
            if (last && has_next) S.a_ready(nxt);
            if constexpr (SP2) {
            PG8_LDB(B0, 0, 0); PG8_LDB(B1, 0, 1); PG8_SCHED; PG8_LDA(At, 0, 0); PG8_STAGE(PG8_SA(1, 1), a1 + hstep, voffA);
            PG8_WAIT_V(8); PG8_WAIT_L(0); PG8_BAR; PG8_MMA(0, 0, At, B0); PG8_MMA(0, 1, At, B1); PG8_BAR; PG8_SCHED;
            PG8_LDA(At, 0, 1); PG8_STAGE(PG8_SB(0, 0), b2, voffB); PG8_STAGE(PG8_SB(0, 1), b2 + hstep, voffB); PG8_STAGE(PG8_SA(0, 0), a2, voffA);
            PG8_WAIT_V(8); PG8_WAIT_L(0); PG8_BAR; PG8_MMA(1, 0, At, B0); PG8_MMA(1, 1, At, B1); PG8_BAR; PG8_SCHED;
            PG8_LDB(B0, 1, 0); PG8_LDB(B1, 1, 1); PG8_SCHED; PG8_LDA(At, 1, 0); PG8_STAGE(PG8_SA(0, 1), a2 + hstep, voffA);
            PG8_WAIT_V(8); PG8_WAIT_L(0); PG8_BAR; PG8_MMA(0, 0, At, B0); PG8_MMA(0, 1, At, B1); PG8_BAR; PG8_SCHED;
            PG8_LDA(At, 1, 1); PG8_STAGE(PG8_SB(1, 0), b3, voffB); PG8_STAGE(PG8_SB(1, 1), b3 + hstep, voffB); PG8_STAGE(PG8_SA(1, 0), a3, voffA);
            PG8_WAIT_V(8); PG8_WAIT_L(0); PG8_BAR; PG8_MMA(1, 0, At, B0); PG8_MMA(1, 1, At, B1); PG8_BAR; PG8_SCHED;
            } else {
            PG8_LDB(B0, 0, 0); PG8_SCHED; PG8_LDA(At, 0, 0); PG8_STAGE(PG8_SA(1, 1), a1 + hstep, voffA);
            PG8_WAIT_L(8); PG8_BAR; PG8_WAIT_L(0); PG8_MMA(0, 0, At, B0); PG8_BAR; PG8_SCHED;
            PG8_LDB(B1, 0, 1); PG8_STAGE(PG8_SB(0, 0), b2, voffB);
            PG8_BAR; PG8_WAIT_L(0); PG8_MMA(0, 1, At, B1); PG8_BAR;
            PG8_LDA(At, 0, 1); PG8_STAGE(PG8_SA(0, 0), a2, voffA);
            PG8_BAR; PG8_WAIT_L(0); PG8_MMA(1, 0, At, B0); PG8_BAR; PG8_SCHED;
            PG8_STAGE(PG8_SB(0, 1), b2 + hstep, voffB);
            PG8_WAIT_V(6); PG8_BAR; PG8_MMA(1, 1, At, B1); PG8_BAR;
            PG8_LDB(B0, 1, 0); PG8_SCHED; PG8_LDA(At, 1, 0); PG8_STAGE(PG8_SA(0, 1), a2 + hstep, voffA);
            PG8_WAIT_L(8); PG8_BAR; PG8_WAIT_L(0); PG8_MMA(0, 0, At, B0); PG8_BAR; PG8_SCHED;
            PG8_LDB(B1, 1, 1); PG8_STAGE(PG8_SB(1, 0), b3, voffB);
            PG8_BAR; PG8_WAIT_L(0); PG8_MMA(0, 1, At, B1); PG8_BAR;
            PG8_LDA(At, 1, 1); PG8_STAGE(PG8_SA(1, 0), a3, voffA);
            PG8_BAR; PG8_WAIT_L(0); PG8_MMA(1, 0, At, B0); PG8_BAR; PG8_SCHED;
            PG8_STAGE(PG8_SB(1, 1), b3 + hstep, voffB);
            PG8_WAIT_V(6); PG8_BAR; PG8_MMA(1, 1, At, B1); PG8_BAR;
            }
        }
        if constexpr (ALIGN_EPI) { if (wr == 0) PG8_BAR; }
        if constexpr (!Epi::AFTER_DRAIN) { E(acc, cur, wr, wc, fr, fq); S.done(cur); }
        if (!has_next) break;
#pragma unroll
        for (int a = 0; a < 2; ++a)
#pragma unroll
            for (int b = 0; b < 2; ++b)
#pragma unroll
                for (int m = 0; m < 4; ++m)
#pragma unroll
                    for (int n = 0; n < 2; ++n) acc[a][b][m][n] = (f32x4){0.f, 0.f, 0.f, 0.f};
        cur = nxt; cA = nA; cB = nB; ++ui;
        if constexpr (ALIGN_EPI) { if (wr == 1) PG8_BAR; }
    }
    PG8_WAIT_V(0);
    if constexpr (!ALIGN_EPI) { if (wr == 0) PG8_BAR; }
    PG8_BAR;
    if constexpr (Epi::AFTER_DRAIN) { E.fused(acc, cur, wr, wc, fr, fq, lds, wid, lane); S.done(cur); }
#undef PG8_SA
#undef PG8_SB
#undef PG8_STAGE
#undef PG8_LDA
#undef PG8_LDB
#undef PG8_MMA
#undef PG8_WAIT_V
#undef PG8_WAIT_L
#undef PG8_BAR
#undef PG8_SCHED
}
}
#define GAS __attribute__((address_space(1)))
#define LAS __attribute__((address_space(3)))
typedef unsigned short bf16;
typedef unsigned v4u __attribute__((ext_vector_type(4)));
typedef float f32x4 __attribute__((ext_vector_type(4)));
typedef short bf16x8 __attribute__((ext_vector_type(8)));
typedef GAS unsigned gu32;
typedef GAS unsigned long long gu64;
#define RLX_AGENT __ATOMIC_RELAXED, __HIP_MEMORY_SCOPE_AGENT
#define LDS_WAIT() asm volatile("s_waitcnt lgkmcnt(0)" ::: "memory")
#define VM_WAIT() asm volatile("s_waitcnt vmcnt(0)" ::: "memory")
__device__ __forceinline__ unsigned long long rt() { return __builtin_amdgcn_s_memrealtime(); }
__device__ __forceinline__ unsigned f2bf(float f) { unsigned u = __builtin_bit_cast(unsigned, f); return (u + 0x7fffu + ((u >> 16) & 1u)) >> 16; }
__device__ __forceinline__ unsigned pk2(float lo, float hi) { return f2bf(lo) | (f2bf(hi) << 16); }

#define XB_TMO      128
#define XB_XCNT(j)  (256  + 64 * (j))
#define XB_XSUB(j)  (1280 + 64 * (j))
#define XB_XGEN(j)  (2304 + 64 * (j))
#define XB_TOP      3328
#define XB_TOPGEN   3392
#define XCD_BAR_WORDS 3456
#define XB_SPIN_CAP (1u << 18)

__device__ __forceinline__ unsigned xb_ld(unsigned* p)              { return __hip_atomic_load(p, __ATOMIC_RELAXED, __HIP_MEMORY_SCOPE_AGENT); }
__device__ __forceinline__ unsigned xb_add(unsigned* p, unsigned v) { return __hip_atomic_fetch_add(p, v, __ATOMIC_RELAXED, __HIP_MEMORY_SCOPE_AGENT); }
__device__ __forceinline__ unsigned xb_xcc_id() { return (unsigned)__builtin_amdgcn_s_getreg((3 << 11) | 20) & 0xFu; }
#define XB_SPIN(cond, bar) do { unsigned _sp = 0; while (cond) { __builtin_amdgcn_s_sleep(1); \
    if ((++_sp & 255u) == 0u) { if (xb_ld(&(bar)[XB_TMO])) break; if (_sp > XB_SPIN_CAP) { atomicAdd(&(bar)[XB_TMO], 1u); break; } } } } while (0)

struct XcdBarrier {
    unsigned* bar; unsigned x;
    volatile LAS unsigned* st;
};

__device__ __forceinline__ XcdBarrier xcd_barrier_post(unsigned* bar, volatile LAS unsigned* st) {
    XcdBarrier b; b.bar = bar; b.x = xb_xcc_id(); b.st = st;
    if (threadIdx.x == 0) (void)xb_add(&bar[XB_XCNT(b.x)], 1u);
    return b;
}
__device__ __forceinline__ void xcd_barrier_complete(unsigned* bar, unsigned x, unsigned& nloc, unsigned& nx) {
    const unsigned G = gridDim.x * gridDim.y * gridDim.z;
    unsigned sum, cnt, mine, sp = 0u;
    for (;;) {
        sum = 0u; cnt = 0u; mine = 0u;
#pragma unroll
        for (unsigned j = 0; j < 16; ++j) { const unsigned c = xb_ld(&bar[XB_XCNT(j)]); sum += c; cnt += (c > 0u) ? 1u : 0u; mine = (j == x) ? c : mine; }
        if (sum == G) break;
        __builtin_amdgcn_s_sleep(1);
        if ((++sp & 255u) == 0u) { if (xb_ld(&bar[XB_TMO])) break; if (sp > XB_SPIN_CAP) { atomicAdd(&bar[XB_TMO], 1u); break; } }
    }
    nloc = mine > 0u ? mine : 1u; nx = cnt > 0u ? cnt : 1u;
}

__device__ __forceinline__ void xcd_barrier(const XcdBarrier& b) {
    asm volatile("s_waitcnt vmcnt(0)" ::: "memory");
    __syncthreads();
    if (threadIdx.x == 0) {
        unsigned* bar = b.bar;
        __builtin_amdgcn_s_waitcnt(0);
        unsigned nloc = b.st[0], nx = b.st[1];
        if (nloc == 0u) { xcd_barrier_complete(bar, b.x, nloc, nx); b.st[0] = nloc; b.st[1] = nx; }
        const unsigned old = xb_add(&bar[XB_XSUB(b.x)], 1u);
        const unsigned gen = old / nloc;
        if (old + 1u == (gen + 1u) * nloc) {
            __builtin_amdgcn_fence(__ATOMIC_RELEASE, "agent");
            asm volatile("s_waitcnt vmcnt(0)" ::: "memory");
            const unsigned og = xb_add(&bar[XB_TOP], 1u);
            const unsigned tg = og / nx;
            if (og + 1u == (tg + 1u) * nx) xb_add(&bar[XB_TOPGEN], 1u);
            else XB_SPIN(xb_ld(&bar[XB_TOPGEN]) == tg, bar);
            __builtin_amdgcn_fence(__ATOMIC_ACQUIRE, "agent");
            xb_add(&bar[XB_XGEN(b.x)], 1u);
            asm volatile("s_waitcnt vmcnt(0)" ::: "memory");
        } else {
            XB_SPIN(xb_ld(&bar[XB_XGEN(b.x)]) == gen, bar);
            __builtin_amdgcn_fence(__ATOMIC_ACQUIRE, "agent");
            asm volatile("s_waitcnt vmcnt(0)" ::: "memory");
        }
    }
    __syncthreads();
}
constexpr int NWAVES = 8;
constexpr int T = 8192, NBATCH = 2, MP = NBATCH * T, MS = 32, MALL = 16640, D = 1024, NIN = 6656, FF = 4096;
constexpr int C_QA = 0, C_KVC = 512, C_KVS = 768, C_KVW = 1024, C_QB = 1280, C_FB = 2304, C_IB = 3328, C_GB = 3840, C_MG = 4352, C_GLA = 6400;
constexpr int PAST = 16384, NPAGES = 128, NCMP_S = 1023, NCMP_P = 511;
constexpr float LN_EPS = 1e-5f;
constexpr float DN_ALPHA = 1.189207115002721f;
constexpr size_t OFF0 = 0, OFF1 = OFF0 + (size_t)MP * D, OFF2 = OFF1 + (size_t)MS * D, OFF3 = OFF2 + (size_t)MP * 256, OFF4 = OFF3 + (size_t)MP * 256,
                 OFF5 = OFF4 + (size_t)NBATCH * 512 * 256, OFF6 = OFF5 + (size_t)NBATCH * 8 * 128 * 64, OFF7 = OFF6 + (size_t)MS * 256, OFF8 = OFF7 + (size_t)MS * 256,
                 OFF9 = OFF8 + (size_t)MS * 512 * 256, OUT_TOTAL = OFF9 + (size_t)MS * 8 * 128 * 64;
constexpr size_t MiB = 1u << 20;
constexpr size_t al(size_t x) { return (x + MiB - 1) / MiB * MiB; }
constexpr size_t WS_CTL = 0, CTL_ZERO_BYTES = 1 * MiB;
constexpr size_t WS_WIN = 2 * MiB;
constexpr size_t WS_WA = WS_WIN + al((size_t)NIN * D * 2);
constexpr size_t WS_WB = WS_WA + al((size_t)D * 512 * 2);
constexpr size_t WS_WO = WS_WB + al((size_t)D * 512 * 2);
constexpr size_t WS_WUP = WS_WO + al((size_t)D * D * 2);
constexpr size_t WS_WDN = WS_WUP + al((size_t)FF * D * 2);
constexpr size_t WS_WC = WS_WDN + al((size_t)FF * D * 2);
constexpr size_t WS_SMALL = WS_WC + al((size_t)2 * 64 * 2048 * 2);
constexpr size_t WS_XB = WS_SMALL + MiB;
constexpr size_t WS_HB = WS_XB + al((size_t)MALL * D * 2);
constexpr size_t WS_KCP = WS_HB + al((size_t)MALL * NIN * 2);
constexpr size_t WS_VCTP = WS_KCP + MiB;
constexpr size_t WS_KCVS = WS_VCTP + MiB;
constexpr size_t WS_VST = WS_KCVS + al((size_t)MS * 1024 * 256 * 4);
constexpr size_t WS_VWT = WS_VST + al((size_t)4 * 64 * T * 2);
constexpr size_t WS_OA = WS_VWT + al((size_t)4 * 64 * T * 2);
constexpr size_t WS_OB = WS_OA + al((size_t)MALL * 512 * 2);
constexpr size_t WS_HGL = WS_OB + al((size_t)MALL * 512 * 2);
constexpr size_t WS_HGD = WS_HGL + al((size_t)16 * 16 * 8192 * 4);
constexpr size_t WS_TB = WS_HGD + MiB;
constexpr size_t WS_MG = WS_TB + al((size_t)MALL * D * 4);
constexpr size_t WS_Z1 = WS_MG + al((size_t)MALL * D * 2);
constexpr size_t WS_X1F = WS_Z1 + al((size_t)MALL * D * 4);
constexpr size_t WS_X1B = WS_X1F + al((size_t)MALL * D * 4);
constexpr size_t WS_UB = WS_X1B + al((size_t)MALL * D * 2);
constexpr size_t WS_Z2 = WS_UB + al((size_t)MALL * FF * 2);
constexpr size_t WS_KSC = WS_Z2 + al((size_t)MALL * D * 4);
constexpr size_t WS_KWC = WS_KSC + al((size_t)4 * T * 64 * 2);
constexpr size_t WS_OTS = WS_KWC + al((size_t)4 * T * 64 * 2);
constexpr size_t WS_END = WS_OTS + al((size_t)256 * 32 * 512 * 4);
constexpr int CW_TMO = 0, CW_CODE = 1, CW_BAR = 4096;
constexpr int RING_OFF = 0, RING_BYTES = 131072;
constexpr int LDSCTL_OFF = RING_BYTES, MISC_OFF = LDSCTL_OFF + 320;
constexpr int LDS_BYTES = 147456;

namespace pg8 {
struct EpiInProj {
    static constexpr bool PERM = true, AFTER_DRAIN = false;
    bf16_t* HB; float* out;
    __device__ __forceinline__ void operator()(const f32x4 (&acc)[2][2][4][2], const Unit& u, int wr, int wc, int fr, int fq) const {
        const int row0 = u.pm * BM + wr * 64 + fr, cc0 = wc * 32 + 8 * fq, col0 = u.pn * BM + cc0;
#pragma unroll
        for (int ai = 0; ai < 2; ++ai)
#pragma unroll
            for (int m = 0; m < 4; ++m) {
                const int r = row0 + ai * HALF + m * 16;
                bf16_t* rowp = HB + (size_t)r * NIN + col0;
                float* fdst = nullptr;
                if (u.pn == 2) { if (r < MP) fdst = out + OFF2 + (size_t)r * 256; else if (r < MP + MS) fdst = out + OFF6 + (size_t)(r - MP) * 256; }
                else if (u.pn == 3) { if (r < MP) fdst = out + OFF3 + (size_t)r * 256; else if (r < MP + MS) fdst = out + OFF7 + (size_t)(r - MP) * 256; }
                else if (u.pn == 4) { if (r < MP) { const int t = r & (T - 1), b = r >> 13; if (t >= T - 512) fdst = out + OFF4 + (size_t)(b * 512 + t - (T - 512)) * 256; }
                                      else if (r < MP + MS) fdst = out + OFF8 + ((size_t)(r - MP) * 512 + 511) * 256; }
#pragma unroll
                for (int bj = 0; bj < 2; ++bj) { const f32x4 v0 = acc[ai][bj][m][0], v1 = acc[ai][bj][m][1];
                    u32x4 w; w.x = cvt_pk_bf16(v0[0], v0[1]); w.y = cvt_pk_bf16(v0[2], v0[3]); w.z = cvt_pk_bf16(v1[0], v1[1]); w.w = cvt_pk_bf16(v1[2], v1[3]);
                    *(u32x4*)(rowp + bj * HALF) = w;
                    if (fdst) { *(f32x4*)(fdst + cc0 + bj * HALF) = v0; *(f32x4*)(fdst + cc0 + bj * HALF + 4) = v1; } }
            }
    }
};
}

struct Frame {
    LAS unsigned char* lds;
    volatile LAS unsigned* MISC;
    gu32* ctl;
    int tid, lane, wave;
    int vcu, G;
    const float* in[21]; float* out; unsigned char* ws;
};
__device__ __forceinline__ float bf2f(unsigned short b) { return __uint_as_float(((unsigned)b) << 16); }
typedef float f32x2_t __attribute__((ext_vector_type(2))); typedef __bf16 bf16x2_t __attribute__((ext_vector_type(2)));
__device__ __forceinline__ unsigned cvtpk(float lo, float hi) { f32x2_t v = {lo, hi}; bf16x2_t b = __builtin_convertvector(v, bf16x2_t); return __builtin_bit_cast(unsigned, b); }
__device__ __forceinline__ float wave_sum(float v) {
#pragma unroll
    for (int o = 1; o < 64; o <<= 1) v += __shfl_xor(v, o);
    return v;
}
__device__ __forceinline__ float sigmoidf_(float x) { return 1.0f / (1.0f + __expf(-x)); }

__device__ __forceinline__ void p0_transpose_item(const float* W, int K, int Nsrc, bf16* WT, int k0, int n0, int s0, int nvalid, LAS float* scr, int lane) {
#pragma unroll 8
    for (int i = 0; i < 32; ++i) { const int kk = 2 * i + (lane >> 5), c = lane & 31; scr[kk * 33 + c] = (c < nvalid) ? W[(size_t)(k0 + kk) * Nsrc + s0 + c] : 0.f; }
    LDS_WAIT(); asm volatile("" ::: "memory");
    const int c = lane & 7;
#pragma unroll
    for (int j = 0; j < 4; ++j) { const int n = (lane >> 3) + 8 * j; const LAS float* s = scr + (8 * c) * 33 + n;
        v4u o; o.x = pk2(s[0 * 33], s[1 * 33]); o.y = pk2(s[2 * 33], s[3 * 33]); o.z = pk2(s[4 * 33], s[5 * 33]); o.w = pk2(s[6 * 33], s[7 * 33]);
        *(GAS v4u*)(WT + (size_t)(n0 + n) * K + k0 + 8 * c) = o; }
    LDS_WAIT(); asm volatile("" ::: "memory");
}
__device__ __forceinline__ void p0_prologue(Frame& F) {
    LAS float* scr = (LAS float*)(F.lds + RING_OFF + F.wave * 16384);
    const int gw = F.vcu * NWAVES + F.wave, NGW = F.G * NWAVES, lane = F.lane;
    bf16* WinT = (bf16*)(F.ws + WS_WIN); bf16* WaT = (bf16*)(F.ws + WS_WA); bf16* WbT = (bf16*)(F.ws + WS_WB); bf16* WoT = (bf16*)(F.ws + WS_WO);
    bf16* WupT = (bf16*)(F.ws + WS_WUP); bf16* WdnT = (bf16*)(F.ws + WS_WDN); bf16* WcT = (bf16*)(F.ws + WS_WC);
    float* small = (float*)(F.ws + WS_SMALL);
    constexpr int I_IN = (D / 64) * (NIN / 32), I_A = (512 / 64) * (D / 32), I_O = (D / 64) * (D / 32), I_UP = (D / 64) * (FF / 32), I_DN = (FF / 64) * (D / 32), I_C = 2 * (2048 / 64) * 2;
    constexpr int I_T = I_IN + 2 * I_A + I_O + I_UP + I_DN + I_C;
    constexpr int I_X = MALL;
    constexpr int I_CB = 64;
    constexpr int I_LB = 16;
    constexpr int I_W8 = 0;
    constexpr int I_Z = 2 * (MALL - MP - MS);
    constexpr int NITEMS = I_T + I_X + I_CB + I_LB + I_W8 + I_Z;
    for (int it = gw; it < NITEMS; it += NGW) {
        int r = it;
        if (r < I_T) {
            if (r < I_IN) { const int nblk = NIN / 32, kb = r / nblk, nb = r % nblk, n0 = 32 * nb; int s0, nv;
                if (n0 < 1280) { s0 = n0; nv = 32; } else if (n0 < 6400) { s0 = n0 + 24; nv = 32; } else if (n0 == 6400) { s0 = 1280; nv = 24; } else { s0 = 0; nv = 0; }
                p0_transpose_item(F.in[7], D, 6424, WinT, 64 * kb, n0, s0, nv, scr, lane); continue; } r -= I_IN;
            if (r < I_A) { const int nblk = D / 32, kb = r / nblk, nb = r % nblk; p0_transpose_item(F.in[12], 512, D, WaT, 64 * kb, 32 * nb, 32 * nb, 32, scr, lane); continue; } r -= I_A;
            if (r < I_A) { const int nblk = D / 32, kb = r / nblk, nb = r % nblk; p0_transpose_item(F.in[13], 512, D, WbT, 64 * kb, 32 * nb, 32 * nb, 32, scr, lane); continue; } r -= I_A;
            if (r < I_O) { const int nblk = D / 32, kb = r / nblk, nb = r % nblk; p0_transpose_item(F.in[14], D, D, WoT, 64 * kb, 32 * nb, 32 * nb, 32, scr, lane); continue; } r -= I_O;
            if (r < I_UP) { const int nblk = FF / 32, kb = r / nblk, nb = r % nblk; p0_transpose_item(F.in[17], D, FF, WupT, 64 * kb, 32 * nb, 32 * nb, 32, scr, lane); continue; } r -= I_UP;
            if (r < I_DN) { const int nblk = D / 32, kb = r / nblk, nb = r % nblk; p0_transpose_item(F.in[18], FF, D, WdnT, 64 * kb, 32 * nb, 32 * nb, 32, scr, lane); continue; } r -= I_DN;
            { const int c = r / 64, q = r % 64, kb = q / 2, nb = q % 2;
              p0_transpose_item(F.in[8] + (size_t)c * 2048 * 64, 2048, 64, WcT + (size_t)c * 64 * 2048, 64 * kb, 32 * nb, 32 * nb, 32, scr, lane); continue; }
        }
        r -= I_T;
        if (r < I_X) {
            const float* src = r < MP ? F.in[0] + (size_t)r * D : (r < MP + MS ? F.in[1] + (size_t)(r - MP) * D : nullptr);
            bf16* dst = (bf16*)(F.ws + WS_XB) + (size_t)r * D;
#pragma unroll
            for (int j = 0; j < 4; ++j) { f32x4 v = src ? *((const GAS f32x4*)src + lane + 64 * j) : (f32x4){0.f, 0.f, 0.f, 0.f};
                *((GAS unsigned long long*)dst + lane + 64 * j) = (unsigned long long)pk2(v.x, v.y) | ((unsigned long long)pk2(v.z, v.w) << 32); }
            continue;
        }
        r -= I_X;
        if (r < I_CB) {
            const int c = r >> 5, l = r & 31; const float* pos = F.in[9] + ((size_t)c * 32 + l) * 64; const float* w = F.in[8] + (((size_t)c * 32 + l) * 64) * 64;
            float s = 0.f;
            for (int d = 0; d < 64; ++d) s += pos[d] * w[(size_t)d * 64 + lane];
            small[(c * 32 + l) * 64 + lane] = s; continue;
        }
        r -= I_CB;
        if (r < I_LB) { const int i = r * 64 + lane; const float l0 = F.in[10][i], l1 = F.in[10][1024 + i]; small[4096 + i] = 1.0f / (1.0f + expf(l1 - l0)); continue; }
        r -= I_LB;
        if (r < I_W8) { const int b = r / 511, i = r % 511;
            const GAS f32x4* s = (const GAS f32x4*)(F.in[4] + ((size_t)b * 512 + i + 1) * 256); GAS f32x4* d = (GAS f32x4*)(F.out + OFF8 + ((size_t)b * 512 + i) * 256);
            d[lane] = s[lane]; continue; }
        r -= I_W8;
        { const int half = I_Z / 2, which = r / half, row = MP + MS + r % half; bf16* o = (bf16*)(F.ws + (which ? WS_OB : WS_OA)) + (size_t)row * 512;
          *((GAS v4u*)o + lane) = (v4u){0u, 0u, 0u, 0u}; }
    }
}
typedef float f32x16 __attribute__((ext_vector_type(16)));
typedef short s16x4 __attribute__((ext_vector_type(4)));
typedef unsigned u32x2 __attribute__((ext_vector_type(2)));
#define MFMA32(a, b, c) __builtin_amdgcn_mfma_f32_32x32x16_bf16((a), (b), (c), 0, 0, 0)
__device__ __forceinline__ int crow(int reg, int h) { return (reg & 3) + 8 * (reg >> 2) + 4 * h; }
__device__ __forceinline__ bf16x8 pack8(f32x4 a, f32x4 b) { v4u p; p.x = cvtpk(a.x, a.y); p.y = cvtpk(a.z, a.w); p.z = cvtpk(b.x, b.y); p.w = cvtpk(b.z, b.w); return __builtin_bit_cast(bf16x8, p); }
#define PACK_STEP(x, s) pack8((f32x4){(x)[8 * (s)], (x)[8 * (s) + 1], (x)[8 * (s) + 2], (x)[8 * (s) + 3]}, (f32x4){(x)[8 * (s) + 4], (x)[8 * (s) + 5], (x)[8 * (s) + 6], (x)[8 * (s) + 7]})
__device__ __forceinline__ bf16x8 join44(s16x4 lo, s16x4 hi) { return __builtin_shufflevector(lo, hi, 0, 1, 2, 3, 4, 5, 6, 7); }

constexpr int NRT = 3, CT_GP = (NCMP_P + NRT * 16 - 1) / (NRT * 16), CT_GS = (NCMP_S + NRT * 16 - 1) / (NRT * 16);
constexpr int CT_PROMPT = NBATCH * 2 * CT_GP, CT_SAMPLE = MS * 2 * CT_GS, CT_ALL = CT_PROMPT + CT_SAMPLE;
__device__ __forceinline__ void compress_task(Frame& F, int task) {
    const int lane = F.lane, m = lane & 31, h = lane >> 5, ii = m & 15, g = m >> 4;
    const bool prompt = task < CT_PROMPT;
    int b, c, ig, nblk, tsrc;
    if (prompt) { b = task / (2 * CT_GP); c = (task / CT_GP) & 1; ig = task % CT_GP; nblk = NCMP_P; tsrc = T; }
    else { const int t2 = task - CT_PROMPT; b = t2 / (2 * CT_GS); c = (t2 / CT_GS) & 1; ig = t2 % CT_GS; nblk = NCMP_S; tsrc = PAST; }
    const int* pt = (const int*)F.in[6] + b * NPAGES;
    const bf16* WcT = (const bf16*)(F.ws + WS_WC) + (size_t)c * 64 * 2048;
    const float* small = (const float*)(F.ws + WS_SMALL);
    f32x16 acc[NRT][2];
#pragma unroll
    for (int rt = 0; rt < NRT; ++rt)
#pragma unroll
        for (int i = 0; i < 16; ++i) { acc[rt][0][i] = 0.f; acc[rt][1][i] = 0.f; }
    const char* rbase = prompt ? (const char*)(F.out + OFF2 + (size_t)b * T * 256) : (const char*)F.in[2];
    unsigned offA[NRT];
    LAS unsigned* offB = (LAS unsigned*)(F.lds + RING_OFF + 98304) + F.tid * 4;
#pragma unroll
    for (int rt = 0; rt < NRT; ++rt) {
        const int blk = ig * (NRT * 16) + rt * 16 + ii;
        int tA = 16 * blk, tB = 16 * blk + 16; tA = tA <= tsrc - 16 ? tA : tsrc - 16; tB = tB <= tsrc - 16 ? tB : tsrc - 16;
        const unsigned rA = prompt ? (unsigned)tA : (unsigned)pt[tA >> 7] * 128u + (unsigned)(tA & 127), rB = prompt ? (unsigned)tB : (unsigned)pt[tB >> 7] * 128u + (unsigned)(tB & 127);
        offA[rt] = (rA * 256u + (unsigned)(c * 128 + g * 64 + 8 * h)) * 4u; offB[rt] = (rB * 256u + (unsigned)(c * 128 + g * 64 + 8 * h)) * 4u;
    }
    const unsigned bo0 = ((unsigned)m * 2048u + 8u * (unsigned)h) * 2u;
    static_assert(NRT == 3, "the schedule below is written for 3 row tiles");
    f32x4 av[2][8]; bf16x8 Bv[4][2];
#define CMP_LOAD_A(st, l_, rt_) do { const char* ap_ = rbase + (((l_) < 16 ? offA[rt_] : offB[rt_]) + (unsigned)(((l_) & 15) * 1024)); \
        _Pragma("unroll") for (int dc = 0; dc < 4; ++dc) { av[st][2 * dc] = *(const GAS f32x4*)(ap_ + dc * 64); av[st][2 * dc + 1] = *(const GAS f32x4*)(ap_ + dc * 64 + 16); } } while (0)
#define CMP_LOAD_B(l_) do { const char* bp_ = (const char*)WcT + (bo0 + (unsigned)((l_) * 128)); _Pragma("unroll") for (int dc = 0; dc < 4; ++dc) { Bv[dc][0] = *(const GAS bf16x8*)(bp_ + dc * 32); Bv[dc][1] = *(const GAS bf16x8*)(bp_ + 32 * 2048 * 2 + dc * 32); } } while (0)
#define CMP_MMA(st, rt_) do { _Pragma("unroll") for (int dc = 0; dc < 4; ++dc) { const bf16x8 A_ = pack8(av[st][2 * dc], av[st][2 * dc + 1]); acc[rt_][0] = MFMA32(A_, Bv[dc][0], acc[rt_][0]); acc[rt_][1] = MFMA32(A_, Bv[dc][1], acc[rt_][1]); } } while (0)
#define SB __builtin_amdgcn_sched_barrier(0)
#define LM(j) (((j) >> 1) + 16 * ((j) & 1))
    CMP_LOAD_B(LM(0)); CMP_LOAD_A(0, LM(0), 0);
#pragma unroll 1
    for (int j = 0; j < 32; j += 2) {
        const int la = LM(j), lb = LM(j + 1), lc = LM(j + 2 < 32 ? j + 2 : 31);
        CMP_LOAD_A(1, la, 1); SB; CMP_MMA(0, 0); SB;
        CMP_LOAD_A(0, la, 2); SB; CMP_MMA(1, 1); SB;
        CMP_LOAD_A(1, lb, 0); SB; CMP_MMA(0, 2); SB;
        CMP_LOAD_B(lb); SB;
        CMP_LOAD_A(0, lb, 1); SB; CMP_MMA(1, 0); SB;
        CMP_LOAD_A(1, lb, 2); SB; CMP_MMA(0, 1); SB;
        CMP_LOAD_A(0, lc, 0); SB; CMP_MMA(1, 2); SB;
        CMP_LOAD_B(lc); SB;
    }
#undef LM
#undef CMP_LOAD_A
#undef CMP_LOAD_B
#undef CMP_MMA
#undef SB
    float be0 = 0.f, be1 = 0.f;
    for (int l = 0; l < 32; ++l) { be0 += small[(c * 32 + l) * 64 + m]; be1 += small[(c * 32 + l) * 64 + 32 + m]; }
#pragma unroll
    for (int rt = 0; rt < NRT; ++rt)
#pragma unroll
    for (int v = 0; v < 16; ++v) {
        const int mr = crow(v, h), oi = mr & 15, og = mr >> 4, ob = ig * (NRT * 16) + rt * 16 + oi;
        if (ob < nblk) {
            const float v0 = acc[rt][0][v] + be0, v1 = acc[rt][1][v] + be1;
            if (prompt) {
                if (c == 0) { bf16* kc = (bf16*)(F.ws + WS_KCP) + ((size_t)(b * 2 + og) * 512 + ob) * 64; kc[m] = (bf16)f2bf(v0); kc[32 + m] = (bf16)f2bf(v1); }
                else { bf16* vc = (bf16*)(F.ws + WS_VCTP) + (size_t)(b * 2 + og) * 64 * 512 + ob; vc[(size_t)m * 512] = (bf16)f2bf(v0); vc[(size_t)(32 + m) * 512] = (bf16)f2bf(v1); }
            } else {
                float* o = (float*)(F.ws + WS_KCVS) + ((size_t)b * 1024 + ob) * 256 + c * 128 + og * 64; o[m] = v0; o[32 + m] = v1;
            }
        }
    }
}
constexpr int VT_ITEMS = 2 * 2 * 2 * 128;
__device__ __forceinline__ void vt_item(Frame& F, int it) {
    const int tensor = it >> 9, b = (it >> 8) & 1, g = (it >> 7) & 1, tb = it & 127, lane = F.lane;
    const bf16* src = (const bf16*)(F.ws + WS_HB) + (size_t)(b * T + tb * 64 + lane) * NIN + (tensor ? C_KVW : C_KVS) + 128 + g * 64;
    bf16* dst = (bf16*)(F.ws + (tensor ? WS_VWT : WS_VST)) + (size_t)(b * 2 + g) * 64 * T + tb * 64 + lane;
    v4u r[8];
#pragma unroll
    for (int i = 0; i < 8; ++i) r[i] = *((const GAS v4u*)src + i);
    { const bf16* ksrc = src - 128; bf16* kdst = (bf16*)(F.ws + (tensor ? WS_KWC : WS_KSC)) + ((size_t)(b * 2 + g) * T + tb * 64 + lane) * 64;
#pragma unroll
      for (int i = 0; i < 8; ++i) *((GAS v4u*)kdst + i) = *((const GAS v4u*)ksrc + i); }
#pragma unroll
    for (int i = 0; i < 8; ++i) {
        const unsigned w[4] = {r[i].x, r[i].y, r[i].z, r[i].w};
#pragma unroll
        for (int j = 0; j < 4; ++j) { dst[(size_t)(i * 8 + 2 * j) * T] = (bf16)(w[j] & 0xffffu); dst[(size_t)(i * 8 + 2 * j + 1) * T] = (bf16)(w[j] >> 16); }
    }
}

constexpr int HG_SEG = 512, HG_NSEG = T / HG_SEG, HG_CH = 32;
constexpr int HL_QT = 0, HL_KT = 8704, HL_KD = 17408, HL_VT = 27648, HL_DEC = 32768, HL_PSUM = 33280, HL_SLAB = 35328, HL_END = HL_SLAB + 4 * 32 * 272;
static_assert(HL_END <= RING_BYTES, "hgrn lds");
template <int MODE> __device__ __forceinline__ void hgrn_segment(Frame& F, int bh, int seg) {
    int tid = F.tid; asm volatile("" : "+v"(tid));
    const int lane = tid & 63, w = F.wave, kt = w >> 1, vt = w & 1, h5 = lane >> 5, l31 = lane & 31;
    const int b = bh >> 3, hh = bh & 7;
    LAS unsigned char* L = F.lds + RING_OFF;
    const bf16* HB = (const bf16*)(F.ws + WS_HB);
    const float* small = (const float*)(F.ws + WS_SMALL);
    float* HGL = (float*)(F.ws + WS_HGL); float* HGD = (float*)(F.ws + WS_HGD);
    f32x16 S;
#pragma unroll
    for (int i = 0; i < 16; ++i) S[i] = 0.f;
    if (MODE == 1) {
        for (int i = 0; i < seg; ++i) {
            const float* Lp = HGL + ((size_t)(bh * HG_NSEG + i)) * 8192 + w * 1024 + lane; const float* Dp = HGD + (size_t)(bh * HG_NSEG + i) * 128 + 32 * kt;
#pragma unroll
            for (int v = 0; v < 16; ++v) S[v] = S[v] * Dp[crow(v, h5)] + Lp[v * 64];
        }
    }
    const int k = tid & 127, q4 = tid >> 7;
    const float lb = small[4096 + hh * 128 + k];
    float lcsum = 0.f;
    unsigned short pf[8], pq[8]; u32x2 pv_, pg_;
#define HG_FETCH(ch_) do { const int r0_ = b * T + seg * HG_SEG + (ch_) * HG_CH; \
        _Pragma("unroll") for (int j = 0; j < 8; ++j) { pf[j] = HB[(size_t)(r0_ + 8 * q4 + j) * NIN + C_FB + hh * 128 + k]; if (MODE == 1) pq[j] = HB[(size_t)(r0_ + 8 * q4 + j) * NIN + C_QB + hh * 128 + k]; } \
        pv_ = *(const GAS u32x2*)(HB + (size_t)(r0_ + (tid >> 4)) * NIN + C_IB + hh * 64 + 4 * (tid & 15)); \
        if (MODE == 1) pg_ = *(const GAS u32x2*)(HB + (size_t)(r0_ + (tid >> 4)) * NIN + C_GB + hh * 64 + 4 * (tid & 15)); } while (0)
    HG_FETCH(0);
    for (int ch = 0; ch < HG_SEG / HG_CH; ++ch) {
        const int row0 = b * T + seg * HG_SEG + ch * HG_CH;
        unsigned short cf[8], cq[8]; const u32x2 vv = pv_, gv = pg_;
#pragma unroll
        for (int j = 0; j < 8; ++j) { cf[j] = pf[j]; cq[j] = pq[j]; }
        { const int chn = ch + 1 < HG_SEG / HG_CH ? ch + 1 : ch; HG_FETCH(chn); }
        float kk[8], cs[8]; float run = 0.f;
#pragma unroll
        for (int j = 0; j < 8; ++j) {
            const float x = bf2f(cf[j]);
            const float e = __expf(-x), sg = 1.0f / (1.0f + e), om = e / (1.0f + e);
            const float f = lb + (1.0f - lb) * sg; kk[j] = (1.0f - lb) * om; run += __logf(f); cs[j] = run;
        }
        ((LAS float*)(L + HL_PSUM))[q4 * 128 + k] = run;
        __syncthreads();
        float off = 0.f, tot = 0.f;
#pragma unroll
        for (int q = 0; q < 4; ++q) { const float p = ((LAS float*)(L + HL_PSUM))[q * 128 + k]; tot += p; if (q < q4) off += p; }
#pragma unroll
        for (int j = 0; j < 8; ++j) {
            const int s = 8 * q4 + j; const float lc = off + cs[j];
            if (MODE == 1) {
                const float qv = bf2f(cq[j]);
                ((LAS bf16*)(L + HL_QT))[s * 136 + k] = (bf16)f2bf(qv * __expf(lc));
                ((LAS bf16*)(L + HL_KT))[s * 136 + k] = (bf16)f2bf(kk[j] * __expf(-lc));
            }
            ((LAS bf16*)(L + HL_KD))[k * 40 + s] = (bf16)f2bf(kk[j] * __expf(tot - lc));
        }
        if (q4 == 0) { ((LAS float*)(L + HL_DEC))[k] = __expf(tot); lcsum += tot; }
        { const int s = tid >> 4, vq = tid & 15;
          LAS bf16* vtp = (LAS bf16*)(L + HL_VT);
          vtp[(4 * vq + 0) * 40 + s] = (bf16)(vv.x & 0xffffu); vtp[(4 * vq + 1) * 40 + s] = (bf16)(vv.x >> 16);
          vtp[(4 * vq + 2) * 40 + s] = (bf16)(vv.y & 0xffffu); vtp[(4 * vq + 3) * 40 + s] = (bf16)(vv.y >> 16); }
        __syncthreads();
        if (MODE == 1) {
            f32x16 oacc;
#pragma unroll
            for (int i = 0; i < 16; ++i) oacc[i] = 0.f;
            if (kt == 0) {
                f32x16 at;
#pragma unroll
                for (int i = 0; i < 16; ++i) at[i] = 0.f;
#pragma unroll
                for (int ks = 0; ks < 8; ++ks) {
                    const bf16x8 a = *(const LAS bf16x8*)(L + HL_KT + l31 * 272 + (16 * ks + 8 * h5) * 2);
                    const bf16x8 bq = *(const LAS bf16x8*)(L + HL_QT + l31 * 272 + (16 * ks + 8 * h5) * 2);
                    at = MFMA32(a, bq, at);
                }
#pragma unroll
                for (int i = 0; i < 16; ++i) at[i] = (crow(i, h5) <= l31) ? at[i] : 0.f;
#pragma unroll
                for (int kq = 0; kq < 2; ++kq) {
                    const s16x4 lo = *(const LAS s16x4*)(L + HL_VT + (32 * vt + l31) * 80 + (16 * kq + 4 * h5) * 2);
                    const s16x4 hi = *(const LAS s16x4*)(L + HL_VT + (32 * vt + l31) * 80 + (16 * kq + 8 + 4 * h5) * 2);
                    oacc = MFMA32(join44(lo, hi), PACK_STEP(at, kq), oacc);
                }
            }
#pragma unroll
            for (int kq = 0; kq < 2; ++kq) {
                const s16x4 lo = *(const LAS s16x4*)(L + HL_QT + l31 * 272 + (32 * kt + 16 * kq + 4 * h5) * 2);
                const s16x4 hi = *(const LAS s16x4*)(L + HL_QT + l31 * 272 + (32 * kt + 16 * kq + 8 + 4 * h5) * 2);
                oacc = MFMA32(PACK_STEP(S, kq), join44(lo, hi), oacc);
            }
#pragma unroll
            for (int a = 0; a < 4; ++a)
                *(LAS f32x4*)(L + HL_SLAB + (kt * 32 + l31) * 272 + (32 * vt + 8 * a + 4 * h5) * 4) = (f32x4){oacc[4 * a], oacc[4 * a + 1], oacc[4 * a + 2], oacc[4 * a + 3]};
        }
        {
#pragma unroll
            for (int a = 0; a < 4; ++a) { const f32x4 d = *(const LAS f32x4*)(L + HL_DEC + (32 * kt + 8 * a + 4 * h5) * 4);
                S[4 * a] *= d.x; S[4 * a + 1] *= d.y; S[4 * a + 2] *= d.z; S[4 * a + 3] *= d.w; }
#pragma unroll
            for (int kq = 0; kq < 2; ++kq) {
                const bf16x8 a = *(const LAS bf16x8*)(L + HL_KD + (32 * kt + l31) * 80 + (16 * kq + 8 * h5) * 2);
                const bf16x8 bv = *(const LAS bf16x8*)(L + HL_VT + (32 * vt + l31) * 80 + (16 * kq + 8 * h5) * 2);
                S = MFMA32(a, bv, S);
            }
        }
        __syncthreads();
        if (MODE == 1) {
            const int t = tid >> 4, vq = tid & 15;
            f32x4 o = (f32x4){0.f, 0.f, 0.f, 0.f};
#pragma unroll
            for (int q = 0; q < 4; ++q) o += *(const LAS f32x4*)(L + HL_SLAB + (q * 32 + t) * 272 + 16 * vq);
            float ss = (o.x * o.x + o.y * o.y) + (o.z * o.z + o.w * o.w);
            ss += __shfl_xor(ss, 1); ss += __shfl_xor(ss, 2); ss += __shfl_xor(ss, 4); ss += __shfl_xor(ss, 8);
            const float rs = 1.0f / sqrtf(ss * (1.0f / 64.0f) + LN_EPS);
            const f32x4 ng = *(const GAS f32x4*)(F.in[11] + 4 * vq);
            const float g0 = bf2f(gv.x & 0xffffu), g1 = bf2f(gv.x >> 16), g2 = bf2f(gv.y & 0xffffu), g3 = bf2f(gv.y >> 16);
            u32x2 ow; ow.x = cvtpk(o.x * rs * ng.x * g0 * sigmoidf_(g0), o.y * rs * ng.y * g1 * sigmoidf_(g1)); ow.y = cvtpk(o.z * rs * ng.z * g2 * sigmoidf_(g2), o.w * rs * ng.w * g3 * sigmoidf_(g3));
            *(GAS u32x2*)((bf16*)(F.ws + WS_OB) + (size_t)(row0 + t) * 512 + hh * 64 + 4 * vq) = ow;
        }
    }
    if (MODE == 0) {
        float* Lp = HGL + ((size_t)(bh * HG_NSEG + seg)) * 8192 + w * 1024 + lane;
#pragma unroll
        for (int v = 0; v < 16; ++v) Lp[v * 64] = S[v];
        if (q4 == 0) HGD[(size_t)(bh * HG_NSEG + seg) * 128 + k] = __expf(lcsum);
    } else if (seg == HG_NSEG - 1) {
        float* o = F.out + OFF5 + (size_t)bh * 8192;
#pragma unroll
        for (int v = 0; v < 16; ++v) o[(32 * kt + crow(v, h5)) * 64 + 32 * vt + l31] = S[v];
    }
#undef HG_FETCH
    __syncthreads();
}
__device__ __forceinline__ void hgrn_sample_unit(Frame& F, int unit) {
    const int b = unit >> 3, hh = unit & 7, tid = F.tid, v = tid & 63, kq = tid >> 6;
    const bf16* HB = (const bf16*)(F.ws + WS_HB) + (size_t)(MP + b) * NIN;
    const float* small = (const float*)(F.ws + WS_SMALL);
    const float* st = F.in[5] + (size_t)(b * 8 + hh) * 8192; float* so = F.out + OFF9 + (size_t)(b * 8 + hh) * 8192;
    const float vv = bf2f(HB[C_IB + hh * 64 + v]);
    float po = 0.f;
#pragma unroll 4
    for (int j = 0; j < 16; ++j) {
        const int k = kq * 16 + j; const float x = bf2f(HB[C_FB + hh * 128 + k]), lb = small[4096 + hh * 128 + k];
        const float e = __expf(-x), sg = 1.0f / (1.0f + e), om = e / (1.0f + e);
        const float f = lb + (1.0f - lb) * sg, kx = (1.0f - lb) * om;
        const float sn = f * st[k * 64 + v] + kx * vv; so[k * 64 + v] = sn;
        po += bf2f(HB[C_QB + hh * 128 + k]) * sn;
    }
    LAS float* red = (LAS float*)(F.lds + RING_OFF);
    red[kq * 64 + v] = po;
    __syncthreads();
    if (tid < 64) {
        float o = 0.f;
#pragma unroll
        for (int q = 0; q < 8; ++q) o += red[q * 64 + v];
        const float ss = wave_sum(o * o), rs = 1.0f / sqrtf(ss * (1.0f / 64.0f) + LN_EPS);
        const float g = bf2f(HB[C_GB + hh * 64 + v]);
        ((bf16*)(F.ws + WS_OB))[(size_t)(MP + b) * 512 + hh * 64 + v] = (bf16)f2bf(o * rs * F.in[11][v] * g * sigmoidf_(g));
    }
    __syncthreads();
}
__device__ __forceinline__ void p2_phase(Frame& F) {
    for (int u = blockIdx.x; u < 16 * (HG_NSEG - 1); u += F.G) hgrn_segment<0>(F, u / (HG_NSEG - 1), u % (HG_NSEG - 1));
    for (int u = blockIdx.x; u < MS * 8; u += F.G) hgrn_sample_unit(F, u);
    const int NGW = F.G * NWAVES;
    for (int it = F.wave * F.G + F.vcu; it < CT_ALL + VT_ITEMS; it += NGW) { if (it < CT_ALL) compress_task(F, it); else vt_item(F, it - CT_ALL); }
    if (F.wave >= 6) { for (int r = (F.wave - 6) * F.G + F.vcu; r < MS * 511; r += 2 * F.G) { const int b = r / 511, i = r % 511;
        const GAS f32x4* sp = (const GAS f32x4*)(F.in[4] + ((size_t)b * 512 + i + 1) * 256); GAS f32x4* dp = (GAS f32x4*)(F.out + OFF8 + ((size_t)b * 512 + i) * 256); dp[F.lane] = sp[F.lane]; } }
}
constexpr int AT_NB = 5, AT_D = 4;
constexpr int AL_BUF = 16384  , AL_K = 0, AL_V = 8192;
constexpr int AL_IMP = AT_NB * AL_BUF, AL_SELM = AL_IMP + 64 * 128 * 4, AL_UNI = AL_SELM + 64 * 4 * 4, AL_TL = AL_UNI + 16, AL_END = AL_TL + 160 * 4;
static_assert(AL_END <= RING_BYTES, "attn lds");
constexpr float LOG2E = 1.4426950408889634f;
#define NEG_INF (-__builtin_inff())
__device__ __forceinline__ int swz(int row, int chunk) { return (chunk ^ ((row >> 1) & 7)) * 16; }
__device__ __forceinline__ f32x16 qk_sub(const LAS unsigned char* L, int sub, const bf16x8 (&qf)[4], int l31, int h5) {
    f32x16 acc;
#pragma unroll
    for (int i = 0; i < 16; ++i) acc[i] = 0.f;
    const int row = sub * 32 + l31;
#pragma unroll
    for (int s = 0; s < 4; ++s) { const bf16x8 a = *(const LAS bf16x8*)(L + AL_K + row * 128 + swz(row, 2 * s + h5)); acc = MFMA32(a, qf[s], acc); }
    return acc;
}
__device__ __forceinline__ void pv_sub(const LAS unsigned char* L, int sub, const f32x16& p, f32x16 (&O)[2], int l31, int h5) {
#pragma unroll
    for (int kq = 0; kq < 2; ++kq) {
        const bf16x8 pb = PACK_STEP(p, kq);
#pragma unroll
        for (int dt = 0; dt < 2; ++dt) {
            const int row = dt * 32 + l31;
            const s16x4 lo = *(const LAS s16x4*)(L + AL_V + row * 128 + swz(row, 4 * sub + 2 * kq) + 8 * h5);
            const s16x4 hi = *(const LAS s16x4*)(L + AL_V + row * 128 + swz(row, 4 * sub + 2 * kq + 1) + 8 * h5);
            O[dt] = MFMA32(join44(lo, hi), pb, O[dt]);
        }
    }
}
__device__ __forceinline__ void online_update2(const LAS unsigned char* L, f32x16& s0, f32x16& s1, float& m, float& l, f32x16 (&O)[2], int l31, int h5) {
    float tmax = fmaxf(s0[0], s1[0]);
#pragma unroll
    for (int i = 1; i < 16; ++i) tmax = fmaxf(tmax, fmaxf(s0[i], s1[i]));
    tmax = fmaxf(tmax, __shfl_xor(tmax, 32));
    const float mnew = fmaxf(m, tmax), ms = (mnew == NEG_INF) ? 0.f : mnew;
    const float alpha = __builtin_amdgcn_exp2f(m - ms);
    float ps = 0.f;
#pragma unroll
    for (int i = 0; i < 16; ++i) { s0[i] = __builtin_amdgcn_exp2f(s0[i] - ms); s1[i] = __builtin_amdgcn_exp2f(s1[i] - ms); ps += s0[i] + s1[i]; }
    l = l * alpha + ps; m = mnew;
    if (__any(alpha != 1.0f)) {
#pragma unroll
        for (int i = 0; i < 16; ++i) { O[0][i] *= alpha; O[1][i] *= alpha; }
    }
    pv_sub(L, 0, s0, O, l31, h5); pv_sub(L, 1, s1, O, l31, h5);
}

__device__ __forceinline__ void bias2(f32x16& s0, f32x16& s1, float scale2, float slopec, float cb) {
    const float cb1 = cb + slopec * 32.f;
#pragma unroll
    for (int k = 0; k < 16; ++k) { const float ck = (float)((k & 3) + 8 * (k >> 2)); s0[k] = s0[k] * scale2 + (slopec * ck + cb); s1[k] = s1[k] * scale2 + (slopec * ck + cb1); }
}
struct AttnSrc { const bf16* KCP; const bf16* VCTP; const bf16* Ks; const bf16* Vs; const bf16* Kw; const bf16* Vw; };
__device__ __forceinline__ void tile_dma(const AttnSrc& A, int e, LAS unsigned char* Lb, int w, int lane) {
    const int kind = e >> 24, idx = e & 0xffffff; const unsigned row = 8u * (unsigned)w + ((unsigned)lane >> 3), ch = (((unsigned)lane & 7u) ^ ((row >> 1) & 7u)) * 16u;
    const char* kb; const char* vb; unsigned vo;
    if (kind <= 1) { kb = (const char*)(A.KCP + (size_t)idx * 64 * 64); vb = (const char*)(A.VCTP + idx * 64); vo = row * 1024u + ch; }
    else if (kind == 2) { kb = (const char*)(A.Kw + (size_t)idx * 64 * 64); vb = (const char*)(A.Vw + idx * 64); vo = row * (unsigned)(T * 2) + ch; }
    else { kb = (const char*)(A.Ks + (size_t)idx * 64 * 64); vb = (const char*)(A.Vs + idx * 64); vo = row * (unsigned)(T * 2) + ch; }
    __builtin_amdgcn_global_load_lds((const unsigned*)(kb + (row * 128u + ch)), (LAS unsigned*)(Lb + AL_K + w * 1024), 16, 0, 0);
    __builtin_amdgcn_global_load_lds((const unsigned*)(vb + vo), (LAS unsigned*)(Lb + AL_V + w * 1024), 16, 0, 0);
}
__device__ __forceinline__ void nsa_prompt_unit(Frame& F, int unit) {
    const int b = unit >> 8, g = (unit >> 7) & 1, qt = unit & 127, t0 = qt * 64;
    int tid = F.tid; asm volatile("" : "+v"(tid));
    const int lane = tid & 63, w = F.wave, l31 = lane & 31, h5 = lane >> 5, ql = l31 >> 2, r = l31 & 3;
    LAS unsigned char* L = F.lds + RING_OFF;
    const bf16* HB = (const bf16*)(F.ws + WS_HB);
    const int pos = t0 + 8 * w + ql;
    const size_t qrow = (size_t)(b * T + pos);
    const float slope2 = __builtin_amdgcn_exp2f(-(float)(g * 4 + r + 1)) * LOG2E, scale2 = 0.125f * LOG2E;
    bf16x8 qf[4];
#pragma unroll
    for (int s = 0; s < 4; ++s) qf[s] = *(const GAS bf16x8*)(HB + qrow * NIN + C_QA + (g * 4 + r) * 64 + 16 * s + 8 * h5);
#define NSA_GATE(i) sigmoidf_(bf2f(HB[qrow * NIN + C_GLA + (g * 4 + r) * 3 + (i)]))
    AttnSrc A;
    A.KCP = (const bf16*)(F.ws + WS_KCP) + (size_t)(b * 2 + g) * 512 * 64; A.VCTP = (const bf16*)(F.ws + WS_VCTP) + (size_t)(b * 2 + g) * 64 * 512;
    A.Ks = (const bf16*)(F.ws + WS_KSC) + (size_t)(b * 2 + g) * T * 64; A.Vs = (const bf16*)(F.ws + WS_VST) + (size_t)(b * 2 + g) * 64 * T;
    A.Kw = (const bf16*)(F.ws + WS_KWC) + (size_t)(b * 2 + g) * T * 64; A.Vw = (const bf16*)(F.ws + WS_VWT) + (size_t)(b * 2 + g) * 64 * T;
    LAS int* TL = (LAS int*)(L + AL_TL);
    for (int i = tid; i < (AL_TL - AL_IMP) / 4; i += NWAVES * 64) ((LAS unsigned*)(L + AL_IMP))[i] = 0u;
    const int nmax_u = (t0 + 63 - 31) >> 4, nc = (nmax_u >> 6) + 1;
    const int nmax_w = (t0 + 8 * w + 7 - 31) >> 4;
    const int kb_lo = qt >= 8 ? qt - 8 : 0, nw = qt - kb_lo + 1;
    if (tid < 2 * nc + nw) TL[tid] = tid < nc ? tid : (tid < 2 * nc ? (1 << 24) | (tid - nc) : (2 << 24) | (kb_lo + tid - 2 * nc));
    __syncthreads();
    f32x16 O[2];
#pragma unroll
    for (int i = 0; i < 16; ++i) { O[0][i] = 0.f; O[1][i] = 0.f; }
    float* ots = (float*)(F.ws + WS_OTS) + ((size_t)blockIdx.x * 512 + tid) * 32;
    float m = NEG_INF, l = 0.f, inv_l = 0.f, mfin = 0.f;
    int n = 2 * nc + nw;
#define NSA_TILE_LOOP(stream) \
    { \
_Pragma("unroll") \
    for (int j = 0; j < AT_D; ++j) tile_dma(A, TL[j < n ? j : n - 1], L + j * AL_BUF, w, lane); \
    int bi = 0; \
_Pragma("unroll 1") \
    for (int i = 0; i < n; ++i) { \
        asm volatile("s_waitcnt vmcnt(6)" ::: "memory"); __builtin_amdgcn_s_barrier(); asm volatile("" ::: "memory"); \
        { const int jn = i + AT_D < n ? i + AT_D : n - 1; const int bn = bi + AT_D >= AT_NB ? bi + AT_D - AT_NB : bi + AT_D; tile_dma(A, TL[jn], L + bn * AL_BUF, w, lane); } \
        const int e = TL[i], kind = (stream) == 1 ? 3 : (e >> 24), idx = e & 0xffffff; \
        const LAS unsigned char* Lb = L + bi * AL_BUF; bi = bi + 1 == AT_NB ? 0 : bi + 1; \
        if (stream == 0 && i == nc) { l += __shfl_xor(l, 32); inv_l = l > 0.f ? 1.0f / l : 0.f; mfin = (m == NEG_INF) ? 0.f : m; } \
        if (stream == 0 && i == 2 * nc) { \
            { const float g0_ = NSA_GATE(0); _Pragma("unroll") for (int k = 0; k < 16; ++k) { ots[k] = g0_ * O[0][k]; ots[16 + k] = g0_ * O[1][k]; O[0][k] = 0.f; O[1][k] = 0.f; } } \
            asm volatile("s_waitcnt vmcnt(0)" ::: "memory"); \
            m = NEG_INF; l = 0.f; } \
        if ((stream) == 0 && kind <= 1) { \
            const int n0 = idx * 64; \
            if (n0 <= nmax_w) { \
                f32x16 s0 = qk_sub(Lb, 0, qf, l31, h5), s1 = qk_sub(Lb, 1, qf, l31, h5); \
                const float slopec = 16.f * slope2; \
                bias2(s0, s1, scale2, slopec, slope2 * (float)(16 * n0 + 31 - pos) + slopec * (float)(4 * h5) - (kind == 1 ? mfin : 0.f)); \
                if (16 * (n0 + 63) + 31 > t0 + 8 * w) { \
_Pragma("unroll") \
                    for (int k = 0; k < 16; ++k) { const int d0 = pos - (16 * (n0 + crow(k, h5)) + 31), d1 = d0 - 512; s0[k] = d0 >= 0 ? s0[k] : NEG_INF; s1[k] = d1 >= 0 ? s1[k] : NEG_INF; } \
                } \
                if (kind == 0) { \
                    float tmax = fmaxf(s0[0], s1[0]); \
_Pragma("unroll") \
                    for (int k = 1; k < 16; ++k) tmax = fmaxf(tmax, fmaxf(s0[k], s1[k])); \
                    tmax = fmaxf(tmax, __shfl_xor(tmax, 32)); \
                    const float mnew = fmaxf(m, tmax), ms = (mnew == NEG_INF) ? 0.f : mnew; \
                    float ps = 0.f; \
_Pragma("unroll") \
                    for (int k = 0; k < 16; ++k) ps += __builtin_amdgcn_exp2f(s0[k] - ms) + __builtin_amdgcn_exp2f(s1[k] - ms); \
                    l = l * __builtin_amdgcn_exp2f(m - ms) + ps; m = mnew; \
                } else { \
_Pragma("unroll") \
                    for (int k = 0; k < 16; ++k) { s0[k] = __builtin_amdgcn_exp2f(s0[k]) * inv_l; s1[k] = __builtin_amdgcn_exp2f(s1[k]) * inv_l; } \
_Pragma("unroll") \
                    for (int a = 0; a < 4; ++a) { \
                        float sm0 = (s0[4 * a] + s0[4 * a + 1]) + (s0[4 * a + 2] + s0[4 * a + 3]), sm1 = (s1[4 * a] + s1[4 * a + 1]) + (s1[4 * a + 2] + s1[4 * a + 3]); \
                        sm0 += __shfl_xor(sm0, 1); sm0 += __shfl_xor(sm0, 2); sm1 += __shfl_xor(sm1, 1); sm1 += __shfl_xor(sm1, 2); \
                        if (r == 0) { ((LAS float*)(L + AL_IMP))[(8 * w + ql) * 128 + (n0 >> 2) + 2 * a + h5] = sm0; ((LAS float*)(L + AL_IMP))[(8 * w + ql) * 128 + (n0 >> 2) + 8 + 2 * a + h5] = sm1; } \
                    } \
                    pv_sub(Lb, 0, s0, O, l31, h5); pv_sub(Lb, 1, s1, O, l31, h5); \
                } \
            } \
        } else { \
            const int pos0 = idx * 64; \
            const bool sel = (stream) == 0 ? true : ((((LAS unsigned*)(L + AL_SELM))[(8 * w + ql) * 4 + (idx >> 5)] >> (idx & 31)) & 1u) != 0u; \
            if (__any(sel && pos >= pos0)) { \
                f32x16 s0 = qk_sub(Lb, 0, qf, l31, h5), s1 = qk_sub(Lb, 1, qf, l31, h5); \
                bias2(s0, s1, scale2, slope2, sel ? slope2 * (float)(pos0 - pos + 4 * h5) : NEG_INF); \
                if (idx == qt || ((stream) == 0 && idx == qt - 8)) { \
_Pragma("unroll") \
                    for (int k = 0; k < 16; ++k) { const int d0 = pos - (pos0 + crow(k, h5)), d1 = d0 - 32; \
                        s0[k] = (d0 >= 0 && ((stream) == 1 || d0 < 512)) ? s0[k] : NEG_INF; s1[k] = (d1 >= 0 && ((stream) == 1 || d1 < 512)) ? s1[k] : NEG_INF; } \
                } \
                online_update2(Lb, s0, s1, m, l, O, l31, h5); \
            } \
        } \
    } \
    asm volatile("s_waitcnt vmcnt(0)" ::: "memory"); __builtin_amdgcn_s_barrier(); asm volatile("" ::: "memory"); \
    l += __shfl_xor(l, 32); \
    const float sc_ = l > 0.f ? NSA_GATE(stream == 0 ? 2 : 1) / l : 0.f; \
    if (stream == 0) { \
_Pragma("unroll") \
        for (int k = 0; k < 16; ++k) { ots[k] += sc_ * O[0][k]; ots[16 + k] += sc_ * O[1][k]; } \
    } else { \
_Pragma("unroll") \
        for (int k = 0; k < 16; ++k) { O[0][k] = ots[k] + sc_ * O[0][k]; O[1][k] = ots[16 + k] + sc_ * O[1][k]; } \
    } \
    }
    NSA_TILE_LOOP(0)
    {
        const int q = tid >> 3, sub = tid & 7, cur = qt;
        float vals[16]; unsigned avail = 0u, bits = 0u;
#pragma unroll
        for (int i = 0; i < 16; ++i) { const int j = sub * 16 + i; vals[i] = ((LAS float*)(L + AL_IMP))[q * 128 + j];
            if (j <= cur) { if (cur < 16 || j == 0 || j == cur || j == cur - 1) bits |= 1u << i; else avail |= 1u << i; } }
        if (cur >= 16) {
            for (int round = 0; round < 13; ++round) {
                float bv = -1.0f; int bi = 1 << 20;
#pragma unroll
                for (int i = 0; i < 16; ++i) if (((avail >> i) & 1u) && vals[i] > bv) { bv = vals[i]; bi = sub * 16 + i; }
#pragma unroll
                for (int o = 1; o < 8; o <<= 1) { const float ov = __shfl_xor(bv, o); const int oi = __shfl_xor(bi, o); if (ov > bv || (ov == bv && oi < bi)) { bv = ov; bi = oi; } }
                if ((bi >> 4) == sub) { avail &= ~(1u << (bi & 15)); bits |= 1u << (bi & 15); }
            }
        }
        if (bits) { __hip_atomic_fetch_or((LAS unsigned*)(L + AL_SELM) + q * 4 + (sub >> 1), bits << (16 * (sub & 1)), __ATOMIC_RELAXED, __HIP_MEMORY_SCOPE_WORKGROUP); __hip_atomic_fetch_or((LAS unsigned*)(L + AL_UNI) + (sub >> 1), bits << (16 * (sub & 1)), __ATOMIC_RELAXED, __HIP_MEMORY_SCOPE_WORKGROUP); }
        __syncthreads();
        const unsigned u0 = ((LAS unsigned*)(L + AL_UNI))[0], u1 = ((LAS unsigned*)(L + AL_UNI))[1], u2 = ((LAS unsigned*)(L + AL_UNI))[2], u3 = ((LAS unsigned*)(L + AL_UNI))[3];
        n = __builtin_popcount(u0) + __builtin_popcount(u1) + __builtin_popcount(u2) + __builtin_popcount(u3);
        n = __builtin_amdgcn_readfirstlane(n);
        if (tid < 128) { const int wq = tid >> 5, bq = tid & 31; const unsigned uw = wq == 0 ? u0 : (wq == 1 ? u1 : (wq == 2 ? u2 : u3));
            if ((uw >> bq) & 1u) { const int rank = __builtin_popcount(uw & ((1u << bq) - 1u)) + (wq > 0 ? __builtin_popcount(u0) : 0) + (wq > 1 ? __builtin_popcount(u1) : 0) + (wq > 2 ? __builtin_popcount(u2) : 0);
                TL[rank] = (3 << 24) | tid; } }
        __syncthreads();
        m = NEG_INF; l = 0.f;
#pragma unroll
        for (int i = 0; i < 16; ++i) { O[0][i] = 0.f; O[1][i] = 0.f; }
    }
    NSA_TILE_LOOP(1)
#undef NSA_TILE_LOOP
#undef NSA_GATE
    bf16* oa = (bf16*)(F.ws + WS_OA) + qrow * 512 + (g * 4 + r) * 64;
#pragma unroll
    for (int dt = 0; dt < 2; ++dt)
#pragma unroll
        for (int a = 0; a < 4; ++a) { u32x2 ow; ow.x = cvtpk(O[dt][4 * a], O[dt][4 * a + 1]); ow.y = cvtpk(O[dt][4 * a + 2], O[dt][4 * a + 3]);
            *(GAS u32x2*)(oa + dt * 32 + 8 * a + 4 * h5) = ow; }
    __syncthreads();
}

constexpr int SL_SC = 0, SL_Q = 16384, SL_RED = SL_Q + 1024, SL_IMP = SL_RED + 8192, SL_SEL = SL_IMP + 2048, SL_SELB = SL_SEL + 64, SL_OUT = SL_SELB + 128, SL_END = SL_OUT + 1024;
static_assert(SL_END <= RING_BYTES, "sample lds");
struct SampleCtx { const float* kcvs; const float* csel; const float* cwin; const float* new_sel; const float* new_win; };
template <int KIND> __device__ __forceinline__ const float* sample_key(const SampleCtx& c, const LAS int* SEL, const LAS unsigned long long* SELB, int kidx, int& dist, bool& valid) {
    if (KIND == 0) { valid = kidx < NCMP_S; dist = PAST - (16 * kidx + 31); return c.kcvs + (size_t)(valid ? kidx : 0) * 256; }
    if (KIND == 1) { const int slot = kidx >> 6, i = kidx & 63, jb = SEL[slot];
        if (jb < 256) { valid = true; dist = PAST - (jb * 64 + i); return c.csel + SELB[slot] + (size_t)i * 256; }
        valid = (i == 0); dist = 0; return c.new_sel; }
    valid = true; dist = 511 - kidx;
    return kidx == 511 ? c.new_win : c.cwin + (size_t)(kidx + 1) * 256;
}
__device__ __forceinline__ void block_max4(LAS float* red, float (&v)[4], int wave, int lane) {
#pragma unroll
    for (int r = 0; r < 4; ++r) { float x = v[r];
#pragma unroll
        for (int o = 1; o < 64; o <<= 1) x = fmaxf(x, __shfl_xor(x, o));
        if (lane == 0) red[wave * 4 + r] = x; }
    __syncthreads();
#pragma unroll
    for (int r = 0; r < 4; ++r) { float x = red[r];
#pragma unroll
        for (int q = 1; q < 8; ++q) x = fmaxf(x, red[q * 4 + r]);
        v[r] = x; }
    __syncthreads();
}
__device__ __forceinline__ void block_sum4(LAS float* red, float (&v)[4], int wave, int lane) {
#pragma unroll
    for (int r = 0; r < 4; ++r) { const float x = wave_sum(v[r]); if (lane == 0) red[wave * 4 + r] = x; }
    __syncthreads();
#pragma unroll
    for (int r = 0; r < 4; ++r) { float x = 0.f;
#pragma unroll
        for (int q = 0; q < 8; ++q) x += red[q * 4 + r];
        v[r] = x; }
    __syncthreads();
}
template <int KIND> __device__ __forceinline__ void sample_branch(Frame& F, const SampleCtx& c, int b, int g, int tid) {
    constexpr int NK = KIND == 2 ? 512 : 1024;
    const int lane = tid & 63, wave = F.wave, sub = lane & 15, kg = lane >> 4;
    LAS unsigned char* L = F.lds + RING_OFF;
    LAS float* SC = (LAS float*)(L + SL_SC); LAS float* Q = (LAS float*)(L + SL_Q); LAS float* red = (LAS float*)(L + SL_RED);
    const LAS int* SEL = (const LAS int*)(L + SL_SEL); const LAS unsigned long long* SELB = (const LAS unsigned long long*)(L + SL_SELB);
    f32x4 q4[4];
#pragma unroll
    for (int r = 0; r < 4; ++r) q4[r] = *(const LAS f32x4*)(Q + r * 64 + 4 * sub);
    constexpr int NIT = NK / 32, NBATCH_S = (NIT % 8 == 0) ? 8 : 1;
#pragma unroll 1
    for (int it0 = 0; it0 < NIT; it0 += NBATCH_S) {
        f32x4 kv[NBATCH_S]; int dist[NBATCH_S]; bool valid[NBATCH_S];
#pragma unroll
        for (int u = 0; u < NBATCH_S; ++u) { const int kidx = (it0 + u) * 32 + wave * 4 + kg; const float* kp = sample_key<KIND>(c, SEL, SELB, kidx, dist[u], valid[u]); kv[u] = *(const GAS f32x4*)(kp + 4 * sub); }
#pragma unroll
        for (int u = 0; u < NBATCH_S; ++u) {
            const int kidx = (it0 + u) * 32 + wave * 4 + kg;
            float part[4];
#pragma unroll
            for (int r = 0; r < 4; ++r) { float p = (kv[u].x * q4[r].x + kv[u].y * q4[r].y) + (kv[u].z * q4[r].z + kv[u].w * q4[r].w);
                p += __shfl_xor(p, 1); p += __shfl_xor(p, 2); p += __shfl_xor(p, 4); p += __shfl_xor(p, 8); part[r] = p; }
            if (sub < 4) { const float pr = sub == 0 ? part[0] : (sub == 1 ? part[1] : (sub == 2 ? part[2] : part[3]));
                SC[sub * 1024 + kidx] = valid[u] ? pr * 0.125f - __builtin_amdgcn_exp2f(-(float)(g * 4 + sub + 1)) * (float)dist[u] : NEG_INF; }
        }
    }
    __syncthreads();
    float mx[4] = {NEG_INF, NEG_INF, NEG_INF, NEG_INF};
    for (int kidx = tid; kidx < NK; kidx += 512)
#pragma unroll
        for (int r = 0; r < 4; ++r) mx[r] = fmaxf(mx[r], SC[r * 1024 + kidx]);
    block_max4(red, mx, wave, lane);
    float sm[4] = {0.f, 0.f, 0.f, 0.f};
    for (int kidx = tid; kidx < NK; kidx += 512)
#pragma unroll
        for (int r = 0; r < 4; ++r) { const float s = SC[r * 1024 + kidx]; const float p = s == NEG_INF ? 0.f : __expf(s - mx[r]); SC[r * 1024 + kidx] = p; sm[r] += p; }
    block_sum4(red, sm, wave, lane);
    for (int kidx = tid; kidx < NK; kidx += 512)
#pragma unroll
        for (int r = 0; r < 4; ++r) SC[r * 1024 + kidx] *= (sm[r] > 0.f ? 1.0f / sm[r] : 0.f);
    __syncthreads();
    f32x4 acc[4];
#pragma unroll
    for (int r = 0; r < 4; ++r) acc[r] = (f32x4){0.f, 0.f, 0.f, 0.f};
#pragma unroll 1
    for (int it0 = 0; it0 < NIT; it0 += NBATCH_S) {
        f32x4 vv[NBATCH_S];
#pragma unroll
        for (int u = 0; u < NBATCH_S; ++u) { const int kidx = (it0 + u) * 32 + wave * 4 + kg; int dist; bool valid; const float* kp = sample_key<KIND>(c, SEL, SELB, kidx, dist, valid); vv[u] = *(const GAS f32x4*)(kp + 128 + 4 * sub); }
#pragma unroll
        for (int u = 0; u < NBATCH_S; ++u) { const int kidx = (it0 + u) * 32 + wave * 4 + kg;
#pragma unroll
            for (int r = 0; r < 4; ++r) acc[r] += vv[u] * SC[r * 1024 + kidx]; }
    }
#pragma unroll
    for (int r = 0; r < 4; ++r)
#pragma unroll
        for (int j = 0; j < 4; ++j) { float x = acc[r][j]; x += __shfl_xor(x, 16); x += __shfl_xor(x, 32); acc[r][j] = x; }
    if (lane < 16) {
#pragma unroll
        for (int r = 0; r < 4; ++r) *(LAS f32x4*)(red + wave * 256 + r * 64 + 4 * sub) = acc[r];
    }
    __syncthreads();
    if (tid < 256) { const int r = tid >> 6; float o = 0.f;
#pragma unroll
        for (int wv = 0; wv < 8; ++wv) o += red[wv * 256 + tid];
        const float gt = sigmoidf_(bf2f(((const bf16*)(F.ws + WS_HB))[(size_t)(MP + b) * NIN + C_GLA + (g * 4 + r) * 3 + KIND]));
        ((LAS float*)(L + SL_OUT))[tid] += gt * o; }
    __syncthreads();
}
__device__ __forceinline__ void nsa_sample_unit(Frame& F, int unit) {
    const int b = unit >> 1, g = unit & 1;
    int tid = F.tid; asm volatile("" : "+v"(tid));
    LAS unsigned char* L = F.lds + RING_OFF;
    LAS float* SC = (LAS float*)(L + SL_SC); LAS float* Q = (LAS float*)(L + SL_Q); LAS float* IMP = (LAS float*)(L + SL_IMP); LAS int* SEL = (LAS int*)(L + SL_SEL);
    LAS unsigned long long* SELB = (LAS unsigned long long*)(L + SL_SELB);
    SampleCtx c;
    c.kcvs = (const float*)(F.ws + WS_KCVS) + (size_t)b * 1024 * 256 + g * 64; c.csel = F.in[3] + g * 64; c.cwin = F.in[4] + (size_t)b * 512 * 256 + g * 64;
    c.new_sel = F.out + OFF7 + (size_t)b * 256 + g * 64; c.new_win = F.out + OFF8 + ((size_t)b * 512 + 511) * 256 + g * 64;
    __syncthreads();
    if (tid < 256) { Q[tid] = bf2f(((const bf16*)(F.ws + WS_HB))[(size_t)(MP + b) * NIN + C_QA + g * 256 + tid]); ((LAS float*)(L + SL_OUT))[tid] = 0.f; }
    __syncthreads();
    sample_branch<0>(F, c, b, g, tid);
    if (tid < 257) { float s = 0.f;
#pragma unroll
        for (int cc = 0; cc < 4; ++cc) { const int n = 4 * tid + cc; if (n < NCMP_S) s += (SC[n] + SC[1024 + n]) + (SC[2048 + n] + SC[3072 + n]); }
        IMP[tid] = (tid == 0 || tid >= 255) ? -1.0f : s; }
    __syncthreads();
    if (tid < 64) {
        if (tid == 0) { SEL[0] = 0; SEL[1] = 255; SEL[2] = 256; }
        float vals[4]; unsigned avail = 0xfu;
#pragma unroll
        for (int i = 0; i < 4; ++i) { const int j = tid * 4 + i; vals[i] = IMP[j]; if (vals[i] < 0.f) avail &= ~(1u << i); }
        for (int round = 0; round < 13; ++round) {
            float bv = -1.0f; int bi = 1 << 20;
#pragma unroll
            for (int i = 0; i < 4; ++i) if (((avail >> i) & 1u) && vals[i] > bv) { bv = vals[i]; bi = tid * 4 + i; }
#pragma unroll
            for (int o = 1; o < 64; o <<= 1) { const float ov = __shfl_xor(bv, o); const int oi = __shfl_xor(bi, o); if (ov > bv || (ov == bv && oi < bi)) { bv = ov; bi = oi; } }
            if ((bi >> 2) == tid) avail &= ~(1u << (bi & 3));
            if (tid == 0) SEL[3 + round] = bi;
        }
    }
    __syncthreads();
    if (tid < 16) { const int jb = SEL[tid]; const int* pt = (const int*)F.in[6] + b * NPAGES;
        SELB[tid] = jb < 256 ? ((unsigned long long)pt[jb >> 1] * 128ull + (unsigned long long)((jb & 1) * 64)) * 256ull : 0ull; }
    __syncthreads();
    sample_branch<1>(F, c, b, g, tid);
    sample_branch<2>(F, c, b, g, tid);
    if (tid < 256) ((bf16*)(F.ws + WS_OA))[(size_t)(MP + b) * 512 + g * 256 + tid] = (bf16)f2bf(((LAS float*)(L + SL_OUT))[tid]);
    __syncthreads();
}
__device__ __forceinline__ void p3_phase(Frame& F) {
    for (int u = blockIdx.x; u < 16 * HG_NSEG; u += F.G) hgrn_segment<1>(F, u / HG_NSEG, u % HG_NSEG);
#pragma unroll 1
    for (int u2 = 2 * blockIdx.x; u2 < 512; u2 += 2 * F.G) {
#pragma unroll 1
        for (int which = 0; which < 2; ++which) { const int p = u2 >> 1, bg = p >> 6, qq = p & 63; nsa_prompt_unit(F, bg * 128 + (which ? qq : 127 - qq)); } }
    for (int u = blockIdx.x; u < 2 * MS; u += F.G) nsa_sample_unit(F, u);
}
namespace pg8 {
typedef unsigned u32x2e __attribute__((ext_vector_type(2)));
__device__ __forceinline__ float bfl(unsigned w) { return __uint_as_float(w << 16); }
__device__ __forceinline__ float bfh(unsigned w) { return __uint_as_float(w & 0xffff0000u); }
__device__ __forceinline__ float sgm(float x) { return 1.0f / (1.0f + __expf(-x)); }
struct EpiGateA {
    static constexpr bool PERM = false, AFTER_DRAIN = false;
    const bf16_t* HBp; bf16_t* TB;
    __device__ __forceinline__ void operator()(const f32x4 (&acc)[2][2][4][2], const Unit& u, int wr, int wc, int fr, int fq) const {
        const int row0 = u.pm * BM + wr * 64 + fr, col0 = u.pn * BM + wc * 32 + 4 * fq;
#pragma unroll
        for (int ai = 0; ai < 2; ++ai)
#pragma unroll
            for (int m = 0; m < 4; ++m) { const size_t r = (size_t)(row0 + ai * HALF + m * 16);
#pragma unroll
                for (int bj = 0; bj < 2; ++bj)
#pragma unroll
                    for (int n = 0; n < 2; ++n) { const int c = col0 + bj * HALF + n * 16; const u32x2e gw = *(const u32x2e*)(HBp + r * NIN + C_MG + c); const f32x4 a = acc[ai][bj][m][n];
                        u32x2e o; o.x = cvt_pk_bf16(sgm(bfl(gw.x)) * a[0], sgm(bfh(gw.x)) * a[1]); o.y = cvt_pk_bf16(sgm(bfl(gw.y)) * a[2], sgm(bfh(gw.y)) * a[3]); *(u32x2e*)(TB + r * D + c) = o; } }
    }
};
struct EpiGateB {
    static constexpr bool PERM = false, AFTER_DRAIN = false;
    const bf16_t* HBp; const bf16_t* TB; bf16_t* MG;
    __device__ __forceinline__ void operator()(const f32x4 (&acc)[2][2][4][2], const Unit& u, int wr, int wc, int fr, int fq) const {
        const int row0 = u.pm * BM + wr * 64 + fr, col0 = u.pn * BM + wc * 32 + 4 * fq;
#pragma unroll
        for (int ai = 0; ai < 2; ++ai)
#pragma unroll
            for (int m = 0; m < 4; ++m) { const size_t r = (size_t)(row0 + ai * HALF + m * 16);
#pragma unroll
                for (int bj = 0; bj < 2; ++bj)
#pragma unroll
                    for (int n = 0; n < 2; ++n) { const int c = col0 + bj * HALF + n * 16; const u32x2e gw = *(const u32x2e*)(HBp + r * NIN + C_MG + D + c); const f32x4 a = acc[ai][bj][m][n]; const u32x2e tw = *(const u32x2e*)(TB + r * D + c); const f32x4 t = (f32x4){bfl(tw.x), bfh(tw.x), bfl(tw.y), bfh(tw.y)};
                        u32x2e o; o.x = cvt_pk_bf16(t[0] + sgm(bfl(gw.x)) * a[0], t[1] + sgm(bfh(gw.x)) * a[1]); o.y = cvt_pk_bf16(t[2] + sgm(bfl(gw.y)) * a[2], t[3] + sgm(bfh(gw.y)) * a[3]);
                        *(u32x2e*)(MG + r * D + c) = o; } }
    }
};
struct EpiResid {
    static constexpr bool PERM = false, AFTER_DRAIN = false;
    const float* rp; const float* rs; bf16_t* Z;
    __device__ __forceinline__ void operator()(const f32x4 (&acc)[2][2][4][2], const Unit& u, int wr, int wc, int fr, int fq) const {
        const int row0 = u.pm * BM + wr * 64 + fr, col0 = u.pn * BM + wc * 32 + 4 * fq;
#pragma unroll
        for (int ai = 0; ai < 2; ++ai)
#pragma unroll
            for (int m = 0; m < 4; ++m) { const int r = row0 + ai * HALF + m * 16; const float* xr = rp + (size_t)r * D;
#pragma unroll
                for (int bj = 0; bj < 2; ++bj)
#pragma unroll
                    for (int n = 0; n < 2; ++n) { const int c = col0 + bj * HALF + n * 16; const f32x4 z = *(const f32x4*)(xr + c) * DN_ALPHA + acc[ai][bj][m][n];
                        u32x2e o; o.x = cvt_pk_bf16(z[0], z[1]); o.y = cvt_pk_bf16(z[2], z[3]); *(u32x2e*)(Z + (size_t)r * D + c) = o; } }
    }
};
struct EpiResidB {
    static constexpr bool PERM = false, AFTER_DRAIN = false;
    const bf16_t* X1; bf16_t* Z;
    __device__ __forceinline__ void operator()(const f32x4 (&acc)[2][2][4][2], const Unit& u, int wr, int wc, int fr, int fq) const {
        const int row0 = u.pm * BM + wr * 64 + fr, col0 = u.pn * BM + wc * 32 + 4 * fq;
#pragma unroll
        for (int ai = 0; ai < 2; ++ai)
#pragma unroll
            for (int m = 0; m < 4; ++m) { const size_t r = (size_t)(row0 + ai * HALF + m * 16);
#pragma unroll
                for (int bj = 0; bj < 2; ++bj)
#pragma unroll
                    for (int n = 0; n < 2; ++n) { const int c = col0 + bj * HALF + n * 16; const u32x2e xw = *(const u32x2e*)(X1 + r * D + c);
                        const f32x4 z = (f32x4){bfl(xw.x), bfh(xw.x), bfl(xw.y), bfh(xw.y)} * DN_ALPHA + acc[ai][bj][m][n]; u32x2e o; o.x = cvt_pk_bf16(z[0], z[1]); o.y = cvt_pk_bf16(z[2], z[3]); *(u32x2e*)(Z + r * D + c) = o; } }
    }
};
struct EpiRelu2 {
    static constexpr bool PERM = true, AFTER_DRAIN = false;
    bf16_t* U;
    __device__ __forceinline__ void operator()(const f32x4 (&acc)[2][2][4][2], const Unit& u, int wr, int wc, int fr, int fq) const {
        const int row0 = u.pm * BM + wr * 64 + fr, col0 = u.pn * BM + wc * 32 + 8 * fq;
#pragma unroll
        for (int ai = 0; ai < 2; ++ai)
#pragma unroll
            for (int m = 0; m < 4; ++m) { bf16_t* rowp = U + (size_t)(row0 + ai * HALF + m * 16) * FF + col0;
#pragma unroll
                for (int bj = 0; bj < 2; ++bj) { f32x4 v0 = acc[ai][bj][m][0], v1 = acc[ai][bj][m][1];
#pragma unroll
                    for (int j = 0; j < 4; ++j) { const float a = fmaxf(v0[j], 0.f), b = fmaxf(v1[j], 0.f); v0[j] = a * a; v1[j] = b * b; }
                    u32x4 w; w.x = cvt_pk_bf16(v0[0], v0[1]); w.y = cvt_pk_bf16(v0[2], v0[3]); w.z = cvt_pk_bf16(v1[0], v1[1]); w.w = cvt_pk_bf16(v1[2], v1[3]);
                    *(u32x4*)(rowp + bj * HALF) = w; } }
    }
};
}
__device__ __forceinline__ void ln_phase(Frame& F, const unsigned char* Zb, const float* gam, const float* bet, int which) {
    const float* Z = (const float*)(Zb + (size_t)MP * D * 2) - (size_t)MP * D;
    const int gw = F.vcu * NWAVES + F.wave, NGW = F.G * NWAVES, lane = F.lane;
    const int nrows = MP + MS;
    for (int r = gw; r < nrows; r += NGW) {
        const GAS f32x4* zr = (const GAS f32x4*)(Z + (size_t)r * D) + lane;
        f32x4 v[4]; float s = 0.f;
        if (which && r >= MP) {
            const GAS unsigned long long* x1r = (const GAS unsigned long long*)((const bf16*)(F.ws + WS_X1B) + (size_t)r * D) + lane;
#pragma unroll
            for (int j = 0; j < 4; ++j) { const unsigned long long xw = x1r[64 * j]; const unsigned xlo = (unsigned)xw, xhi = (unsigned)(xw >> 32);
                f32x4 t = (f32x4){__uint_as_float(xlo << 16), __uint_as_float(xlo & 0xffff0000u), __uint_as_float(xhi << 16), __uint_as_float(xhi & 0xffff0000u)} * DN_ALPHA;
#pragma unroll
                for (int kq = 0; kq < 4; ++kq) t += *((const GAS f32x4*)(Z + (size_t)(MP + 32 * kq + (r - MP)) * D) + lane + 64 * j);
                v[j] = t; s += (t.x + t.y) + (t.z + t.w); }
        } else if (r >= MP) {
#pragma unroll
        for (int j = 0; j < 4; ++j) { v[j] = zr[64 * j]; s += (v[j].x + v[j].y) + (v[j].z + v[j].w); }
        } else {
            const GAS unsigned long long* zb = (const GAS unsigned long long*)((const bf16*)Zb + (size_t)r * D) + lane;
#pragma unroll
            for (int j = 0; j < 4; ++j) { const unsigned long long zw = zb[64 * j]; const unsigned zlo = (unsigned)zw, zhi = (unsigned)(zw >> 32);
                v[j] = (f32x4){__uint_as_float(zlo << 16), __uint_as_float(zlo & 0xffff0000u), __uint_as_float(zhi << 16), __uint_as_float(zhi & 0xffff0000u)}; s += (v[j].x + v[j].y) + (v[j].z + v[j].w); }
        }
        const float mean = wave_sum(s) * (1.f / D); float s2 = 0.f;
#pragma unroll
        for (int j = 0; j < 4; ++j) { v[j] = v[j] - mean; s2 += (v[j].x * v[j].x + v[j].y * v[j].y) + (v[j].z * v[j].z + v[j].w * v[j].w); }
        const float rstd = 1.f / sqrtf(wave_sum(s2) * (1.f / D) + LN_EPS);
        float* of = r < MP ? F.out + OFF0 + (size_t)r * D : F.out + OFF1 + (size_t)(r - MP) * D;
#pragma unroll
        for (int j = 0; j < 4; ++j) { const f32x4 gg = *((const GAS f32x4*)gam + lane + 64 * j), bb = *((const GAS f32x4*)bet + lane + 64 * j);
            v[j] = v[j] * rstd * gg + bb; if (which) *((GAS f32x4*)of + lane + 64 * j) = v[j]; }
        if (!which) { GAS unsigned long long* o8 = (GAS unsigned long long*)((bf16*)(F.ws + WS_X1B) + (size_t)r * D) + lane;
#pragma unroll
            for (int j = 0; j < 4; ++j) o8[64 * j] = (unsigned long long)pk2(v[j].x, v[j].y) | ((unsigned long long)pk2(v[j].z, v[j].w) << 32); }
    }
}
__device__ __forceinline__ f32x16 small_gemm(const bf16* A, int lda, const bf16* Bt, int K, int n0, int k0, int k1, int l31, int h5, f32x16 acc) {
    const bf16* ap = A + (size_t)l31 * lda + 8 * h5; const bf16* bp = Bt + (size_t)(n0 + l31) * K + 8 * h5;
#pragma unroll 1
    for (int k = k0; k < k1; k += 256) {
        bf16x8 av[16], bv[16];
#pragma unroll
        for (int j = 0; j < 16; ++j) { av[j] = *(const GAS bf16x8*)(ap + k + 16 * j); bv[j] = *(const GAS bf16x8*)(bp + k + 16 * j); }
#pragma unroll
        for (int j = 0; j < 16; ++j) acc = MFMA32(av[j], bv[j], acc);
    }
    return acc;
}
#define SMALL_TASK_LOOP(NT) for (int it = F.vcu + F.G * F.wave; it < (NT); it += F.G * NWAVES)
__device__ __forceinline__ f32x16 zero16() { f32x16 z;
#pragma unroll
    for (int i = 0; i < 16; ++i) z[i] = 0.f;
    return z; }
__device__ __forceinline__ void sample_merge_tasks(Frame& F) {
    const int l31 = F.lane & 31, h5 = F.lane >> 5; const bf16* HB = (const bf16*)(F.ws + WS_HB);
    SMALL_TASK_LOOP(32) { const int n0 = it * 32, n = n0 + l31;
        const f32x16 aa = small_gemm((const bf16*)(F.ws + WS_OA) + (size_t)MP * 512, 512, (const bf16*)(F.ws + WS_WA), 512, n0, 0, 512, l31, h5, zero16());
        const f32x16 ab = small_gemm((const bf16*)(F.ws + WS_OB) + (size_t)MP * 512, 512, (const bf16*)(F.ws + WS_WB), 512, n0, 0, 512, l31, h5, zero16());
#pragma unroll
        for (int v = 0; v < 16; ++v) { const size_t row = (size_t)(MP + crow(v, h5));
            const float g1 = sigmoidf_(bf2f(HB[row * NIN + C_MG + n])), g2 = sigmoidf_(bf2f(HB[row * NIN + C_MG + D + n]));
            ((bf16*)(F.ws + WS_MG))[row * D + n] = (bf16)f2bf(g1 * aa[v] + g2 * ab[v]); } }
}
__device__ __forceinline__ void sample_wout_tasks(Frame& F) {
    const int l31 = F.lane & 31, h5 = F.lane >> 5;
    SMALL_TASK_LOOP(32) { const int n0 = it * 32, n = n0 + l31;
        const f32x16 a = small_gemm((const bf16*)(F.ws + WS_MG) + (size_t)MP * D, D, (const bf16*)(F.ws + WS_WO), D, n0, 0, D, l31, h5, zero16());
#pragma unroll
        for (int v = 0; v < 16; ++v) { const int row = crow(v, h5); ((float*)(F.ws + WS_Z1 + (size_t)MP * D * 2))[(size_t)row * D + n] = DN_ALPHA * F.in[1][(size_t)row * D + n] + a[v]; } }
}
__device__ __forceinline__ void sample_up_tasks(Frame& F) {
    const int l31 = F.lane & 31, h5 = F.lane >> 5;
    SMALL_TASK_LOOP(128) { const int n0 = it * 32, n = n0 + l31;
        const f32x16 a = small_gemm((const bf16*)(F.ws + WS_X1B) + (size_t)MP * D, D, (const bf16*)(F.ws + WS_WUP), D, n0, 0, D, l31, h5, zero16());
#pragma unroll
        for (int v = 0; v < 16; ++v) { const float x = fmaxf(a[v], 0.f); ((bf16*)(F.ws + WS_UB))[(size_t)(MP + crow(v, h5)) * FF + n] = (bf16)f2bf(x * x); } }
}
__device__ __forceinline__ void sample_down_tasks(Frame& F) {
    const int l31 = F.lane & 31, h5 = F.lane >> 5;
    SMALL_TASK_LOOP(128) { const int n0 = (it & 31) * 32, kq = it >> 5, n = n0 + l31;
        const f32x16 a = small_gemm((const bf16*)(F.ws + WS_UB) + (size_t)MP * FF, FF, (const bf16*)(F.ws + WS_WDN), FF, n0, kq * 1024, kq * 1024 + 1024, l31, h5, zero16());
#pragma unroll
        for (int v = 0; v < 16; ++v) ((float*)(F.ws + WS_Z2 + (size_t)MP * D * 2))[(size_t)(32 * kq + crow(v, h5)) * D + n] = a[v]; }
}

#ifdef PROBE_LAST
#ifndef PROBE_BASE
#define PROBE_BASE WS_KCP
#endif
#ifndef PROBE_BYTES
#define PROBE_BYTES (WS_TB - WS_KCP)
#endif
__device__ __forceinline__ void probe_digest(Frame& F, const XcdBarrier& bar) {
    const size_t i0 = (size_t)blockIdx.x * 512 + F.tid, st = (size_t)F.G * 512;
    for (size_t i = i0; i < OUT_TOTAL; i += st) F.out[i] = 0.f;
    xcd_barrier(bar);
    const unsigned* w = (const unsigned*)(F.ws + PROBE_BASE); const size_t nw = (size_t)(PROBE_BYTES) / 4;
    unsigned h = 0u;
    for (size_t i = i0; i < nw; i += st) h += (w[i] ^ (unsigned)i) * 2654435761u;
#pragma unroll
    for (int o = 1; o < 64; o <<= 1) h += __shfl_xor(h, o);
    if (F.lane == 0) F.out[(size_t)blockIdx.x * 8 + F.wave] = (float)(h & 0xFFFFFu);
}
#endif
struct Args { const float* in[21]; float* out; unsigned char* ws; int ph_lo, ph_hi; };
__global__ void __launch_bounds__(NWAVES * 64, 2) nsa_fwd(Args args) {
    extern __shared__ __attribute__((aligned(16))) unsigned char lds[];
    Frame F;
    F.lds = (LAS unsigned char*)lds;
    F.MISC = (volatile LAS unsigned*)(F.lds + MISC_OFF);
    F.tid = threadIdx.x; F.lane = F.tid & 63; F.wave = __builtin_amdgcn_readfirstlane(F.tid >> 6);
    F.G = gridDim.x; { const int bx = blockIdx.x; F.vcu = (F.G % 8 == 0) ? (bx % 8) * (F.G / 8) + bx / 8 : bx; }
    F.ws = args.ws; F.out = args.out;
#pragma unroll
    for (int i = 0; i < 21; ++i) F.in[i] = args.in[i];
    F.ctl = (gu32*)(F.ws + WS_CTL);
    for (int u = F.tid; u < (LDS_BYTES - LDSCTL_OFF) / 4; u += NWAVES * 64) ((LAS unsigned*)(F.lds + LDSCTL_OFF))[u] = 0u;
    __syncthreads();
    XcdBarrier bar = xcd_barrier_post((unsigned*)(F.ctl + CW_BAR), F.MISC + 8);
    const int lo = args.ph_lo, hi = args.ph_hi;
#ifdef PROBE_TIMING
    unsigned long long ts[11];
#define STAMP(k) ts[k] = rt();
#else
#define STAMP(k)
#endif
    STAMP(0)
#define IN(k) (lo <= (k) && (k) < hi)
#define BOTH(k) (IN(k) && IN((k) + 1))
#define GRID_BAR() xcd_barrier(bar)


#ifdef PROBE_LAST
#define PROBE_AFTER(k) if ((k) == PROBE_LAST) { probe_digest(F, bar); return; }
#else
#define PROBE_AFTER(k)
#endif
    if (IN(0)) { p0_prologue(F); if (BOTH(0)) GRID_BAR(); }
    PROBE_AFTER(0)
    STAMP(1)
    if (IN(1)) {
        pg8::Gemm g{(const pg8::bf16_t*)(F.ws + WS_XB), (const pg8::bf16_t*)(F.ws + WS_WIN), MALL, NIN, D}; pg8::StaticOrder S; S.init(MALL, NIN, F.G, (int)blockIdx.x);
        pg8::EpiInProj E{(pg8::bf16_t*)(F.ws + WS_HB), F.out};
        pg8::gemm_phase<pg8::EpiInProj, pg8::StaticOrder, true, true>(F.lds + RING_OFF, g, S, E);
        if (BOTH(1)) GRID_BAR();
    }
    PROBE_AFTER(1)
    STAMP(2)

    if (IN(2)) { p2_phase(F); if (BOTH(2)) GRID_BAR(); }
    PROBE_AFTER(2)
    STAMP(3)
    if (IN(3)) { p3_phase(F); if (BOTH(3)) GRID_BAR(); }
    PROBE_AFTER(3)
    STAMP(4)
    if (IN(4)) {
        { pg8::Gemm g{(const pg8::bf16_t*)(F.ws + WS_OA), (const pg8::bf16_t*)(F.ws + WS_WA), MP, D, 512}; pg8::StaticOrder S; S.init(MP, D, F.G, (int)blockIdx.x);
          pg8::EpiGateA E{(const pg8::bf16_t*)(F.ws + WS_HB), (pg8::bf16_t*)(F.ws + WS_TB)};
          pg8::gemm_phase<pg8::EpiGateA, pg8::StaticOrder, true, true>(F.lds + RING_OFF, g, S, E); }
        { pg8::Gemm g{(const pg8::bf16_t*)(F.ws + WS_OB), (const pg8::bf16_t*)(F.ws + WS_WB), MP, D, 512}; pg8::StaticOrder S; S.init(MP, D, F.G, (int)blockIdx.x);
          pg8::EpiGateB E{(const pg8::bf16_t*)(F.ws + WS_HB), (const pg8::bf16_t*)(F.ws + WS_TB), (pg8::bf16_t*)(F.ws + WS_MG)};
          pg8::gemm_phase<pg8::EpiGateB, pg8::StaticOrder, true, true>(F.lds + RING_OFF, g, S, E); }
        sample_merge_tasks(F);
        if (BOTH(4)) GRID_BAR();
    }
    PROBE_AFTER(4)
    STAMP(5)
    if (IN(5)) {
        pg8::Gemm g{(const pg8::bf16_t*)(F.ws + WS_MG), (const pg8::bf16_t*)(F.ws + WS_WO), MP, D, D}; pg8::StaticOrder S; S.init(MP, D, F.G, (int)blockIdx.x);
        pg8::EpiResid E{F.in[0], F.in[1], (pg8::bf16_t*)(F.ws + WS_Z1)};
        pg8::gemm_phase<pg8::EpiResid, pg8::StaticOrder, true, true>(F.lds + RING_OFF, g, S, E);
        sample_wout_tasks(F);
        if (BOTH(5)) GRID_BAR();
    }
    PROBE_AFTER(5)
    STAMP(6)
    if (IN(6)) { ln_phase(F, F.ws + WS_Z1, F.in[15], F.in[16], 0); if (BOTH(6)) GRID_BAR(); }
    PROBE_AFTER(6)
    STAMP(7)
    if (IN(7)) {
        pg8::Gemm g{(const pg8::bf16_t*)(F.ws + WS_X1B), (const pg8::bf16_t*)(F.ws + WS_WUP), MP, FF, D}; pg8::StaticOrder S; S.init(MP, FF, F.G, (int)blockIdx.x);
        pg8::EpiRelu2 E{(pg8::bf16_t*)(F.ws + WS_UB)};
        pg8::gemm_phase<pg8::EpiRelu2, pg8::StaticOrder, true, true>(F.lds + RING_OFF, g, S, E);
        sample_up_tasks(F);
        if (BOTH(7)) GRID_BAR();
    }
    PROBE_AFTER(7)
    STAMP(8)
    if (IN(8)) {
        pg8::Gemm g{(const pg8::bf16_t*)(F.ws + WS_UB), (const pg8::bf16_t*)(F.ws + WS_WDN), MP, D, FF}; pg8::StaticOrder S; S.init(MP, D, F.G, (int)blockIdx.x);
        pg8::EpiResidB E{(const pg8::bf16_t*)(F.ws + WS_X1B), (pg8::bf16_t*)(F.ws + WS_Z2)};
        pg8::gemm_phase<pg8::EpiResidB, pg8::StaticOrder, true, true>(F.lds + RING_OFF, g, S, E);
        sample_down_tasks(F);
        if (BOTH(8)) GRID_BAR();
    }
    PROBE_AFTER(8)
    STAMP(9)
    if (IN(9)) { ln_phase(F, F.ws + WS_Z2, F.in[19], F.in[20], 1); }
#ifdef PROBE_TIMING
    GRID_BAR();
    STAMP(10)
    { const size_t i0 = (size_t)blockIdx.x * 512 + F.tid, st = (size_t)F.G * 512; for (size_t i = i0; i < OUT_TOTAL; i += st) ((unsigned*)F.out)[i] = 0xAAAAAAABu; }
    GRID_BAR();
    if (blockIdx.x == 0) {
        const size_t offs[10] = {OFF0, OFF1, OFF2, OFF3, OFF4, OFF5, OFF6, OFF7, OFF8, OFF9};
#pragma unroll
        for (int k = 0; k < 10; ++k) { const unsigned n = (unsigned)((ts[k + 1] - ts[k]) / 10ull); for (unsigned i = F.tid; i < n; i += 512) ((unsigned*)F.out)[offs[k] + i] = 0xAAAAAAAAu; }
    }
#endif
#ifdef PROBE_SANITIZE
    GRID_BAR();
    { const size_t i0 = (size_t)blockIdx.x * 512 + F.tid, st = (size_t)F.G * 512;
      for (size_t i = i0; i < OUT_TOTAL; i += st) { const float v = F.out[i]; if (!(v - v == 0.f)) F.out[i] = 0.f; } }
#endif
#undef IN
#undef BOTH
}

extern "C" void kernel_launch(void* const* d_in, const int* in_sizes, int n_in, void* d_out, int out_size, void* d_ws, size_t ws_size, hipStream_t stream) {
    static int grid = 0;
    if (grid == 0) {
        if (n_in != 21 || (size_t)out_size != OUT_TOTAL || ws_size < WS_END) { fprintf(stderr, "kernel_launch: unexpected shapes: n_in %d out %d ws %zu (need %zu)\n", n_in, out_size, ws_size, (size_t)WS_END); grid = -1; return; }
        int dev = 0, cus = 0, per_cu = 0;
        if (hipGetDevice(&dev) != hipSuccess || hipDeviceGetAttribute(&cus, hipDeviceAttributeMultiprocessorCount, dev) != hipSuccess) { grid = -1; return; }
        if (hipFuncSetAttribute((const void*)nsa_fwd, hipFuncAttributeMaxDynamicSharedMemorySize, LDS_BYTES) != hipSuccess) { fprintf(stderr, "kernel_launch: hipFuncSetAttribute failed\n"); grid = -1; return; }
        if (hipOccupancyMaxActiveBlocksPerMultiprocessor(&per_cu, (const void*)nsa_fwd, NWAVES * 64, LDS_BYTES) != hipSuccess || per_cu < 1) { fprintf(stderr, "kernel_launch: occupancy query says %d\n", per_cu); }
        (void)hipGetLastError();
        grid = cus;
    }
    if (grid < 0) return;
    if (hipMemsetAsync((char*)d_ws + WS_CTL, 0, CTL_ZERO_BYTES, stream) != hipSuccess) return;
    Args a{};
    for (int i = 0; i < 21; ++i) a.in[i] = (const float*)d_in[i];
    a.out = (float*)d_out; a.ws = (unsigned char*)d_ws; a.ph_lo = 0; a.ph_hi = 100;
    hipLaunchKernelGGL(nsa_fwd, dim3(grid), dim3(NWAVES * 64), LDS_BYTES, stream, a);
}
```
